# Optimizing an MI355X kernel written in HIP

```python
import jax
import jax.numpy as jnp
from jax import lax
import numpy as np

D_MODEL = 2048
BATCH = 4
SEQ = 2048
DEPTH = 1

MLSTM_HEADS = 8
MLSTM_DV = D_MODEL // 16
MLSTM_DK = MLSTM_DV // 2
MLSTM_CHUNK = 64
GATE_SOFTCAP = 15.0
MLSTM_WIDTH = MLSTM_HEADS * MLSTM_DV

MOBA_HEADS = 8
MOBA_HEAD_DIM = D_MODEL // 16
MOBA_BLOCK = 256
MOBA_TOPK = 3
MOBA_QCHUNK = 64
MOBA_WIDTH = MOBA_HEADS * MOBA_HEAD_DIM

N_EXPERTS = 32
TOP_K = 4
D_EXPERT = D_MODEL
SWIGLU_ALPHA = 1.702
SWIGLU_LIMIT = 7.0

NORM_EPS = 1e-6
NEG_INF = -1e30

IN_WIDTHS = (MLSTM_HEADS * MLSTM_DK, MLSTM_HEADS * MLSTM_DK, MLSTM_WIDTH, MLSTM_WIDTH,
             MLSTM_HEADS, MLSTM_HEADS, MOBA_WIDTH, MOBA_WIDTH, MOBA_WIDTH, D_MODEL, D_MODEL)
D_IN = sum(IN_WIDTHS)

kernel_name = 'hybrid_mlstm_moba_moe_block'


def rms_norm(x, g):
    xf = x.astype(jnp.float32)
    y = xf * lax.rsqrt(jnp.mean(xf * xf, axis=-1, keepdims=True) + NORM_EPS)
    return (y * g).astype(x.dtype)


def modulate(h, shift, scale):
    return h * (1.0 + scale[:, None, :]) + shift[:, None, :]


def soft_cap(x, cap):
    return cap * jnp.tanh(x / cap)


def mlstm_chunkwise(q, k, v, log_i, log_f):
    B, H, S, DK = q.shape
    DV = v.shape[-1]
    L = MLSTM_CHUNK
    NC = S // L
    q = q.reshape(B, H, NC, L, DK)
    k = k.reshape(B, H, NC, L, DK)
    v = v.reshape(B, H, NC, L, DV)
    li = log_i.reshape(B, H, NC, L)
    lf = log_f.reshape(B, H, NC, L)
    b = jnp.cumsum(lf, axis=-1)
    g = b[..., -1]
    a = g[..., None] - b + li
    m_loc = jnp.max(a, axis=-1)
    w = jnp.exp(a - m_loc[..., None])
    C_loc = jnp.einsum('bhcl,bhcld,bhcle->bhcde', w, v, k)
    n_loc = jnp.einsum('bhcl,bhcle->bhce', w, k)

    def step(carry, inp):
        C, n, m = carry
        Cl, nl, ml, gc = inp
        m_new = jnp.maximum(gc + m, ml)
        s_prev = jnp.exp(gc + m - m_new)
        s_loc = jnp.exp(ml - m_new)
        C_new = s_prev[..., None, None] * C + s_loc[..., None, None] * Cl
        n_new = s_prev[..., None] * n + s_loc[..., None] * nl
        return (C_new, n_new, m_new), (C, n, m)

    def to_front(t):
        return jnp.moveaxis(t, 2, 0)

    init = (jnp.zeros((B, H, DV, DK), jnp.float32), jnp.zeros((B, H, DK), jnp.float32),
            jnp.zeros((B, H), jnp.float32))
    _, (C_in, n_in, m_in) = lax.scan(step, init, (to_front(C_loc), to_front(n_loc),
                                                   to_front(m_loc), to_front(g)))
    C_in = jnp.moveaxis(C_in, 0, 2)
    n_in = jnp.moveaxis(n_in, 0, 2)
    m_in = jnp.moveaxis(m_in, 0, 2)
    causal = jnp.tril(jnp.ones((L, L), dtype=bool))
    d = jnp.where(causal, b[..., :, None] - b[..., None, :] + li[..., None, :], -jnp.inf)
    inter_log = b + m_in[..., None]
    m_j = jnp.maximum(inter_log, jnp.max(d, axis=-1))
    s_intra = jnp.einsum('bhcjd,bhcsd->bhcjs', q, k) * jnp.exp(d - m_j[..., None])
    s_inter = jnp.exp(inter_log - m_j)
    num = (jnp.einsum('bhcjs,bhcsd->bhcjd', s_intra, v)
           + s_inter[..., None] * jnp.einsum('bhcde,bhcje->bhcjd', C_in, q))
    den = jnp.sum(s_intra, axis=-1) + s_inter * jnp.einsum('bhce,bhcje->bhcj', n_in, q)
    h = num / jnp.maximum(jnp.abs(den), jnp.exp(-m_j))[..., None]
    return h.reshape(B, H, S, DV)


def moba_attention(q, k, v):
    B, H, S, Dh = q.shape
    nb = -(-S // MOBA_BLOCK)
    pad = nb * MOBA_BLOCK - S
    kp = jnp.pad(k, ((0, 0), (0, 0), (0, pad), (0, 0)))
    vp = jnp.pad(v, ((0, 0), (0, 0), (0, pad), (0, 0)))
    kb = kp.reshape(B, H, nb, MOBA_BLOCK, Dh)
    vb = vp.reshape(B, H, nb, MOBA_BLOCK, Dh)
    k_mean = jnp.mean(kb.astype(jnp.float32), axis=3)
    q_blk = jnp.arange(S) // MOBA_BLOCK
    past = jnp.arange(nb)[None, :] < q_blk[:, None]
    gate = jnp.einsum('bhsd,bhnd->bhsn', q.astype(jnp.float32), k_mean)
    gate = jnp.where(past, gate, NEG_INF)
    n_sel = min(MOBA_TOPK, nb)
    _, sel = lax.top_k(gate, n_sel)
    sel_ok = sel < q_blk[:, None]
    nq = S // MOBA_QCHUNK

    def to_chunks(t):
        return jnp.moveaxis(t.reshape(B, H, nq, MOBA_QCHUNK, *t.shape[3:]), 2, 0)

    bi = jnp.arange(B)[:, None, None]
    hi = jnp.arange(H)[None, :, None]
    scale = Dh ** -0.5

    def attend_chunk(args):
        ci, qc, sc, okc = args
        q0 = ci * MOBA_QCHUNK
        blk = q0 // MOBA_BLOCK
        k_own = lax.dynamic_slice_in_dim(kp, blk * MOBA_BLOCK, MOBA_BLOCK, axis=2)
        v_own = lax.dynamic_slice_in_dim(vp, blk * MOBA_BLOCK, MOBA_BLOCK, axis=2)
        q_pos = q0 + jnp.arange(MOBA_QCHUNK)
        k_pos = blk * MOBA_BLOCK + jnp.arange(MOBA_BLOCK)
        own = jnp.einsum('bhqd,bhkd->bhqk', qc, k_own).astype(jnp.float32) * scale
        own = jnp.where(k_pos[None, :] <= q_pos[:, None], own, NEG_INF)
        logits = []
        for j in range(n_sel):
            kj = kb[bi, hi, sc[..., j]]
            lj = jnp.einsum('bhqd,bhqkd->bhqk', qc, kj).astype(jnp.float32) * scale
            logits.append(jnp.where(okc[..., j, None], lj, NEG_INF))
        logits.append(own)
        p = jax.nn.softmax(jnp.concatenate(logits, axis=-1), axis=-1)
        out = jnp.einsum('bhqk,bhkd->bhqd', p[..., n_sel * MOBA_BLOCK:], v_own.astype(jnp.float32))
        for j in range(n_sel):
            vj = vb[bi, hi, sc[..., j]]
            out = out + jnp.einsum('bhqk,bhqkd->bhqd',
                                   p[..., j * MOBA_BLOCK:(j + 1) * MOBA_BLOCK],
                                   vj.astype(jnp.float32))
        return out.astype(q.dtype)

    out = lax.map(attend_chunk, (jnp.arange(nq), to_chunks(q), to_chunks(sel), to_chunks(sel_ok)))
    return jnp.moveaxis(out, 0, 2).reshape(B, H, S, Dh)


def expert_ffn(t, w_up, b_up, w_down, b_down):
    hh = t @ w_up + b_up
    glu, lin = jnp.split(hh, 2, axis=-1)
    glu = jnp.minimum(glu, SWIGLU_LIMIT)
    lin = jnp.clip(lin, -SWIGLU_LIMIT, SWIGLU_LIMIT)
    act = glu * jax.nn.sigmoid(SWIGLU_ALPHA * glu) * (lin + 1.0)
    return act @ w_down + b_down


def setup_inputs(seed: int = 0) -> dict:
    key = jax.random.key(seed)
    ks = jax.random.split(key, 24)
    L = DEPTH
    D = D_MODEL

    def nrm(k, shape, scale):
        return jax.random.normal(k, shape, jnp.float32) * scale

    return {
        'x': nrm(ks[0], (BATCH, SEQ, D), 1.0),
        'c': nrm(ks[1], (BATCH, D), 1.0),
        'w_ada': nrm(ks[2], (L, D, 6 * D), 0.5 * D ** -0.5),
        'b_ada': nrm(ks[3], (L, 6 * D), 0.02),
        'g_mix': 1.0 + nrm(ks[4], (L, D), 0.02),
        'w_in': nrm(ks[5], (L, D, D_IN), D ** -0.5),
        'b_igate': nrm(ks[6], (L, MLSTM_HEADS), 0.1),
        'b_fgate': jnp.linspace(3.0, 6.0, MLSTM_HEADS, dtype=jnp.float32)[None, :]
                   + nrm(ks[7], (L, MLSTM_HEADS), 0.1),
        'g_mlstm_out': 1.0 + nrm(ks[8], (L, MLSTM_HEADS, MLSTM_DV), 0.02),
        'g_q': 1.0 + nrm(ks[9], (L, MOBA_HEAD_DIM), 0.02),
        'g_k': 1.0 + nrm(ks[10], (L, MOBA_HEAD_DIM), 0.02),
        'w_branch_a': nrm(ks[11], (L, MLSTM_WIDTH, D), MLSTM_WIDTH ** -0.5),
        'w_branch_b': nrm(ks[12], (L, MOBA_WIDTH, D), MOBA_WIDTH ** -0.5),
        'w_out': nrm(ks[13], (L, D, D), D ** -0.5),
        'g_ffn': 1.0 + nrm(ks[14], (L, D), 0.02),
        'w_router': nrm(ks[15], (L, D, N_EXPERTS), D ** -0.5),
        'b_router': nrm(ks[16], (L, N_EXPERTS), 0.01),
        'w_up': nrm(ks[17], (L, N_EXPERTS, D, 2 * D_EXPERT), D ** -0.5),
        'b_up': nrm(ks[18], (L, N_EXPERTS, 2 * D_EXPERT), 0.02),
        'w_down': nrm(ks[19], (L, N_EXPERTS, D_EXPERT, D), D_EXPERT ** -0.5),
        'b_down': nrm(ks[20], (L, N_EXPERTS, D), 0.02),
    }


def reference(x, c, w_ada, b_ada, g_mix, w_in, b_igate, b_fgate, g_mlstm_out, g_q, g_k,
              w_branch_a, w_branch_b, w_out, g_ffn, w_router, b_router, w_up, b_up,
              w_down, b_down):
    B, S, D = x.shape
    offsets = []
    acc = 0
    for wdt in IN_WIDTHS[:-1]:
        acc += wdt
        offsets.append(acc)
    for l in range(DEPTH):
        mod = jax.nn.silu(c) @ w_ada[l] + b_ada[l]
        sh1, sc1, gt1, sh2, sc2, gt2 = jnp.split(mod, 6, axis=-1)

        h = modulate(rms_norm(x, g_mix[l]), sh1, sc1)
        z = h @ w_in[l]
        qa, ka, va, oa, ia, fa, qb, kb, vb, ga, gb = jnp.split(z, offsets, axis=-1)

        q_m = qa.reshape(B, S, MLSTM_HEADS, MLSTM_DK).transpose(0, 2, 1, 3).astype(jnp.float32) * (MLSTM_DK ** -0.5)
        k_m = ka.reshape(B, S, MLSTM_HEADS, MLSTM_DK).transpose(0, 2, 1, 3).astype(jnp.float32)
        v_m = va.reshape(B, S, MLSTM_HEADS, MLSTM_DV).transpose(0, 2, 1, 3).astype(jnp.float32)
        log_i = soft_cap((ia + b_igate[l]).astype(jnp.float32), GATE_SOFTCAP).transpose(0, 2, 1)
        log_f = jax.nn.log_sigmoid(soft_cap((fa + b_fgate[l]).astype(jnp.float32), GATE_SOFTCAP)).transpose(0, 2, 1)
        h_m = mlstm_chunkwise(q_m, k_m, v_m, log_i, log_f).transpose(0, 2, 1, 3)
        h_m = rms_norm(h_m, g_mlstm_out[l]).astype(x.dtype)
        h_m = h_m * jax.nn.sigmoid(oa.reshape(B, S, MLSTM_HEADS, MLSTM_DV))
        y_a = h_m.reshape(B, S, MLSTM_WIDTH) @ w_branch_a[l]

        q_b = rms_norm(qb.reshape(B, S, MOBA_HEADS, MOBA_HEAD_DIM), g_q[l]).transpose(0, 2, 1, 3)
        k_b = rms_norm(kb.reshape(B, S, MOBA_HEADS, MOBA_HEAD_DIM), g_k[l]).transpose(0, 2, 1, 3)
        v_b = vb.reshape(B, S, MOBA_HEADS, MOBA_HEAD_DIM).transpose(0, 2, 1, 3)
        o_b = moba_attention(q_b, k_b, v_b).transpose(0, 2, 1, 3).reshape(B, S, MOBA_WIDTH)
        y_b = o_b.astype(x.dtype) @ w_branch_b[l]

        y = jax.nn.sigmoid(ga) * y_a + jax.nn.sigmoid(gb) * y_b
        x = x + gt1[:, None, :] * (y @ w_out[l])

        t = modulate(rms_norm(x, g_ffn[l]), sh2, sc2).reshape(B * S, D)
        logits = (t @ w_router[l] + b_router[l]).astype(jnp.float32)
        top_val, top_idx = lax.top_k(logits, TOP_K)
        top_w = jax.nn.softmax(top_val, axis=-1)
        combine = jnp.sum(jax.nn.one_hot(top_idx, N_EXPERTS, dtype=jnp.float32) * top_w[..., None],
                          axis=1).astype(t.dtype)
        moe = jnp.zeros_like(t)
        for e in range(N_EXPERTS):
            out_e = expert_ffn(t, w_up[l, e], b_up[l, e], w_down[l, e], b_down[l, e])
            moe = moe + combine[:, e:e + 1] * out_e.astype(t.dtype)
        x = x + gt2[:, None, :] * moe.reshape(B, S, D)
    return x
```

```cpp
#include <hip/hip_runtime.h>
#include <cstdio>
#include <cstdint>

#ifndef MK_PER_PHASE
#define MK_PER_PHASE 0
#endif

#define LAS __attribute__((address_space(3)))
#define GAS __attribute__((address_space(1)))
typedef unsigned short bf16_t;
typedef short bf16x8 __attribute__((ext_vector_type(8)));
typedef short s16x4 __attribute__((ext_vector_type(4)));
typedef float f32x4 __attribute__((ext_vector_type(4)));
typedef float f32x2 __attribute__((ext_vector_type(2)));
typedef unsigned u32x4 __attribute__((ext_vector_type(4)));
typedef unsigned u32x2 __attribute__((ext_vector_type(2)));
typedef int i32x8 __attribute__((ext_vector_type(8)));
typedef int i32x4 __attribute__((ext_vector_type(4)));

constexpr int D = 2048, NB = 4, SEQ = 2048, T = NB * SEQ;
constexpr int DIN = 10256, ZP = 10240;
constexpr int ZQA = 0, ZKA = 512, ZVA = 1024, ZOA = 2048, ZQB = 3072, ZKB = 4096, ZVB = 5120, ZGA = 6144, ZGB = 8192;
constexpr int GATE_COL = 3072;
constexpr int NE = 32, TOPK = 4, ECAP = 8192, CROWS = 40960;
constexpr float EPS = 1e-6f;

constexpr size_t MiB = 1ull << 20;
constexpr size_t WS_CTL = 0, CTL_BYTES = 1 * MiB;
constexpr size_t WS_MODP = 1 * MiB;
constexpr size_t WS_GATES = 2 * MiB;
constexpr size_t WS_KMEAN = 3 * MiB;
constexpr size_t WS_WGF = 3 * MiB + 512 * 1024;
constexpr size_t WS_WRF = 3 * MiB + 640 * 1024;
constexpr size_t WS_MODF = 4 * MiB;
constexpr size_t WS_TOKE = 5 * MiB;
constexpr size_t WS_TOKW = 5 * MiB + 256 * 1024;
constexpr size_t WS_TOKS = 5 * MiB + 512 * 1024;
constexpr size_t WS_ROWW = 6 * MiB;
constexpr size_t WS_WIN = 8 * MiB;
constexpr size_t WS_WOUT8 = 8 * MiB;
constexpr size_t WS_WA = 48 * MiB, WS_WB = 52 * MiB, WS_WOUT = 56 * MiB;
constexpr size_t WS_HBUF = 64 * MiB;
constexpr size_t WS_YBUF8 = 64 * MiB;
constexpr float Y8_SCALE = 8.0f;
constexpr float YD_SCALE = 16.0f;
constexpr float H8_SCALE = 8.0f, O8_SCALE = 32.0f;
constexpr size_t WS_Z = 96 * MiB;
constexpr size_t WS_HM = 256 * MiB, WS_OB = 272 * MiB;
constexpr size_t WS_TMPF = 288 * MiB;
constexpr size_t WS_YBUF = 352 * MiB;
constexpr size_t WS_X1 = 384 * MiB;
constexpr size_t WS_ACT = 448 * MiB;
constexpr size_t WS_YDN = 608 * MiB;
constexpr size_t WS_CLOC = 928 * MiB;
constexpr size_t WS_CIN = 960 * MiB;
constexpr size_t WS_NLOC = 976 * MiB, WS_NIN = 977 * MiB, WS_MSC = 978 * MiB;
constexpr size_t WS_HBUF8 = 980 * MiB;
constexpr size_t WS_WIN8 = 996 * MiB;
constexpr size_t WS_WUP = 1024 * MiB;
constexpr size_t WS_WDN = 1536 * MiB;
constexpr size_t WS_TA = 2048 * MiB;
constexpr size_t WS_END = 3072 * MiB;
constexpr int CW_BAR = 4096;
constexpr int CW_CNT = 16384;
constexpr int CW_QUEUE = 32768;
constexpr int CW_MISC = 49152;
constexpr int CW_UPD = 65536;
constexpr int CW_MQ = 32768 + 64;
constexpr int CW_CUD = 36864, CW_CDD = 40960, CW_GUD = 45056;

constexpr int LDS_BYTES = 157696;
constexpr int LDS_XB = 157568;
constexpr int LDS_TABS = 147456;

__device__ __forceinline__ float bf_lo(unsigned u) { return __uint_as_float(u << 16); }
__device__ __forceinline__ float bf_hi(unsigned u) { return __uint_as_float(u & 0xffff0000u); }
__device__ __forceinline__ float bf1(bf16_t v) { return __uint_as_float(((unsigned)v) << 16); }
__device__ __forceinline__ unsigned pk2(float lo, float hi) { unsigned r; asm("v_cvt_pk_bf16_f32 %0, %1, %2" : "=v"(r) : "v"(lo), "v"(hi)); return r; }
__device__ __forceinline__ bf16_t f2bf(float f) { return (bf16_t)(pk2(f, 0.f) & 0xffffu); }
__device__ __forceinline__ float wave_sum(float v) {
#pragma unroll
    for (int o = 1; o < 64; o <<= 1) v += __shfl_xor(v, o);
    return v;
}
__device__ __forceinline__ void store16_sc1(void* p, u32x4 v) { asm volatile("global_store_dwordx4 %0, %1, off sc1\n\ts_nop 1" :: "v"(p), "v"(v) : "memory"); }
__device__ __forceinline__ void store8_sc1(void* p, u32x2 v) { asm volatile("global_store_dwordx2 %0, %1, off sc1\n\ts_nop 1" :: "v"(p), "v"(v) : "memory"); }
__device__ __forceinline__ unsigned pk4_fp8(float a, float b, float c, float d) {
    a = __builtin_amdgcn_fmed3f(a, -448.0f, 448.0f); b = __builtin_amdgcn_fmed3f(b, -448.0f, 448.0f); c = __builtin_amdgcn_fmed3f(c, -448.0f, 448.0f); d = __builtin_amdgcn_fmed3f(d, -448.0f, 448.0f);
    int r = __builtin_amdgcn_cvt_pk_fp8_f32(a, b, 0, false); r = __builtin_amdgcn_cvt_pk_fp8_f32(c, d, r, true); return (unsigned)r; }
__device__ __forceinline__ unsigned pk4_fp8_ns(float a, float b, float c, float d) { int r = __builtin_amdgcn_cvt_pk_fp8_f32(a, b, 0, false); r = __builtin_amdgcn_cvt_pk_fp8_f32(c, d, r, true); return (unsigned)r; }
constexpr float W8_SCALE = 256.0f, W8_INV = 1.0f / 256.0f;
__device__ __forceinline__ float sigmoidf_(float x) { return __builtin_amdgcn_rcpf(1.f + __expf(-x)); }

namespace pg8 {
constexpr int BM = 256, BK = 64, HALF = 128, HTB = HALF * BK * 2, STAGE_BYTES = 8 * HTB, NXCD = 8, WGM = 8;
__host__ __device__ __forceinline__ int lds_byte(int r, int c) { const int st = (r >> 4) * 2 + (c >> 5), rr = r & 15, cc = c & 31, ob = rr * 64 + cc * 2; return st * 1024 + (ob ^ (((ob >> 9) & 1) << 5)); }
__host__ __device__ __forceinline__ void stage_rc(int b, int& R, int& C) { const int st = b / 1024, sb = b % 1024, swz = sb ^ (((sb >> 9) & 1) << 5); R = (st >> 1) * 16 + swz / 64; C = (st & 1) * 32 + (swz % 64) / 2; }
__host__ __device__ __forceinline__ int perm32(int rho) { const int n = rho >> 4, i = rho & 15; return 8 * (i >> 2) + 4 * n + (i & 3); }

struct Unit { int pm, pn, e; };

struct DenseOrder {
    static constexpr bool HAS_DEP = false;
    const char* A; const char* Bt; int nM, nN, nwg, G, c;
    __device__ void init(const void* A_, const void* Bt_, int M, int N, int G_, int c_) { A = (const char*)A_; Bt = (const char*)Bt_; nM = M / BM; nN = N / BM; nwg = nM * nN; G = G_; c = c_; }
    __device__ bool next(int i, Unit& u) const {
        const long L = (long)i * G + c; if (L >= nwg) return false;
        int wgid = (int)L; { const int q = nwg / NXCD, r = nwg % NXCD, xcd = wgid % NXCD, off = wgid / NXCD; wgid = (xcd < r ? xcd * (q + 1) : r * (q + 1) + (xcd - r) * q) + off; }
        const int nig = WGM * nN, gid = wgid / nig, fm = gid * WGM, gsz = (nM - fm) < WGM ? (nM - fm) : WGM;
        u.pm = fm + ((wgid % nig) % gsz); u.pn = (wgid % nig) / gsz; u.e = 0; return true;
    }
    __device__ __forceinline__ const char* a_ptr(const Unit& u, size_t tstep) const { return A + (size_t)u.pm * tstep; }
    __device__ __forceinline__ const char* b_ptr(const Unit& u, size_t tstep) const { return Bt + (size_t)u.pn * tstep; }
};

constexpr unsigned DEP_NEED = 16u;
template <bool DEP>
struct MoeOrderT {
    static constexpr bool HAS_DEP = DEP;
    const char* A; const char* Bt; const LAS int* tiles; const LAS int* arow; const LAS int* ub; int nN, G, c; size_t estepB; int total; unsigned* dep; unsigned need_hi;
    __device__ bool next(int i, Unit& u) const {
        const int L = i * G + c; if (L >= total) return false;
        unsigned zz = 0u; asm volatile("" : "+v"(zz));
        const int ln = (int)__builtin_amdgcn_mbcnt_hi(~0u, __builtin_amdgcn_mbcnt_lo(~0u, zz));
        const int ubv = ub[(ln < NE ? ln : NE - 1) + 1];
        const int e = __builtin_popcountll(__ballot(ln < NE && L >= ubv));
        const int r = L - __builtin_amdgcn_readfirstlane(ub[e]), te = __builtin_amdgcn_readfirstlane(tiles[e]);
        u.e = e; u.pm = r % te; u.pn = r / te; return true;
    }
    __device__ __forceinline__ unsigned dep_issue(int i) const {
        Unit u; if (!next(i, u)) return 0xffffffffu;
        return __hip_atomic_load(dep + (u.e * 32 + u.pm) * 16, __ATOMIC_RELAXED, __HIP_MEMORY_SCOPE_AGENT);
    }
    __device__ __forceinline__ void dep_confirm(const Unit& u, unsigned v) const {
        const unsigned* ctr = dep + (u.e * 32 + u.pm) * 16;
        const unsigned need = DEP_NEED + (u.e >= 16 ? need_hi : 0u);
        while ((unsigned)__builtin_amdgcn_readfirstlane((int)v) < need) { __builtin_amdgcn_s_sleep(2); v = __hip_atomic_load(ctr, __ATOMIC_RELAXED, __HIP_MEMORY_SCOPE_AGENT); }
        asm volatile("" ::: "memory");
    }
    __device__ __forceinline__ const char* a_ptr(const Unit& u, size_t tstep) const { return A + ((size_t)arow[u.e] / 256 + (size_t)u.pm) * tstep; }
    __device__ __forceinline__ const char* b_ptr(const Unit& u, size_t tstep) const { return Bt + (size_t)u.e * estepB + (size_t)u.pn * tstep; }
};
typedef MoeOrderT<false> MoeOrder;
typedef MoeOrderT<true> MoeDepOrder;

template <class Base> struct SubOrder {
    static constexpr bool HAS_DEP = false;
    Base b; int i0, n;
    __device__ bool next(int i, Unit& u) const { if (i >= n) return false; return b.next(i0 + i, u); }
    __device__ __forceinline__ const char* a_ptr(const Unit& u, size_t tstep) const { return b.a_ptr(u, tstep); }
    __device__ __forceinline__ const char* b_ptr(const Unit& u, size_t tstep) const { return b.b_ptr(u, tstep); }
};
struct OneUnit {
    static constexpr bool HAS_DEP = false;
    const char* A; const char* Bt; Unit u;
    __device__ bool next(int i, Unit& o) const { if (i > 0) return false; o = u; return true; }
    __device__ __forceinline__ const char* a_ptr(const Unit&, size_t) const { return A; }
    __device__ __forceinline__ const char* b_ptr(const Unit&, size_t) const { return Bt; }
};

struct PairOrder {
    static constexpr bool HAS_DEP = false;
    DenseOrder d; const char* A2; const char* Bt2;
    __device__ bool next(int i, Unit& u) const { if (!d.next(i >> 1, u)) return false; u.e = i & 1; return true; }
    __device__ __forceinline__ const char* a_ptr(const Unit& u, size_t tstep) const { return (u.e ? A2 : d.A) + (size_t)u.pm * tstep; }
    __device__ __forceinline__ const char* b_ptr(const Unit& u, size_t tstep) const { return (u.e ? Bt2 : d.Bt) + (size_t)u.pn * tstep; }
};

template <class Epi, class Sched, bool FP8 = false>
__device__ __forceinline__ void gemm_phase(LAS unsigned char* lds, const int K, const Sched& S, const Epi& E) {
    int tid = threadIdx.x; asm volatile("" : "+v"(tid));
    const int wid = __builtin_amdgcn_readfirstlane(tid >> 6), lane = tid & 63, wr = wid >> 2, wc = wid & 3, fr = lane & 15, fq = lane >> 4;
    const int nt = K / BK;
    unsigned voffA, voffB;
    { int R, C; stage_rc(tid * 16, R, C); const int Rb = Epi::PERM ? ((R & ~31) + perm32(R & 31)) : R;
      voffA = (unsigned)(R * K + C) * 2u; voffB = (unsigned)(Rb * K + C) * 2u; }
    const size_t pstep = (size_t)64 * K * 2;
    const size_t kstep = (size_t)(BK * 2);
    const size_t hstep = (size_t)HALF * K * 2;
    const size_t tstep = 2 * hstep;
    const unsigned ldsw = (unsigned)wid * 1024u;
    int lanex;
    { unsigned _z = 0u; asm volatile("" : "+v"(_z)); const int _ln = (int)__builtin_amdgcn_mbcnt_hi(~0u, __builtin_amdgcn_mbcnt_lo(~0u, _z)); lanex = lds_byte(_ln & 15, (_ln >> 4) * 8); }
#define PG8_LANE_OFFS asm volatile("" : "+v"(lanex)); const int aoff = lanex + wr * 8192, boff = lanex + wc * 4096; (void)aoff; (void)boff
#define PG8_SA(b, h) (((b) * 2 + (h)) * HTB)
#define PG8_SB(b, h) ((4 + (b) * 2 + (h)) * HTB)
#define PG8_STAGE(bufoff, gbase, voff) do { asm volatile("" : "+v"(voff)); _Pragma("unroll") for (int _i = 0; _i < 2; ++_i) \
        __builtin_amdgcn_global_load_lds((const unsigned*)((const char*)(gbase) + _i * pstep + (voff)), (LAS unsigned*)(lds + (bufoff) + ldsw + _i * 8192), 16, 0, 0); } while (0)
#define PG8_LDA(dst, b, h) do { _Pragma("unroll") for (int m = 0; m < 4; ++m) { const i32x4 _l = *(const LAS i32x4*)(lds + PG8_SA(b, h) + aoff + m * 2048), _h = *(const LAS i32x4*)(lds + PG8_SA(b, h) + aoff + m * 2048 + 1024); \
        dst[m] = __builtin_shufflevector(_l, _h, 0, 1, 2, 3, 4, 5, 6, 7); } } while (0)
#define PG8_LDB(dst, b, h) do { _Pragma("unroll") for (int n = 0; n < 2; ++n) { const i32x4 _l = *(const LAS i32x4*)(lds + PG8_SB(b, h) + boff + n * 2048), _h = *(const LAS i32x4*)(lds + PG8_SB(b, h) + boff + n * 2048 + 1024); \
        dst[n] = __builtin_shufflevector(_l, _h, 0, 1, 2, 3, 4, 5, 6, 7); } } while (0)
#define PG8_LO(x) __builtin_bit_cast(bf16x8, __builtin_shufflevector((x), (x), 0, 1, 2, 3))
#define PG8_HI(x) __builtin_bit_cast(bf16x8, __builtin_shufflevector((x), (x), 4, 5, 6, 7))
#define PG8_MMA(ai, bj, At, Bt) do { __builtin_amdgcn_s_setprio(1); \
        if constexpr (FP8) { _Pragma("unroll") for (int m = 0; m < 4; ++m) _Pragma("unroll") for (int n = 0; n < 2; ++n) \
            acc[ai][bj][m][n] = __builtin_amdgcn_mfma_scale_f32_16x16x128_f8f6f4(Bt[n], At[m], acc[ai][bj][m][n], 0, 0, 0, 0x7f7f7f7f, 0, 0x7f7f7f7f); } \
        else { _Pragma("unroll") for (int m = 0; m < 4; ++m) _Pragma("unroll") for (int n = 0; n < 2; ++n) { \
            acc[ai][bj][m][n] = __builtin_amdgcn_mfma_f32_16x16x32_bf16(PG8_LO(Bt[n]), PG8_LO(At[m]), acc[ai][bj][m][n], 0, 0, 0); \
            acc[ai][bj][m][n] = __builtin_amdgcn_mfma_f32_16x16x32_bf16(PG8_HI(Bt[n]), PG8_HI(At[m]), acc[ai][bj][m][n], 0, 0, 0); } } \
        __builtin_amdgcn_s_setprio(0); } while (0)
#define PG8_WAIT_V(n) asm volatile("s_waitcnt vmcnt(" #n ")" ::: "memory")
#define PG8_WAIT_L(n) asm volatile("s_waitcnt lgkmcnt(" #n ")" ::: "memory")
#define PG8_BAR __builtin_amdgcn_s_barrier()
#define PG8_SCHED __builtin_amdgcn_sched_barrier(0)
    Unit cur, nxt, prv; int ui = 0; prv.pm = prv.pn = prv.e = 0; (void)prv;
    if (!S.next(0, cur)) return;
    unsigned depv = 0u; (void)depv;
    if constexpr (Sched::HAS_DEP) { S.dep_confirm(cur, S.dep_issue(0)); depv = S.dep_issue(1); }
    f32x4 acc[2][2][4][2];
#define PG8_ACC_INIT(U) do { f32x4 _bi[2][2]; \
        if constexpr (Epi::ACC_INIT) { unsigned _zz = 0u; asm volatile("" : "+v"(_zz)); const int _ln = (int)__builtin_amdgcn_mbcnt_hi(~0u, __builtin_amdgcn_mbcnt_lo(~0u, _zz)); E.acc_bias((U), wc, _ln >> 4, _bi); } \
        else { _bi[0][0] = (f32x4){0.f, 0.f, 0.f, 0.f}; _bi[0][1] = _bi[0][0]; _bi[1][0] = _bi[0][0]; _bi[1][1] = _bi[0][0]; } \
        _Pragma("unroll") for (int a = 0; a < 2; ++a) _Pragma("unroll") for (int b = 0; b < 2; ++b) _Pragma("unroll") for (int m = 0; m < 4; ++m) _Pragma("unroll") for (int n = 0; n < 2; ++n) acc[a][b][m][n] = _bi[b][n]; } while (0)
    PG8_ACC_INIT(cur);
    i32x8 At[4], B0[2], B1[2];
    const char* cA = S.a_ptr(cur, tstep); const char* cB = S.b_ptr(cur, tstep);
    PG8_STAGE(PG8_SB(0, 0), cB, voffB); PG8_STAGE(PG8_SB(0, 1), cB + hstep, voffB); PG8_STAGE(PG8_SA(0, 0), cA, voffA); PG8_STAGE(PG8_SA(0, 1), cA + hstep, voffA);
    if (wr == 1) PG8_BAR;
    PG8_WAIT_V(2); PG8_BAR;
    PG8_STAGE(PG8_SB(1, 0), cB + kstep, voffB); PG8_STAGE(PG8_SA(1, 0), cA + kstep, voffA); PG8_STAGE(PG8_SB(1, 1), cB + hstep + kstep, voffB);
    PG8_WAIT_V(6); PG8_BAR;
    for (;;) {
        const bool has_next = S.next(ui + 1, nxt);
        if constexpr (Sched::HAS_DEP) { if (has_next) S.dep_confirm(nxt, depv); }
        const char* nA = has_next ? S.a_ptr(nxt, tstep) : cA; const char* nB = has_next ? S.b_ptr(nxt, tstep) : cB;
#pragma unroll 1
        for (int t = 0; t < nt; t += 2) {
            const bool last = (t == nt - 2);
            const char* a1 = cA + (size_t)(t + 1) * kstep;
            const char* a2 = last ? nA : cA + (size_t)(t + 2) * kstep; const char* b2 = last ? nB : cB + (size_t)(t + 2) * kstep;
            const char* a3 = a2 + kstep; const char* b3 = b2 + kstep;
            { PG8_LANE_OFFS; PG8_LDB(B0, 0, 0); PG8_LDB(B1, 0, 1); PG8_SCHED; PG8_LDA(At, 0, 0); PG8_STAGE(PG8_SA(1, 1), a1 + hstep, voffA); }
            PG8_WAIT_V(8); PG8_WAIT_L(0); PG8_BAR; PG8_MMA(0, 0, At, B0); PG8_MMA(0, 1, At, B1); PG8_BAR; PG8_SCHED;
            { PG8_LANE_OFFS; PG8_LDA(At, 0, 1); PG8_STAGE(PG8_SB(0, 0), b2, voffB); PG8_STAGE(PG8_SB(0, 1), b2 + hstep, voffB); PG8_STAGE(PG8_SA(0, 0), a2, voffA); }
            PG8_WAIT_V(8); PG8_WAIT_L(0); PG8_BAR; PG8_MMA(1, 0, At, B0); PG8_MMA(1, 1, At, B1); PG8_BAR; PG8_SCHED;
            { PG8_LANE_OFFS; PG8_LDB(B0, 1, 0); PG8_LDB(B1, 1, 1); PG8_SCHED; PG8_LDA(At, 1, 0); PG8_STAGE(PG8_SA(0, 1), a2 + hstep, voffA); }
            PG8_WAIT_V(8); PG8_WAIT_L(0); PG8_BAR; PG8_MMA(0, 0, At, B0); PG8_MMA(0, 1, At, B1); PG8_BAR; PG8_SCHED;
            { PG8_LANE_OFFS; PG8_LDA(At, 1, 1); PG8_STAGE(PG8_SB(1, 0), b3, voffB); PG8_STAGE(PG8_SB(1, 1), b3 + hstep, voffB); PG8_STAGE(PG8_SA(1, 0), a3, voffA); }
            PG8_WAIT_V(8); PG8_WAIT_L(0); PG8_BAR; PG8_MMA(1, 0, At, B0); PG8_MMA(1, 1, At, B1); PG8_BAR; PG8_SCHED;
        }
        if (wr == 0) PG8_BAR;
        if constexpr (Sched::HAS_DEP) depv = S.dep_issue(ui + 2);
        if constexpr (Epi::SIGNALS) { if (ui > 0) { PG8_WAIT_V(8); PG8_BAR; E.signal(prv, tid == 0); } }
        { unsigned zz = 0u; asm volatile("" : "+v"(zz));
          const int ln = (int)__builtin_amdgcn_mbcnt_hi(~0u, __builtin_amdgcn_mbcnt_lo(~0u, zz));
          E(acc, cur, wr, wc, ln & 15, ln >> 4); }
        if (!has_next) break;
        if (!(Epi::CHAIN && cur.e == 0)) { PG8_ACC_INIT(nxt); }
        prv = cur; cur = nxt; cA = nA; cB = nB; ++ui;
        if (wr == 1) PG8_BAR;
    }
    PG8_WAIT_V(0);
    PG8_BAR;
    if constexpr (Epi::SIGNALS) E.signal(cur, tid == 0);
#undef PG8_SA
#undef PG8_ACC_INIT
#undef PG8_SB
#undef PG8_STAGE
#undef PG8_LDA
#undef PG8_LDB
#undef PG8_MMA
#undef PG8_LO
#undef PG8_LANE_OFFS
#undef PG8_HI
#undef PG8_WAIT_V
#undef PG8_WAIT_L
#undef PG8_BAR
#undef PG8_SCHED
}
}

using pg8::Unit;
template <bool F8>
struct EpiZT {
    static constexpr bool PERM = true;
    static constexpr bool SIGNALS = false;
    static constexpr bool CHAIN = false;
    static constexpr bool ACC_INIT = false;
    static constexpr float ASC = F8 ? W8_INV : 1.0f;
    bf16_t* O; int ldc; const float* gq; const float* gk; float* kmean; LAS unsigned char* xl;
    __device__ __forceinline__ void operator()(const f32x4 (&acc)[2][2][4][2], const Unit& u, int wr, int wc, int fr, int fq) const {
        const int row0 = u.pm * 256 + wr * 64 + fr, col0 = u.pn * 256 + wc * 32 + 8 * fq;
        if (u.pn < 12 || u.pn >= 20) {
#pragma unroll
            for (int ai = 0; ai < 2; ++ai)
#pragma unroll
                for (int m = 0; m < 4; ++m) { bf16_t* rowp = O + (size_t)(row0 + ai * 128 + m * 16) * ldc + col0;
#pragma unroll
                    for (int bj = 0; bj < 2; ++bj) { const f32x4 v0 = acc[ai][bj][m][0] * ASC, v1 = acc[ai][bj][m][1] * ASC;
                        u32x4 w; w.x = pk2(v0[0], v0[1]); w.y = pk2(v0[2], v0[3]); w.z = pk2(v1[0], v1[1]); w.w = pk2(v1[2], v1[3]);
                        *(u32x4*)(rowp + bj * 128) = w; } }
            return;
        }
        LAS float* P = (LAS float*)xl;
        LAS float* Cs = (LAS float*)(xl + 8192);
#pragma unroll
        for (int ai = 0; ai < 2; ++ai)
#pragma unroll
            for (int m = 0; m < 4; ++m)
#pragma unroll
                for (int bj = 0; bj < 2; ++bj) { const f32x4 v0 = acc[ai][bj][m][0], v1 = acc[ai][bj][m][1];
                    float ss = (v0[0] * v0[0] + v0[1] * v0[1]) + (v0[2] * v0[2] + v0[3] * v0[3]) + (v1[0] * v1[0] + v1[1] * v1[1]) + (v1[2] * v1[2] + v1[3] * v1[3]);
                    ss += __shfl_xor(ss, 16); ss += __shfl_xor(ss, 32);
                    if (fq == 0) P[((ai * 128 + wr * 64 + m * 16 + fr) * 2 + bj) * 4 + wc] = ss; asm volatile("" ::: "memory"); }
        __syncthreads();
        const bool isk = u.pn >= 16;
        const float* gv = (isk ? gk : gq) + wc * 32 + 8 * fq;
        const f32x4 g0 = *(const f32x4*)gv, g1 = *(const f32x4*)(gv + 4);
        f32x4 cs[2][2];
#pragma unroll
        for (int bj = 0; bj < 2; ++bj) { cs[bj][0] = (f32x4){0.f, 0.f, 0.f, 0.f}; cs[bj][1] = cs[bj][0]; }
#pragma unroll
        for (int ai = 0; ai < 2; ++ai)
#pragma unroll
            for (int m = 0; m < 4; ++m) { const int rl = ai * 128 + wr * 64 + m * 16 + fr; bf16_t* rowp = O + (size_t)(u.pm * 256 + rl) * ldc + col0;
#pragma unroll
                for (int bj = 0; bj < 2; ++bj) { const f32x4 pp = *(const LAS f32x4*)(P + (rl * 2 + bj) * 4);
                    const float rinv = rsqrtf(((pp[0] + pp[1]) + (pp[2] + pp[3])) * (ASC * ASC / 128.0f) + EPS) * ASC;
                    const f32x4 y0 = acc[ai][bj][m][0] * rinv * g0, y1 = acc[ai][bj][m][1] * rinv * g1;
                    cs[bj][0] += y0; cs[bj][1] += y1;
                    u32x4 w; w.x = pk2(y0[0], y0[1]); w.y = pk2(y0[2], y0[3]); w.z = pk2(y1[0], y1[1]); w.w = pk2(y1[2], y1[3]);
                    *(u32x4*)(rowp + bj * 128) = w; }
                asm volatile("" : "+v"(cs[0][0]), "+v"(cs[0][1]), "+v"(cs[1][0]), "+v"(cs[1][1]) :: "memory"); }
        if (isk) {
#pragma unroll
            for (int bj = 0; bj < 2; ++bj)
#pragma unroll
                for (int n = 0; n < 2; ++n)
#pragma unroll
                    for (int j = 0; j < 4; ++j) { float t = cs[bj][n][j]; t += __shfl_xor(t, 1); t += __shfl_xor(t, 2); t += __shfl_xor(t, 4); t += __shfl_xor(t, 8);
                        if (fr == 0) Cs[(wr * 2 + bj) * 128 + wc * 32 + 8 * fq + 4 * n + j] = t; }
            __syncthreads();
            const int t = (wr * 4 + wc) * 64 + fq * 16 + fr;
            if (t < 256) { const int bj = t >> 7, d = t & 127, hd = (u.pn - 16) * 2 + bj;
                kmean[((((size_t)(u.pm >> 3) * 8 + hd) * 8) + (u.pm & 7)) * 128 + d] = (Cs[bj * 128 + d] + Cs[(2 + bj) * 128 + d]) * (1.0f / 256.0f); }
        }
    }
};
typedef EpiZT<false> EpiZ;
struct EpiZ8 {
    static constexpr bool PERM = true;
    static constexpr bool SIGNALS = false;
    static constexpr bool CHAIN = false;
    static constexpr bool ACC_INIT = false;
    bf16_t* O; int ldc, col_off;
    __device__ __forceinline__ void operator()(const f32x4 (&acc)[2][2][4][2], const Unit& u, int wr, int wc, int fr, int fq) const {
        const int row0 = u.pm * 256 + wr * 64 + fr, col0 = col_off + u.pn * 256 + wc * 32 + 8 * fq;
#pragma unroll
        for (int ai = 0; ai < 2; ++ai)
#pragma unroll
            for (int m = 0; m < 4; ++m) { bf16_t* rowp = O + (size_t)(row0 + ai * 128 + m * 16) * ldc + col0;
#pragma unroll
                for (int bj = 0; bj < 2; ++bj) { const f32x4 v0 = acc[ai][bj][m][0] * W8_INV, v1 = acc[ai][bj][m][1] * W8_INV;
                    u32x4 w; w.x = pk2(v0[0], v0[1]); w.y = pk2(v0[2], v0[3]); w.z = pk2(v1[0], v1[1]); w.w = pk2(v1[2], v1[3]);
                    *(u32x4*)(rowp + bj * 128) = w; } }
    }
};
struct EpiBranchA {
    static constexpr bool PERM = true;
    static constexpr bool SIGNALS = false;
    static constexpr bool CHAIN = false;
    static constexpr bool ACC_INIT = false;
    float* tmp; const bf16_t* z;
    __device__ __forceinline__ void operator()(const f32x4 (&acc)[2][2][4][2], const Unit& u, int wr, int wc, int fr, int fq) const {
        const int row0 = u.pm * 256 + wr * 64 + fr, col0 = u.pn * 256 + wc * 32 + 8 * fq;
#pragma unroll
        for (int ai = 0; ai < 2; ++ai)
#pragma unroll
            for (int m = 0; m < 4; ++m) { const size_t row = (size_t)(row0 + ai * 128 + m * 16);
#pragma unroll
                for (int bj = 0; bj < 2; ++bj) { const int col = col0 + bj * 128;
                    const u32x4 g = *(const u32x4*)(z + row * ZP + ZGA + col);
                    const f32x4 v0 = acc[ai][bj][m][0] * (W8_INV / H8_SCALE), v1 = acc[ai][bj][m][1] * (W8_INV / H8_SCALE);
                    f32x4 o0, o1;
                    o0[0] = v0[0] * sigmoidf_(bf_lo(g.x)); o0[1] = v0[1] * sigmoidf_(bf_hi(g.x)); o0[2] = v0[2] * sigmoidf_(bf_lo(g.y)); o0[3] = v0[3] * sigmoidf_(bf_hi(g.y));
                    o1[0] = v1[0] * sigmoidf_(bf_lo(g.z)); o1[1] = v1[1] * sigmoidf_(bf_hi(g.z)); o1[2] = v1[2] * sigmoidf_(bf_lo(g.w)); o1[3] = v1[3] * sigmoidf_(bf_hi(g.w));
                    float* p = tmp + row * D + col; *(f32x4*)p = o0; *(f32x4*)(p + 4) = o1; } }
    }
};
struct EpiBranchB {
    static constexpr bool PERM = true;
    static constexpr bool SIGNALS = false;
    static constexpr bool CHAIN = false;
    static constexpr bool ACC_INIT = false;
    const float* tmp; const bf16_t* z; unsigned char* y;
    __device__ __forceinline__ void operator()(const f32x4 (&acc)[2][2][4][2], const Unit& u, int wr, int wc, int fr, int fq) const {
        const int row0 = u.pm * 256 + wr * 64 + fr, col0 = u.pn * 256 + wc * 32 + 8 * fq;
#pragma unroll
        for (int ai = 0; ai < 2; ++ai)
#pragma unroll
            for (int m = 0; m < 4; ++m) { const size_t row = (size_t)(row0 + ai * 128 + m * 16);
#pragma unroll
                for (int bj = 0; bj < 2; ++bj) { const int col = col0 + bj * 128;
                    const u32x4 g = *(const u32x4*)(z + row * ZP + ZGB + col);
                    const float* p = tmp + row * D + col; const f32x4 t0 = *(const f32x4*)p, t1 = *(const f32x4*)(p + 4);
                    const f32x4 v0 = acc[ai][bj][m][0] * (W8_INV / O8_SCALE), v1 = acc[ai][bj][m][1] * (W8_INV / O8_SCALE);
                    f32x4 o0, o1;
                    o0[0] = t0[0] + v0[0] * sigmoidf_(bf_lo(g.x)); o0[1] = t0[1] + v0[1] * sigmoidf_(bf_hi(g.x)); o0[2] = t0[2] + v0[2] * sigmoidf_(bf_lo(g.y)); o0[3] = t0[3] + v0[3] * sigmoidf_(bf_hi(g.y));
                    o1[0] = t1[0] + v1[0] * sigmoidf_(bf_lo(g.z)); o1[1] = t1[1] + v1[1] * sigmoidf_(bf_hi(g.z)); o1[2] = t1[2] + v1[2] * sigmoidf_(bf_lo(g.w)); o1[3] = t1[3] + v1[3] * sigmoidf_(bf_hi(g.w));
                    o0 *= Y8_SCALE; o1 *= Y8_SCALE;
                    u32x2 w; w.x = pk4_fp8(o0[0], o0[1], o0[2], o0[3]); w.y = pk4_fp8(o1[0], o1[1], o1[2], o1[3]);
                    *(u32x2*)(y + row * D + col) = w; } }
    }
};
struct EpiBranchAB {
    static constexpr bool PERM = true;
    static constexpr bool SIGNALS = false;
    static constexpr bool CHAIN = true;
    static constexpr bool ACC_INIT = false;
    const bf16_t* z; unsigned char* y;
    __device__ __forceinline__ void operator()(f32x4 (&acc)[2][2][4][2], const Unit& u, int wr, int wc, int fr, int fq) const {
        const int row0 = u.pm * 256 + wr * 64 + fr, col0 = u.pn * 256 + wc * 32 + 8 * fq;
        if (u.e == 0) {
#pragma unroll
            for (int ai = 0; ai < 2; ++ai) {
                u32x4 ga[4][2], gb[4][2];
#pragma unroll
                for (int m = 0; m < 4; ++m)
#pragma unroll
                    for (int bj = 0; bj < 2; ++bj) { const bf16_t* zp = z + (size_t)(row0 + ai * 128 + m * 16) * ZP + col0 + bj * 128; ga[m][bj] = *(const u32x4*)(zp + ZGA); gb[m][bj] = *(const u32x4*)(zp + ZGB); }
                __builtin_amdgcn_sched_barrier(0);
#pragma unroll
                for (int m = 0; m < 4; ++m)
#pragma unroll
                    for (int bj = 0; bj < 2; ++bj) { const u32x4 a_ = ga[m][bj], b_ = gb[m][bj];
#define RHO(aw, bw, lo) ((O8_SCALE / H8_SCALE) * (1.0f + __expf(-(lo ? bf_lo(bw) : bf_hi(bw)))) * __builtin_amdgcn_rcpf(1.0f + __expf(-(lo ? bf_lo(aw) : bf_hi(aw)))))
                        f32x4 r0, r1;
                        r0[0] = RHO(a_.x, b_.x, 1); r0[1] = RHO(a_.x, b_.x, 0); r0[2] = RHO(a_.y, b_.y, 1); r0[3] = RHO(a_.y, b_.y, 0);
                        r1[0] = RHO(a_.z, b_.z, 1); r1[1] = RHO(a_.z, b_.z, 0); r1[2] = RHO(a_.w, b_.w, 1); r1[3] = RHO(a_.w, b_.w, 0);
#undef RHO
                        acc[ai][bj][m][0] *= r0; acc[ai][bj][m][1] *= r1; }
                __builtin_amdgcn_sched_barrier(0);
            }
        } else {
            u32x4 gb[2][4][2];
#pragma unroll
            for (int ai = 0; ai < 2; ++ai)
#pragma unroll
                for (int m = 0; m < 4; ++m)
#pragma unroll
                    for (int bj = 0; bj < 2; ++bj) gb[ai][m][bj] = *(const u32x4*)(z + (size_t)(row0 + ai * 128 + m * 16) * ZP + ZGB + col0 + bj * 128);
            __builtin_amdgcn_sched_barrier(0);
#pragma unroll
            for (int ai = 0; ai < 2; ++ai)
#pragma unroll
                for (int m = 0; m < 4; ++m) { const size_t row = (size_t)(row0 + ai * 128 + m * 16);
#pragma unroll
                    for (int bj = 0; bj < 2; ++bj) { const int col = col0 + bj * 128;
                        const u32x4 g = gb[ai][m][bj];
                        const f32x4 v0 = acc[ai][bj][m][0] * (W8_INV / O8_SCALE * Y8_SCALE), v1 = acc[ai][bj][m][1] * (W8_INV / O8_SCALE * Y8_SCALE);
                        u32x2 w;
                        w.x = pk4_fp8(v0[0] * sigmoidf_(bf_lo(g.x)), v0[1] * sigmoidf_(bf_hi(g.x)), v0[2] * sigmoidf_(bf_lo(g.y)), v0[3] * sigmoidf_(bf_hi(g.y)));
                        w.y = pk4_fp8(v1[0] * sigmoidf_(bf_lo(g.z)), v1[1] * sigmoidf_(bf_hi(g.z)), v1[2] * sigmoidf_(bf_lo(g.w)), v1[3] * sigmoidf_(bf_hi(g.w)));
                        *(u32x2*)(y + row * D + col) = w; } }
        }
    }
};
struct EpiOut {
    static constexpr bool PERM = false;
    static constexpr bool SIGNALS = false;
    static constexpr bool CHAIN = false;
    static constexpr bool ACC_INIT = false;
    const float* x; const float* modf; bf16_t* x1;
    __device__ __forceinline__ void operator()(const f32x4 (&acc)[2][2][4][2], const Unit& u, int wr, int wc, int fr, int fq) const {
        const int row0 = u.pm * 256 + wr * 64 + fr, col0 = u.pn * 256 + wc * 32 + 4 * fq;
        const float* gt = modf + (size_t)(u.pm >> 3) * (6 * D) + 2 * D;
        f32x4 gv[2][2];
#pragma unroll
        for (int bj = 0; bj < 2; ++bj)
#pragma unroll
            for (int n = 0; n < 2; ++n) gv[bj][n] = *(const f32x4*)(gt + col0 + bj * 128 + n * 16);
#pragma unroll
        for (int ai = 0; ai < 2; ++ai) {
            f32x4 xv[4][2][2];
#pragma unroll
            for (int m = 0; m < 4; ++m)
#pragma unroll
                for (int bj = 0; bj < 2; ++bj)
#pragma unroll
                    for (int n = 0; n < 2; ++n) xv[m][bj][n] = *(const f32x4*)(x + (size_t)(row0 + ai * 128 + m * 16) * D + col0 + bj * 128 + n * 16);
            __builtin_amdgcn_sched_barrier(0);
#pragma unroll
            for (int m = 0; m < 4; ++m) { const size_t off = (size_t)(row0 + ai * 128 + m * 16) * D + col0;
#pragma unroll
                for (int bj = 0; bj < 2; ++bj)
#pragma unroll
                    for (int n = 0; n < 2; ++n) {
                        const f32x4 v = xv[m][bj][n] + gv[bj][n] * (acc[ai][bj][m][n] * (W8_INV / Y8_SCALE));
                        u32x2 o; o.x = pk2(v[0], v[1]); o.y = pk2(v[2], v[3]);
                        *(u32x2*)(x1 + off + bj * 128 + n * 16) = o; } }
            __builtin_amdgcn_sched_barrier(0);
        }
    }
};
template <bool SC1>
struct EpiUpT {
    static constexpr bool PERM = true;
    static constexpr bool CHAIN = false;
    static constexpr bool ACC_INIT = true;
    static constexpr bool SIGNALS = SC1;
    unsigned char* act; const float* b_up; const LAS int* cbase; unsigned* upd;
    __device__ __forceinline__ void operator()(const f32x4 (&acc)[2][2][4][2], const Unit& u, int wr, int wc, int fr, int fq) const {
        const int row0 = cbase[u.e] + u.pm * 256 + wr * 64 + fr, colh = u.pn * 128 + wc * 32 + 8 * fq;
#pragma unroll
        for (int ai = 0; ai < 2; ++ai)
#pragma unroll
            for (int m = 0; m < 4; ++m) {
                const f32x4 g0 = acc[ai][0][m][0], g1 = acc[ai][0][m][1], l0 = acc[ai][1][m][0], l1 = acc[ai][1][m][1];
                constexpr float KE = 1.702f * 1.4426950408889634f * W8_INV, GC = 7.0f * W8_SCALE, OS = W8_INV * W8_INV;
                float o[8];
#pragma unroll
                for (int j = 0; j < 4; ++j) {
                    float g = fminf(g0[j], GC), l = __builtin_amdgcn_fmed3f(l0[j], -GC, GC); o[j] = (g * OS) * __builtin_amdgcn_rcpf(1.0f + __builtin_amdgcn_exp2f(g * -KE)) * (l + W8_SCALE);
                    g = fminf(g1[j], GC); l = __builtin_amdgcn_fmed3f(l1[j], -GC, GC); o[4 + j] = (g * OS) * __builtin_amdgcn_rcpf(1.0f + __builtin_amdgcn_exp2f(g * -KE)) * (l + W8_SCALE); }
                u32x2 w; w.x = pk4_fp8_ns(o[0], o[1], o[2], o[3]); w.y = pk4_fp8_ns(o[4], o[5], o[6], o[7]);
                if (SC1) store8_sc1(act + (size_t)(row0 + ai * 128 + m * 16) * D + colh, w); else *(u32x2*)(act + (size_t)(row0 + ai * 128 + m * 16) * D + colh) = w; }
    }
    __device__ __forceinline__ void acc_bias(const Unit& u, int wc, int fq, f32x4 (&bi)[2][2]) const {
        const float* bg = b_up + (size_t)u.e * (2 * D) + u.pn * 128 + wc * 32 + 8 * fq;
#pragma unroll
        for (int n = 0; n < 2; ++n) { bi[0][n] = *(const f32x4*)(bg + 4 * n) * W8_SCALE; bi[1][n] = *(const f32x4*)(bg + D + 4 * n) * W8_SCALE; }
    }
    __device__ __forceinline__ void signal(const Unit& u, bool first_lane) const { if (first_lane) __hip_atomic_fetch_add(upd + (u.e * 32 + u.pm) * 16, 1u, __ATOMIC_RELAXED, __HIP_MEMORY_SCOPE_AGENT); }
};
typedef EpiUpT<true> EpiUp;
struct EpiDown {
    static constexpr bool PERM = true;
    static constexpr bool SIGNALS = false;
    static constexpr bool CHAIN = false;
    static constexpr bool ACC_INIT = true;
    __device__ __forceinline__ void acc_bias(const Unit& u, int wc, int fq, f32x4 (&bi)[2][2]) const {
        const float* bd = b_dn + (size_t)u.e * D + u.pn * 256 + wc * 32 + 8 * fq;
#pragma unroll
        for (int bj = 0; bj < 2; ++bj)
#pragma unroll
            for (int n = 0; n < 2; ++n) bi[bj][n] = *(const f32x4*)(bd + bj * 128 + 4 * n) * W8_SCALE;
    }
    unsigned char* ydn; const float* b_dn; const float* roww; const LAS int* cbase;
    __device__ __forceinline__ void operator()(const f32x4 (&acc)[2][2][4][2], const Unit& u, int wr, int wc, int fr, int fq) const {
        const int rl = u.pm * 256 + wr * 64 + fr, row0 = cbase[u.e] + rl, col0 = u.pn * 256 + wc * 32 + 8 * fq;
        float wv[2][4];
#pragma unroll
        for (int ai = 0; ai < 2; ++ai)
#pragma unroll
            for (int m = 0; m < 4; ++m) wv[ai][m] = roww[(size_t)u.e * ECAP + rl + ai * 128 + m * 16];
        __builtin_amdgcn_sched_barrier(0);
#pragma unroll
        for (int ai = 0; ai < 2; ++ai)
#pragma unroll
            for (int m = 0; m < 4; ++m) { const float w = wv[ai][m] * YD_SCALE; unsigned char* p = ydn + (size_t)(row0 + ai * 128 + m * 16) * D + col0;
#pragma unroll
                for (int bj = 0; bj < 2; ++bj) {
                    const f32x4 v0 = acc[ai][bj][m][0] * (W8_INV * w), v1 = acc[ai][bj][m][1] * (W8_INV * w);
                    u32x2 o; o.x = pk4_fp8(v0[0], v0[1], v0[2], v0[3]); o.y = pk4_fp8(v1[0], v1[1], v1[2], v1[3]);
                    *(u32x2*)(p + bj * 128) = o; } }
    }
};

#define XB_TMO      128
#define XB_XCNT(j)  (256  + 64 * (j))
#define XB_XSUB(j)  (1280 + 64 * (j))
#define XB_XGEN(j)  (2304 + 64 * (j))
#define XB_TOP      3328
#define XB_TOPGEN   3392
#define XCD_BAR_WORDS 3456
#define XB_SPIN_CAP (1u << 18)
__device__ __forceinline__ unsigned xb_ld(unsigned* p)              { return __hip_atomic_load(p, __ATOMIC_RELAXED, __HIP_MEMORY_SCOPE_AGENT); }
__device__ __forceinline__ unsigned xb_add(unsigned* p, unsigned v) { return __hip_atomic_fetch_add(p, v, __ATOMIC_RELAXED, __HIP_MEMORY_SCOPE_AGENT); }
__device__ __forceinline__ unsigned xb_xcc_id() { return (unsigned)__builtin_amdgcn_s_getreg((3 << 11) | 20) & 0xFu; }
#define XB_SPIN(cond, bar) do { unsigned _sp = 0; while (cond) { __builtin_amdgcn_s_sleep(1); \
    if ((++_sp & 255u) == 0u) { if (xb_ld(&(bar)[XB_TMO])) break; if (_sp > XB_SPIN_CAP) { atomicAdd(&(bar)[XB_TMO], 1u); break; } } } } while (0)
struct XcdBarrier { unsigned* bar; unsigned x; volatile LAS unsigned* st; };
__device__ __forceinline__ XcdBarrier xcd_barrier_post(unsigned* bar, volatile LAS unsigned* st) {
    XcdBarrier b; b.bar = bar; b.x = xb_xcc_id(); b.st = st;
    if (threadIdx.x == 0) (void)xb_add(&bar[XB_XCNT(b.x)], 1u);
    return b;
}
__device__ __forceinline__ void xcd_barrier_complete(unsigned* bar, unsigned x, unsigned& nloc, unsigned& nx) {
    const unsigned G = gridDim.x * gridDim.y * gridDim.z;
    unsigned sum, cnt, mine, sp = 0u;
    for (;;) {
        sum = 0u; cnt = 0u; mine = 0u;
#pragma unroll
        for (unsigned j = 0; j < 16; ++j) { const unsigned c = xb_ld(&bar[XB_XCNT(j)]); sum += c; cnt += (c > 0u) ? 1u : 0u; mine = (j == x) ? c : mine; }
        if (sum == G) break;
        __builtin_amdgcn_s_sleep(1);
        if ((++sp & 255u) == 0u) { if (xb_ld(&bar[XB_TMO])) break; if (sp > XB_SPIN_CAP) { atomicAdd(&bar[XB_TMO], 1u); break; } }
    }
    nloc = mine > 0u ? mine : 1u; nx = cnt > 0u ? cnt : 1u;
}
__device__ __forceinline__ void xcd_barrier(const XcdBarrier& b) {
    asm volatile("s_waitcnt vmcnt(0)" ::: "memory");
    __syncthreads();
    if (threadIdx.x == 0) {
        unsigned* bar = b.bar;
        __builtin_amdgcn_s_waitcnt(0);
        unsigned nloc = b.st[0], nx = b.st[1];
        if (nloc == 0u) { xcd_barrier_complete(bar, b.x, nloc, nx); b.st[0] = nloc; b.st[1] = nx; }
        const unsigned old = xb_add(&bar[XB_XSUB(b.x)], 1u);
        const unsigned gen = old / nloc;
        if (old + 1u == (gen + 1u) * nloc) {
            __builtin_amdgcn_fence(__ATOMIC_RELEASE, "agent");
            asm volatile("s_waitcnt vmcnt(0)" ::: "memory");
            const unsigned og = xb_add(&bar[XB_TOP], 1u);
            const unsigned tg = og / nx;
            if (og + 1u == (tg + 1u) * nx) xb_add(&bar[XB_TOPGEN], 1u);
            else XB_SPIN(xb_ld(&bar[XB_TOPGEN]) == tg, bar);
            __builtin_amdgcn_fence(__ATOMIC_ACQUIRE, "agent");
            xb_add(&bar[XB_XGEN(b.x)], 1u);
            asm volatile("s_waitcnt vmcnt(0)" ::: "memory");
        } else {
            XB_SPIN(xb_ld(&bar[XB_XGEN(b.x)]) == gen, bar);
            __builtin_amdgcn_fence(__ATOMIC_ACQUIRE, "agent");
            asm volatile("s_waitcnt vmcnt(0)" ::: "memory");
        }
    }
    __syncthreads();
}

struct Args { const float* in[21]; float* out; unsigned char* ws; int ph_lo, ph_hi; };
enum { I_X = 0, I_C, I_WADA, I_BADA, I_GMIX, I_WIN, I_BIG, I_BFG, I_GMO, I_GQ, I_GK, I_WBA, I_WBB, I_WOUT, I_GFFN, I_WR, I_BR, I_WUP, I_BUP, I_WDN, I_BDN };

struct Frame {
    LAS unsigned char* lds; unsigned char* ws; unsigned* ctl;
    int tid, lane, wave, G, wg, vcu;
};

__device__ __forceinline__ void p0_mod_partial(Frame& F, const float* c, const float* w_ada, float* modp, int item) {
    const int cg = item % 48, ks = item / 48;
    LAS float* sS = (LAS float*)F.lds;
    LAS float* red = (LAS float*)(F.lds + 8192);
    {
        const int k = F.tid;
#pragma unroll
        for (int b = 0; b < 4; ++b) { const float v = c[b * D + ks * 512 + k]; sS[b * 512 + k] = v * sigmoidf_(v); }
    }
    __syncthreads();
    f32x4 a0 = {0.f, 0.f, 0.f, 0.f}, a1 = a0, a2 = a0, a3 = a0;
    const float* wp = w_ada + (size_t)(ks * 512 + F.wave) * (6 * D) + cg * 256 + 4 * F.lane;
#pragma unroll 8
    for (int i = 0; i < 64; ++i) {
        const f32x4 w = *(const f32x4*)(wp + (size_t)(8 * i) * (6 * D));
        const int kk = F.wave + 8 * i;
        a0 += w * sS[kk]; a1 += w * sS[512 + kk]; a2 += w * sS[1024 + kk]; a3 += w * sS[1536 + kk];
    }
    *(LAS f32x4*)(red + (F.wave * 4 + 0) * 256 + 4 * F.lane) = a0;
    *(LAS f32x4*)(red + (F.wave * 4 + 1) * 256 + 4 * F.lane) = a1;
    *(LAS f32x4*)(red + (F.wave * 4 + 2) * 256 + 4 * F.lane) = a2;
    *(LAS f32x4*)(red + (F.wave * 4 + 3) * 256 + 4 * F.lane) = a3;
    __syncthreads();
#pragma unroll
    for (int r = 0; r < 2; ++r) {
        const int o = F.tid + 512 * r, b = o >> 8, col = o & 255;
        float s = 0.f;
#pragma unroll
        for (int w = 0; w < 8; ++w) s += red[(w * 4 + b) * 256 + col];
        modp[((size_t)ks * 4 + b) * (6 * D) + cg * 256 + col] = s;
    }
    __syncthreads();
}
__device__ __forceinline__ void p0_frag_item(const float* W, int ldw, int col0, bf16_t* dst, int p) {
    const int s = p >> 6, lane = p & 63;
    const float* src = W + (size_t)(32 * s + 8 * (lane >> 4)) * ldw + col0 + (lane & 15);
    u32x4 o; o.x = pk2(src[0], src[ldw]); o.y = pk2(src[2 * (size_t)ldw], src[3 * (size_t)ldw]); o.z = pk2(src[4 * (size_t)ldw], src[5 * (size_t)ldw]); o.w = pk2(src[6 * (size_t)ldw], src[7 * (size_t)ldw]);
    *(u32x4*)(dst + (size_t)p * 8) = o;
}
constexpr int CV_RS = 528, CV_BUF = 128 * CV_RS;
struct CvtItem { const float* src; bf16_t* dst; int K, ldw; };
__device__ __forceinline__ CvtItem cvt_decode(const Args& a, unsigned char* ws, int it) {
    constexpr int N_IN = 0, N_A = 4 * 16, N_O = 8 * 16, N_UP = 8 * 32, N_DN = 8 * 16;
    CvtItem c; int r = it;
    if (r < N_IN) { const int kb = r / 48, nb = r % 48, n0 = nb * 128; c.K = D; c.ldw = DIN; c.src = a.in[I_WIN] + (size_t)(kb * 256) * DIN + n0 + (n0 >= 3072 ? 16 : 0); c.dst = (bf16_t*)(ws + WS_WIN) + (size_t)n0 * D + kb * 256; return c; } r -= N_IN;
    if (r < N_A) { const int kb = r / 16, nb = r % 16; c.K = 1024; c.ldw = D; c.src = a.in[I_WBA] + (size_t)(kb * 256) * D + nb * 128; c.dst = (bf16_t*)(ws + WS_WA) + (size_t)(nb * 128) * 1024 + kb * 256; return c; } r -= N_A;
    if (r < N_A) { const int kb = r / 16, nb = r % 16; c.K = 1024; c.ldw = D; c.src = a.in[I_WBB] + (size_t)(kb * 256) * D + nb * 128; c.dst = (bf16_t*)(ws + WS_WB) + (size_t)(nb * 128) * 1024 + kb * 256; return c; } r -= N_A;
    if (r < N_O) { const int kb = r / 16, nb = r % 16; c.K = D; c.ldw = D; c.src = a.in[I_WOUT] + (size_t)(kb * 256) * D + nb * 128; c.dst = (bf16_t*)(ws + WS_WOUT) + (size_t)(nb * 128) * D + kb * 256; return c; } r -= N_O;
    const int e = r / (N_UP + N_DN); r -= e * (N_UP + N_DN);
    if (r < N_UP) { const int kb = r / 32, nb = r % 32, t = nb >> 1; c.K = D; c.ldw = 2 * D;
        c.src = a.in[I_WUP] + (size_t)e * D * (2 * D) + (size_t)(kb * 256) * (2 * D) + ((nb & 1) ? 2048 + 128 * t : 128 * t);
        c.dst = (bf16_t*)(ws + WS_WUP) + (size_t)e * (2 * D) * D + (size_t)(nb * 128) * D + kb * 256; return c; }
    r -= N_UP; { const int kb = r / 16, nb = r % 16; c.K = D; c.ldw = D; c.src = a.in[I_WDN] + (size_t)e * D * D + (size_t)(kb * 256) * D + nb * 128; c.dst = (bf16_t*)(ws + WS_WDN) + (size_t)e * D * D + (size_t)(nb * 128) * D + kb * 256; }
    return c;
}
constexpr int CVT_DENSE_ITEMS = 2 * 4 * 16 + 8 * 16;
__device__ __forceinline__ CvtItem cvt_decode_moe(const Args& a, unsigned char* ws, int e, int which, int j, int kb) {
    CvtItem c; c.K = D;
    if (which == 0) { const int t = j >> 1; c.ldw = 2 * D;
        c.src = a.in[I_WUP] + (size_t)e * D * (2 * D) + (size_t)(kb * 256) * (2 * D) + ((j & 1) ? 2048 + 128 * t : 128 * t);
        c.dst = (bf16_t*)(ws + WS_WUP) + (size_t)e * (2 * D) * D + (size_t)(j * 128) * D + kb * 256; }
    else { c.ldw = D; c.src = a.in[I_WDN] + (size_t)e * D * D + (size_t)(kb * 256) * D + j * 128; c.dst = (bf16_t*)(ws + WS_WDN) + (size_t)e * D * D + (size_t)(j * 128) * D + kb * 256; }
    return c;
}
__device__ __forceinline__ void cvt_load(const CvtItem& c, f32x4 (&v)[16], int wave, int lane) {
    const float* p = c.src + (size_t)(32 * wave + 16 * (lane >> 5)) * c.ldw + 4 * (lane & 31);
#pragma unroll
    for (int i = 0; i < 16; ++i) v[i] = __builtin_nontemporal_load((const f32x4*)(p + (size_t)i * c.ldw));
}
__device__ __forceinline__ void cvt_to_lds(const f32x4 (&v)[16], LAS unsigned char* buf, int wave, int lane) {
    const int n4 = lane & 31, hh = lane >> 5;
#pragma unroll
    for (int g = 0; g < 2; ++g)
#pragma unroll
        for (int j = 0; j < 4; ++j) {
            u32x4 o; o.x = pk2(v[8 * g + 0][j], v[8 * g + 1][j]); o.y = pk2(v[8 * g + 2][j], v[8 * g + 3][j]); o.z = pk2(v[8 * g + 4][j], v[8 * g + 5][j]); o.w = pk2(v[8 * g + 6][j], v[8 * g + 7][j]);
            *(LAS u32x4*)(buf + (4 * n4 + j) * CV_RS + (4 * wave + 2 * hh + g) * 16) = o; }
}
template <bool SC1>
__device__ __forceinline__ void cvt_store(const CvtItem& c, const LAS unsigned char* buf, int tid) {
#pragma unroll
    for (int i = 0; i < 8; ++i) { const int id = tid + 512 * i, row = id >> 5, ch = id & 31;
        const u32x4 v = *(const LAS u32x4*)(buf + row * CV_RS + ch * 16);
        if (SC1) store16_sc1(c.dst + (size_t)row * c.K + ch * 8, v); else *(u32x4*)(c.dst + (size_t)row * c.K + ch * 8) = v; }
}
template <bool SC1, class Dec>
__device__ __forceinline__ void cvt_stream(Frame& F, const Dec& dec, int first, int n, int step) {
    int it = first;
    if (it >= n) return;
    int tid = threadIdx.x; asm volatile("" : "+v"(tid));
    const int wave = __builtin_amdgcn_readfirstlane(tid >> 6), lane = tid & 63;
    f32x4 v[16];
    CvtItem cur = dec(it);
    cvt_load(cur, v, wave, lane);
    cvt_to_lds(v, F.lds, wave, lane);
    __syncthreads();
#pragma unroll 1
    for (int i = 0;; ++i) {
        const int nx = it + step; const bool has_next = nx < n;
        CvtItem nxt = cur;
        if (has_next) { nxt = dec(nx); cvt_load(nxt, v, wave, lane); }
        cvt_store<SC1>(cur, F.lds + (i & 1) * CV_BUF, tid);
        if (has_next) cvt_to_lds(v, F.lds + ((i + 1) & 1) * CV_BUF, wave, lane);
        __syncthreads();
        if (!has_next) break;
        cur = nxt; it = nx;
    }
}
constexpr int C8_RS = 272, C8_BUF = 128 * C8_RS;
struct Cvt8Item { const float* src; unsigned char* dst; int ldw; };
__device__ __forceinline__ Cvt8Item cvt8_decode(const Args& a, unsigned char* ws, int e, int which, int j, int kb) {
    Cvt8Item c;
    if (which == 0) { const int t = j >> 1; c.ldw = 2 * D;
        c.src = a.in[I_WUP] + (size_t)e * D * (2 * D) + (size_t)(kb * 256) * (2 * D) + ((j & 1) ? 2048 + 128 * t : 128 * t);
        c.dst = ws + WS_WUP + ((size_t)e * (2 * D) + (size_t)(j * 128)) * D + kb * 256; }
    else { c.ldw = D; c.src = a.in[I_WDN] + (size_t)e * D * D + (size_t)(kb * 256) * D + j * 128; c.dst = ws + WS_WDN + ((size_t)e * D + (size_t)(j * 128)) * D + kb * 256; }
    return c;
}
__device__ __forceinline__ void cvt8_load(const Cvt8Item& c, f32x4 (&v)[16], int wave, int lane) {
    const float* p = c.src + (size_t)(32 * wave + 16 * (lane >> 5)) * c.ldw + 4 * (lane & 31);
#pragma unroll
    for (int i = 0; i < 16; ++i) v[i] = __builtin_nontemporal_load((const f32x4*)(p + (size_t)i * c.ldw));
}
__device__ __forceinline__ void cvt8_to_lds(const f32x4 (&v)[16], LAS unsigned char* buf, int wave, int lane) {
    const int n4 = lane & 31, hh = lane >> 5;
#pragma unroll
    for (int j = 0; j < 4; ++j) {
        u32x4 o;
        o.x = pk4_fp8(v[0][j] * W8_SCALE, v[1][j] * W8_SCALE, v[2][j] * W8_SCALE, v[3][j] * W8_SCALE);
        o.y = pk4_fp8(v[4][j] * W8_SCALE, v[5][j] * W8_SCALE, v[6][j] * W8_SCALE, v[7][j] * W8_SCALE);
        o.z = pk4_fp8(v[8][j] * W8_SCALE, v[9][j] * W8_SCALE, v[10][j] * W8_SCALE, v[11][j] * W8_SCALE);
        o.w = pk4_fp8(v[12][j] * W8_SCALE, v[13][j] * W8_SCALE, v[14][j] * W8_SCALE, v[15][j] * W8_SCALE);
        *(LAS u32x4*)(buf + (4 * n4 + j) * C8_RS + (2 * wave + hh) * 16) = o; }
}
__device__ __forceinline__ void cvt8_store(const Cvt8Item& c, const LAS unsigned char* buf, int tid) {
#pragma unroll
    for (int i = 0; i < 4; ++i) { const int id = tid + 512 * i, row = id >> 4, ch = id & 15;
        store16_sc1(c.dst + (size_t)row * D + ch * 16, *(const LAS u32x4*)(buf + row * C8_RS + ch * 16)); }
}
template <bool SC1>
__device__ __forceinline__ void cvt8_store_t(const Cvt8Item& c, const LAS unsigned char* buf, int tid) {
#pragma unroll
    for (int i = 0; i < 4; ++i) { const int id = tid + 512 * i, row = id >> 4, ch = id & 15;
        const u32x4 v = *(const LAS u32x4*)(buf + row * C8_RS + ch * 16);
        if (SC1) store16_sc1(c.dst + (size_t)row * D + ch * 16, v); else __builtin_nontemporal_store(v, (u32x4*)(c.dst + (size_t)row * D + ch * 16)); }
}
__device__ __forceinline__ Cvt8Item cvt8_decode_lin(const Args& a, unsigned char* ws, int idx) {
    const int e = idx / 384; int r = idx - e * 384; int which = 0;
    if (r >= 256) { r -= 256; which = 1; }
    return cvt8_decode(a, ws, e, which, r >> 3, r & 7);
}
__device__ __forceinline__ void cvt8_all(Frame& F, const Args& a, unsigned char* ws) {
    constexpr int N = NE * 384;
    int it = F.vcu;
    if (it >= N) return;
    int tid = threadIdx.x; asm volatile("" : "+v"(tid));
    const int wave = __builtin_amdgcn_readfirstlane(tid >> 6), lane = tid & 63;
    f32x4 v[16];
    Cvt8Item cur = cvt8_decode_lin(a, ws, it);
    cvt8_load(cur, v, wave, lane);
    cvt8_to_lds(v, F.lds, wave, lane);
    __syncthreads();
#pragma unroll 1
    for (int i = 0;; ++i) {
        const int nx = it + F.G; const bool has_next = nx < N;
        Cvt8Item nxt = cur;
        if (has_next) { nxt = cvt8_decode_lin(a, ws, nx); cvt8_load(nxt, v, wave, lane); }
        cvt8_store_t<false>(cur, F.lds + (i & 1) * C8_BUF, tid);
        if (has_next) cvt8_to_lds(v, F.lds + ((i + 1) & 1) * C8_BUF, wave, lane);
        __syncthreads();
        if (!has_next) break;
        cur = nxt; it = nx;
    }
}
__device__ __forceinline__ void cvt8_item(Frame& F, const Args& a, int idx);
template <bool SC1>
__device__ __forceinline__ void cvt8_stream(Frame& F, const Args& a, unsigned char* ws, int e, int which, int j) {
    int tid = threadIdx.x; asm volatile("" : "+v"(tid));
    const int wave = __builtin_amdgcn_readfirstlane(tid >> 6), lane = tid & 63;
    f32x4 va[16], vb[16];
    Cvt8Item c0 = cvt8_decode(a, ws, e, which, j, 0), c1 = cvt8_decode(a, ws, e, which, j, 1);
    cvt8_load(c0, va, wave, lane);
    cvt8_load(c1, vb, wave, lane);
    __builtin_amdgcn_sched_barrier(0);
    cvt8_to_lds(va, F.lds, wave, lane);
    __syncthreads();
#pragma unroll
    for (int k = 0; k < 8; k += 2) {
        Cvt8Item c2 = c0, c3 = c1;
        __builtin_amdgcn_sched_barrier(0);
        if (k + 2 < 8) { c2 = cvt8_decode(a, ws, e, which, j, k + 2); cvt8_load(c2, va, wave, lane); }
        __builtin_amdgcn_sched_barrier(0);
        cvt8_store_t<SC1>(c0, F.lds, tid);
        __builtin_amdgcn_sched_barrier(0);
        cvt8_to_lds(vb, F.lds + C8_BUF, wave, lane);
        __syncthreads();
        __builtin_amdgcn_sched_barrier(0);
        if (k + 3 < 8) { c3 = cvt8_decode(a, ws, e, which, j, k + 3); cvt8_load(c3, vb, wave, lane); }
        __builtin_amdgcn_sched_barrier(0);
        cvt8_store_t<SC1>(c1, F.lds + C8_BUF, tid);
        __builtin_amdgcn_sched_barrier(0);
        if (k + 2 < 8) cvt8_to_lds(va, F.lds, wave, lane);
        __syncthreads();
        c0 = c2; c1 = c3;
    }
}
__device__ __forceinline__ void cvt8_win_sub(Frame& F, const Args& a, int q) {
    int tid = threadIdx.x; asm volatile("" : "+v"(tid));
    const int wave = __builtin_amdgcn_readfirstlane(tid >> 6), lane = tid & 63, j = q >> 3, kb = q & 7;
    Cvt8Item c; c.ldw = DIN; c.src = a.in[I_WIN] + (size_t)(kb * 256) * DIN + j * 128 + (j >= 24 ? 16 : 0); c.dst = F.ws + WS_WIN8 + (size_t)(j * 128) * D + kb * 256;
    f32x4 v[16];
    __syncthreads();
    cvt8_load(c, v, wave, lane);
    cvt8_to_lds(v, F.lds, wave, lane);
    __syncthreads();
    cvt8_store_t<false>(c, F.lds, tid);
    __syncthreads();
}
__device__ __forceinline__ void cvt8_wout_sub(Frame& F, const Args& a, int q) {
    int tid = threadIdx.x; asm volatile("" : "+v"(tid));
    const int wave = __builtin_amdgcn_readfirstlane(tid >> 6), lane = tid & 63, j = q >> 3, kb = q & 7;
    Cvt8Item c; c.ldw = D; c.src = a.in[I_WOUT] + (size_t)(kb * 256) * D + j * 128; c.dst = F.ws + WS_WOUT8 + (size_t)(j * 128) * D + kb * 256;
    f32x4 v[16];
    __syncthreads();
    cvt8_load(c, v, wave, lane);
    cvt8_to_lds(v, F.lds, wave, lane);
    __syncthreads();
    cvt8_store_t<false>(c, F.lds, tid);
    __syncthreads();
}
__device__ __forceinline__ void cvt8_wbr_sub(Frame& F, const Args& a, int q) {
    int tid = threadIdx.x; asm volatile("" : "+v"(tid));
    const int wave = __builtin_amdgcn_readfirstlane(tid >> 6), lane = tid & 63, which = q >> 6, j = (q >> 2) & 15, kb = q & 3;
    Cvt8Item c; c.ldw = D; c.src = (which ? a.in[I_WBB] : a.in[I_WBA]) + (size_t)(kb * 256) * D + j * 128; c.dst = F.ws + (which ? WS_WB : WS_WA) + (size_t)(j * 128) * 1024 + kb * 256;
    f32x4 v[16];
    __syncthreads();
    cvt8_load(c, v, wave, lane);
    cvt8_to_lds(v, F.lds, wave, lane);
    __syncthreads();
#pragma unroll
    for (int i = 0; i < 4; ++i) { const int id = tid + 512 * i, row = id >> 4, ch = id & 15;
        *(u32x4*)(c.dst + (size_t)row * 1024 + ch * 16) = *(const LAS u32x4*)(F.lds + row * C8_RS + ch * 16); }
    __syncthreads();
}
__device__ __forceinline__ void cvt8_item(Frame& F, const Args& a, int idx) {
    if (idx < 1024) cvt8_stream<false>(F, a, F.ws, idx >> 5, 0, idx & 31);
    else cvt8_stream<false>(F, a, F.ws, (idx - 1024) >> 4, 1, (idx - 1024) & 15);
}
__device__ __forceinline__ void cvt8_item_signal(Frame& F, const Args& a, int idx, unsigned* upd) {
    const int e = (idx - 1024) >> 4;
    cvt8_stream<true>(F, a, F.ws, e, 1, (idx - 1024) & 15);
    asm volatile("s_waitcnt vmcnt(0)" ::: "memory");
    __syncthreads();
    if (F.tid < 32) __hip_atomic_fetch_add(upd + (e * 32 + F.tid) * 16, 1u, __ATOMIC_RELAXED, __HIP_MEMORY_SCOPE_AGENT);
}
struct DenseDec { const Args* a; unsigned char* ws; __device__ __forceinline__ CvtItem operator()(int it) const { return cvt_decode(*a, ws, it); } };
struct MoeDec { const Args* a; unsigned char* ws; int e, which, j; __device__ __forceinline__ CvtItem operator()(int kb) const { return cvt_decode_moe(*a, ws, e, which, j, kb); } };
__device__ __forceinline__ void p0_prologue(Frame& F, const Args& a) {
    unsigned char* ws = F.ws;
    for (int it = F.wg; it < 192; it += F.G) p0_mod_partial(F, a.in[I_C], a.in[I_WADA], (float*)(ws + WS_MODP), it);
    for (int p = (F.G - 1 - F.wg) * 512 + F.tid; p < 4096 + 8192; p += F.G * 512) {
        if (p < 4096) p0_frag_item(a.in[I_WIN], DIN, GATE_COL, (bf16_t*)(ws + WS_WGF), p);
        else { const int q = p - 4096, ct = q >> 12; p0_frag_item(a.in[I_WR], NE, 16 * ct, (bf16_t*)(ws + WS_WRF) + (size_t)ct * 4096 * 8, q & 4095); }
    }
    __syncthreads();
    for (int q = F.vcu; q < 640; q += F.G) cvt8_win_sub(F, a, q);
    for (int q = F.G - 1 - F.vcu; q < 256; q += F.G) { if (q < 128) cvt8_wout_sub(F, a, q); else cvt8_wbr_sub(F, a, q - 128); }
}

constexpr int HL_STRIDE = 4112;
constexpr int HL_BYTES = 32 * HL_STRIDE;
constexpr int PART_OFF = 132096;
constexpr int LOGIT_OFF = PART_OFF + 8192;
constexpr int DST_OFF = LOGIT_OFF + 4096;

__device__ __forceinline__ f32x4 mod4(const float* modp, const float* b_ada, int b, int idx) {
    f32x4 s = *(const f32x4*)(b_ada + idx);
#pragma unroll
    for (int ks = 0; ks < 4; ++ks) s += *(const f32x4*)(modp + ((size_t)ks * 4 + b) * (6 * D) + idx);
    return s;
}
template <bool FROM_PARTIALS>
__device__ __forceinline__ void norm_rows_32(Frame& F, const float* xin, const float* gvec, const float* modsrc, const float* b_ada, int chunk_sh, int rb, bf16_t* gout, unsigned char* gout8 = nullptr) {
    const int b = rb >> 6; int lane = F.lane; asm volatile("" : "+v"(lane));
    f32x4 xa[8], xb[8];
    const float* xr = xin + ((size_t)rb * 32 + 4 * F.wave) * D + 4 * lane;
#pragma unroll
    for (int j = 0; j < 8; ++j) xa[j] = *(const f32x4*)(xr + 256 * j);
#pragma unroll
    for (int j = 0; j < 8; ++j) xb[j] = *(const f32x4*)(xr + D + 256 * j);
    f32x4 xc[8], xd[8];
    if (!FROM_PARTIALS) {
#pragma unroll
        for (int j = 0; j < 8; ++j) xc[j] = *(const f32x4*)(xr + 2 * D + 256 * j);
#pragma unroll
        for (int j = 0; j < 8; ++j) xd[j] = *(const f32x4*)(xr + 3 * D + 256 * j);
    }
    f32x4 gsc[8], shv[8];
#pragma unroll
    for (int j = 0; j < 8; ++j) {
        const int col = 4 * (lane + 64 * j);
        f32x4 sh, sc;
        if (FROM_PARTIALS) { sh = mod4(modsrc, b_ada, b, chunk_sh * D + col); sc = mod4(modsrc, b_ada, b, (chunk_sh + 1) * D + col); }
        else { sh = *(const f32x4*)(modsrc + (size_t)b * (6 * D) + chunk_sh * D + col); sc = *(const f32x4*)(modsrc + (size_t)b * (6 * D) + (chunk_sh + 1) * D + col); }
        const f32x4 g = *(const f32x4*)(gvec + col);
        gsc[j] = g * (sc + 1.0f); shv[j] = sh;
        if (j & 1) __builtin_amdgcn_sched_barrier(0);
    }
#pragma unroll
    for (int i = 0; i < 4; ++i) {
        const int r = 4 * F.wave + i; const size_t row = (size_t)rb * 32 + r;
        f32x4 xv[8]; float ss = 0.f;
#pragma unroll
        for (int j = 0; j < 8; ++j) { xv[j] = FROM_PARTIALS ? ((i & 1) ? xb[j] : xa[j]) : (i == 0 ? xa[j] : i == 1 ? xb[j] : i == 2 ? xc[j] : xd[j]); ss += (xv[j][0] * xv[j][0] + xv[j][1] * xv[j][1]) + (xv[j][2] * xv[j][2] + xv[j][3] * xv[j][3]); }
        if (FROM_PARTIALS && i < 2) {
#pragma unroll
            for (int j = 0; j < 8; ++j) { const f32x4 nx = *(const f32x4*)(xr + (size_t)(i + 2) * D + 256 * j); if (i & 1) xb[j] = nx; else xa[j] = nx; }
        }
        __builtin_amdgcn_sched_barrier(0);
        const float rinv = rsqrtf(wave_sum(ss) * (1.0f / D) + EPS);
        int ls = lane; asm volatile("" : "+v"(ls));
        const size_t so = row * D + 4 * (size_t)ls;
#pragma unroll
        for (int j = 0; j < 8; ++j) {
            const f32x4 hv = xv[j] * rinv * gsc[j] + shv[j];
            u32x2 p; p.x = pk2(hv[0], hv[1]); p.y = pk2(hv[2], hv[3]);
            *(LAS u32x2*)(F.lds + r * HL_STRIDE + 8 * ls + 512 * j) = p;
            if (gout) *(u32x2*)(gout + so + 256 * j) = p;
            if (gout8) *(unsigned*)(gout8 + so + 256 * j) = pk4_fp8(hv[0], hv[1], hv[2], hv[3]);
        }
        __builtin_amdgcn_sched_barrier(0);
    }
}
__device__ __forceinline__ void norm_rows_32_b(Frame& F, const bf16_t* xin, const float* gvec, const float* modsrc, int chunk_sh, int rb) {
    const int b = rb >> 6; int lane = F.lane; asm volatile("" : "+v"(lane));
    u32x2 xr_[4][8];
    const bf16_t* xr = xin + ((size_t)rb * 32 + 4 * F.wave) * D + 4 * lane;
#pragma unroll
    for (int i = 0; i < 4; ++i)
#pragma unroll
        for (int j = 0; j < 8; ++j) xr_[i][j] = *(const u32x2*)(xr + (size_t)i * D + 256 * j);
    f32x4 gsc[8], shv[8];
#pragma unroll
    for (int j = 0; j < 8; ++j) {
        const int col = 4 * (lane + 64 * j);
        const f32x4 sh = *(const f32x4*)(modsrc + (size_t)b * (6 * D) + chunk_sh * D + col), sc = *(const f32x4*)(modsrc + (size_t)b * (6 * D) + (chunk_sh + 1) * D + col);
        const f32x4 g = *(const f32x4*)(gvec + col);
        gsc[j] = g * (sc + 1.0f); shv[j] = sh;
    }
#pragma unroll
    for (int i = 0; i < 4; ++i) {
        const int r = 4 * F.wave + i;
        f32x4 xv[8]; float ss = 0.f;
#pragma unroll
        for (int j = 0; j < 8; ++j) { const u32x2 q = xr_[i][j]; xv[j] = (f32x4){bf_lo(q.x), bf_hi(q.x), bf_lo(q.y), bf_hi(q.y)}; ss += (xv[j][0] * xv[j][0] + xv[j][1] * xv[j][1]) + (xv[j][2] * xv[j][2] + xv[j][3] * xv[j][3]); }
        const float rinv = rsqrtf(wave_sum(ss) * (1.0f / D) + EPS);
#pragma unroll
        for (int j = 0; j < 8; ++j) {
            const f32x4 hv = xv[j] * rinv * gsc[j] + shv[j];
            u32x2 p; p.x = pk2(hv[0], hv[1]); p.y = pk2(hv[2], hv[3]);
            *(LAS u32x2*)(F.lds + r * HL_STRIDE + 8 * lane + 512 * j) = p;
        }
    }
}
__device__ __forceinline__ void p1_rows(Frame& F, const Args& a) {
    unsigned char* ws = F.ws;
    const float* modp = (const float*)(ws + WS_MODP);
    { float* modf = (float*)(ws + WS_MODF);
      for (int i = F.wg * 512 + F.tid; i < NB * 6 * D; i += F.G * 512) { const int b = i / (6 * D), idx = i % (6 * D); float s = a.in[I_BADA][idx];
#pragma unroll
          for (int ks = 0; ks < 4; ++ks) s += modp[((size_t)ks * 4 + b) * (6 * D) + idx];
          modf[i] = s; } }
    if (F.wg == 0 && F.wave == 0) {
        float mq = fmaxf(fabsf(a.in[I_GQ][2 * F.lane]), fabsf(a.in[I_GQ][2 * F.lane + 1])), mk = fmaxf(fabsf(a.in[I_GK][2 * F.lane]), fabsf(a.in[I_GK][2 * F.lane + 1]));
#pragma unroll
        for (int o = 1; o < 64; o <<= 1) { mq = fmaxf(mq, __shfl_xor(mq, o)); mk = fmaxf(mk, __shfl_xor(mk, o)); }
        if (F.lane == 0) ((float*)F.ctl)[CW_MISC] = 16.3223f * 1.01f * mq * mk;
    }
    const bf16_t* wgf = (const bf16_t*)(ws + WS_WGF);
    float* gates = (float*)(ws + WS_GATES);
    LAS float* part = (LAS float*)(F.lds + PART_OFF);
    const int lane = F.lane, l15 = lane & 15, g4 = lane >> 4;
    for (int rb = F.wg; rb < T / 32; rb += F.G) {
        norm_rows_32<true>(F, a.in[I_X], a.in[I_GMIX], modp, a.in[I_BADA], 0, rb, nullptr, ws + WS_HBUF8);
        { const int rg = F.wave & 1, kq = F.wave >> 1; f32x4 acc = {0.f, 0.f, 0.f, 0.f};
          bf16x8 bvv[16];
          __builtin_amdgcn_sched_barrier(0);
          const bf16_t* wq = wgf + ((size_t)(16 * kq) * 64 + lane) * 8; asm volatile("" : "+v"(wq));
#pragma unroll
          for (int s = 0; s < 16; ++s) bvv[s] = *(const bf16x8*)(wq + (size_t)s * 512);
          __syncthreads();
#pragma unroll
          for (int s = 0; s < 16; ++s) { const int ks = 16 * kq + s;
              const bf16x8 av = *(const LAS bf16x8*)(F.lds + (16 * rg + l15) * HL_STRIDE + (32 * ks + 8 * g4) * 2);
              acc = __builtin_amdgcn_mfma_f32_16x16x32_bf16(av, bvv[s], acc, 0, 0, 0); }
#pragma unroll
          for (int r = 0; r < 4; ++r) part[(kq * 2 + rg) * 256 + (4 * g4 + r) * 16 + l15] = acc[r]; }
        __syncthreads();
        { const int rg = F.tid >> 8, rc = F.tid & 255; float s = 0.f;
#pragma unroll
          for (int kq = 0; kq < 4; ++kq) s += part[(kq * 2 + rg) * 256 + rc];
          gates[((size_t)rb * 32 + 16 * rg + (rc >> 4)) * 16 + (rc & 15)] = s; }
        __syncthreads();
    }
}

__device__ __forceinline__ void p3_qknorm(Frame& F, const Args& a) {
    bf16_t* z = (bf16_t*)(F.ws + WS_Z); float* kmean = (float*)(F.ws + WS_KMEAN);
    LAS float* cs = (LAS float*)F.lds;
    const int lane = F.lane;
    for (int u = F.wg; u < 512; u += F.G) {
        const int which = u & 1, h = (u >> 1) & 7, blk = (u >> 4) & 7, b = u >> 7;
        const float* gv = which ? a.in[I_GK] : a.in[I_GQ];
        const float g0 = gv[2 * lane], g1 = gv[2 * lane + 1];
        bf16_t* base = z + ((size_t)b * SEQ + blk * 256 + 32 * F.wave) * ZP + (which ? ZKB : ZQB) + h * 128 + 2 * lane;
        unsigned v[32];
#pragma unroll
        for (int i = 0; i < 32; ++i) v[i] = *(const unsigned*)(base + (size_t)i * ZP);
        float c0 = 0.f, c1 = 0.f;
#pragma unroll
        for (int i = 0; i < 32; ++i) {
            const float f0 = bf_lo(v[i]), f1 = bf_hi(v[i]);
            const float rinv = rsqrtf(wave_sum(f0 * f0 + f1 * f1) * (1.0f / 128.0f) + EPS);
            const float y0 = f0 * rinv * g0, y1 = f1 * rinv * g1;
            *(unsigned*)(base + (size_t)i * ZP) = pk2(y0, y1);
            c0 += y0; c1 += y1;
        }
        if (which) {
            cs[F.wave * 128 + 2 * lane] = c0; cs[F.wave * 128 + 2 * lane + 1] = c1;
            __syncthreads();
            if (F.tid < 128) { float s = 0.f;
#pragma unroll
                for (int w = 0; w < 8; ++w) s += cs[w * 128 + F.tid];
                kmean[(((size_t)b * 8 + h) * 8 + blk) * 128 + F.tid] = s * (1.0f / 256.0f); }
            __syncthreads();
        }
    }
}

__device__ __forceinline__ s16x4 tr16(LAS unsigned char* p) { return __builtin_amdgcn_ds_read_tr16_b64_v4i16((LAS s16x4*)p); }
__device__ __forceinline__ bf16x8 cat8(s16x4 a, s16x4 b) { return (bf16x8){a[0], a[1], a[2], a[3], b[0], b[1], b[2], b[3]}; }
#define MFMA16(a, b, c) __builtin_amdgcn_mfma_f32_16x16x32_bf16((a), (b), (c), 0, 0, 0)

struct ChunkGates { float li, bcs, u, pmx, g, umax; };
__device__ __forceinline__ ChunkGates chunk_gates(float gi_raw, float gf_raw, float bi, float bfg, int lane) {
    ChunkGates G;
    const float ti = __expf((gi_raw + bi) * (2.0f / 15.0f)), tf = __expf((gf_raw + bfg) * (2.0f / 15.0f));
    G.li = 15.0f - 30.0f * __builtin_amdgcn_rcpf(ti + 1.0f);
    const float xf = 15.0f - 30.0f * __builtin_amdgcn_rcpf(tf + 1.0f);
    const float lf = fminf(xf, 0.f) - __logf(1.0f + __expf(-fabsf(xf)));
    float bcs = lf;
#pragma unroll
    for (int o = 1; o < 64; o <<= 1) { const float t = __shfl_up(bcs, o); if (lane >= o) bcs += t; }
    G.bcs = bcs; G.g = __shfl(bcs, 63); G.u = G.li - bcs;
    float pmx = G.u;
#pragma unroll
    for (int o = 1; o < 64; o <<= 1) { const float t = __shfl_up(pmx, o); if (lane >= o) pmx = fmaxf(pmx, t); }
    G.pmx = pmx; G.umax = __shfl(pmx, 63);
    return G;
}
constexpr int ML_QS = 0, ML_KS = 9216, ML_KW = 18432, ML_VS = 27648, ML_SB = 45056, ML_CB = 54272, ML_HO = 72704, ML_FLO = 90112, ML_RS = 144, ML_VR = 272;

struct PassAIn { u32x4 kv, v0, v1; float gi, gf; };
__device__ __forceinline__ PassAIn mlstm_passA_load(Frame& F, int u) {
    const bf16_t* z = (const bf16_t*)(F.ws + WS_Z); const float* gates = (const float*)(F.ws + WS_GATES);
    const int c = u & 31, h = (u >> 5) & 7, b = u >> 8;
    const size_t tok0 = (size_t)b * SEQ + c * 64;
    const int lr = F.tid >> 3, ls = F.tid & 7;
    const bf16_t* zr = z + (tok0 + lr) * ZP;
    PassAIn I;
    I.kv = *(const u32x4*)(zr + ZKA + h * 64 + ls * 8);
    I.v0 = *(const u32x4*)(zr + ZVA + h * 128 + ls * 8); I.v1 = *(const u32x4*)(zr + ZVA + h * 128 + 64 + ls * 8);
    I.gi = gates[(tok0 + F.lane) * 16 + h]; I.gf = gates[(tok0 + F.lane) * 16 + 8 + h];
    return I;
}
__device__ __forceinline__ void mlstm_passA(Frame& F, const Args& a, int u, const PassAIn& I) {
    LAS unsigned char* L = F.lds; LAS float* fl = (LAS float*)(L + ML_FLO);
    float* cloc = (float*)(F.ws + WS_CLOC) + (size_t)u * 8192; float* nloc = (float*)(F.ws + WS_NLOC) + (size_t)u * 64; float* msc = (float*)(F.ws + WS_MSC) + (size_t)u * 4;
    const int tid = F.tid, lane = F.lane, w = F.wave, l15 = lane & 15, g4 = lane >> 4;
    const int h = (u >> 5) & 7;
    const int lr = tid >> 3, ls = tid & 7;
    const u32x4 kv = I.kv, v0 = I.v0, v1 = I.v1;
    __syncthreads();
    if (w == 0) {
        const ChunkGates G = chunk_gates(I.gi, I.gf, a.in[I_BIG][h], a.in[I_BFG][h], lane);
        fl[256 + lane] = __expf(G.u - G.umax);
        if (lane == 0) { msc[0] = G.g + G.umax; msc[1] = G.g; }
    }
    *(LAS u32x4*)(L + ML_VS + lr * ML_VR + ls * 16) = v0; *(LAS u32x4*)(L + ML_VS + lr * ML_VR + 128 + ls * 16) = v1;
    __syncthreads();
    { const float wr_ = fl[256 + lr];
      u32x4 o; o.x = pk2(bf_lo(kv.x) * wr_, bf_hi(kv.x) * wr_); o.y = pk2(bf_lo(kv.y) * wr_, bf_hi(kv.y) * wr_); o.z = pk2(bf_lo(kv.z) * wr_, bf_hi(kv.z) * wr_); o.w = pk2(bf_lo(kv.w) * wr_, bf_hi(kv.w) * wr_);
      *(LAS u32x4*)(L + ML_KW + lr * ML_RS + ls * 16) = o; }
    __syncthreads();
    f32x4 Cacc[4];
#pragma unroll
    for (int et = 0; et < 4; ++et) Cacc[et] = (f32x4){0.f, 0.f, 0.f, 0.f};
#pragma unroll
    for (int ks = 0; ks < 2; ++ks) {
        LAS unsigned char* vp = L + ML_VS + (32 * ks + 8 * g4 + (l15 >> 2)) * ML_VR + (16 * w + 4 * (l15 & 3)) * 2;
        const bf16x8 av = cat8(tr16(vp), tr16(vp + 4 * ML_VR));
#pragma unroll
        for (int et = 0; et < 4; ++et) {
            LAS unsigned char* kp = L + ML_KW + (32 * ks + 8 * g4 + (l15 >> 2)) * ML_RS + (16 * et + 4 * (l15 & 3)) * 2;
            Cacc[et] = MFMA16(av, cat8(tr16(kp), tr16(kp + 4 * ML_RS)), Cacc[et]); } }
#pragma unroll
    for (int et = 0; et < 4; ++et)
#pragma unroll
        for (int r = 0; r < 4; ++r) cloc[(16 * w + 4 * g4 + r) * 64 + 16 * et + l15] = Cacc[et][r];
    { const int e = tid >> 3, part = tid & 7; float sacc = 0.f;
#pragma unroll
      for (int i = 0; i < 8; ++i) sacc += bf1(*(const LAS bf16_t*)(L + ML_KW + (8 * part + i) * ML_RS + e * 2));
      sacc += __shfl_xor(sacc, 1); sacc += __shfl_xor(sacc, 2); sacc += __shfl_xor(sacc, 4);
      if (part == 0) nloc[e] = sacc; }
}

__device__ __forceinline__ void mlstm_passA4(Frame& F, const Args& a) {
    constexpr int CH = 27648, VS = 0, KW = 17408, FL = 26624;
    const bf16_t* z = (const bf16_t*)(F.ws + WS_Z); const float* gates = (const float*)(F.ws + WS_GATES);
    int tid = F.tid; asm volatile("" : "+v"(tid));
    const int lane = tid & 63, w = F.wave, l15 = lane & 15, g4 = lane >> 4, lr = tid >> 3, ls = tid & 7;
    u32x4 kv[4], v0[4], v1[4]; float gi[4], gf[4];
#pragma unroll
    for (int k = 0; k < 4; ++k) {
        const int u = F.wg + 256 * k, c = u & 31, h = (u >> 5) & 7, b = u >> 8;
        const size_t tok0 = (size_t)b * SEQ + c * 64;
        const bf16_t* zr = z + (tok0 + lr) * ZP;
        kv[k] = *(const u32x4*)(zr + ZKA + h * 64 + ls * 8);
        v0[k] = *(const u32x4*)(zr + ZVA + h * 128 + ls * 8); v1[k] = *(const u32x4*)(zr + ZVA + h * 128 + 64 + ls * 8);
        gi[k] = gates[(tok0 + lane) * 16 + h]; gf[k] = gates[(tok0 + lane) * 16 + 8 + h];
    }
    __syncthreads();
#pragma unroll
    for (int k = 0; k < 4; ++k) {
        const int u = F.wg + 256 * k, h = (u >> 5) & 7;
        LAS unsigned char* L = F.lds + k * CH; LAS float* fl = (LAS float*)(L + FL);
        if (w == k) {
            const ChunkGates G = chunk_gates(gi[k], gf[k], a.in[I_BIG][h], a.in[I_BFG][h], lane);
            fl[lane] = __expf(G.u - G.umax);
            if (lane == 0) { float* msc = (float*)(F.ws + WS_MSC) + (size_t)u * 4; msc[0] = G.g + G.umax; msc[1] = G.g; }
        }
        *(LAS u32x4*)(L + VS + lr * ML_VR + ls * 16) = v0[k]; *(LAS u32x4*)(L + VS + lr * ML_VR + 128 + ls * 16) = v1[k];
    }
    __syncthreads();
#pragma unroll
    for (int k = 0; k < 4; ++k) {
        LAS unsigned char* L = F.lds + k * CH; const LAS float* fl = (const LAS float*)(L + FL);
        const float wr_ = fl[lr]; const u32x4 q = kv[k];
        u32x4 o; o.x = pk2(bf_lo(q.x) * wr_, bf_hi(q.x) * wr_); o.y = pk2(bf_lo(q.y) * wr_, bf_hi(q.y) * wr_); o.z = pk2(bf_lo(q.z) * wr_, bf_hi(q.z) * wr_); o.w = pk2(bf_lo(q.w) * wr_, bf_hi(q.w) * wr_);
        *(LAS u32x4*)(L + KW + lr * ML_RS + ls * 16) = o;
    }
    __syncthreads();
#pragma unroll
    for (int k = 0; k < 4; ++k) {
        const int u = F.wg + 256 * k;
        LAS unsigned char* L = F.lds + k * CH;
        float* cloc = (float*)(F.ws + WS_CLOC) + (size_t)u * 8192; float* nloc = (float*)(F.ws + WS_NLOC) + (size_t)u * 64;
        f32x4 Cacc[4];
#pragma unroll
        for (int et = 0; et < 4; ++et) Cacc[et] = (f32x4){0.f, 0.f, 0.f, 0.f};
#pragma unroll
        for (int ks = 0; ks < 2; ++ks) {
            LAS unsigned char* vp = L + VS + (32 * ks + 8 * g4 + (l15 >> 2)) * ML_VR + (16 * w + 4 * (l15 & 3)) * 2;
            const bf16x8 av = cat8(tr16(vp), tr16(vp + 4 * ML_VR));
#pragma unroll
            for (int et = 0; et < 4; ++et) {
                LAS unsigned char* kp = L + KW + (32 * ks + 8 * g4 + (l15 >> 2)) * ML_RS + (16 * et + 4 * (l15 & 3)) * 2;
                Cacc[et] = MFMA16(av, cat8(tr16(kp), tr16(kp + 4 * ML_RS)), Cacc[et]); } }
#pragma unroll
        for (int et = 0; et < 4; ++et)
#pragma unroll
            for (int r = 0; r < 4; ++r) cloc[(16 * w + 4 * g4 + r) * 64 + 16 * et + l15] = Cacc[et][r];
        { const int e = tid >> 3, part = tid & 7; float sacc = 0.f;
#pragma unroll
          for (int i = 0; i < 8; ++i) sacc += bf1(*(const LAS bf16_t*)(L + KW + (8 * part + i) * ML_RS + e * 2));
          sacc += __shfl_xor(sacc, 1); sacc += __shfl_xor(sacc, 2); sacc += __shfl_xor(sacc, 4);
          if (part == 0) nloc[e] = sacc; }
    }
}

__device__ __forceinline__ void mlstm_passB(Frame& F, int item) {
    const int bh = item >> 3, slice = item & 7, tid = F.tid;
    const float* cloc = (const float*)(F.ws + WS_CLOC) + (size_t)bh * 32 * 8192 + slice * 1024 + 2 * tid;
    bf16_t* cin = (bf16_t*)(F.ws + WS_CIN) + (size_t)bh * 32 * 8192 + slice * 1024 + 2 * tid;
    const float* nloc = (const float*)(F.ws + WS_NLOC) + (size_t)bh * 32 * 64 + 2 * tid;
    float* nin = (float*)(F.ws + WS_NIN) + (size_t)bh * 32 * 64 + 2 * tid;
    float* msc = (float*)(F.ws + WS_MSC) + (size_t)bh * 32 * 4;
    const bool do_n = (slice == 0) && (tid < 32);
    f32x2 cl[32], nl[32], mg[32];
#pragma unroll
    for (int c = 0; c < 32; ++c) { cl[c] = *(const f32x2*)(cloc + (size_t)c * 8192); nl[c] = do_n ? *(const f32x2*)(nloc + c * 64) : (f32x2){0.f, 0.f}; mg[c] = *(const f32x2*)(msc + c * 4); }
    __builtin_amdgcn_sched_barrier(0);
    float m = 0.f; f32x2 C = {0.f, 0.f}, N = {0.f, 0.f};
#pragma unroll
    for (int c = 0; c < 32; ++c) {
        *(unsigned*)(cin + (size_t)c * 8192) = pk2(C[0], C[1]);
        if (do_n) *(f32x2*)(nin + c * 64) = N;
        if (slice == 0 && tid == 0) msc[c * 4 + 2] = m;
        const float mloc = mg[c][0], g = mg[c][1];
        const float m_new = fmaxf(g + m, mloc), sp = __expf(g + m - m_new), sl = __expf(mloc - m_new);
        C = C * sp + cl[c] * sl; N = N * sp + nl[c] * sl; m = m_new;
    }
}

__device__ __forceinline__ void mlstm_passC(Frame& F, const Args& a, int u) {
    constexpr int QS = ML_QS, KS = ML_KS, VS = ML_VS, SB = ML_SB, CB = ML_CB, HO = ML_HO, RS = ML_RS, VR = ML_VR;
    LAS unsigned char* L = F.lds; LAS float* fl = (LAS float*)(L + ML_FLO);
    const bf16_t* z = (const bf16_t*)(F.ws + WS_Z); const float* gates = (const float*)(F.ws + WS_GATES);
    unsigned char* hm = F.ws + WS_HM;
    int tid = F.tid; asm volatile("" : "+v"(tid));
    const int lane = tid & 63, w = F.wave, l15 = lane & 15, g4 = lane >> 4;
    const int c = u & 31, h = (u >> 5) & 7, b = u >> 8;
    const float* gmo = a.in[I_GMO] + h * 128;
    const size_t tok0 = (size_t)b * SEQ + c * 64;
    const int lr = tid >> 3, ls = tid & 7, jt = w & 3, hf = w >> 2;
    const bf16_t* zr = z + (tok0 + lr) * ZP;
    const u32x4 qv = *(const u32x4*)(zr + ZQA + h * 64 + ls * 8), kv = *(const u32x4*)(zr + ZKA + h * 64 + ls * 8);
    const u32x4 v0 = *(const u32x4*)(zr + ZVA + h * 128 + ls * 8), v1 = *(const u32x4*)(zr + ZVA + h * 128 + 64 + ls * 8);
    const u32x4 oc0 = *(const u32x4*)(zr + ZOA + h * 128 + ls * 16), oc1 = *(const u32x4*)(zr + ZOA + h * 128 + ls * 16 + 8);
    const bf16_t* cin = (const bf16_t*)(F.ws + WS_CIN) + (size_t)u * 8192;
    const u32x4 c0 = *(const u32x4*)(cin + tid * 8), c1 = *(const u32x4*)(cin + 4096 + tid * 8);
    const float* msc = (const float*)(F.ws + WS_MSC) + (size_t)u * 4;
    const float mstate = msc[2], gi_raw = gates[(tok0 + lane) * 16 + h], gf_raw = gates[(tok0 + lane) * 16 + 8 + h], big = a.in[I_BIG][h], bfg = a.in[I_BFG][h];
    const float nin_l = ((const float*)(F.ws + WS_NIN))[(size_t)u * 64 + lane];
    float gmo_r[4];
#pragma unroll
    for (int d4 = 0; d4 < 4; ++d4) gmo_r[d4] = gmo[16 * (4 * hf + d4) + l15];
    __syncthreads();
    if (w == 0) {
        const ChunkGates G = chunk_gates(gi_raw, gf_raw, big, bfg, lane);
        const float M = fmaxf(mstate, G.pmx);
        fl[lane] = -M; fl[64 + lane] = G.u; fl[128 + lane] = __expf(mstate - M); fl[192 + lane] = __expf(-(G.bcs + M));
    }
    if (w == 1) fl[640 + lane] = nin_l;
    *(LAS u32x4*)(L + QS + lr * RS + ls * 16) = qv; *(LAS u32x4*)(L + KS + lr * RS + ls * 16) = kv;
    *(LAS u32x4*)(L + VS + lr * VR + ls * 16) = v0; *(LAS u32x4*)(L + VS + lr * VR + 128 + ls * 16) = v1;
    *(LAS u32x4*)(L + CB + lr * RS + ls * 16) = c0; *(LAS u32x4*)(L + CB + (64 + lr) * RS + ls * 16) = c1;
    __syncthreads();
    { const LAS float* nv = fl + 640 + ls * 8;
      float s = bf_lo(qv.x) * nv[0] + bf_hi(qv.x) * nv[1] + bf_lo(qv.y) * nv[2] + bf_hi(qv.y) * nv[3] + bf_lo(qv.z) * nv[4] + bf_hi(qv.z) * nv[5] + bf_lo(qv.w) * nv[6] + bf_hi(qv.w) * nv[7];
      s += __shfl_xor(s, 1); s += __shfl_xor(s, 2); s += __shfl_xor(s, 4);
      if (ls == 0) fl[320 + lr] = s * 0.125f; }
    { bf16x8 aq[2];
#pragma unroll
      for (int ks = 0; ks < 2; ++ks) aq[ks] = *(const LAS bf16x8*)(L + QS + (16 * jt + l15) * RS + (32 * ks + 8 * g4) * 2);
      float rsum[4] = {0.f, 0.f, 0.f, 0.f};
#pragma unroll
      for (int st2 = 0; st2 < 2; ++st2) { const int st = 2 * hf + st2; f32x4 s = {0.f, 0.f, 0.f, 0.f};
          if (st <= jt) {
#pragma unroll
              for (int ks = 0; ks < 2; ++ks) { const bf16x8 bk = *(const LAS bf16x8*)(L + KS + (16 * st + l15) * RS + (32 * ks + 8 * g4) * 2); s = MFMA16(aq[ks], bk, s); } }
          const int scol = 16 * st + l15; const float cf = fl[64 + scol];
#pragma unroll
          for (int r = 0; r < 4; ++r) { const int j = 16 * jt + 4 * g4 + r;
              const float val = (scol <= j) ? s[r] * 0.125f * __expf(fl[j] + cf) : 0.f; rsum[r] += val;
              *(LAS bf16_t*)(L + SB + j * RS + scol * 2) = f2bf(val); } }
#pragma unroll
      for (int r = 0; r < 4; ++r) { float t = rsum[r]; t += __shfl_xor(t, 1); t += __shfl_xor(t, 2); t += __shfl_xor(t, 4); t += __shfl_xor(t, 8);
          if (l15 == 0) fl[384 + hf * 64 + 16 * jt + 4 * g4 + r] = t; } }
    __syncthreads();
    float hv[4][4];
    { bf16x8 as_[2], aq[2];
#pragma unroll
      for (int ks = 0; ks < 2; ++ks) { as_[ks] = *(const LAS bf16x8*)(L + SB + (16 * jt + l15) * RS + (32 * ks + 8 * g4) * 2); aq[ks] = *(const LAS bf16x8*)(L + QS + (16 * jt + l15) * RS + (32 * ks + 8 * g4) * 2); }
      float si[4], dn[4], en[4], ss[4] = {0.f, 0.f, 0.f, 0.f};
#pragma unroll
      for (int r = 0; r < 4; ++r) { const int j = 16 * jt + 4 * g4 + r; si[r] = fl[128 + j]; dn[r] = fl[384 + j] + fl[448 + j] + si[r] * fl[320 + j]; en[r] = fl[192 + j]; si[r] *= 0.125f; }
#pragma unroll
      for (int d4 = 0; d4 < 4; ++d4) { const int dt = 4 * hf + d4; f32x4 nacc = {0.f, 0.f, 0.f, 0.f}, iacc = nacc;
#pragma unroll
          for (int ks = 0; ks < 2; ++ks) {
              LAS unsigned char* vp = L + VS + (32 * ks + 8 * g4 + (l15 >> 2)) * VR + (16 * dt + 4 * (l15 & 3)) * 2;
              nacc = MFMA16(as_[ks], cat8(tr16(vp), tr16(vp + 4 * VR)), nacc);
              const bf16x8 bc = *(const LAS bf16x8*)(L + CB + (16 * dt + l15) * RS + (32 * ks + 8 * g4) * 2);
              iacc = MFMA16(aq[ks], bc, iacc); }
#pragma unroll
          for (int r = 0; r < 4; ++r) { const float num = nacc[r] + si[r] * iacc[r]; const float hvv = num * __builtin_amdgcn_rcpf(fmaxf(fabsf(dn[r]), en[r])); hv[d4][r] = hvv; ss[r] += hvv * hvv; } }
#pragma unroll
      for (int r = 0; r < 4; ++r) { float t = ss[r]; t += __shfl_xor(t, 1); t += __shfl_xor(t, 2); t += __shfl_xor(t, 4); t += __shfl_xor(t, 8);
          if (l15 == 0) fl[512 + hf * 64 + 16 * jt + 4 * g4 + r] = t; } }
    __syncthreads();
    { float rinv[4];
#pragma unroll
      for (int r = 0; r < 4; ++r) { const int j = 16 * jt + 4 * g4 + r; rinv[r] = rsqrtf((fl[512 + j] + fl[576 + j]) * (1.0f / 128.0f) + EPS); }
#pragma unroll
      for (int d4 = 0; d4 < 4; ++d4) { const int d = 16 * (4 * hf + d4) + l15; const float gg = gmo_r[d4];
#pragma unroll
          for (int r = 0; r < 4; ++r) *(LAS bf16_t*)(L + HO + (16 * jt + 4 * g4 + r) * VR + d * 2) = f2bf(hv[d4][r] * rinv[r] * gg); } }
    __syncthreads();
    { const u32x4 h0 = *(const LAS u32x4*)(L + HO + lr * VR + ls * 32), h1 = *(const LAS u32x4*)(L + HO + lr * VR + ls * 32 + 16);
#define HG(hw, ow, lo) ((lo ? bf_lo(hw) : bf_hi(hw)) * sigmoidf_(lo ? bf_lo(ow) : bf_hi(ow)) * H8_SCALE)
      u32x4 r;
      r.x = pk4_fp8(HG(h0.x, oc0.x, 1), HG(h0.x, oc0.x, 0), HG(h0.y, oc0.y, 1), HG(h0.y, oc0.y, 0));
      r.y = pk4_fp8(HG(h0.z, oc0.z, 1), HG(h0.z, oc0.z, 0), HG(h0.w, oc0.w, 1), HG(h0.w, oc0.w, 0));
      r.z = pk4_fp8(HG(h1.x, oc1.x, 1), HG(h1.x, oc1.x, 0), HG(h1.y, oc1.y, 1), HG(h1.y, oc1.y, 0));
      r.w = pk4_fp8(HG(h1.z, oc1.z, 1), HG(h1.z, oc1.z, 0), HG(h1.w, oc1.w, 1), HG(h1.w, oc1.w, 0));
#undef HG
      *(u32x4*)(hm + (tok0 + lr) * 1024 + h * 128 + ls * 16) = r; }
}

__device__ __forceinline__ void mlstm_passC2(Frame& F, const Args& a, int ua, int ub) {
    constexpr int QS = 0, KS = 9216, VS = 18432, SB = 35840, CB = 45056, HO = 0, FLO = 63488, CH = 66560, RS = ML_RS, VR = ML_VR;
    const bf16_t* z = (const bf16_t*)(F.ws + WS_Z); const float* gates = (const float*)(F.ws + WS_GATES);
    unsigned char* hm = F.ws + WS_HM;
    int tid = F.tid; asm volatile("" : "+v"(tid));
    const int lane = tid & 63, w = F.wave, l15 = lane & 15, g4 = lane >> 4;
    const int lr = tid >> 3, ls = tid & 7, jt = w & 3, hf = w >> 2;
    u32x4 qv[2], kv[2], v0[2], v1[2], oc0[2], oc1[2], c0[2], c1[2];
    float mstate[2], gi_raw[2], gf_raw[2], big[2], bfg[2], nin_l[2], gmo_r[2][4];
    size_t tok0[2]; int hh[2];
#pragma unroll
    for (int k = 0; k < 2; ++k) {
        const int u = k ? ub : ua, c = u & 31, h = (u >> 5) & 7, b = u >> 8;
        hh[k] = h; tok0[k] = (size_t)b * SEQ + c * 64;
        const bf16_t* zr = z + (tok0[k] + lr) * ZP;
        qv[k] = *(const u32x4*)(zr + ZQA + h * 64 + ls * 8); kv[k] = *(const u32x4*)(zr + ZKA + h * 64 + ls * 8);
        v0[k] = *(const u32x4*)(zr + ZVA + h * 128 + ls * 8); v1[k] = *(const u32x4*)(zr + ZVA + h * 128 + 64 + ls * 8);
        oc0[k] = *(const u32x4*)(zr + ZOA + h * 128 + ls * 16); oc1[k] = *(const u32x4*)(zr + ZOA + h * 128 + ls * 16 + 8);
        const bf16_t* cin = (const bf16_t*)(F.ws + WS_CIN) + (size_t)u * 8192;
        c0[k] = *(const u32x4*)(cin + tid * 8); c1[k] = *(const u32x4*)(cin + 4096 + tid * 8);
        const float* msc = (const float*)(F.ws + WS_MSC) + (size_t)u * 4;
        mstate[k] = msc[2]; gi_raw[k] = gates[(tok0[k] + lane) * 16 + h]; gf_raw[k] = gates[(tok0[k] + lane) * 16 + 8 + h]; big[k] = a.in[I_BIG][h]; bfg[k] = a.in[I_BFG][h];
        nin_l[k] = ((const float*)(F.ws + WS_NIN))[(size_t)u * 64 + lane];
        const float* gmo = a.in[I_GMO] + h * 128;
#pragma unroll
        for (int d4 = 0; d4 < 4; ++d4) gmo_r[k][d4] = gmo[16 * (4 * hf + d4) + l15];
    }
    __syncthreads();
#pragma unroll
    for (int k = 0; k < 2; ++k) {
        LAS unsigned char* L = F.lds + k * CH; LAS float* fl = (LAS float*)(L + FLO);
        if (w == k) {
            const ChunkGates G = chunk_gates(gi_raw[k], gf_raw[k], big[k], bfg[k], lane);
            const float M = fmaxf(mstate[k], G.pmx);
            fl[lane] = -M; fl[64 + lane] = G.u; fl[128 + lane] = __expf(mstate[k] - M); fl[192 + lane] = __expf(-(G.bcs + M));
        }
        if (w == 2 + k) fl[640 + lane] = nin_l[k];
        *(LAS u32x4*)(L + QS + lr * RS + ls * 16) = qv[k]; *(LAS u32x4*)(L + KS + lr * RS + ls * 16) = kv[k];
        *(LAS u32x4*)(L + VS + lr * VR + ls * 16) = v0[k]; *(LAS u32x4*)(L + VS + lr * VR + 128 + ls * 16) = v1[k];
        *(LAS u32x4*)(L + CB + lr * RS + ls * 16) = c0[k]; *(LAS u32x4*)(L + CB + (64 + lr) * RS + ls * 16) = c1[k];
    }
    __syncthreads();
#pragma unroll
    for (int k = 0; k < 2; ++k) {
        LAS unsigned char* L = F.lds + k * CH; LAS float* fl = (LAS float*)(L + FLO);
        { const LAS float* nv = fl + 640 + ls * 8; const u32x4 q = qv[k];
          float s = bf_lo(q.x) * nv[0] + bf_hi(q.x) * nv[1] + bf_lo(q.y) * nv[2] + bf_hi(q.y) * nv[3] + bf_lo(q.z) * nv[4] + bf_hi(q.z) * nv[5] + bf_lo(q.w) * nv[6] + bf_hi(q.w) * nv[7];
          s += __shfl_xor(s, 1); s += __shfl_xor(s, 2); s += __shfl_xor(s, 4);
          if (ls == 0) fl[320 + lr] = s * 0.125f; }
        { bf16x8 aq[2];
#pragma unroll
          for (int ks = 0; ks < 2; ++ks) aq[ks] = *(const LAS bf16x8*)(L + QS + (16 * jt + l15) * RS + (32 * ks + 8 * g4) * 2);
          float rsum[4] = {0.f, 0.f, 0.f, 0.f};
#pragma unroll
          for (int st2 = 0; st2 < 2; ++st2) { const int st = 2 * hf + st2; f32x4 s = {0.f, 0.f, 0.f, 0.f};
              if (st <= jt) {
#pragma unroll
                  for (int ks = 0; ks < 2; ++ks) { const bf16x8 bk = *(const LAS bf16x8*)(L + KS + (16 * st + l15) * RS + (32 * ks + 8 * g4) * 2); s = MFMA16(aq[ks], bk, s); } }
              const int scol = 16 * st + l15; const float cf = fl[64 + scol];
#pragma unroll
              for (int r = 0; r < 4; ++r) { const int j = 16 * jt + 4 * g4 + r;
                  const float val = (scol <= j) ? s[r] * 0.125f * __expf(fl[j] + cf) : 0.f; rsum[r] += val;
                  *(LAS bf16_t*)(L + SB + j * RS + scol * 2) = f2bf(val); } }
#pragma unroll
          for (int r = 0; r < 4; ++r) { float t = rsum[r]; t += __shfl_xor(t, 1); t += __shfl_xor(t, 2); t += __shfl_xor(t, 4); t += __shfl_xor(t, 8);
              if (l15 == 0) fl[384 + hf * 64 + 16 * jt + 4 * g4 + r] = t; } }
    }
    __syncthreads();
    float hv[2][4][4];
#pragma unroll
    for (int k = 0; k < 2; ++k) {
        LAS unsigned char* L = F.lds + k * CH; LAS float* fl = (LAS float*)(L + FLO);
        bf16x8 as_[2], aq[2];
#pragma unroll
        for (int ks = 0; ks < 2; ++ks) { as_[ks] = *(const LAS bf16x8*)(L + SB + (16 * jt + l15) * RS + (32 * ks + 8 * g4) * 2); aq[ks] = *(const LAS bf16x8*)(L + QS + (16 * jt + l15) * RS + (32 * ks + 8 * g4) * 2); }
        float si[4], dn[4], en[4], ss[4] = {0.f, 0.f, 0.f, 0.f};
#pragma unroll
        for (int r = 0; r < 4; ++r) { const int j = 16 * jt + 4 * g4 + r; si[r] = fl[128 + j]; dn[r] = fl[384 + j] + fl[448 + j] + si[r] * fl[320 + j]; en[r] = fl[192 + j]; si[r] *= 0.125f; }
#pragma unroll
        for (int d4 = 0; d4 < 4; ++d4) { const int dt = 4 * hf + d4; f32x4 nacc = {0.f, 0.f, 0.f, 0.f}, iacc = nacc;
#pragma unroll
            for (int ks = 0; ks < 2; ++ks) {
                LAS unsigned char* vp = L + VS + (32 * ks + 8 * g4 + (l15 >> 2)) * VR + (16 * dt + 4 * (l15 & 3)) * 2;
                nacc = MFMA16(as_[ks], cat8(tr16(vp), tr16(vp + 4 * VR)), nacc);
                const bf16x8 bc = *(const LAS bf16x8*)(L + CB + (16 * dt + l15) * RS + (32 * ks + 8 * g4) * 2);
                iacc = MFMA16(aq[ks], bc, iacc); }
#pragma unroll
            for (int r = 0; r < 4; ++r) { const float num = nacc[r] + si[r] * iacc[r]; const float hvv = num * __builtin_amdgcn_rcpf(fmaxf(fabsf(dn[r]), en[r])); hv[k][d4][r] = hvv; ss[r] += hvv * hvv; } }
#pragma unroll
        for (int r = 0; r < 4; ++r) { float t = ss[r]; t += __shfl_xor(t, 1); t += __shfl_xor(t, 2); t += __shfl_xor(t, 4); t += __shfl_xor(t, 8);
            if (l15 == 0) fl[512 + hf * 64 + 16 * jt + 4 * g4 + r] = t; }
    }
    __syncthreads();
#pragma unroll
    for (int k = 0; k < 2; ++k) {
        LAS unsigned char* L = F.lds + k * CH; LAS float* fl = (LAS float*)(L + FLO);
        float rinv[4];
#pragma unroll
        for (int r = 0; r < 4; ++r) { const int j = 16 * jt + 4 * g4 + r; rinv[r] = rsqrtf((fl[512 + j] + fl[576 + j]) * (1.0f / 128.0f) + EPS); }
#pragma unroll
        for (int d4 = 0; d4 < 4; ++d4) { const int d = 16 * (4 * hf + d4) + l15; const float gg = gmo_r[k][d4];
#pragma unroll
            for (int r = 0; r < 4; ++r) *(LAS bf16_t*)(L + HO + (16 * jt + 4 * g4 + r) * VR + d * 2) = f2bf(hv[k][d4][r] * rinv[r] * gg); }
    }
    __syncthreads();
#pragma unroll
    for (int k = 0; k < 2; ++k) {
        LAS unsigned char* L = F.lds + k * CH;
        const u32x4 h0 = *(const LAS u32x4*)(L + HO + lr * VR + ls * 32), h1 = *(const LAS u32x4*)(L + HO + lr * VR + ls * 32 + 16);
        const u32x4 o0 = oc0[k], o1 = oc1[k];
#define HG(hw, ow, lo) ((lo ? bf_lo(hw) : bf_hi(hw)) * sigmoidf_(lo ? bf_lo(ow) : bf_hi(ow)) * H8_SCALE)
        u32x4 r;
        r.x = pk4_fp8(HG(h0.x, o0.x, 1), HG(h0.x, o0.x, 0), HG(h0.y, o0.y, 1), HG(h0.y, o0.y, 0));
        r.y = pk4_fp8(HG(h0.z, o0.z, 1), HG(h0.z, o0.z, 0), HG(h0.w, o0.w, 1), HG(h0.w, o0.w, 0));
        r.z = pk4_fp8(HG(h1.x, o1.x, 1), HG(h1.x, o1.x, 0), HG(h1.y, o1.y, 1), HG(h1.y, o1.y, 0));
        r.w = pk4_fp8(HG(h1.z, o1.z, 1), HG(h1.z, o1.z, 0), HG(h1.w, o1.w, 1), HG(h1.w, o1.w, 0));
#undef HG
        *(u32x4*)(hm + (tok0[k] + lr) * 1024 + hh[k] * 128 + ls * 16) = r;
    }
}

template <bool FIXED>
__device__ __forceinline__ void moba_unit(Frame& F, const Args& a, int b, int h, int qb, const float B2) {
    constexpr int KT = 0, VT = 34816, KM = 88064, TS = 17408, VR = 272;
    LAS unsigned char* L = F.lds;
    const bf16_t* z = (const bf16_t*)(F.ws + WS_Z);
    const float* kmean = (const float*)(F.ws + WS_KMEAN) + ((size_t)b * 8 + h) * 8 * 128;
    unsigned char* ob = F.ws + WS_OB;
    int tid = F.tid; asm volatile("" : "+v"(tid));
    const int lane = tid & 63, w = F.wave, l15 = lane & 15, g4 = lane >> 4;
    const int q0 = qb * 256, blk = qb, ntile = 4 * qb + 4;
    const size_t tokb = (size_t)b * SEQ;
    __syncthreads();
    if (tid < 256) *(LAS f32x4*)(L + KM + tid * 16) = *(const f32x4*)(kmean + tid * 4);
    bf16x8 qf[2][4];
#pragma unroll
    for (int g = 0; g < 2; ++g) { const bf16_t* qr = z + (tokb + q0 + 32 * w + 16 * g + l15) * ZP + ZQB + h * 128 + 8 * g4;
#pragma unroll
        for (int ks = 0; ks < 4; ++ks) qf[g][ks] = *(const bf16x8*)(qr + 32 * ks); }
    const int key0 = tid >> 4, seg = tid & 15;
    const bf16_t* kbase = z + (tokb + key0) * ZP + ZKB + h * 128 + seg * 8;
    const bf16_t* vbase = z + (tokb + key0) * ZP + ZVB + h * 128 + seg * 8;
    u32x4 kA0 = *(const u32x4*)kbase, kA1 = *(const u32x4*)(kbase + (size_t)32 * ZP), vA0 = *(const u32x4*)vbase, vA1 = *(const u32x4*)(vbase + (size_t)32 * ZP);
    u32x4 kB0 = *(const u32x4*)(kbase + (size_t)64 * ZP), kB1 = *(const u32x4*)(kbase + (size_t)96 * ZP), vB0 = *(const u32x4*)(vbase + (size_t)64 * ZP), vB1 = *(const u32x4*)(vbase + (size_t)96 * ZP);
    __syncthreads();
    unsigned mymask[2];
#pragma unroll
    for (int g = 0; g < 2; ++g) {
        if (blk <= 3) mymask[g] = (1u << blk) - 1u;
        else {
            float gate[7];
#pragma unroll
            for (int n = 0; n < 7; ++n) { float s = 0.f;
                if (n < blk) {
#pragma unroll
                    for (int ks = 0; ks < 4; ++ks) { const LAS float* km = (const LAS float*)(L + KM) + n * 128 + 32 * ks + 8 * g4;
#pragma unroll
                        for (int j = 0; j < 8; ++j) s += bf1((bf16_t)qf[g][ks][j]) * km[j]; }
                    s += __shfl_xor(s, 16); s += __shfl_xor(s, 32); }
                gate[n] = (n < blk) ? s : -3.0e38f; }
            unsigned mm = 0u;
#pragma unroll
            for (int t = 0; t < 3; ++t) { float best = -3.0e38f; int bi = 0;
#pragma unroll
                for (int n = 0; n < 7; ++n) { const bool take = (n < blk) && !((mm >> n) & 1u) && (gate[n] > best); best = take ? gate[n] : best; bi = take ? n : bi; }
                mm |= 1u << bi; }
            mymask[g] = mm;
        }
    }
    f32x4 O[2][8];
#pragma unroll
    for (int g = 0; g < 2; ++g)
#pragma unroll
        for (int dt = 0; dt < 8; ++dt) O[g][dt] = (f32x4){0.f, 0.f, 0.f, 0.f};
    float mrun[2] = {-1.0e30f, -1.0e30f}, lsum[2] = {0.f, 0.f};
    const float SC = 0.08838834764831845f * 1.4426950408889634f;
#pragma unroll 1
    for (int kt2 = 0; kt2 < ntile; kt2 += 2) {
#pragma unroll
      for (int buf = 0; buf < 2; ++buf) {
        const int kt = kt2 + buf;
        { LAS unsigned char* kd = L + KT + buf * TS + key0 * VR + seg * 16; LAS unsigned char* vd = L + VT + buf * TS + key0 * VR + seg * 16;
          const int t2 = (kt + 2 < ntile) ? kt + 2 : ntile - 1;
          const size_t adv = (size_t)t2 * 64 * ZP;
          if (buf == 0) { *(LAS u32x4*)kd = kA0; *(LAS u32x4*)(kd + 32 * VR) = kA1; *(LAS u32x4*)vd = vA0; *(LAS u32x4*)(vd + 32 * VR) = vA1;
              kA0 = *(const u32x4*)(kbase + adv); kA1 = *(const u32x4*)(kbase + adv + (size_t)32 * ZP); vA0 = *(const u32x4*)(vbase + adv); vA1 = *(const u32x4*)(vbase + adv + (size_t)32 * ZP); }
          else { *(LAS u32x4*)kd = kB0; *(LAS u32x4*)(kd + 32 * VR) = kB1; *(LAS u32x4*)vd = vB0; *(LAS u32x4*)(vd + 32 * VR) = vB1;
              kB0 = *(const u32x4*)(kbase + adv); kB1 = *(const u32x4*)(kbase + adv + (size_t)32 * ZP); vB0 = *(const u32x4*)(vbase + adv); vB1 = *(const u32x4*)(vbase + adv + (size_t)32 * ZP); } }
        __syncthreads();
        const int kb = kt >> 2; const bool past = kb < blk;
        const int kmin = 64 * kt;
        int cls[2];
#pragma unroll
        for (int g = 0; g < 2; ++g) { const int qmin = q0 + 32 * w + 16 * g; cls[g] = past ? 1 : ((kmin + 63 <= qmin) ? 1 : ((kmin > qmin + 15) ? 0 : 2)); }
        if ((cls[0] | cls[1]) != 0) {
            f32x4 st[2][4];
#pragma unroll
            for (int nt = 0; nt < 4; ++nt) { st[0][nt] = (f32x4){0.f, 0.f, 0.f, 0.f}; st[1][nt] = st[0][nt];
                bf16x8 bk[4];
#pragma unroll
                for (int ks = 0; ks < 4; ++ks) bk[ks] = *(const LAS bf16x8*)(L + KT + buf * TS + (16 * nt + l15) * VR + (32 * ks + 8 * g4) * 2);
                __builtin_amdgcn_sched_barrier(0);
#pragma unroll
                for (int ks = 0; ks < 4; ++ks) { st[0][nt] = MFMA16(bk[ks], qf[0][ks], st[0][nt]); st[1][nt] = MFMA16(bk[ks], qf[1][ks], st[1][nt]); }
                __builtin_amdgcn_sched_barrier(0); }
            bf16x8 pf[2][2];
#pragma unroll
            for (int g = 0; g < 2; ++g) {
                float pv[4][4]; float mnew = 0.f, alpha = 1.0f;
                if (FIXED) {
                    if (cls[g] == 1) {
                        const bool sel = past ? (((mymask[g] >> kb) & 1u) != 0u) : true;
                        const float nb = sel ? -B2 : -1.0e30f;
#pragma unroll
                        for (int nt = 0; nt < 4; ++nt)
#pragma unroll
                            for (int r = 0; r < 4; ++r) pv[nt][r] = __builtin_amdgcn_exp2f(fmaf(st[g][nt][r], SC, nb));
                    } else if (cls[g] == 2) {
                        const int qpos = q0 + 32 * w + 16 * g + l15;
#pragma unroll
                        for (int nt = 0; nt < 4; ++nt)
#pragma unroll
                            for (int r = 0; r < 4; ++r) { const bool ok = (kmin + 16 * nt + 4 * g4 + r) <= qpos; pv[nt][r] = __builtin_amdgcn_exp2f(ok ? fmaf(st[g][nt][r], SC, -B2) : -1.0e30f); }
                    } else {
#pragma unroll
                        for (int nt = 0; nt < 4; ++nt)
#pragma unroll
                            for (int r = 0; r < 4; ++r) pv[nt][r] = 0.f;
                    }
                } else if (cls[g] == 1) {
                    const bool sel = past ? (((mymask[g] >> kb) & 1u) != 0u) : true;
                    float mx = fmaxf(fmaxf(fmaxf(st[g][0][0], st[g][0][1]), fmaxf(st[g][0][2], st[g][0][3])), fmaxf(fmaxf(st[g][1][0], st[g][1][1]), fmaxf(st[g][1][2], st[g][1][3])));
                    mx = fmaxf(mx, fmaxf(fmaxf(fmaxf(st[g][2][0], st[g][2][1]), fmaxf(st[g][2][2], st[g][2][3])), fmaxf(fmaxf(st[g][3][0], st[g][3][1]), fmaxf(st[g][3][2], st[g][3][3]))));
                    mx = sel ? mx * SC : -1.0e30f;
                    mx = fmaxf(mx, __shfl_xor(mx, 16)); mx = fmaxf(mx, __shfl_xor(mx, 32));
                    mnew = fmaxf(mrun[g], mx); alpha = __builtin_amdgcn_exp2f(mrun[g] - mnew);
                    const float nb = sel ? -mnew : -1.0e30f;
#pragma unroll
                    for (int nt = 0; nt < 4; ++nt)
#pragma unroll
                        for (int r = 0; r < 4; ++r) pv[nt][r] = __builtin_amdgcn_exp2f(fmaf(st[g][nt][r], SC, nb));
                } else if (cls[g] == 2) {
                    const int qpos = q0 + 32 * w + 16 * g + l15; float sv[4][4]; float mx = -1.0e30f;
#pragma unroll
                    for (int nt = 0; nt < 4; ++nt)
#pragma unroll
                        for (int r = 0; r < 4; ++r) { const bool ok = (kmin + 16 * nt + 4 * g4 + r) <= qpos; sv[nt][r] = ok ? st[g][nt][r] * SC : -1.0e30f; mx = fmaxf(mx, sv[nt][r]); }
                    mx = fmaxf(mx, __shfl_xor(mx, 16)); mx = fmaxf(mx, __shfl_xor(mx, 32));
                    mnew = fmaxf(mrun[g], mx); alpha = __builtin_amdgcn_exp2f(mrun[g] - mnew);
#pragma unroll
                    for (int nt = 0; nt < 4; ++nt)
#pragma unroll
                        for (int r = 0; r < 4; ++r) pv[nt][r] = (sv[nt][r] > -1.0e29f) ? __builtin_amdgcn_exp2f(sv[nt][r] - mnew) : 0.f;
                } else {
                    mnew = mrun[g]; alpha = 1.0f;
#pragma unroll
                    for (int nt = 0; nt < 4; ++nt)
#pragma unroll
                        for (int r = 0; r < 4; ++r) pv[nt][r] = 0.f;
                }
                float ps = 0.f;
#pragma unroll
                for (int nt = 0; nt < 4; ++nt) ps += (pv[nt][0] + pv[nt][1]) + (pv[nt][2] + pv[nt][3]);
                if (FIXED) lsum[g] += ps;
                else { mrun[g] = mnew; lsum[g] = lsum[g] * alpha + ps;
#pragma unroll
                    for (int dt = 0; dt < 8; ++dt) O[g][dt] *= alpha; }
#pragma unroll
                for (int k2 = 0; k2 < 2; ++k2) {
                    u32x4 pw4; pw4.x = pk2(pv[2 * k2][0], pv[2 * k2][1]); pw4.y = pk2(pv[2 * k2][2], pv[2 * k2][3]); pw4.z = pk2(pv[2 * k2 + 1][0], pv[2 * k2 + 1][1]); pw4.w = pk2(pv[2 * k2 + 1][2], pv[2 * k2 + 1][3]);
                    pf[g][k2] = __builtin_bit_cast(bf16x8, pw4); }
            }
            bf16x8 vf[2][4];
#define MOBA_VREAD(bq, slot) do { _Pragma("unroll") for (int d = 0; d < 4; ++d) { const int k2_ = (bq) >> 1, dt_ = 4 * ((bq) & 1) + d; \
                LAS unsigned char* vp = L + VT + buf * TS + (32 * k2_ + 4 * g4 + (l15 >> 2)) * VR + (16 * dt_ + 4 * (l15 & 3)) * 2; vf[slot][d] = cat8(tr16(vp), tr16(vp + 16 * VR)); } } while (0)
            MOBA_VREAD(0, 0);
#pragma unroll
            for (int bq = 0; bq < 4; ++bq) {
                if (bq + 1 < 4) MOBA_VREAD(bq + 1, (bq + 1) & 1);
                __builtin_amdgcn_sched_barrier(0);
#pragma unroll
                for (int d = 0; d < 4; ++d) { const int k2 = bq >> 1, dt = 4 * (bq & 1) + d;
                    O[0][dt] = MFMA16(vf[bq & 1][d], pf[0][k2], O[0][dt]); O[1][dt] = MFMA16(vf[bq & 1][d], pf[1][k2], O[1][dt]); }
                __builtin_amdgcn_sched_barrier(0);
            }
#undef MOBA_VREAD
        }
      }
    }
#pragma unroll
    for (int g = 0; g < 2; ++g) { float t = lsum[g]; t += __shfl_xor(t, 16); t += __shfl_xor(t, 32);
      const float inv = O8_SCALE / t; unsigned char* op = ob + (tokb + q0 + 32 * w + 16 * g + l15) * 1024 + h * 128 + 4 * g4;
#pragma unroll
      for (int dt = 0; dt < 8; ++dt) *(unsigned*)(op + 16 * dt) = pk4_fp8(O[g][dt][0] * inv, O[g][dt][1] * inv, O[g][dt][2] * inv, O[g][dt][3] * inv); }
}

__device__ __forceinline__ void p4_mixers(Frame& F, const Args& a, bool with_cvt) {
    LAS int* qslot = (LAS int*)(F.lds + 140032);
    const int total = with_cvt ? 768 + 256 : 768;
    const float B2 = __builtin_bit_cast(float, __builtin_amdgcn_readfirstlane((int)__hip_atomic_load(F.ctl + CW_MISC, __ATOMIC_RELAXED, __HIP_MEMORY_SCOPE_AGENT)));
    const bool fixed_ok = B2 <= 40.0f;
    for (;;) {
        __syncthreads();
        if (F.tid == 0) *qslot = (int)__hip_atomic_fetch_add(F.ctl + CW_QUEUE, 1u, __ATOMIC_RELAXED, __HIP_MEMORY_SCOPE_AGENT);
        __syncthreads();
        const int idx = *qslot;
        __syncthreads();
        if (idx >= total) break;
        int it = idx;
        if (with_cvt) { const int g = idx >> 2, r = idx & 3; if (r == 3) { cvt8_item(F, a, 512 + g); continue; } it = 3 * g + r; }
        if (it < 256) { if (fixed_ok) moba_unit<true>(F, a, (it & 31) >> 3, it & 7, 7 - (it >> 5), B2); else moba_unit<false>(F, a, (it & 31) >> 3, it & 7, 7 - (it >> 5), B2); }
        else mlstm_passC2(F, a, it - 256, it - 256 + 512);
    }
}

__device__ __forceinline__ void p7_router(Frame& F, const Args& a) {
    unsigned char* ws = F.ws;
    const float* modf = (const float*)(ws + WS_MODF);
    const bf16_t* wrf = (const bf16_t*)(ws + WS_WRF);
    int* toke = (int*)(ws + WS_TOKE); float* tokw = (float*)(ws + WS_TOKW); int* toks = (int*)(ws + WS_TOKS); float* roww = (float*)(ws + WS_ROWW);
    unsigned char* tA = ws + WS_TA;
    LAS float* part = (LAS float*)(F.lds + PART_OFF);
    LAS float* logit = (LAS float*)(F.lds + LOGIT_OFF);
    LAS int* dstl = (LAS int*)(F.lds + DST_OFF);
    LAS int* lcnt = (LAS int*)(F.lds + DST_OFF + 512);
    const int lane = F.lane, l15 = lane & 15, g4 = lane >> 4;
    for (int rb = F.wg; rb < T / 32; rb += F.G) {
        norm_rows_32_b(F, (const bf16_t*)(ws + WS_X1), a.in[I_GFFN], modf, 3, rb);
        { const int rg = F.wave & 1, ct = (F.wave >> 1) & 1, kh = F.wave >> 2; f32x4 acc = {0.f, 0.f, 0.f, 0.f};
          bf16x8 bvv[32];
          __builtin_amdgcn_sched_barrier(0);
          const bf16_t* wq = wrf + ((size_t)ct * 4096 + (size_t)(32 * kh) * 64 + lane) * 8; asm volatile("" : "+v"(wq));
#pragma unroll
          for (int s = 0; s < 32; ++s) bvv[s] = *(const bf16x8*)(wq + (size_t)s * 512);
          __syncthreads();
#pragma unroll
          for (int s = 0; s < 32; ++s) { const int ks = 32 * kh + s;
              const bf16x8 av = *(const LAS bf16x8*)(F.lds + (16 * rg + l15) * HL_STRIDE + (32 * ks + 8 * g4) * 2);
              acc = __builtin_amdgcn_mfma_f32_16x16x32_bf16(av, bvv[s], acc, 0, 0, 0); }
#pragma unroll
          for (int r = 0; r < 4; ++r) part[((kh * 2 + rg) * 2 + ct) * 256 + (4 * g4 + r) * 16 + l15] = acc[r]; }
        __syncthreads();
#pragma unroll
        for (int q = 0; q < 2; ++q) { const int o = F.tid + 512 * q, row = o >> 5, e = o & 31, rg = row >> 4, ct = e >> 4;
            logit[o] = part[((0 * 2 + rg) * 2 + ct) * 256 + (row & 15) * 16 + (e & 15)] + part[((1 * 2 + rg) * 2 + ct) * 256 + (row & 15) * 16 + (e & 15)] + a.in[I_BR][e]; }
        __syncthreads();
        if (F.tid < 32) {
            const int row = F.tid; const size_t tok = (size_t)rb * 32 + row;
            lcnt[row] = 0;
            float v[NE];
#pragma unroll
            for (int e = 0; e < NE; ++e) v[e] = logit[row * NE + e];
            float tv[4]; int ti[4]; unsigned used = 0u;
#pragma unroll
            for (int k = 0; k < 4; ++k) { float best = -3.0e38f; int bi = 0;
#pragma unroll
                for (int e = 0; e < NE; ++e) { const bool take = !((used >> e) & 1u) && (v[e] > best); best = take ? v[e] : best; bi = take ? e : bi; }
                used |= 1u << bi; tv[k] = best; ti[k] = bi; }
            float ex[4], sum = 0.f;
#pragma unroll
            for (int k = 0; k < 4; ++k) { ex[k] = __expf(tv[k] - tv[0]); sum += ex[k]; }
            const float inv = 1.0f / sum;
            int lr[4];
#pragma unroll
            for (int k = 0; k < 4; ++k) lr[k] = __hip_atomic_fetch_add(lcnt + ti[k], 1, __ATOMIC_RELAXED, __HIP_MEMORY_SCOPE_WORKGROUP);
            __builtin_amdgcn_wave_barrier();
            { const int mine = lcnt[row];
              int base = 0; if (mine > 0) base = (int)__hip_atomic_fetch_add(F.ctl + CW_CNT + 64 * row, (unsigned)mine, __ATOMIC_RELAXED, __HIP_MEMORY_SCOPE_AGENT);
              lcnt[32 + row] = base; }
            __builtin_amdgcn_wave_barrier();
#pragma unroll
            for (int k = 0; k < 4; ++k) {
                const int slot = lcnt[32 + ti[k]] + lr[k];
                const float wk = ex[k] * inv;
                toke[tok * 4 + k] = ti[k]; tokw[tok * 4 + k] = wk; toks[tok * 4 + k] = slot;
                roww[(size_t)ti[k] * ECAP + slot] = wk;
                dstl[row * 4 + k] = ti[k] * ECAP + slot;
            }
        }
        __syncthreads();
#pragma unroll 1
        for (int i = 0; i < 4; ++i) { const int r = 4 * F.wave + i;
            u32x4 q8[2];
#pragma unroll
            for (int cidx = 0; cidx < 2; ++cidx) { const int ch = lane + 64 * cidx;
                const u32x4 lo = *(const LAS u32x4*)(F.lds + r * HL_STRIDE + ch * 32), hi = *(const LAS u32x4*)(F.lds + r * HL_STRIDE + ch * 32 + 16);
                q8[cidx].x = pk4_fp8(bf_lo(lo.x), bf_hi(lo.x), bf_lo(lo.y), bf_hi(lo.y)); q8[cidx].y = pk4_fp8(bf_lo(lo.z), bf_hi(lo.z), bf_lo(lo.w), bf_hi(lo.w));
                q8[cidx].z = pk4_fp8(bf_lo(hi.x), bf_hi(hi.x), bf_lo(hi.y), bf_hi(hi.y)); q8[cidx].w = pk4_fp8(bf_lo(hi.z), bf_hi(hi.z), bf_lo(hi.w), bf_hi(hi.w)); }
#pragma unroll
            for (int k = 0; k < 4; ++k) { unsigned char* dp = tA + (size_t)dstl[r * 4 + k] * D;
#pragma unroll
                for (int cidx = 0; cidx < 2; ++cidx) *(u32x4*)(dp + (lane + 64 * cidx) * 16) = q8[cidx]; } }
        __syncthreads();
    }
}

__device__ __forceinline__ void moe_tables(Frame& F) {
    LAS int* tb = (LAS int*)(F.lds + LDS_TABS);
    __syncthreads();
    if (F.wave == 0) {
        const int e = F.lane & 31;
        const int cnt = (int)__hip_atomic_load(F.ctl + CW_CNT + 64 * e, __ATOMIC_RELAXED, __HIP_MEMORY_SCOPE_AGENT);
        const int tl = (cnt + 255) >> 8;
        int inc = tl;
#pragma unroll
        for (int o = 1; o < 32; o <<= 1) { const int t = __shfl_up(inc, o); if (e >= o) inc += t; }
        const int exc = inc - tl;
        if (F.lane < 32) {
            tb[e] = tl; tb[32 + e] = exc * 256; tb[64 + e] = e * ECAP; tb[96 + e] = exc * 16; tb[160 + e] = exc * 8;
            if (e == NE - 1) { tb[96 + NE] = inc * 16; tb[160 + NE] = inc * 8; }
        }
    }
    __syncthreads();
}

__device__ __forceinline__ void p10_combine(Frame& F, const Args& a) {
    unsigned char* ws = F.ws;
    const bf16_t* x1 = (const bf16_t*)(ws + WS_X1); const unsigned char* ydn = ws + WS_YDN; const float* modf = (const float*)(ws + WS_MODF);
    const int* toke = (const int*)(ws + WS_TOKE); const int* toks = (const int*)(ws + WS_TOKS);
    const LAS int* tb = (const LAS int*)(F.lds + LDS_TABS);
    int tz = threadIdx.x; asm volatile("" : "+v"(tz));
    const int gw = F.vcu * 8 + F.wave, NGW = F.G * 8, lane = tz & 63;
    for (int tok = gw; tok < T; tok += NGW) {
        const float* gt = modf + (size_t)(tok >> 11) * (6 * D) + 5 * D;
        const unsigned char* yr[4];
#pragma unroll
        for (int k = 0; k < 4; ++k) yr[k] = ydn + (size_t)(tb[32 + toke[tok * 4 + k]] + toks[tok * 4 + k]) * D;
        u32x2 y[4][4]; u32x4 xq[4]; f32x4 g0[4], g1[4];
#pragma unroll
        for (int j = 0; j < 4; ++j) { const int col = 8 * (lane + 64 * j);
#pragma unroll
            for (int k = 0; k < 4; ++k) y[j][k] = __builtin_nontemporal_load((const u32x2*)(yr[k] + col));
            xq[j] = __builtin_nontemporal_load((const u32x4*)(x1 + (size_t)tok * D + col));
            g0[j] = *(const f32x4*)(gt + col); g1[j] = *(const f32x4*)(gt + col + 4); }
        __builtin_amdgcn_sched_barrier(0);
#pragma unroll
        for (int j = 0; j < 4; ++j) { const int col = 8 * (lane + 64 * j);
            f32x4 s0 = {0.f, 0.f, 0.f, 0.f}, s1 = s0;
#pragma unroll
            for (int k = 0; k < 4; ++k) {
                const f32x2 p0 = __builtin_amdgcn_cvt_pk_f32_fp8((int)y[j][k].x, false), p1 = __builtin_amdgcn_cvt_pk_f32_fp8((int)y[j][k].x, true);
                const f32x2 p2 = __builtin_amdgcn_cvt_pk_f32_fp8((int)y[j][k].y, false), p3 = __builtin_amdgcn_cvt_pk_f32_fp8((int)y[j][k].y, true);
                s0[0] += p0[0]; s0[1] += p0[1]; s0[2] += p1[0]; s0[3] += p1[1]; s1[0] += p2[0]; s1[1] += p2[1]; s1[2] += p3[0]; s1[3] += p3[1]; }
            const size_t o = (size_t)tok * D + col;
            const f32x4 xa = {bf_lo(xq[j].x), bf_hi(xq[j].x), bf_lo(xq[j].y), bf_hi(xq[j].y)}, xb = {bf_lo(xq[j].z), bf_hi(xq[j].z), bf_lo(xq[j].w), bf_hi(xq[j].w)};
            __builtin_nontemporal_store(xa + g0[j] * (s0 * (1.0f / YD_SCALE)), (f32x4*)(a.out + o));
            __builtin_nontemporal_store(xb + g1[j] * (s1 * (1.0f / YD_SCALE)), (f32x4*)(a.out + o + 4)); }
    }
}

__global__ void __launch_bounds__(512, 2) hybrid_fwd(Args args) {
    extern __shared__ __attribute__((aligned(16))) unsigned char lds_raw[];
    Frame F;
    F.lds = (LAS unsigned char*)lds_raw; F.ws = args.ws; F.ctl = (unsigned*)(args.ws + WS_CTL);
    F.tid = threadIdx.x; F.lane = F.tid & 63; F.wave = __builtin_amdgcn_readfirstlane(F.tid >> 6);
    F.G = gridDim.x; F.wg = blockIdx.x; F.vcu = (F.G % 8 == 0) ? (F.wg % 8) * (F.G / 8) + F.wg / 8 : F.wg;
    if (F.tid < 4) ((LAS unsigned*)(F.lds + LDS_XB))[F.tid] = 0u;
    __syncthreads();
    XcdBarrier bar; bar.bar = F.ctl + CW_BAR; bar.x = 0; bar.st = nullptr;
#if !MK_PER_PHASE
    bar = xcd_barrier_post(F.ctl + CW_BAR, (volatile LAS unsigned*)(F.lds + LDS_XB));
#endif
    const int lo = args.ph_lo, hi = args.ph_hi;
#define IN(k) (lo <= (k) && (k) < hi)
#define SEAM(k) do { if (IN(k) && IN((k) + 1)) xcd_barrier(bar); } while (0)
    unsigned char* ws = args.ws;

    if (IN(0)) { p0_prologue(F, args); } SEAM(0);
    if (IN(1)) { p1_rows(F, args); } SEAM(1);
    const bool cv_ok = (F.G == 256);
    if (IN(2)) {
        pg8::DenseOrder S0; S0.init(ws + WS_HBUF8, ws + WS_WIN8, T, ZP, F.G, F.wg);
        EpiZT<true> E{(bf16_t*)(ws + WS_Z), ZP, args.in[I_GQ], args.in[I_GK], (float*)(ws + WS_KMEAN), F.lds + 131072};
        unsigned gaps = 0u;
        if (cv_ok) { int c = F.wg % 15, g0 = 0; while (c >= 5 - g0) { c -= 5 - g0; ++g0; } gaps = (1u << g0) | (1u << (g0 + 1 + c)); }
        int cvn = F.wg * 2;
        if (!cv_ok) { for (int idx = F.wg; idx < 1536; idx += F.G) cvt8_item(F, args, idx); }
        int lo = 0;
#pragma unroll 1
        for (int seg = 0; seg < 3; ++seg) {
            if ((gaps >> lo) & 1u) { cvt8_item(F, args, cvn++); gaps &= ~(1u << lo); }
            int hi = lo + 1; while (hi < 5 && !((gaps >> hi) & 1u)) ++hi;
            if (lo < 5) { pg8::SubOrder<pg8::DenseOrder> S{S0, lo, hi - lo}; pg8::gemm_phase<EpiZT<true>, pg8::SubOrder<pg8::DenseOrder>, true>(F.lds, D / 2, S, E); }
            lo = hi;
        }
        if (gaps & 32u) cvt8_item(F, args, cvn++);
    } SEAM(2);
    if (IN(3) && F.G == 256) { mlstm_passA4(F, args); }
    else if (IN(3)) {
        PassAIn cur = mlstm_passA_load(F, F.wg < 1024 ? F.wg : 0);
        for (int u = F.wg; u < 1024; u += F.G) { const int un = u + F.G; const PassAIn nxt = mlstm_passA_load(F, un < 1024 ? un : u); mlstm_passA(F, args, u, cur); cur = nxt; }
    } SEAM(3);
    if (IN(11)) { for (int it = F.wg; it < 256; it += F.G) mlstm_passB(F, it); }
    if (IN(3) && IN(4)) xcd_barrier(bar);
    if (IN(4)) { p4_mixers(F, args, F.G == 256); } SEAM(4);
    if (IN(5)) {
        if (cv_ok && (F.wg & 1) == 0) cvt8_item(F, args, 768 + F.wg);
        { pg8::PairOrder S; S.d.init(ws + WS_HM, ws + WS_WA, T, D, F.G, F.wg); S.A2 = (const char*)(ws + WS_OB); S.Bt2 = (const char*)(ws + WS_WB);
          EpiBranchAB E{(const bf16_t*)(ws + WS_Z), ws + WS_YBUF8};
          pg8::gemm_phase<EpiBranchAB, pg8::PairOrder, true>(F.lds, 512, S, E); }
        if (cv_ok && (F.wg & 1) == 1) cvt8_item(F, args, 768 + F.wg);
    } SEAM(5);
    if (IN(6)) {
        if (cv_ok && (F.wg & 1) == 0) cvt8_item(F, args, 1024 + F.wg);
        pg8::DenseOrder S; S.init(ws + WS_YBUF8, ws + WS_WOUT8, T, D, F.G, F.wg);
        EpiOut E{args.in[I_X], (const float*)(ws + WS_MODF), (bf16_t*)(ws + WS_X1)};
        pg8::gemm_phase<EpiOut, pg8::DenseOrder, true>(F.lds, D / 2, S, E);
        if (cv_ok && (F.wg & 1) == 1) cvt8_item(F, args, 1024 + F.wg);
    } SEAM(6);
    if (IN(7)) { p7_router(F, args); } SEAM(7);
    if (IN(8)) {
        moe_tables(F);
        const LAS int* tb = (const LAS int*)(F.lds + LDS_TABS);
        pg8::MoeOrder S{(const char*)(ws + WS_TA), (const char*)(ws + WS_WUP), tb, tb + 64, tb + 96, 16, F.G, F.vcu, (size_t)(2 * D) * D, __builtin_amdgcn_readfirstlane(tb[96 + NE]), nullptr, 0u};
        EpiUpT<true> E{ws + WS_ACT, args.in[I_BUP], tb + 32, F.ctl + CW_UPD};
        const int cut = cv_ok ? (F.wg & 7) : 0;
        if (cut > 0) { pg8::SubOrder<pg8::MoeOrder> S1{S, 0, cut}; pg8::gemm_phase<EpiUpT<true>, pg8::SubOrder<pg8::MoeOrder>, true>(F.lds, D / 2, S1, E); }
        if (cv_ok) cvt8_item_signal(F, args, 1280 + F.wg, F.ctl + CW_UPD);
        { pg8::SubOrder<pg8::MoeOrder> S2{S, cut, 1 << 20}; pg8::gemm_phase<EpiUpT<true>, pg8::SubOrder<pg8::MoeOrder>, true>(F.lds, D / 2, S2, E); }
    }
    if (IN(9)) {
        if (!IN(8)) moe_tables(F);
        const LAS int* tb = (const LAS int*)(F.lds + LDS_TABS);
        const int utot = __builtin_amdgcn_readfirstlane(tb[96 + NE]);
        pg8::MoeDepOrder S{(const char*)(ws + WS_ACT), (const char*)(ws + WS_WDN), tb, tb + 32, tb + 160, 8, F.G, (F.vcu - utot % F.G + F.G) % F.G, (size_t)D * D, __builtin_amdgcn_readfirstlane(tb[160 + NE]), F.ctl + CW_UPD, cv_ok ? 16u : 0u};
        EpiDown E{ws + WS_YDN, args.in[I_BDN], (const float*)(ws + WS_ROWW), tb + 32};
        pg8::gemm_phase<EpiDown, pg8::MoeDepOrder, true>(F.lds, D / 2, S, E);
    } SEAM(9);
    if (IN(10)) { if (!IN(8) && !IN(9)) moe_tables(F); p10_combine(F, args); }
#undef IN
#undef SEAM
}

constexpr int N_PHASES = 12;
extern "C" void kernel_launch(void* const* d_in, const int* in_sizes, int n_in, void* d_out, int out_size, void* d_ws, size_t ws_size, hipStream_t stream) {
    static int grid = 0;
    if (grid == 0) {
        if (n_in != 21 || out_size != T * D || ws_size < WS_END) { fprintf(stderr, "kernel_launch: unexpected problem (n_in %d out %d ws %zu)\n", n_in, out_size, ws_size); grid = -1; return; }
        int dev = 0, cus = 0, per_cu = 0;
        if (hipGetDevice(&dev) != hipSuccess || hipDeviceGetAttribute(&cus, hipDeviceAttributeMultiprocessorCount, dev) != hipSuccess) { grid = -1; return; }
        if (hipFuncSetAttribute((const void*)hybrid_fwd, hipFuncAttributeMaxDynamicSharedMemorySize, LDS_BYTES) != hipSuccess) { fprintf(stderr, "kernel_launch: hipFuncSetAttribute failed\n"); grid = -1; return; }
        if (hipOccupancyMaxActiveBlocksPerMultiprocessor(&per_cu, (const void*)hybrid_fwd, 512, LDS_BYTES) != hipSuccess || per_cu < 1) fprintf(stderr, "kernel_launch: occupancy query says %d\n", per_cu);
        (void)hipGetLastError();
        grid = cus;
    }
    if (grid < 0) return;
    if (hipMemsetAsync((char*)d_ws + WS_CTL, 0, CTL_BYTES, stream) != hipSuccess) return;
    Args a{};
    for (int i = 0; i < 21; ++i) a.in[i] = (const float*)d_in[i];
    a.out = (float*)d_out; a.ws = (unsigned char*)d_ws;
#if MK_PER_PHASE
    for (int p = 0; p < N_PHASES; ++p) { a.ph_lo = p; a.ph_hi = p + 1; hipLaunchKernelGGL(hybrid_fwd, dim3(grid), dim3(512), LDS_BYTES, stream, a); }
#else
    a.ph_lo = 0; a.ph_hi = N_PHASES;
    hipLaunchKernelGGL(hybrid_fwd, dim3(grid), dim3(512), LDS_BYTES, stream, a);
#endif
}
```

```cpp
#include <hip/hip_runtime.h>
#include <cstdio>
#include <cstdint>

#ifndef MK_PER_PHASE
#define MK_PER_PHASE 0
#endif

#define LAS __attribute__((address_space(3)))
#define GAS __attribute__((address_space(1)))
typedef unsigned short bf16_t;
typedef short bf16x8 __attribute__((ext_vector_type(8)));
typedef short s16x4 __attribute__((ext_vector_type(4)));
typedef float f32x4 __attribute__((ext_vector_type(4)));
typedef float f32x2 __attribute__((ext_vector_type(2)));
typedef unsigned u32x4 __attribute__((ext_vector_type(4)));
typedef unsigned u32x2 __attribute__((ext_vector_type(2)));
typedef int i32x8 __attribute__((ext_vector_type(8)));
typedef int i32x4 __attribute__((ext_vector_type(4)));

constexpr int D = 2048, NB = 4, SEQ = 2048, T = NB * SEQ;
constexpr int DIN = 10256, ZP = 10240;
constexpr int ZQA = 0, ZKA = 512, ZVA = 1024, ZOA = 2048, ZQB = 3072, ZKB = 4096, ZVB = 5120, ZGA = 6144, ZGB = 8192;
constexpr int GATE_COL = 3072;
constexpr int NE = 32, TOPK = 4, ECAP = 8192, CROWS = 40960;
constexpr float EPS = 1e-6f;

constexpr size_t MiB = 1ull << 20;
constexpr size_t WS_CTL = 0, CTL_BYTES = 1 * MiB;
constexpr size_t WS_MODP = 1 * MiB;
constexpr size_t WS_GATES = 2 * MiB;
constexpr size_t WS_KMEAN = 3 * MiB;
constexpr size_t WS_WGF = 3 * MiB + 512 * 1024;
constexpr size_t WS_WRF = 3 * MiB + 640 * 1024;
constexpr size_t WS_MODF = 4 * MiB;
constexpr size_t WS_TOKE = 5 * MiB;
constexpr size_t WS_TOKW = 5 * MiB + 256 * 1024;
constexpr size_t WS_TOKS = 5 * MiB + 512 * 1024;
constexpr size_t WS_ROWW = 6 * MiB;
constexpr size_t WS_WIN = 8 * MiB;
constexpr size_t WS_WOUT8 = 8 * MiB;
constexpr size_t WS_WA = 48 * MiB, WS_WB = 52 * MiB, WS_WOUT = 56 * MiB;
constexpr size_t WS_HBUF = 64 * MiB;
constexpr size_t WS_YBUF8 = 64 * MiB;
constexpr float Y8_SCALE = 8.0f;
constexpr float YD_SCALE = 16.0f;
constexpr float H8_SCALE = 8.0f, O8_SCALE = 32.0f;
constexpr size_t WS_Z = 96 * MiB;
constexpr size_t WS_HM = 256 * MiB, WS_OB = 272 * MiB;
constexpr size_t WS_TMPF = 288 * MiB;
constexpr size_t WS_YBUF = 352 * MiB;
constexpr size_t WS_X1 = 384 * MiB;
constexpr size_t WS_ACT = 448 * MiB;
constexpr size_t WS_YDN = 608 * MiB;
constexpr size_t WS_CLOC = 928 * MiB;
constexpr size_t WS_CIN = 960 * MiB;
constexpr size_t WS_NLOC = 976 * MiB, WS_NIN = 977 * MiB, WS_MSC = 978 * MiB;
constexpr size_t WS_HBUF8 = 980 * MiB;
constexpr size_t WS_WIN8 = 996 * MiB;
constexpr size_t WS_WUP = 1024 * MiB;
constexpr size_t WS_WDN = 1536 * MiB;
constexpr size_t WS_TA = 2048 * MiB;
constexpr size_t WS_END = 3072 * MiB;
constexpr int CW_BAR = 4096;
constexpr int CW_CNT = 16384;
constexpr int CW_QUEUE = 32768;
constexpr int CW_MISC = 49152;
constexpr int CW_UPD = 65536;
constexpr int CW_MQ = 32768 + 64;
constexpr int CW_CUD = 36864, CW_CDD = 40960, CW_GUD = 45056;

constexpr int LDS_BYTES = 157696;
constexpr int LDS_XB = 157568;
constexpr int LDS_TABS = 147456;

__device__ __forceinline__ float bf_lo(unsigned u) { return __uint_as_float(u << 16); }
__device__ __forceinline__ float bf_hi(unsigned u) { return __uint_as_float(u & 0xffff0000u); }
__device__ __forceinline__ float bf1(bf16_t v) { return __uint_as_float(((unsigned)v) << 16); }
__device__ __forceinline__ unsigned pk2(float lo, float hi) { unsigned r; asm("v_cvt_pk_bf16_f32 %0, %1, %2" : "=v"(r) : "v"(lo), "v"(hi)); return r; }
__device__ __forceinline__ bf16_t f2bf(float f) { return (bf16_t)(pk2(f, 0.f) & 0xffffu); }
__device__ __forceinline__ float wave_sum(float v) {
#pragma unroll
    for (int o = 1; o < 64; o <<= 1) v += __shfl_xor(v, o);
    return v;
}
__device__ __forceinline__ void store16_sc1(void* p, u32x4 v) { asm volatile("global_store_dwordx4 %0, %1, off sc1\n\ts_nop 1" :: "v"(p), "v"(v) : "memory"); }
__device__ __forceinline__ void store8_sc1(void* p, u32x2 v) { asm volatile("global_store_dwordx2 %0, %1, off sc1\n\ts_nop 1" :: "v"(p), "v"(v) : "memory"); }
__device__ __forceinline__ unsigned pk4_fp8(float a, float b, float c, float d) {
    a = __builtin_amdgcn_fmed3f(a, -448.0f, 448.0f); b = __builtin_amdgcn_fmed3f(b, -448.0f, 448.0f); c = __builtin_amdgcn_fmed3f(c, -448.0f, 448.0f); d = __builtin_amdgcn_fmed3f(d, -448.0f, 448.0f);
    int r = __builtin_amdgcn_cvt_pk_fp8_f32(a, b, 0, false); r = __builtin_amdgcn_cvt_pk_fp8_f32(c, d, r, true); return (unsigned)r; }
__device__ __forceinline__ unsigned pk4_fp8_ns(float a, float b, float c, float d) { int r = __builtin_amdgcn_cvt_pk_fp8_f32(a, b, 0, false); r = __builtin_amdgcn_cvt_pk_fp8_f32(c, d, r, true); return (unsigned)r; }
constexpr float W8_SCALE = 256.0f, W8_INV = 1.0f / 256.0f;
__device__ __forceinline__ float sigmoidf_(float x) { return __builtin_amdgcn_rcpf(1.f + __expf(-x)); }
#define DPP_ADD(t, CTRL) ((t) + __builtin_bit_cast(float, __builtin_amdgcn_update_dpp(0, __builtin_bit_cast(int, (t)), (CTRL), 0xf, 0xf, false)))
__device__ __forceinline__ float sum8_(float t) { t = DPP_ADD(t, 0xB1); t = DPP_ADD(t, 0x4E); t = DPP_ADD(t, 0x141); return t; }
__device__ __forceinline__ float sum16_(float t) { t = sum8_(t); t = DPP_ADD(t, 0x140); return t; }

namespace pg8 {
constexpr int BM = 256, BK = 64, HALF = 128, HTB = HALF * BK * 2, STAGE_BYTES = 8 * HTB, NXCD = 8, WGM = 8;
__host__ __device__ __forceinline__ int lds_byte(int r, int c) { const int st = (r >> 4) * 2 + (c >> 5), rr = r & 15, cc = c & 31, ob = rr * 64 + cc * 2; return st * 1024 + (ob ^ (((ob >> 9) & 1) << 5)); }
__host__ __device__ __forceinline__ void stage_rc(int b, int& R, int& C) { const int st = b / 1024, sb = b % 1024, swz = sb ^ (((sb >> 9) & 1) << 5); R = (st >> 1) * 16 + swz / 64; C = (st & 1) * 32 + (swz % 64) / 2; }
__host__ __device__ __forceinline__ int perm32(int rho) { const int n = rho >> 4, i = rho & 15; return 8 * (i >> 2) + 4 * n + (i & 3); }

struct Unit { int pm, pn, e; };

struct DenseOrder {
    static constexpr bool HAS_DEP = false;
    const char* A; const char* Bt; int nM, nN, nwg, G, c;
    __device__ void init(const void* A_, const void* Bt_, int M, int N, int G_, int c_) { A = (const char*)A_; Bt = (const char*)Bt_; nM = M / BM; nN = N / BM; nwg = nM * nN; G = G_; c = c_; }
    __device__ bool next(int i, Unit& u) const {
        const long L = (long)i * G + c; if (L >= nwg) return false;
        int wgid = (int)L; { const int q = nwg / NXCD, r = nwg % NXCD, xcd = wgid % NXCD, off = wgid / NXCD; wgid = (xcd < r ? xcd * (q + 1) : r * (q + 1) + (xcd - r) * q) + off; }
        const int nig = WGM * nN, gid = wgid / nig, fm = gid * WGM, gsz = (nM - fm) < WGM ? (nM - fm) : WGM;
        u.pm = fm + ((wgid % nig) % gsz); u.pn = (wgid % nig) / gsz; u.e = 0; return true;
    }
    __device__ __forceinline__ const char* a_ptr(const Unit& u, size_t tstep) const { return A + (size_t)u.pm * tstep; }
    __device__ __forceinline__ const char* b_ptr(const Unit& u, size_t tstep) const { return Bt + (size_t)u.pn * tstep; }
};

constexpr unsigned DEP_NEED = 16u;
template <bool DEP>
struct MoeOrderT {
    static constexpr bool HAS_DEP = DEP;
    const char* A; const char* Bt; const LAS int* tiles; const LAS int* arow; const LAS int* ub; int nN, G, c; size_t estepB; int total; unsigned* dep; unsigned need_hi;
    __device__ bool next(int i, Unit& u) const {
        const int L = i * G + c; if (L >= total) return false;
        unsigned zz = 0u; asm volatile("" : "+v"(zz));
        const int ln = (int)__builtin_amdgcn_mbcnt_hi(~0u, __builtin_amdgcn_mbcnt_lo(~0u, zz));
        const int ubv = ub[(ln < NE ? ln : NE - 1) + 1];
        const int e = __builtin_popcountll(__ballot(ln < NE && L >= ubv));
        const int r = L - __builtin_amdgcn_readfirstlane(ub[e]), te = __builtin_amdgcn_readfirstlane(tiles[e]);
        u.e = e; u.pm = r % te; u.pn = r / te; return true;
    }
    __device__ __forceinline__ unsigned dep_issue(int i) const {
        Unit u; if (!next(i, u)) return 0xffffffffu;
        return __hip_atomic_load(dep + (u.e * 32 + u.pm) * 16, __ATOMIC_RELAXED, __HIP_MEMORY_SCOPE_AGENT);
    }
    __device__ __forceinline__ void dep_confirm(const Unit& u, unsigned v) const {
        const unsigned* ctr = dep + (u.e * 32 + u.pm) * 16;
        const unsigned need = DEP_NEED + (u.e >= 16 ? need_hi : 0u);
        while ((unsigned)__builtin_amdgcn_readfirstlane((int)v) < need) { __builtin_amdgcn_s_sleep(2); v = __hip_atomic_load(ctr, __ATOMIC_RELAXED, __HIP_MEMORY_SCOPE_AGENT); }
        asm volatile("" ::: "memory");
    }
    __device__ __forceinline__ const char* a_ptr(const Unit& u, size_t tstep) const { return A + ((size_t)arow[u.e] / 256 + (size_t)u.pm) * tstep; }
    __device__ __forceinline__ const char* b_ptr(const Unit& u, size_t tstep) const { return Bt + (size_t)u.e * estepB + (size_t)u.pn * tstep; }
};
typedef MoeOrderT<false> MoeOrder;
typedef MoeOrderT<true> MoeDepOrder;

template <class Base> struct SubOrder {
    static constexpr bool HAS_DEP = false;
    Base b; int i0, n;
    __device__ bool next(int i, Unit& u) const { if (i >= n) return false; return b.next(i0 + i, u); }
    __device__ __forceinline__ const char* a_ptr(const Unit& u, size_t tstep) const { return b.a_ptr(u, tstep); }
    __device__ __forceinline__ const char* b_ptr(const Unit& u, size_t tstep) const { return b.b_ptr(u, tstep); }
};
struct OneUnit {
    static constexpr bool HAS_DEP = false;
    const char* A; const char* Bt; Unit u;
    __device__ bool next(int i, Unit& o) const { if (i > 0) return false; o = u; return true; }
    __device__ __forceinline__ const char* a_ptr(const Unit&, size_t) const { return A; }
    __device__ __forceinline__ const char* b_ptr(const Unit&, size_t) const { return Bt; }
};

struct PairOrder {
    static constexpr bool HAS_DEP = false;
    DenseOrder d; const char* A2; const char* Bt2;
    __device__ bool next(int i, Unit& u) const { if (!d.next(i >> 1, u)) return false; u.e = i & 1; return true; }
    __device__ __forceinline__ const char* a_ptr(const Unit& u, size_t tstep) const { return (u.e ? A2 : d.A) + (size_t)u.pm * tstep; }
    __device__ __forceinline__ const char* b_ptr(const Unit& u, size_t tstep) const { return (u.e ? Bt2 : d.Bt) + (size_t)u.pn * tstep; }
};

template <class Epi, class Sched, bool FP8 = false>
__device__ __forceinline__ void gemm_phase(LAS unsigned char* lds, const int K, const Sched& S, const Epi& E) {
    int tid = threadIdx.x; asm volatile("" : "+v"(tid));
    const int wid = __builtin_amdgcn_readfirstlane(tid >> 6), lane = tid & 63, wr = wid >> 2, wc = wid & 3, fr = lane & 15, fq = lane >> 4;
    const int nt = K / BK;
    unsigned voffA, voffB;
    { int R, C; stage_rc(tid * 16, R, C); const int Rb = Epi::PERM ? ((R & ~31) + perm32(R & 31)) : R;
      voffA = (unsigned)(R * K + C) * 2u; voffB = (unsigned)(Rb * K + C) * 2u; }
    const size_t pstep = (size_t)64 * K * 2;
    const size_t kstep = (size_t)(BK * 2);
    const size_t hstep = (size_t)HALF * K * 2;
    const size_t tstep = 2 * hstep;
    const unsigned ldsw = (unsigned)wid * 1024u;
    int lanex;
    { unsigned _z = 0u; asm volatile("" : "+v"(_z)); const int _ln = (int)__builtin_amdgcn_mbcnt_hi(~0u, __builtin_amdgcn_mbcnt_lo(~0u, _z)); lanex = lds_byte(_ln & 15, (_ln >> 4) * 8); }
#define PG8_LANE_OFFS asm volatile("" : "+v"(lanex)); const int aoff = lanex + wr * 8192, boff = lanex + wc * 4096; (void)aoff; (void)boff
#define PG8_SA(b, h) (((b) * 2 + (h)) * HTB)
#define PG8_SB(b, h) ((4 + (b) * 2 + (h)) * HTB)
#define PG8_STAGE(bufoff, gbase, voff) do { asm volatile("" : "+v"(voff)); _Pragma("unroll") for (int _i = 0; _i < 2; ++_i) \
        __builtin_amdgcn_global_load_lds((const unsigned*)((const char*)(gbase) + _i * pstep + (voff)), (LAS unsigned*)(lds + (bufoff) + ldsw + _i * 8192), 16, 0, 0); } while (0)
#define PG8_LDA(dst, b, h) do { _Pragma("unroll") for (int m = 0; m < 4; ++m) { const i32x4 _l = *(const LAS i32x4*)(lds + PG8_SA(b, h) + aoff + m * 2048), _h = *(const LAS i32x4*)(lds + PG8_SA(b, h) + aoff + m * 2048 + 1024); \
        dst[m] = __builtin_shufflevector(_l, _h, 0, 1, 2, 3, 4, 5, 6, 7); } } while (0)
#define PG8_LDB(dst, b, h) do { _Pragma("unroll") for (int n = 0; n < 2; ++n) { const i32x4 _l = *(const LAS i32x4*)(lds + PG8_SB(b, h) + boff + n * 2048), _h = *(const LAS i32x4*)(lds + PG8_SB(b, h) + boff + n * 2048 + 1024); \
        dst[n] = __builtin_shufflevector(_l, _h, 0, 1, 2, 3, 4, 5, 6, 7); } } while (0)
#define PG8_LO(x) __builtin_bit_cast(bf16x8, __builtin_shufflevector((x), (x), 0, 1, 2, 3))
#define PG8_HI(x) __builtin_bit_cast(bf16x8, __builtin_shufflevector((x), (x), 4, 5, 6, 7))
#define PG8_MMA(ai, bj, At, Bt) do { __builtin_amdgcn_s_setprio(1); \
        if constexpr (FP8) { _Pragma("unroll") for (int m = 0; m < 4; ++m) _Pragma("unroll") for (int n = 0; n < 2; ++n) \
            acc[ai][bj][m][n] = __builtin_amdgcn_mfma_scale_f32_16x16x128_f8f6f4(Bt[n], At[m], acc[ai][bj][m][n], 0, 0, 0, 0x7f7f7f7f, 0, 0x7f7f7f7f); } \
        else { _Pragma("unroll") for (int m = 0; m < 4; ++m) _Pragma("unroll") for (int n = 0; n < 2; ++n) { \
            acc[ai][bj][m][n] = __builtin_amdgcn_mfma_f32_16x16x32_bf16(PG8_LO(Bt[n]), PG8_LO(At[m]), acc[ai][bj][m][n], 0, 0, 0); \
            acc[ai][bj][m][n] = __builtin_amdgcn_mfma_f32_16x16x32_bf16(PG8_HI(Bt[n]), PG8_HI(At[m]), acc[ai][bj][m][n], 0, 0, 0); } } \
        __builtin_amdgcn_s_setprio(0); } while (0)
#define PG8_WAIT_V(n) asm volatile("s_waitcnt vmcnt(" #n ")" ::: "memory")
#define PG8_WAIT_L(n) asm volatile("s_waitcnt lgkmcnt(" #n ")" ::: "memory")
#define PG8_BAR __builtin_amdgcn_s_barrier()
#define PG8_SCHED __builtin_amdgcn_sched_barrier(0)
    Unit cur, nxt, prv; int ui = 0; prv.pm = prv.pn = prv.e = 0; (void)prv;
    if (!S.next(0, cur)) return;
    unsigned depv = 0u; (void)depv;
    if constexpr (Sched::HAS_DEP) { S.dep_confirm(cur, S.dep_issue(0)); depv = S.dep_issue(1); }
    f32x4 acc[2][2][4][2];
#define PG8_ACC_INIT(U) do { f32x4 _bi[2][2]; \
        if constexpr (Epi::ACC_INIT) { unsigned _zz = 0u; asm volatile("" : "+v"(_zz)); const int _ln = (int)__builtin_amdgcn_mbcnt_hi(~0u, __builtin_amdgcn_mbcnt_lo(~0u, _zz)); E.acc_bias((U), wc, _ln >> 4, _bi); } \
        else { _bi[0][0] = (f32x4){0.f, 0.f, 0.f, 0.f}; _bi[0][1] = _bi[0][0]; _bi[1][0] = _bi[0][0]; _bi[1][1] = _bi[0][0]; } \
        _Pragma("unroll") for (int a = 0; a < 2; ++a) _Pragma("unroll") for (int b = 0; b < 2; ++b) _Pragma("unroll") for (int m = 0; m < 4; ++m) _Pragma("unroll") for (int n = 0; n < 2; ++n) acc[a][b][m][n] = _bi[b][n]; } while (0)
    PG8_ACC_INIT(cur);
    i32x8 At[4], B0[2], B1[2];
    const char* cA = S.a_ptr(cur, tstep); const char* cB = S.b_ptr(cur, tstep);
    PG8_STAGE(PG8_SB(0, 0), cB, voffB); PG8_STAGE(PG8_SB(0, 1), cB + hstep, voffB); PG8_STAGE(PG8_SA(0, 0), cA, voffA); PG8_STAGE(PG8_SA(0, 1), cA + hstep, voffA);
    if (wr == 1) PG8_BAR;
    PG8_WAIT_V(2); PG8_BAR;
    PG8_STAGE(PG8_SB(1, 0), cB + kstep, voffB); PG8_STAGE(PG8_SA(1, 0), cA + kstep, voffA); PG8_STAGE(PG8_SB(1, 1), cB + hstep + kstep, voffB);
    PG8_WAIT_V(6); PG8_BAR;
    for (;;) {
        const bool has_next = S.next(ui + 1, nxt);
        if constexpr (Sched::HAS_DEP) { if (has_next) S.dep_confirm(nxt, depv); }
        const char* nA = has_next ? S.a_ptr(nxt, tstep) : cA; const char* nB = has_next ? S.b_ptr(nxt, tstep) : cB;
#pragma unroll 1
        for (int t = 0; t < nt; t += 2) {
            const bool last = (t == nt - 2);
            const char* a1 = cA + (size_t)(t + 1) * kstep;
            const char* a2 = last ? nA : cA + (size_t)(t + 2) * kstep; const char* b2 = last ? nB : cB + (size_t)(t + 2) * kstep;
            const char* a3 = a2 + kstep; const char* b3 = b2 + kstep;
            { PG8_LANE_OFFS; PG8_LDB(B0, 0, 0); PG8_LDB(B1, 0, 1); PG8_SCHED; PG8_LDA(At, 0, 0); PG8_STAGE(PG8_SA(1, 1), a1 + hstep, voffA); }
            PG8_WAIT_V(8); PG8_WAIT_L(0); PG8_BAR; PG8_MMA(0, 0, At, B0); PG8_MMA(0, 1, At, B1); PG8_BAR; PG8_SCHED;
            { PG8_LANE_OFFS; PG8_LDA(At, 0, 1); PG8_STAGE(PG8_SB(0, 0), b2, voffB); PG8_STAGE(PG8_SB(0, 1), b2 + hstep, voffB); PG8_STAGE(PG8_SA(0, 0), a2, voffA); }
            PG8_WAIT_V(8); PG8_WAIT_L(0); PG8_BAR; PG8_MMA(1, 0, At, B0); PG8_MMA(1, 1, At, B1); PG8_BAR; PG8_SCHED;
            { PG8_LANE_OFFS; PG8_LDB(B0, 1, 0); PG8_LDB(B1, 1, 1); PG8_SCHED; PG8_LDA(At, 1, 0); PG8_STAGE(PG8_SA(0, 1), a2 + hstep, voffA); }
            PG8_WAIT_V(8); PG8_WAIT_L(0); PG8_BAR; PG8_MMA(0, 0, At, B0); PG8_MMA(0, 1, At, B1); PG8_BAR; PG8_SCHED;
            { PG8_LANE_OFFS; PG8_LDA(At, 1, 1); PG8_STAGE(PG8_SB(1, 0), b3, voffB); PG8_STAGE(PG8_SB(1, 1), b3 + hstep, voffB); PG8_STAGE(PG8_SA(1, 0), a3, voffA); }
            PG8_WAIT_V(8); PG8_WAIT_L(0); PG8_BAR; PG8_MMA(1, 0, At, B0); PG8_MMA(1, 1, At, B1); PG8_BAR; PG8_SCHED;
        }
        if (wr == 0) PG8_BAR;
        if constexpr (Sched::HAS_DEP) depv = S.dep_issue(ui + 2);
        if constexpr (Epi::SIGNALS) { if (ui > 0) { PG8_WAIT_V(8); PG8_BAR; E.signal(prv, tid == 0); } }
        { unsigned zz = 0u; asm volatile("" : "+v"(zz));
          const int ln = (int)__builtin_amdgcn_mbcnt_hi(~0u, __builtin_amdgcn_mbcnt_lo(~0u, zz));
          E(acc, cur, wr, wc, ln & 15, ln >> 4); }
        if (!has_next) break;
        if (!(Epi::CHAIN && cur.e == 0)) { PG8_ACC_INIT(nxt); }
        prv = cur; cur = nxt; cA = nA; cB = nB; ++ui;
        if (wr == 1) PG8_BAR;
    }
    PG8_WAIT_V(0);
    PG8_BAR;
    if constexpr (Epi::SIGNALS) E.signal(cur, tid == 0);
#undef PG8_SA
#undef PG8_ACC_INIT
#undef PG8_SB
#undef PG8_STAGE
#undef PG8_LDA
#undef PG8_LDB
#undef PG8_MMA
#undef PG8_LO
#undef PG8_LANE_OFFS
#undef PG8_HI
#undef PG8_WAIT_V
#undef PG8_WAIT_L
#undef PG8_BAR
#undef PG8_SCHED
}
}

using pg8::Unit;
template <bool F8>
struct EpiZT {
    static constexpr bool PERM = true;
    static constexpr bool SIGNALS = false;
    static constexpr bool CHAIN = false;
    static constexpr bool ACC_INIT = false;
    static constexpr float ASC = F8 ? W8_INV : 1.0f;
    bf16_t* O; int ldc; const float* gq; const float* gk; float* kmean; LAS unsigned char* xl;
    __device__ __forceinline__ void operator()(const f32x4 (&acc)[2][2][4][2], const Unit& u, int wr, int wc, int fr, int fq) const {
        const int row0 = u.pm * 256 + wr * 64 + fr, col0 = u.pn * 256 + wc * 32 + 8 * fq;
        if (u.pn < 12 || u.pn >= 20) {
#pragma unroll
            for (int ai = 0; ai < 2; ++ai)
#pragma unroll
                for (int m = 0; m < 4; ++m) { bf16_t* rowp = O + (size_t)(row0 + ai * 128 + m * 16) * ldc + col0;
#pragma unroll
                    for (int bj = 0; bj < 2; ++bj) { const f32x4 v0 = acc[ai][bj][m][0] * ASC, v1 = acc[ai][bj][m][1] * ASC;
                        u32x4 w; w.x = pk2(v0[0], v0[1]); w.y = pk2(v0[2], v0[3]); w.z = pk2(v1[0], v1[1]); w.w = pk2(v1[2], v1[3]);
                        *(u32x4*)(rowp + bj * 128) = w; } }
            return;
        }
        LAS float* P = (LAS float*)xl;
        LAS float* Cs = (LAS float*)(xl + 8192);
#pragma unroll
        for (int ai = 0; ai < 2; ++ai)
#pragma unroll
            for (int m = 0; m < 4; ++m)
#pragma unroll
                for (int bj = 0; bj < 2; ++bj) { const f32x4 v0 = acc[ai][bj][m][0], v1 = acc[ai][bj][m][1];
                    float ss = (v0[0] * v0[0] + v0[1] * v0[1]) + (v0[2] * v0[2] + v0[3] * v0[3]) + (v1[0] * v1[0] + v1[1] * v1[1]) + (v1[2] * v1[2] + v1[3] * v1[3]);
                    ss += __shfl_xor(ss, 16); ss += __shfl_xor(ss, 32);
                    if (fq == 0) P[((ai * 128 + wr * 64 + m * 16 + fr) * 2 + bj) * 4 + wc] = ss; asm volatile("" ::: "memory"); }
        __syncthreads();
        const bool isk = u.pn >= 16;
        const float* gv = (isk ? gk : gq) + wc * 32 + 8 * fq;
        const f32x4 g0 = *(const f32x4*)gv, g1 = *(const f32x4*)(gv + 4);
        f32x4 cs[2][2];
#pragma unroll
        for (int bj = 0; bj < 2; ++bj) { cs[bj][0] = (f32x4){0.f, 0.f, 0.f, 0.f}; cs[bj][1] = cs[bj][0]; }
#pragma unroll
        for (int ai = 0; ai < 2; ++ai)
#pragma unroll
            for (int m = 0; m < 4; ++m) { const int rl = ai * 128 + wr * 64 + m * 16 + fr; bf16_t* rowp = O + (size_t)(u.pm * 256 + rl) * ldc + col0;
#pragma unroll
                for (int bj = 0; bj < 2; ++bj) { const f32x4 pp = *(const LAS f32x4*)(P + (rl * 2 + bj) * 4);
                    const float rinv = rsqrtf(((pp[0] + pp[1]) + (pp[2] + pp[3])) * (ASC * ASC / 128.0f) + EPS) * ASC;
                    const f32x4 y0 = acc[ai][bj][m][0] * rinv * g0, y1 = acc[ai][bj][m][1] * rinv * g1;
                    cs[bj][0] += y0; cs[bj][1] += y1;
                    u32x4 w; w.x = pk2(y0[0], y0[1]); w.y = pk2(y0[2], y0[3]); w.z = pk2(y1[0], y1[1]); w.w = pk2(y1[2], y1[3]);
                    *(u32x4*)(rowp + bj * 128) = w; }
                asm volatile("" : "+v"(cs[0][0]), "+v"(cs[0][1]), "+v"(cs[1][0]), "+v"(cs[1][1]) :: "memory"); }
        if (isk) {
#pragma unroll
            for (int bj = 0; bj < 2; ++bj)
#pragma unroll
                for (int n = 0; n < 2; ++n)
#pragma unroll
                    for (int j = 0; j < 4; ++j) { float t = sum16_(cs[bj][n][j]);
                        if (fr == 0) Cs[(wr * 2 + bj) * 128 + wc * 32 + 8 * fq + 4 * n + j] = t; }
            __syncthreads();
            const int t = (wr * 4 + wc) * 64 + fq * 16 + fr;
            if (t < 256) { const int bj = t >> 7, d = t & 127, hd = (u.pn - 16) * 2 + bj;
                kmean[((((size_t)(u.pm >> 3) * 8 + hd) * 8) + (u.pm & 7)) * 128 + d] = (Cs[bj * 128 + d] + Cs[(2 + bj) * 128 + d]) * (1.0f / 256.0f); }
        }
    }
};
typedef EpiZT<false> EpiZ;
struct EpiZ8 {
    static constexpr bool PERM = true;
    static constexpr bool SIGNALS = false;
    static constexpr bool CHAIN = false;
    static constexpr bool ACC_INIT = false;
    bf16_t* O; int ldc, col_off;
    __device__ __forceinline__ void operator()(const f32x4 (&acc)[2][2][4][2], const Unit& u, int wr, int wc, int fr, int fq) const {
        const int row0 = u.pm * 256 + wr * 64 + fr, col0 = col_off + u.pn * 256 + wc * 32 + 8 * fq;
#pragma unroll
        for (int ai = 0; ai < 2; ++ai)
#pragma unroll
            for (int m = 0; m < 4; ++m) { bf16_t* rowp = O + (size_t)(row0 + ai * 128 + m * 16) * ldc + col0;
#pragma unroll
                for (int bj = 0; bj < 2; ++bj) { const f32x4 v0 = acc[ai][bj][m][0] * W8_INV, v1 = acc[ai][bj][m][1] * W8_INV;
                    u32x4 w; w.x = pk2(v0[0], v0[1]); w.y = pk2(v0[2], v0[3]); w.z = pk2(v1[0], v1[1]); w.w = pk2(v1[2], v1[3]);
                    *(u32x4*)(rowp + bj * 128) = w; } }
    }
};
struct EpiBranchA {
    static constexpr bool PERM = true;
    static constexpr bool SIGNALS = false;
    static constexpr bool CHAIN = false;
    static constexpr bool ACC_INIT = false;
    float* tmp; const bf16_t* z;
    __device__ __forceinline__ void operator()(const f32x4 (&acc)[2][2][4][2], const Unit& u, int wr, int wc, int fr, int fq) const {
        const int row0 = u.pm * 256 + wr * 64 + fr, col0 = u.pn * 256 + wc * 32 + 8 * fq;
#pragma unroll
        for (int ai = 0; ai < 2; ++ai)
#pragma unroll
            for (int m = 0; m < 4; ++m) { const size_t row = (size_t)(row0 + ai * 128 + m * 16);
#pragma unroll
                for (int bj = 0; bj < 2; ++bj) { const int col = col0 + bj * 128;
                    const u32x4 g = *(const u32x4*)(z + row * ZP + ZGA + col);
                    const f32x4 v0 = acc[ai][bj][m][0] * (W8_INV / H8_SCALE), v1 = acc[ai][bj][m][1] * (W8_INV / H8_SCALE);
                    f32x4 o0, o1;
                    o0[0] = v0[0] * sigmoidf_(bf_lo(g.x)); o0[1] = v0[1] * sigmoidf_(bf_hi(g.x)); o0[2] = v0[2] * sigmoidf_(bf_lo(g.y)); o0[3] = v0[3] * sigmoidf_(bf_hi(g.y));
                    o1[0] = v1[0] * sigmoidf_(bf_lo(g.z)); o1[1] = v1[1] * sigmoidf_(bf_hi(g.z)); o1[2] = v1[2] * sigmoidf_(bf_lo(g.w)); o1[3] = v1[3] * sigmoidf_(bf_hi(g.w));
                    float* p = tmp + row * D + col; *(f32x4*)p = o0; *(f32x4*)(p + 4) = o1; } }
    }
};
struct EpiBranchB {
    static constexpr bool PERM = true;
    static constexpr bool SIGNALS = false;
    static constexpr bool CHAIN = false;
    static constexpr bool ACC_INIT = false;
    const float* tmp; const bf16_t* z; unsigned char* y;
    __device__ __forceinline__ void operator()(const f32x4 (&acc)[2][2][4][2], const Unit& u, int wr, int wc, int fr, int fq) const {
        const int row0 = u.pm * 256 + wr * 64 + fr, col0 = u.pn * 256 + wc * 32 + 8 * fq;
#pragma unroll
        for (int ai = 0; ai < 2; ++ai)
#pragma unroll
            for (int m = 0; m < 4; ++m) { const size_t row = (size_t)(row0 + ai * 128 + m * 16);
#pragma unroll
                for (int bj = 0; bj < 2; ++bj) { const int col = col0 + bj * 128;
                    const u32x4 g = *(const u32x4*)(z + row * ZP + ZGB + col);
                    const float* p = tmp + row * D + col; const f32x4 t0 = *(const f32x4*)p, t1 = *(const f32x4*)(p + 4);
                    const f32x4 v0 = acc[ai][bj][m][0] * (W8_INV / O8_SCALE), v1 = acc[ai][bj][m][1] * (W8_INV / O8_SCALE);
                    f32x4 o0, o1;
                    o0[0] = t0[0] + v0[0] * sigmoidf_(bf_lo(g.x)); o0[1] = t0[1] + v0[1] * sigmoidf_(bf_hi(g.x)); o0[2] = t0[2] + v0[2] * sigmoidf_(bf_lo(g.y)); o0[3] = t0[3] + v0[3] * sigmoidf_(bf_hi(g.y));
                    o1[0] = t1[0] + v1[0] * sigmoidf_(bf_lo(g.z)); o1[1] = t1[1] + v1[1] * sigmoidf_(bf_hi(g.z)); o1[2] = t1[2] + v1[2] * sigmoidf_(bf_lo(g.w)); o1[3] = t1[3] + v1[3] * sigmoidf_(bf_hi(g.w));
                    o0 *= Y8_SCALE; o1 *= Y8_SCALE;
                    u32x2 w; w.x = pk4_fp8(o0[0], o0[1], o0[2], o0[3]); w.y = pk4_fp8(o1[0], o1[1], o1[2], o1[3]);
                    *(u32x2*)(y + row * D + col) = w; } }
    }
};
struct EpiBranchAB {
    static constexpr bool PERM = true;
    static constexpr bool SIGNALS = false;
    static constexpr bool CHAIN = true;
    static constexpr bool ACC_INIT = false;
    const bf16_t* z; unsigned char* y;
    __device__ __forceinline__ void operator()(f32x4 (&acc)[2][2][4][2], const Unit& u, int wr, int wc, int fr, int fq) const {
        const int row0 = u.pm * 256 + wr * 64 + fr, col0 = u.pn * 256 + wc * 32 + 8 * fq;
        if (u.e == 0) {
#pragma unroll
            for (int ai = 0; ai < 2; ++ai) {
                u32x4 ga[4][2], gb[4][2];
#pragma unroll
                for (int m = 0; m < 4; ++m)
#pragma unroll
                    for (int bj = 0; bj < 2; ++bj) { const bf16_t* zp = z + (size_t)(row0 + ai * 128 + m * 16) * ZP + col0 + bj * 128; ga[m][bj] = *(const u32x4*)(zp + ZGA); gb[m][bj] = *(const u32x4*)(zp + ZGB); }
                __builtin_amdgcn_sched_barrier(0);
#pragma unroll
                for (int m = 0; m < 4; ++m)
#pragma unroll
                    for (int bj = 0; bj < 2; ++bj) { const u32x4 a_ = ga[m][bj], b_ = gb[m][bj];
#define RHO(aw, bw, lo) ((O8_SCALE / H8_SCALE) * (1.0f + __expf(-(lo ? bf_lo(bw) : bf_hi(bw)))) * __builtin_amdgcn_rcpf(1.0f + __expf(-(lo ? bf_lo(aw) : bf_hi(aw)))))
                        f32x4 r0, r1;
                        r0[0] = RHO(a_.x, b_.x, 1); r0[1] = RHO(a_.x, b_.x, 0); r0[2] = RHO(a_.y, b_.y, 1); r0[3] = RHO(a_.y, b_.y, 0);
                        r1[0] = RHO(a_.z, b_.z, 1); r1[1] = RHO(a_.z, b_.z, 0); r1[2] = RHO(a_.w, b_.w, 1); r1[3] = RHO(a_.w, b_.w, 0);
#undef RHO
                        acc[ai][bj][m][0] *= r0; acc[ai][bj][m][1] *= r1; }
                __builtin_amdgcn_sched_barrier(0);
            }
        } else {
            u32x4 gb[2][4][2];
#pragma unroll
            for (int ai = 0; ai < 2; ++ai)
#pragma unroll
                for (int m = 0; m < 4; ++m)
#pragma unroll
                    for (int bj = 0; bj < 2; ++bj) gb[ai][m][bj] = *(const u32x4*)(z + (size_t)(row0 + ai * 128 + m * 16) * ZP + ZGB + col0 + bj * 128);
            __builtin_amdgcn_sched_barrier(0);
#pragma unroll
            for (int ai = 0; ai < 2; ++ai)
#pragma unroll
                for (int m = 0; m < 4; ++m) { const size_t row = (size_t)(row0 + ai * 128 + m * 16);
#pragma unroll
                    for (int bj = 0; bj < 2; ++bj) { const int col = col0 + bj * 128;
                        const u32x4 g = gb[ai][m][bj];
                        const f32x4 v0 = acc[ai][bj][m][0] * (W8_INV / O8_SCALE * Y8_SCALE), v1 = acc[ai][bj][m][1] * (W8_INV / O8_SCALE * Y8_SCALE);
                        u32x2 w;
                        w.x = pk4_fp8(v0[0] * sigmoidf_(bf_lo(g.x)), v0[1] * sigmoidf_(bf_hi(g.x)), v0[2] * sigmoidf_(bf_lo(g.y)), v0[3] * sigmoidf_(bf_hi(g.y)));
                        w.y = pk4_fp8(v1[0] * sigmoidf_(bf_lo(g.z)), v1[1] * sigmoidf_(bf_hi(g.z)), v1[2] * sigmoidf_(bf_lo(g.w)), v1[3] * sigmoidf_(bf_hi(g.w)));
                        *(u32x2*)(y + row * D + col) = w; } }
        }
    }
};
struct EpiOut {
    static constexpr bool PERM = false;
    static constexpr bool SIGNALS = false;
    static constexpr bool CHAIN = false;
    static constexpr bool ACC_INIT = false;
    const float* x; const float* modf; bf16_t* x1;
    __device__ __forceinline__ void operator()(const f32x4 (&acc)[2][2][4][2], const Unit& u, int wr, int wc, int fr, int fq) const {
        const int row0 = u.pm * 256 + wr * 64 + fr, col0 = u.pn * 256 + wc * 32 + 4 * fq;
        const float* gt = modf + (size_t)(u.pm >> 3) * (6 * D) + 2 * D;
        f32x4 gv[2][2];
#pragma unroll
        for (int bj = 0; bj < 2; ++bj)
#pragma unroll
            for (int n = 0; n < 2; ++n) gv[bj][n] = *(const f32x4*)(gt + col0 + bj * 128 + n * 16);
#pragma unroll
        for (int ai = 0; ai < 2; ++ai) {
            f32x4 xv[4][2][2];
#pragma unroll
            for (int m = 0; m < 4; ++m)
#pragma unroll
                for (int bj = 0; bj < 2; ++bj)
#pragma unroll
                    for (int n = 0; n < 2; ++n) xv[m][bj][n] = *(const f32x4*)(x + (size_t)(row0 + ai * 128 + m * 16) * D + col0 + bj * 128 + n * 16);
            __builtin_amdgcn_sched_barrier(0);
#pragma unroll
            for (int m = 0; m < 4; ++m) { const size_t off = (size_t)(row0 + ai * 128 + m * 16) * D + col0;
#pragma unroll
                for (int bj = 0; bj < 2; ++bj)
#pragma unroll
                    for (int n = 0; n < 2; ++n) {
                        const f32x4 v = xv[m][bj][n] + gv[bj][n] * (acc[ai][bj][m][n] * (W8_INV / Y8_SCALE));
                        u32x2 o; o.x = pk2(v[0], v[1]); o.y = pk2(v[2], v[3]);
                        *(u32x2*)(x1 + off + bj * 128 + n * 16) = o; } }
            __builtin_amdgcn_sched_barrier(0);
        }
    }
};
template <bool SC1>
struct EpiUpT {
    static constexpr bool PERM = true;
    static constexpr bool CHAIN = false;
    static constexpr bool ACC_INIT = true;
    static constexpr bool SIGNALS = SC1;
    unsigned char* act; const float* b_up; const LAS int* cbase; unsigned* upd;
    __device__ __forceinline__ void operator()(const f32x4 (&acc)[2][2][4][2], const Unit& u, int wr, int wc, int fr, int fq) const {
        const int row0 = cbase[u.e] + u.pm * 256 + wr * 64 + fr, colh = u.pn * 128 + wc * 32 + 8 * fq;
#pragma unroll
        for (int ai = 0; ai < 2; ++ai)
#pragma unroll
            for (int m = 0; m < 4; ++m) {
                const f32x4 g0 = acc[ai][0][m][0], g1 = acc[ai][0][m][1], l0 = acc[ai][1][m][0], l1 = acc[ai][1][m][1];
                constexpr float KE = 1.702f * 1.4426950408889634f * W8_INV, GC = 7.0f * W8_SCALE, OS = W8_INV * W8_INV;
                float o[8];
#pragma unroll
                for (int j = 0; j < 4; ++j) {
                    float g = fminf(g0[j], GC), l = __builtin_amdgcn_fmed3f(l0[j], -GC, GC); o[j] = (g * OS) * __builtin_amdgcn_rcpf(1.0f + __builtin_amdgcn_exp2f(g * -KE)) * (l + W8_SCALE);
                    g = fminf(g1[j], GC); l = __builtin_amdgcn_fmed3f(l1[j], -GC, GC); o[4 + j] = (g * OS) * __builtin_amdgcn_rcpf(1.0f + __builtin_amdgcn_exp2f(g * -KE)) * (l + W8_SCALE); }
                u32x2 w; w.x = pk4_fp8_ns(o[0], o[1], o[2], o[3]); w.y = pk4_fp8_ns(o[4], o[5], o[6], o[7]);
                if (SC1) store8_sc1(act + (size_t)(row0 + ai * 128 + m * 16) * D + colh, w); else *(u32x2*)(act + (size_t)(row0 + ai * 128 + m * 16) * D + colh) = w; }
    }
    __device__ __forceinline__ void acc_bias(const Unit& u, int wc, int fq, f32x4 (&bi)[2][2]) const {
        const float* bg = b_up + (size_t)u.e * (2 * D) + u.pn * 128 + wc * 32 + 8 * fq;
#pragma unroll
        for (int n = 0; n < 2; ++n) { bi[0][n] = *(const f32x4*)(bg + 4 * n) * W8_SCALE; bi[1][n] = *(const f32x4*)(bg + D + 4 * n) * W8_SCALE; }
    }
    __device__ __forceinline__ void signal(const Unit& u, bool first_lane) const { if (first_lane) __hip_atomic_fetch_add(upd + (u.e * 32 + u.pm) * 16, 1u, __ATOMIC_RELAXED, __HIP_MEMORY_SCOPE_AGENT); }
};
typedef EpiUpT<true> EpiUp;
struct EpiDown {
    static constexpr bool PERM = true;
    static constexpr bool SIGNALS = false;
    static constexpr bool CHAIN = false;
    static constexpr bool ACC_INIT = true;
    __device__ __forceinline__ void acc_bias(const Unit& u, int wc, int fq, f32x4 (&bi)[2][2]) const {
        const float* bd = b_dn + (size_t)u.e * D + u.pn * 256 + wc * 32 + 8 * fq;
#pragma unroll
        for (int bj = 0; bj < 2; ++bj)
#pragma unroll
            for (int n = 0; n < 2; ++n) bi[bj][n] = *(const f32x4*)(bd + bj * 128 + 4 * n) * W8_SCALE;
    }
    unsigned char* ydn; const float* b_dn; const float* roww; const LAS int* cbase;
    __device__ __forceinline__ void operator()(const f32x4 (&acc)[2][2][4][2], const Unit& u, int wr, int wc, int fr, int fq) const {
        const int rl = u.pm * 256 + wr * 64 + fr, row0 = cbase[u.e] + rl, col0 = u.pn * 256 + wc * 32 + 8 * fq;
        float wv[2][4];
#pragma unroll
        for (int ai = 0; ai < 2; ++ai)
#pragma unroll
            for (int m = 0; m < 4; ++m) wv[ai][m] = roww[(size_t)u.e * ECAP + rl + ai * 128 + m * 16];
        __builtin_amdgcn_sched_barrier(0);
#pragma unroll
        for (int ai = 0; ai < 2; ++ai)
#pragma unroll
            for (int m = 0; m < 4; ++m) { const float w = wv[ai][m] * YD_SCALE; unsigned char* p = ydn + (size_t)(row0 + ai * 128 + m * 16) * D + col0;
#pragma unroll
                for (int bj = 0; bj < 2; ++bj) {
                    const f32x4 v0 = acc[ai][bj][m][0] * (W8_INV * w), v1 = acc[ai][bj][m][1] * (W8_INV * w);
                    u32x2 o; o.x = pk4_fp8(v0[0], v0[1], v0[2], v0[3]); o.y = pk4_fp8(v1[0], v1[1], v1[2], v1[3]);
                    *(u32x2*)(p + bj * 128) = o; } }
    }
};

#define XB_TMO      128
#define XB_XCNT(j)  (256  + 64 * (j))
#define XB_XSUB(j)  (1280 + 64 * (j))
#define XB_XGEN(j)  (2304 + 64 * (j))
#define XB_TOP      3328
#define XB_TOPGEN   3392
#define XCD_BAR_WORDS 3456
#define XB_SPIN_CAP (1u << 18)
__device__ __forceinline__ unsigned xb_ld(unsigned* p)              { return __hip_atomic_load(p, __ATOMIC_RELAXED, __HIP_MEMORY_SCOPE_AGENT); }
__device__ __forceinline__ unsigned xb_add(unsigned* p, unsigned v) { return __hip_atomic_fetch_add(p, v, __ATOMIC_RELAXED, __HIP_MEMORY_SCOPE_AGENT); }
__device__ __forceinline__ unsigned xb_xcc_id() { return (unsigned)__builtin_amdgcn_s_getreg((3 << 11) | 20) & 0xFu; }
#define XB_SPIN(cond, bar) do { unsigned _sp = 0; while (cond) { __builtin_amdgcn_s_sleep(1); \
    if ((++_sp & 255u) == 0u) { if (xb_ld(&(bar)[XB_TMO])) break; if (_sp > XB_SPIN_CAP) { atomicAdd(&(bar)[XB_TMO], 1u); break; } } } } while (0)
struct XcdBarrier { unsigned* bar; unsigned x; volatile LAS unsigned* st; };
__device__ __forceinline__ XcdBarrier xcd_barrier_post(unsigned* bar, volatile LAS unsigned* st) {
    XcdBarrier b; b.bar = bar; b.x = xb_xcc_id(); b.st = st;
    if (threadIdx.x == 0) (void)xb_add(&bar[XB_XCNT(b.x)], 1u);
    return b;
}
__device__ __forceinline__ void xcd_barrier_complete(unsigned* bar, unsigned x, unsigned& nloc, unsigned& nx) {
    const unsigned G = gridDim.x * gridDim.y * gridDim.z;
    unsigned sum, cnt, mine, sp = 0u;
    for (;;) {
        sum = 0u; cnt = 0u; mine = 0u;
#pragma unroll
        for (unsigned j = 0; j < 16; ++j) { const unsigned c = xb_ld(&bar[XB_XCNT(j)]); sum += c; cnt += (c > 0u) ? 1u : 0u; mine = (j == x) ? c : mine; }
        if (sum == G) break;
        __builtin_amdgcn_s_sleep(1);
        if ((++sp & 255u) == 0u) { if (xb_ld(&bar[XB_TMO])) break; if (sp > XB_SPIN_CAP) { atomicAdd(&bar[XB_TMO], 1u); break; } }
    }
    nloc = mine > 0u ? mine : 1u; nx = cnt > 0u ? cnt : 1u;
}
__device__ __forceinline__ void xcd_barrier(const XcdBarrier& b) {
    asm volatile("s_waitcnt vmcnt(0)" ::: "memory");
    __syncthreads();
    if (threadIdx.x == 0) {
        unsigned* bar = b.bar;
        __builtin_amdgcn_s_waitcnt(0);
        unsigned nloc = b.st[0], nx = b.st[1];
        if (nloc == 0u) { xcd_barrier_complete(bar, b.x, nloc, nx); b.st[0] = nloc; b.st[1] = nx; }
        const unsigned old = xb_add(&bar[XB_XSUB(b.x)], 1u);
        const unsigned gen = old / nloc;
        if (old + 1u == (gen + 1u) * nloc) {
            __builtin_amdgcn_fence(__ATOMIC_RELEASE, "agent");
            asm volatile("s_waitcnt vmcnt(0)" ::: "memory");
            const unsigned og = xb_add(&bar[XB_TOP], 1u);
            const unsigned tg = og / nx;
            if (og + 1u == (tg + 1u) * nx) xb_add(&bar[XB_TOPGEN], 1u);
            else XB_SPIN(xb_ld(&bar[XB_TOPGEN]) == tg, bar);
            __builtin_amdgcn_fence(__ATOMIC_ACQUIRE, "agent");
            xb_add(&bar[XB_XGEN(b.x)], 1u);
            asm volatile("s_waitcnt vmcnt(0)" ::: "memory");
        } else {
            XB_SPIN(xb_ld(&bar[XB_XGEN(b.x)]) == gen, bar);
            __builtin_amdgcn_fence(__ATOMIC_ACQUIRE, "agent");
            asm volatile("s_waitcnt vmcnt(0)" ::: "memory");
        }
    }
    __syncthreads();
}

struct Args { const float* in[21]; float* out; unsigned char* ws; int ph_lo, ph_hi; };
enum { I_X = 0, I_C, I_WADA, I_BADA, I_GMIX, I_WIN, I_BIG, I_BFG, I_GMO, I_GQ, I_GK, I_WBA, I_WBB, I_WOUT, I_GFFN, I_WR, I_BR, I_WUP, I_BUP, I_WDN, I_BDN };

struct Frame {
    LAS unsigned char* lds; unsigned char* ws; unsigned* ctl;
    int tid, lane, wave, G, wg, vcu;
};

__device__ __forceinline__ void p0_mod_partial(Frame& F, const float* c, const float* w_ada, float* modp, int item) {
    const int cg = item % 48, ks = item / 48;
    LAS float* sS = (LAS float*)F.lds;
    LAS float* red = (LAS float*)(F.lds + 8192);
    {
        const int k = F.tid;
#pragma unroll
        for (int b = 0; b < 4; ++b) { const float v = c[b * D + ks * 512 + k]; sS[b * 512 + k] = v * sigmoidf_(v); }
    }
    __syncthreads();
    f32x4 a0 = {0.f, 0.f, 0.f, 0.f}, a1 = a0, a2 = a0, a3 = a0;
    const float* wp = w_ada + (size_t)(ks * 512 + F.wave) * (6 * D) + cg * 256 + 4 * F.lane;
#pragma unroll 8
    for (int i = 0; i < 64; ++i) {
        const f32x4 w = *(const f32x4*)(wp + (size_t)(8 * i) * (6 * D));
        const int kk = F.wave + 8 * i;
        a0 += w * sS[kk]; a1 += w * sS[512 + kk]; a2 += w * sS[1024 + kk]; a3 += w * sS[1536 + kk];
    }
    *(LAS f32x4*)(red + (F.wave * 4 + 0) * 256 + 4 * F.lane) = a0;
    *(LAS f32x4*)(red + (F.wave * 4 + 1) * 256 + 4 * F.lane) = a1;
    *(LAS f32x4*)(red + (F.wave * 4 + 2) * 256 + 4 * F.lane) = a2;
    *(LAS f32x4*)(red + (F.wave * 4 + 3) * 256 + 4 * F.lane) = a3;
    __syncthreads();
#pragma unroll
    for (int r = 0; r < 2; ++r) {
        const int o = F.tid + 512 * r, b = o >> 8, col = o & 255;
        float s = 0.f;
#pragma unroll
        for (int w = 0; w < 8; ++w) s += red[(w * 4 + b) * 256 + col];
        modp[((size_t)ks * 4 + b) * (6 * D) + cg * 256 + col] = s;
    }
    __syncthreads();
}
__device__ __forceinline__ void p0_frag_item(const float* W, int ldw, int col0, bf16_t* dst, int p) {
    const int s = p >> 6, lane = p & 63;
    const float* src = W + (size_t)(32 * s + 8 * (lane >> 4)) * ldw + col0 + (lane & 15);
    u32x4 o; o.x = pk2(src[0], src[ldw]); o.y = pk2(src[2 * (size_t)ldw], src[3 * (size_t)ldw]); o.z = pk2(src[4 * (size_t)ldw], src[5 * (size_t)ldw]); o.w = pk2(src[6 * (size_t)ldw], src[7 * (size_t)ldw]);
    *(u32x4*)(dst + (size_t)p * 8) = o;
}
constexpr int CV_RS = 528, CV_BUF = 128 * CV_RS;
struct CvtItem { const float* src; bf16_t* dst; int K, ldw; };
__device__ __forceinline__ CvtItem cvt_decode(const Args& a, unsigned char* ws, int it) {
    constexpr int N_IN = 0, N_A = 4 * 16, N_O = 8 * 16, N_UP = 8 * 32, N_DN = 8 * 16;
    CvtItem c; int r = it;
    if (r < N_IN) { const int kb = r / 48, nb = r % 48, n0 = nb * 128; c.K = D; c.ldw = DIN; c.src = a.in[I_WIN] + (size_t)(kb * 256) * DIN + n0 + (n0 >= 3072 ? 16 : 0); c.dst = (bf16_t*)(ws + WS_WIN) + (size_t)n0 * D + kb * 256; return c; } r -= N_IN;
    if (r < N_A) { const int kb = r / 16, nb = r % 16; c.K = 1024; c.ldw = D; c.src = a.in[I_WBA] + (size_t)(kb * 256) * D + nb * 128; c.dst = (bf16_t*)(ws + WS_WA) + (size_t)(nb * 128) * 1024 + kb * 256; return c; } r -= N_A;
    if (r < N_A) { const int kb = r / 16, nb = r % 16; c.K = 1024; c.ldw = D; c.src = a.in[I_WBB] + (size_t)(kb * 256) * D + nb * 128; c.dst = (bf16_t*)(ws + WS_WB) + (size_t)(nb * 128) * 1024 + kb * 256; return c; } r -= N_A;
    if (r < N_O) { const int kb = r / 16, nb = r % 16; c.K = D; c.ldw = D; c.src = a.in[I_WOUT] + (size_t)(kb * 256) * D + nb * 128; c.dst = (bf16_t*)(ws + WS_WOUT) + (size_t)(nb * 128) * D + kb * 256; return c; } r -= N_O;
    const int e = r / (N_UP + N_DN); r -= e * (N_UP + N_DN);
    if (r < N_UP) { const int kb = r / 32, nb = r % 32, t = nb >> 1; c.K = D; c.ldw = 2 * D;
        c.src = a.in[I_WUP] + (size_t)e * D * (2 * D) + (size_t)(kb * 256) * (2 * D) + ((nb & 1) ? 2048 + 128 * t : 128 * t);
        c.dst = (bf16_t*)(ws + WS_WUP) + (size_t)e * (2 * D) * D + (size_t)(nb * 128) * D + kb * 256; return c; }
    r -= N_UP; { const int kb = r / 16, nb = r % 16; c.K = D; c.ldw = D; c.src = a.in[I_WDN] + (size_t)e * D * D + (size_t)(kb * 256) * D + nb * 128; c.dst = (bf16_t*)(ws + WS_WDN) + (size_t)e * D * D + (size_t)(nb * 128) * D + kb * 256; }
    return c;
}
constexpr int CVT_DENSE_ITEMS = 2 * 4 * 16 + 8 * 16;
__device__ __forceinline__ CvtItem cvt_decode_moe(const Args& a, unsigned char* ws, int e, int which, int j, int kb) {
    CvtItem c; c.K = D;
    if (which == 0) { const int t = j >> 1; c.ldw = 2 * D;
        c.src = a.in[I_WUP] + (size_t)e * D * (2 * D) + (size_t)(kb * 256) * (2 * D) + ((j & 1) ? 2048 + 128 * t : 128 * t);
        c.dst = (bf16_t*)(ws + WS_WUP) + (size_t)e * (2 * D) * D + (size_t)(j * 128) * D + kb * 256; }
    else { c.ldw = D; c.src = a.in[I_WDN] + (size_t)e * D * D + (size_t)(kb * 256) * D + j * 128; c.dst = (bf16_t*)(ws + WS_WDN) + (size_t)e * D * D + (size_t)(j * 128) * D + kb * 256; }
    return c;
}
__device__ __forceinline__ void cvt_load(const CvtItem& c, f32x4 (&v)[16], int wave, int lane) {
    const float* p = c.src + (size_t)(32 * wave + 16 * (lane >> 5)) * c.ldw + 4 * (lane & 31);
#pragma unroll
    for (int i = 0; i < 16; ++i) v[i] = __builtin_nontemporal_load((const f32x4*)(p + (size_t)i * c.ldw));
}
__device__ __forceinline__ void cvt_to_lds(const f32x4 (&v)[16], LAS unsigned char* buf, int wave, int lane) {
    const int n4 = lane & 31, hh = lane >> 5;
#pragma unroll
    for (int g = 0; g < 2; ++g)
#pragma unroll
        for (int j = 0; j < 4; ++j) {
            u32x4 o; o.x = pk2(v[8 * g + 0][j], v[8 * g + 1][j]); o.y = pk2(v[8 * g + 2][j], v[8 * g + 3][j]); o.z = pk2(v[8 * g + 4][j], v[8 * g + 5][j]); o.w = pk2(v[8 * g + 6][j], v[8 * g + 7][j]);
            *(LAS u32x4*)(buf + (4 * n4 + j) * CV_RS + (4 * wave + 2 * hh + g) * 16) = o; }
}
template <bool SC1>
__device__ __forceinline__ void cvt_store(const CvtItem& c, const LAS unsigned char* buf, int tid) {
#pragma unroll
    for (int i = 0; i < 8; ++i) { const int id = tid + 512 * i, row = id >> 5, ch = id & 31;
        const u32x4 v = *(const LAS u32x4*)(buf + row * CV_RS + ch * 16);
        if (SC1) store16_sc1(c.dst + (size_t)row * c.K + ch * 8, v); else *(u32x4*)(c.dst + (size_t)row * c.K + ch * 8) = v; }
}
template <bool SC1, class Dec>
__device__ __forceinline__ void cvt_stream(Frame& F, const Dec& dec, int first, int n, int step) {
    int it = first;
    if (it >= n) return;
    int tid = threadIdx.x; asm volatile("" : "+v"(tid));
    const int wave = __builtin_amdgcn_readfirstlane(tid >> 6), lane = tid & 63;
    f32x4 v[16];
    CvtItem cur = dec(it);
    cvt_load(cur, v, wave, lane);
    cvt_to_lds(v, F.lds, wave, lane);
    __syncthreads();
#pragma unroll 1
    for (int i = 0;; ++i) {
        const int nx = it + step; const bool has_next = nx < n;
        CvtItem nxt = cur;
        if (has_next) { nxt = dec(nx); cvt_load(nxt, v, wave, lane); }
        cvt_store<SC1>(cur, F.lds + (i & 1) * CV_BUF, tid);
        if (has_next) cvt_to_lds(v, F.lds + ((i + 1) & 1) * CV_BUF, wave, lane);
        __syncthreads();
        if (!has_next) break;
        cur = nxt; it = nx;
    }
}
constexpr int C8_RS = 272, C8_BUF = 128 * C8_RS;
struct Cvt8Item { const float* src; unsigned char* dst; int ldw; };
__device__ __forceinline__ Cvt8Item cvt8_decode(const Args& a, unsigned char* ws, int e, int which, int j, int kb) {
    Cvt8Item c;
    if (which == 0) { const int t = j >> 1; c.ldw = 2 * D;
        c.src = a.in[I_WUP] + (size_t)e * D * (2 * D) + (size_t)(kb * 256) * (2 * D) + ((j & 1) ? 2048 + 128 * t : 128 * t);
        c.dst = ws + WS_WUP + ((size_t)e * (2 * D) + (size_t)(j * 128)) * D + kb * 256; }
    else { c.ldw = D; c.src = a.in[I_WDN] + (size_t)e * D * D + (size_t)(kb * 256) * D + j * 128; c.dst = ws + WS_WDN + ((size_t)e * D + (size_t)(j * 128)) * D + kb * 256; }
    return c;
}
__device__ __forceinline__ void cvt8_load(const Cvt8Item& c, f32x4 (&v)[16], int wave, int lane) {
    const float* p = c.src + (size_t)(32 * wave + 16 * (lane >> 5)) * c.ldw + 4 * (lane & 31);
#pragma unroll
    for (int i = 0; i < 16; ++i) v[i] = __builtin_nontemporal_load((const f32x4*)(p + (size_t)i * c.ldw));
}
__device__ __forceinline__ void cvt8_to_lds(const f32x4 (&v)[16], LAS unsigned char* buf, int wave, int lane) {
    const int n4 = lane & 31, hh = lane >> 5;
#pragma unroll
    for (int j = 0; j < 4; ++j) {
        u32x4 o;
        o.x = pk4_fp8(v[0][j] * W8_SCALE, v[1][j] * W8_SCALE, v[2][j] * W8_SCALE, v[3][j] * W8_SCALE);
        o.y = pk4_fp8(v[4][j] * W8_SCALE, v[5][j] * W8_SCALE, v[6][j] * W8_SCALE, v[7][j] * W8_SCALE);
        o.z = pk4_fp8(v[8][j] * W8_SCALE, v[9][j] * W8_SCALE, v[10][j] * W8_SCALE, v[11][j] * W8_SCALE);
        o.w = pk4_fp8(v[12][j] * W8_SCALE, v[13][j] * W8_SCALE, v[14][j] * W8_SCALE, v[15][j] * W8_SCALE);
        *(LAS u32x4*)(buf + (4 * n4 + j) * C8_RS + (2 * wave + hh) * 16) = o; }
}
__device__ __forceinline__ void cvt8_store(const Cvt8Item& c, const LAS unsigned char* buf, int tid) {
#pragma unroll
    for (int i = 0; i < 4; ++i) { const int id = tid + 512 * i, row = id >> 4, ch = id & 15;
        store16_sc1(c.dst + (size_t)row * D + ch * 16, *(const LAS u32x4*)(buf + row * C8_RS + ch * 16)); }
}
template <bool SC1>
__device__ __forceinline__ void cvt8_store_t(const Cvt8Item& c, const LAS unsigned char* buf, int tid) {
#pragma unroll
    for (int i = 0; i < 4; ++i) { const int id = tid + 512 * i, row = id >> 4, ch = id & 15;
        const u32x4 v = *(const LAS u32x4*)(buf + row * C8_RS + ch * 16);
        if (SC1) store16_sc1(c.dst + (size_t)row * D + ch * 16, v); else __builtin_nontemporal_store(v, (u32x4*)(c.dst + (size_t)row * D + ch * 16)); }
}
__device__ __forceinline__ Cvt8Item cvt8_decode_lin(const Args& a, unsigned char* ws, int idx) {
    const int e = idx / 384; int r = idx - e * 384; int which = 0;
    if (r >= 256) { r -= 256; which = 1; }
    return cvt8_decode(a, ws, e, which, r >> 3, r & 7);
}
__device__ __forceinline__ void cvt8_all(Frame& F, const Args& a, unsigned char* ws) {
    constexpr int N = NE * 384;
    int it = F.vcu;
    if (it >= N) return;
    int tid = threadIdx.x; asm volatile("" : "+v"(tid));
    const int wave = __builtin_amdgcn_readfirstlane(tid >> 6), lane = tid & 63;
    f32x4 v[16];
    Cvt8Item cur = cvt8_decode_lin(a, ws, it);
    cvt8_load(cur, v, wave, lane);
    cvt8_to_lds(v, F.lds, wave, lane);
    __syncthreads();
#pragma unroll 1
    for (int i = 0;; ++i) {
        const int nx = it + F.G; const bool has_next = nx < N;
        Cvt8Item nxt = cur;
        if (has_next) { nxt = cvt8_decode_lin(a, ws, nx); cvt8_load(nxt, v, wave, lane); }
        cvt8_store_t<false>(cur, F.lds + (i & 1) * C8_BUF, tid);
        if (has_next) cvt8_to_lds(v, F.lds + ((i + 1) & 1) * C8_BUF, wave, lane);
        __syncthreads();
        if (!has_next) break;
        cur = nxt; it = nx;
    }
}
__device__ __forceinline__ void cvt8_item(Frame& F, const Args& a, int idx);
template <bool SC1>
__device__ __forceinline__ void cvt8_stream(Frame& F, const Args& a, unsigned char* ws, int e, int which, int j) {
    int tid = threadIdx.x; asm volatile("" : "+v"(tid));
    const int wave = __builtin_amdgcn_readfirstlane(tid >> 6), lane = tid & 63;
    f32x4 va[16], vb[16];
    Cvt8Item c0 = cvt8_decode(a, ws, e, which, j, 0), c1 = cvt8_decode(a, ws, e, which, j, 1);
    cvt8_load(c0, va, wave, lane);
    cvt8_load(c1, vb, wave, lane);
    __builtin_amdgcn_sched_barrier(0);
    cvt8_to_lds(va, F.lds, wave, lane);
    __syncthreads();
#pragma unroll
    for (int k = 0; k < 8; k += 2) {
        Cvt8Item c2 = c0, c3 = c1;
        __builtin_amdgcn_sched_barrier(0);
        if (k + 2 < 8) { c2 = cvt8_decode(a, ws, e, which, j, k + 2); cvt8_load(c2, va, wave, lane); }
        __builtin_amdgcn_sched_barrier(0);
        cvt8_store_t<SC1>(c0, F.lds, tid);
        __builtin_amdgcn_sched_barrier(0);
        cvt8_to_lds(vb, F.lds + C8_BUF, wave, lane);
        __syncthreads();
        __builtin_amdgcn_sched_barrier(0);
        if (k + 3 < 8) { c3 = cvt8_decode(a, ws, e, which, j, k + 3); cvt8_load(c3, vb, wave, lane); }
        __builtin_amdgcn_sched_barrier(0);
        cvt8_store_t<SC1>(c1, F.lds + C8_BUF, tid);
        __builtin_amdgcn_sched_barrier(0);
        if (k + 2 < 8) cvt8_to_lds(va, F.lds, wave, lane);
        __syncthreads();
        c0 = c2; c1 = c3;
    }
}
__device__ __forceinline__ void cvt8_win_sub(Frame& F, const Args& a, int q) {
    int tid = threadIdx.x; asm volatile("" : "+v"(tid));
    const int wave = __builtin_amdgcn_readfirstlane(tid >> 6), lane = tid & 63, j = q >> 3, kb = q & 7;
    Cvt8Item c; c.ldw = DIN; c.src = a.in[I_WIN] + (size_t)(kb * 256) * DIN + j * 128 + (j >= 24 ? 16 : 0); c.dst = F.ws + WS_WIN8 + (size_t)(j * 128) * D + kb * 256;
    f32x4 v[16];
    __syncthreads();
    cvt8_load(c, v, wave, lane);
    cvt8_to_lds(v, F.lds, wave, lane);
    __syncthreads();
    cvt8_store_t<false>(c, F.lds, tid);
    __syncthreads();
}
__device__ __forceinline__ void cvt8_wout_sub(Frame& F, const Args& a, int q) {
    int tid = threadIdx.x; asm volatile("" : "+v"(tid));
    const int wave = __builtin_amdgcn_readfirstlane(tid >> 6), lane = tid & 63, j = q >> 3, kb = q & 7;
    Cvt8Item c; c.ldw = D; c.src = a.in[I_WOUT] + (size_t)(kb * 256) * D + j * 128; c.dst = F.ws + WS_WOUT8 + (size_t)(j * 128) * D + kb * 256;
    f32x4 v[16];
    __syncthreads();
    cvt8_load(c, v, wave, lane);
    cvt8_to_lds(v, F.lds, wave, lane);
    __syncthreads();
    cvt8_store_t<false>(c, F.lds, tid);
    __syncthreads();
}
__device__ __forceinline__ void cvt8_wbr_sub(Frame& F, const Args& a, int q) {
    int tid = threadIdx.x; asm volatile("" : "+v"(tid));
    const int wave = __builtin_amdgcn_readfirstlane(tid >> 6), lane = tid & 63, which = q >> 6, j = (q >> 2) & 15, kb = q & 3;
    Cvt8Item c; c.ldw = D; c.src = (which ? a.in[I_WBB] : a.in[I_WBA]) + (size_t)(kb * 256) * D + j * 128; c.dst = F.ws + (which ? WS_WB : WS_WA) + (size_t)(j * 128) * 1024 + kb * 256;
    f32x4 v[16];
    __syncthreads();
    cvt8_load(c, v, wave, lane);
    cvt8_to_lds(v, F.lds, wave, lane);
    __syncthreads();
#pragma unroll
    for (int i = 0; i < 4; ++i) { const int id = tid + 512 * i, row = id >> 4, ch = id & 15;
        *(u32x4*)(c.dst + (size_t)row * 1024 + ch * 16) = *(const LAS u32x4*)(F.lds + row * C8_RS + ch * 16); }
    __syncthreads();
}
__device__ __forceinline__ void cvt8_item(Frame& F, const Args& a, int idx) {
    if (idx < 1024) cvt8_stream<false>(F, a, F.ws, idx >> 5, 0, idx & 31);
    else cvt8_stream<false>(F, a, F.ws, (idx - 1024) >> 4, 1, (idx - 1024) & 15);
}
__device__ __forceinline__ void cvt8_item_signal(Frame& F, const Args& a, int idx, unsigned* upd) {
    const int e = (idx - 1024) >> 4;
    cvt8_stream<true>(F, a, F.ws, e, 1, (idx - 1024) & 15);
    asm volatile("s_waitcnt vmcnt(0)" ::: "memory");
    __syncthreads();
    if (F.tid < 32) __hip_atomic_fetch_add(upd + (e * 32 + F.tid) * 16, 1u, __ATOMIC_RELAXED, __HIP_MEMORY_SCOPE_AGENT);
}
struct DenseDec { const Args* a; unsigned char* ws; __device__ __forceinline__ CvtItem operator()(int it) const { return cvt_decode(*a, ws, it); } };
struct MoeDec { const Args* a; unsigned char* ws; int e, which, j; __device__ __forceinline__ CvtItem operator()(int kb) const { return cvt_decode_moe(*a, ws, e, which, j, kb); } };
__device__ __forceinline__ void p0_prologue(Frame& F, const Args& a) {
    unsigned char* ws = F.ws;
    for (int it = F.wg; it < 192; it += F.G) p0_mod_partial(F, a.in[I_C], a.in[I_WADA], (float*)(ws + WS_MODP), it);
    for (int p = (F.G - 1 - F.wg) * 512 + F.tid; p < 4096 + 8192; p += F.G * 512) {
        if (p < 4096) p0_frag_item(a.in[I_WIN], DIN, GATE_COL, (bf16_t*)(ws + WS_WGF), p);
        else { const int q = p - 4096, ct = q >> 12; p0_frag_item(a.in[I_WR], NE, 16 * ct, (bf16_t*)(ws + WS_WRF) + (size_t)ct * 4096 * 8, q & 4095); }
    }
    __syncthreads();
    for (int q = F.vcu; q < 640; q += F.G) cvt8_win_sub(F, a, q);
    for (int q = F.G - 1 - F.vcu; q < 256; q += F.G) { if (q < 128) cvt8_wout_sub(F, a, q); else cvt8_wbr_sub(F, a, q - 128); }
}

constexpr int HL_STRIDE = 4112;
constexpr int HL_BYTES = 32 * HL_STRIDE;
constexpr int PART_OFF = 132096;
constexpr int LOGIT_OFF = PART_OFF + 8192;
constexpr int DST_OFF = LOGIT_OFF + 4096;

__device__ __forceinline__ f32x4 mod4(const float* modp, const float* b_ada, int b, int idx) {
    f32x4 s = *(const f32x4*)(b_ada + idx);
#pragma unroll
    for (int ks = 0; ks < 4; ++ks) s += *(const f32x4*)(modp + ((size_t)ks * 4 + b) * (6 * D) + idx);
    return s;
}
template <bool FROM_PARTIALS>
__device__ __forceinline__ void norm_rows_32(Frame& F, const float* xin, const float* gvec, const float* modsrc, const float* b_ada, int chunk_sh, int rb, bf16_t* gout, unsigned char* gout8 = nullptr) {
    const int b = rb >> 6; int lane = F.lane; asm volatile("" : "+v"(lane));
    f32x4 xa[8], xb[8];
    const float* xr = xin + ((size_t)rb * 32 + 4 * F.wave) * D + 4 * lane;
#pragma unroll
    for (int j = 0; j < 8; ++j) xa[j] = *(const f32x4*)(xr + 256 * j);
#pragma unroll
    for (int j = 0; j < 8; ++j) xb[j] = *(const f32x4*)(xr + D + 256 * j);
    f32x4 xc[8], xd[8];
    if (!FROM_PARTIALS) {
#pragma unroll
        for (int j = 0; j < 8; ++j) xc[j] = *(const f32x4*)(xr + 2 * D + 256 * j);
#pragma unroll
        for (int j = 0; j < 8; ++j) xd[j] = *(const f32x4*)(xr + 3 * D + 256 * j);
    }
    f32x4 gsc[8], shv[8];
#pragma unroll
    for (int j = 0; j < 8; ++j) {
        const int col = 4 * (lane + 64 * j);
        f32x4 sh, sc;
        if (FROM_PARTIALS) { sh = mod4(modsrc, b_ada, b, chunk_sh * D + col); sc = mod4(modsrc, b_ada, b, (chunk_sh + 1) * D + col); }
        else { sh = *(const f32x4*)(modsrc + (size_t)b * (6 * D) + chunk_sh * D + col); sc = *(const f32x4*)(modsrc + (size_t)b * (6 * D) + (chunk_sh + 1) * D + col); }
        const f32x4 g = *(const f32x4*)(gvec + col);
        gsc[j] = g * (sc + 1.0f); shv[j] = sh;
        if (j & 1) __builtin_amdgcn_sched_barrier(0);
    }
#pragma unroll
    for (int i = 0; i < 4; ++i) {
        const int r = 4 * F.wave + i; const size_t row = (size_t)rb * 32 + r;
        f32x4 xv[8]; float ss = 0.f;
#pragma unroll
        for (int j = 0; j < 8; ++j) { xv[j] = FROM_PARTIALS ? ((i & 1) ? xb[j] : xa[j]) : (i == 0 ? xa[j] : i == 1 ? xb[j] : i == 2 ? xc[j] : xd[j]); ss += (xv[j][0] * xv[j][0] + xv[j][1] * xv[j][1]) + (xv[j][2] * xv[j][2] + xv[j][3] * xv[j][3]); }
        if (FROM_PARTIALS && i < 2) {
#pragma unroll
            for (int j = 0; j < 8; ++j) { const f32x4 nx = *(const f32x4*)(xr + (size_t)(i + 2) * D + 256 * j); if (i & 1) xb[j] = nx; else xa[j] = nx; }
        }
        __builtin_amdgcn_sched_barrier(0);
        const float rinv = rsqrtf(wave_sum(ss) * (1.0f / D) + EPS);
        int ls = lane; asm volatile("" : "+v"(ls));
        const size_t so = row * D + 4 * (size_t)ls;
#pragma unroll
        for (int j = 0; j < 8; ++j) {
            const f32x4 hv = xv[j] * rinv * gsc[j] + shv[j];
            u32x2 p; p.x = pk2(hv[0], hv[1]); p.y = pk2(hv[2], hv[3]);
            *(LAS u32x2*)(F.lds + r * HL_STRIDE + 8 * ls + 512 * j) = p;
            if (gout) *(u32x2*)(gout + so + 256 * j) = p;
            if (gout8) *(unsigned*)(gout8 + so + 256 * j) = pk4_fp8(hv[0], hv[1], hv[2], hv[3]);
        }
        __builtin_amdgcn_sched_barrier(0);
    }
}
__device__ __forceinline__ void norm_rows_32_b(Frame& F, const bf16_t* xin, const float* gvec, const float* modsrc, int chunk_sh, int rb) {
    const int b = rb >> 6; int lane = F.lane; asm volatile("" : "+v"(lane));
    u32x2 xr_[4][8];
    const bf16_t* xr = xin + ((size_t)rb * 32 + 4 * F.wave) * D + 4 * lane;
#pragma unroll
    for (int i = 0; i < 4; ++i)
#pragma unroll
        for (int j = 0; j < 8; ++j) xr_[i][j] = *(const u32x2*)(xr + (size_t)i * D + 256 * j);
    f32x4 gsc[8], shv[8];
#pragma unroll
    for (int j = 0; j < 8; ++j) {
        const int col = 4 * (lane + 64 * j);
        const f32x4 sh = *(const f32x4*)(modsrc + (size_t)b * (6 * D) + chunk_sh * D + col), sc = *(const f32x4*)(modsrc + (size_t)b * (6 * D) + (chunk_sh + 1) * D + col);
        const f32x4 g = *(const f32x4*)(gvec + col);
        gsc[j] = g * (sc + 1.0f); shv[j] = sh;
    }
#pragma unroll
    for (int i = 0; i < 4; ++i) {
        const int r = 4 * F.wave + i;
        f32x4 xv[8]; float ss = 0.f;
#pragma unroll
        for (int j = 0; j < 8; ++j) { const u32x2 q = xr_[i][j]; xv[j] = (f32x4){bf_lo(q.x), bf_hi(q.x), bf_lo(q.y), bf_hi(q.y)}; ss += (xv[j][0] * xv[j][0] + xv[j][1] * xv[j][1]) + (xv[j][2] * xv[j][2] + xv[j][3] * xv[j][3]); }
        const float rinv = rsqrtf(wave_sum(ss) * (1.0f / D) + EPS);
#pragma unroll
        for (int j = 0; j < 8; ++j) {
            const f32x4 hv = xv[j] * rinv * gsc[j] + shv[j];
            u32x2 p; p.x = pk2(hv[0], hv[1]); p.y = pk2(hv[2], hv[3]);
            *(LAS u32x2*)(F.lds + r * HL_STRIDE + 8 * lane + 512 * j) = p;
        }
    }
}
__device__ __forceinline__ void p1_rows(Frame& F, const Args& a) {
    unsigned char* ws = F.ws;
    const float* modp = (const float*)(ws + WS_MODP);
    { float* modf = (float*)(ws + WS_MODF);
      for (int i = F.wg * 512 + F.tid; i < NB * 6 * D; i += F.G * 512) { const int b = i / (6 * D), idx = i % (6 * D); float s = a.in[I_BADA][idx];
#pragma unroll
          for (int ks = 0; ks < 4; ++ks) s += modp[((size_t)ks * 4 + b) * (6 * D) + idx];
          modf[i] = s; } }
    if (F.wg == 0 && F.wave == 0) {
        float mq = fmaxf(fabsf(a.in[I_GQ][2 * F.lane]), fabsf(a.in[I_GQ][2 * F.lane + 1])), mk = fmaxf(fabsf(a.in[I_GK][2 * F.lane]), fabsf(a.in[I_GK][2 * F.lane + 1]));
#pragma unroll
        for (int o = 1; o < 64; o <<= 1) { mq = fmaxf(mq, __shfl_xor(mq, o)); mk = fmaxf(mk, __shfl_xor(mk, o)); }
        if (F.lane == 0) ((float*)F.ctl)[CW_MISC] = 16.3223f * 1.01f * mq * mk;
    }
    const bf16_t* wgf = (const bf16_t*)(ws + WS_WGF);
    float* gates = (float*)(ws + WS_GATES);
    LAS float* part = (LAS float*)(F.lds + PART_OFF);
    const int lane = F.lane, l15 = lane & 15, g4 = lane >> 4;
    for (int rb = F.wg; rb < T / 32; rb += F.G) {
        norm_rows_32<true>(F, a.in[I_X], a.in[I_GMIX], modp, a.in[I_BADA], 0, rb, nullptr, ws + WS_HBUF8);
        { const int rg = F.wave & 1, kq = F.wave >> 1; f32x4 acc = {0.f, 0.f, 0.f, 0.f};
          bf16x8 bvv[16];
          __builtin_amdgcn_sched_barrier(0);
          const bf16_t* wq = wgf + ((size_t)(16 * kq) * 64 + lane) * 8; asm volatile("" : "+v"(wq));
#pragma unroll
          for (int s = 0; s < 16; ++s) bvv[s] = *(const bf16x8*)(wq + (size_t)s * 512);
          __syncthreads();
#pragma unroll
          for (int s = 0; s < 16; ++s) { const int ks = 16 * kq + s;
              const bf16x8 av = *(const LAS bf16x8*)(F.lds + (16 * rg + l15) * HL_STRIDE + (32 * ks + 8 * g4) * 2);
              acc = __builtin_amdgcn_mfma_f32_16x16x32_bf16(av, bvv[s], acc, 0, 0, 0); }
#pragma unroll
          for (int r = 0; r < 4; ++r) part[(kq * 2 + rg) * 256 + (4 * g4 + r) * 16 + l15] = acc[r]; }
        __syncthreads();
        { const int rg = F.tid >> 8, rc = F.tid & 255; float s = 0.f;
#pragma unroll
          for (int kq = 0; kq < 4; ++kq) s += part[(kq * 2 + rg) * 256 + rc];
          gates[((size_t)rb * 32 + 16 * rg + (rc >> 4)) * 16 + (rc & 15)] = s; }
        __syncthreads();
    }
}

__device__ __forceinline__ void p3_qknorm(Frame& F, const Args& a) {
    bf16_t* z = (bf16_t*)(F.ws + WS_Z); float* kmean = (float*)(F.ws + WS_KMEAN);
    LAS float* cs = (LAS float*)F.lds;
    const int lane = F.lane;
    for (int u = F.wg; u < 512; u += F.G) {
        const int which = u & 1, h = (u >> 1) & 7, blk = (u >> 4) & 7, b = u >> 7;
        const float* gv = which ? a.in[I_GK] : a.in[I_GQ];
        const float g0 = gv[2 * lane], g1 = gv[2 * lane + 1];
        bf16_t* base = z + ((size_t)b * SEQ + blk * 256 + 32 * F.wave) * ZP + (which ? ZKB : ZQB) + h * 128 + 2 * lane;
        unsigned v[32];
#pragma unroll
        for (int i = 0; i < 32; ++i) v[i] = *(const unsigned*)(base + (size_t)i * ZP);
        float c0 = 0.f, c1 = 0.f;
#pragma unroll
        for (int i = 0; i < 32; ++i) {
            const float f0 = bf_lo(v[i]), f1 = bf_hi(v[i]);
            const float rinv = rsqrtf(wave_sum(f0 * f0 + f1 * f1) * (1.0f / 128.0f) + EPS);
            const float y0 = f0 * rinv * g0, y1 = f1 * rinv * g1;
            *(unsigned*)(base + (size_t)i * ZP) = pk2(y0, y1);
            c0 += y0; c1 += y1;
        }
        if (which) {
            cs[F.wave * 128 + 2 * lane] = c0; cs[F.wave * 128 + 2 * lane + 1] = c1;
            __syncthreads();
            if (F.tid < 128) { float s = 0.f;
#pragma unroll
                for (int w = 0; w < 8; ++w) s += cs[w * 128 + F.tid];
                kmean[(((size_t)b * 8 + h) * 8 + blk) * 128 + F.tid] = s * (1.0f / 256.0f); }
            __syncthreads();
        }
    }
}

__device__ __forceinline__ s16x4 tr16(LAS unsigned char* p) { return __builtin_amdgcn_ds_read_tr16_b64_v4i16((LAS s16x4*)p); }
__device__ __forceinline__ bf16x8 cat8(s16x4 a, s16x4 b) { return (bf16x8){a[0], a[1], a[2], a[3], b[0], b[1], b[2], b[3]}; }
#define MFMA16(a, b, c) __builtin_amdgcn_mfma_f32_16x16x32_bf16((a), (b), (c), 0, 0, 0)

struct ChunkGates { float li, bcs, u, pmx, g, umax; };
__device__ __forceinline__ ChunkGates chunk_gates(float gi_raw, float gf_raw, float bi, float bfg, int lane) {
    ChunkGates G;
    const float ti = __expf((gi_raw + bi) * (2.0f / 15.0f)), tf = __expf((gf_raw + bfg) * (2.0f / 15.0f));
    G.li = 15.0f - 30.0f * __builtin_amdgcn_rcpf(ti + 1.0f);
    const float xf = 15.0f - 30.0f * __builtin_amdgcn_rcpf(tf + 1.0f);
    const float lf = fminf(xf, 0.f) - __logf(1.0f + __expf(-fabsf(xf)));
    float bcs = lf;
#pragma unroll
    for (int o = 1; o < 64; o <<= 1) { const float t = __shfl_up(bcs, o); if (lane >= o) bcs += t; }
    G.bcs = bcs; G.g = __shfl(bcs, 63); G.u = G.li - bcs;
    float pmx = G.u;
#pragma unroll
    for (int o = 1; o < 64; o <<= 1) { const float t = __shfl_up(pmx, o); if (lane >= o) pmx = fmaxf(pmx, t); }
    G.pmx = pmx; G.umax = __shfl(pmx, 63);
    return G;
}
constexpr int ML_QS = 0, ML_KS = 9216, ML_KW = 18432, ML_VS = 27648, ML_SB = 45056, ML_CB = 54272, ML_HO = 72704, ML_FLO = 90112, ML_RS = 144, ML_VR = 272;

struct PassAIn { u32x4 kv, v0, v1; float gi, gf; };
__device__ __forceinline__ PassAIn mlstm_passA_load(Frame& F, int u) {
    const bf16_t* z = (const bf16_t*)(F.ws + WS_Z); const float* gates = (const float*)(F.ws + WS_GATES);
    const int c = u & 31, h = (u >> 5) & 7, b = u >> 8;
    const size_t tok0 = (size_t)b * SEQ + c * 64;
    const int lr = F.tid >> 3, ls = F.tid & 7;
    const bf16_t* zr = z + (tok0 + lr) * ZP;
    PassAIn I;
    I.kv = *(const u32x4*)(zr + ZKA + h * 64 + ls * 8);
    I.v0 = *(const u32x4*)(zr + ZVA + h * 128 + ls * 8); I.v1 = *(const u32x4*)(zr + ZVA + h * 128 + 64 + ls * 8);
    I.gi = gates[(tok0 + F.lane) * 16 + h]; I.gf = gates[(tok0 + F.lane) * 16 + 8 + h];
    return I;
}
__device__ __forceinline__ void mlstm_passA(Frame& F, const Args& a, int u, const PassAIn& I) {
    LAS unsigned char* L = F.lds; LAS float* fl = (LAS float*)(L + ML_FLO);
    float* cloc = (float*)(F.ws + WS_CLOC) + (size_t)u * 8192; float* nloc = (float*)(F.ws + WS_NLOC) + (size_t)u * 64; float* msc = (float*)(F.ws + WS_MSC) + (size_t)u * 4;
    const int tid = F.tid, lane = F.lane, w = F.wave, l15 = lane & 15, g4 = lane >> 4;
    const int h = (u >> 5) & 7;
    const int lr = tid >> 3, ls = tid & 7;
    const u32x4 kv = I.kv, v0 = I.v0, v1 = I.v1;
    __syncthreads();
    if (w == 0) {
        const ChunkGates G = chunk_gates(I.gi, I.gf, a.in[I_BIG][h], a.in[I_BFG][h], lane);
        fl[256 + lane] = __expf(G.u - G.umax);
        if (lane == 0) { msc[0] = G.g + G.umax; msc[1] = G.g; }
    }
    *(LAS u32x4*)(L + ML_VS + lr * ML_VR + ls * 16) = v0; *(LAS u32x4*)(L + ML_VS + lr * ML_VR + 128 + ls * 16) = v1;
    __syncthreads();
    { const float wr_ = fl[256 + lr];
      u32x4 o; o.x = pk2(bf_lo(kv.x) * wr_, bf_hi(kv.x) * wr_); o.y = pk2(bf_lo(kv.y) * wr_, bf_hi(kv.y) * wr_); o.z = pk2(bf_lo(kv.z) * wr_, bf_hi(kv.z) * wr_); o.w = pk2(bf_lo(kv.w) * wr_, bf_hi(kv.w) * wr_);
      *(LAS u32x4*)(L + ML_KW + lr * ML_RS + ls * 16) = o; }
    __syncthreads();
    f32x4 Cacc[4];
#pragma unroll
    for (int et = 0; et < 4; ++et) Cacc[et] = (f32x4){0.f, 0.f, 0.f, 0.f};
#pragma unroll
    for (int ks = 0; ks < 2; ++ks) {
        LAS unsigned char* vp = L + ML_VS + (32 * ks + 8 * g4 + (l15 >> 2)) * ML_VR + (16 * w + 4 * (l15 & 3)) * 2;
        const bf16x8 av = cat8(tr16(vp), tr16(vp + 4 * ML_VR));
#pragma unroll
        for (int et = 0; et < 4; ++et) {
            LAS unsigned char* kp = L + ML_KW + (32 * ks + 8 * g4 + (l15 >> 2)) * ML_RS + (16 * et + 4 * (l15 & 3)) * 2;
            Cacc[et] = MFMA16(av, cat8(tr16(kp), tr16(kp + 4 * ML_RS)), Cacc[et]); } }
#pragma unroll
    for (int et = 0; et < 4; ++et)
#pragma unroll
        for (int r = 0; r < 4; ++r) cloc[(16 * w + 4 * g4 + r) * 64 + 16 * et + l15] = Cacc[et][r];
    { const int e = tid >> 3, part = tid & 7; float sacc = 0.f;
#pragma unroll
      for (int i = 0; i < 8; ++i) sacc += bf1(*(const LAS bf16_t*)(L + ML_KW + (8 * part + i) * ML_RS + e * 2));
      sacc = sum8_(sacc);
      if (part == 0) nloc[e] = sacc; }
}

__device__ __forceinline__ void mlstm_passA4(Frame& F, const Args& a) {
    constexpr int CH = 27648, VS = 0, KW = 17408, FL = 26624;
    const bf16_t* z = (const bf16_t*)(F.ws + WS_Z); const float* gates = (const float*)(F.ws + WS_GATES);
    int tid = F.tid; asm volatile("" : "+v"(tid));
    const int lane = tid & 63, w = F.wave, l15 = lane & 15, g4 = lane >> 4, lr = tid >> 3, ls = tid & 7;
    u32x4 kv[4], v0[4], v1[4]; float gi[4], gf[4];
#pragma unroll
    for (int k = 0; k < 4; ++k) {
        const int u = F.wg + 256 * k, c = u & 31, h = (u >> 5) & 7, b = u >> 8;
        const size_t tok0 = (size_t)b * SEQ + c * 64;
        const bf16_t* zr = z + (tok0 + lr) * ZP;
        kv[k] = *(const u32x4*)(zr + ZKA + h * 64 + ls * 8);
        v0[k] = *(const u32x4*)(zr + ZVA + h * 128 + ls * 8); v1[k] = *(const u32x4*)(zr + ZVA + h * 128 + 64 + ls * 8);
        gi[k] = gates[(tok0 + lane) * 16 + h]; gf[k] = gates[(tok0 + lane) * 16 + 8 + h];
    }
    __syncthreads();
#pragma unroll
    for (int k = 0; k < 4; ++k) {
        const int u = F.wg + 256 * k, h = (u >> 5) & 7;
        LAS unsigned char* L = F.lds + k * CH; LAS float* fl = (LAS float*)(L + FL);
        if (w == k) {
            const ChunkGates G = chunk_gates(gi[k], gf[k], a.in[I_BIG][h], a.in[I_BFG][h], lane);
            fl[lane] = __expf(G.u - G.umax);
            if (lane == 0) { float* msc = (float*)(F.ws + WS_MSC) + (size_t)u * 4; msc[0] = G.g + G.umax; msc[1] = G.g; }
        }
        *(LAS u32x4*)(L + VS + lr * ML_VR + ls * 16) = v0[k]; *(LAS u32x4*)(L + VS + lr * ML_VR + 128 + ls * 16) = v1[k];
    }
    __syncthreads();
#pragma unroll
    for (int k = 0; k < 4; ++k) {
        LAS unsigned char* L = F.lds + k * CH; const LAS float* fl = (const LAS float*)(L + FL);
        const float wr_ = fl[lr]; const u32x4 q = kv[k];
        u32x4 o; o.x = pk2(bf_lo(q.x) * wr_, bf_hi(q.x) * wr_); o.y = pk2(bf_lo(q.y) * wr_, bf_hi(q.y) * wr_); o.z = pk2(bf_lo(q.z) * wr_, bf_hi(q.z) * wr_); o.w = pk2(bf_lo(q.w) * wr_, bf_hi(q.w) * wr_);
        *(LAS u32x4*)(L + KW + lr * ML_RS + ls * 16) = o;
    }
    __syncthreads();
#pragma unroll
    for (int k = 0; k < 4; ++k) {
        const int u = F.wg + 256 * k;
        LAS unsigned char* L = F.lds + k * CH;
        float* cloc = (float*)(F.ws + WS_CLOC) + (size_t)u * 8192; float* nloc = (float*)(F.ws + WS_NLOC) + (size_t)u * 64;
        f32x4 Cacc[4];
#pragma unroll
        for (int et = 0; et < 4; ++et) Cacc[et] = (f32x4){0.f, 0.f, 0.f, 0.f};
#pragma unroll
        for (int ks = 0; ks < 2; ++ks) {
            LAS unsigned char* vp = L + VS + (32 * ks + 8 * g4 + (l15 >> 2)) * ML_VR + (16 * w + 4 * (l15 & 3)) * 2;
            const bf16x8 av = cat8(tr16(vp), tr16(vp + 4 * ML_VR));
#pragma unroll
            for (int et = 0; et < 4; ++et) {
                LAS unsigned char* kp = L + KW + (32 * ks + 8 * g4 + (l15 >> 2)) * ML_RS + (16 * et + 4 * (l15 & 3)) * 2;
                Cacc[et] = MFMA16(av, cat8(tr16(kp), tr16(kp + 4 * ML_RS)), Cacc[et]); } }
#pragma unroll
        for (int et = 0; et < 4; ++et)
#pragma unroll
            for (int r = 0; r < 4; ++r) cloc[(16 * w + 4 * g4 + r) * 64 + 16 * et + l15] = Cacc[et][r];
        { const int e = tid >> 3, part = tid & 7; float sacc = 0.f;
#pragma unroll
          for (int i = 0; i < 8; ++i) sacc += bf1(*(const LAS bf16_t*)(L + KW + (8 * part + i) * ML_RS + e * 2));
          sacc = sum8_(sacc);
          if (part == 0) nloc[e] = sacc; }
    }
}

__device__ __forceinline__ void mlstm_passB(Frame& F, int item) {
    const int bh = item >> 3, slice = item & 7, tid = F.tid;
    const float* cloc = (const float*)(F.ws + WS_CLOC) + (size_t)bh * 32 * 8192 + slice * 1024 + 2 * tid;
    bf16_t* cin = (bf16_t*)(F.ws + WS_CIN) + (size_t)bh * 32 * 8192 + slice * 1024 + 2 * tid;
    const float* nloc = (const float*)(F.ws + WS_NLOC) + (size_t)bh * 32 * 64 + 2 * tid;
    float* nin = (float*)(F.ws + WS_NIN) + (size_t)bh * 32 * 64 + 2 * tid;
    float* msc = (float*)(F.ws + WS_MSC) + (size_t)bh * 32 * 4;
    const bool do_n = (slice == 0) && (tid < 32);
    f32x2 cl[32], nl[32], mg[32];
#pragma unroll
    for (int c = 0; c < 32; ++c) { cl[c] = *(const f32x2*)(cloc + (size_t)c * 8192); nl[c] = do_n ? *(const f32x2*)(nloc + c * 64) : (f32x2){0.f, 0.f}; mg[c] = *(const f32x2*)(msc + c * 4); }
    __builtin_amdgcn_sched_barrier(0);
    float m = 0.f; f32x2 C = {0.f, 0.f}, N = {0.f, 0.f};
#pragma unroll
    for (int c = 0; c < 32; ++c) {
        *(unsigned*)(cin + (size_t)c * 8192) = pk2(C[0], C[1]);
        if (do_n) *(f32x2*)(nin + c * 64) = N;
        if (slice == 0 && tid == 0) msc[c * 4 + 2] = m;
        const float mloc = mg[c][0], g = mg[c][1];
        const float m_new = fmaxf(g + m, mloc), sp = __expf(g + m - m_new), sl = __expf(mloc - m_new);
        C = C * sp + cl[c] * sl; N = N * sp + nl[c] * sl; m = m_new;
    }
}

__device__ __forceinline__ void mlstm_passC(Frame& F, const Args& a, int u) {
    constexpr int QS = ML_QS, KS = ML_KS, VS = ML_VS, SB = ML_SB, CB = ML_CB, HO = ML_HO, RS = ML_RS, VR = ML_VR;
    LAS unsigned char* L = F.lds; LAS float* fl = (LAS float*)(L + ML_FLO);
    const bf16_t* z = (const bf16_t*)(F.ws + WS_Z); const float* gates = (const float*)(F.ws + WS_GATES);
    unsigned char* hm = F.ws + WS_HM;
    int tid = F.tid; asm volatile("" : "+v"(tid));
    const int lane = tid & 63, w = F.wave, l15 = lane & 15, g4 = lane >> 4;
    const int c = u & 31, h = (u >> 5) & 7, b = u >> 8;
    const float* gmo = a.in[I_GMO] + h * 128;
    const size_t tok0 = (size_t)b * SEQ + c * 64;
    const int lr = tid >> 3, ls = tid & 7, jt = w & 3, hf = w >> 2;
    const bf16_t* zr = z + (tok0 + lr) * ZP;
    const u32x4 qv = *(const u32x4*)(zr + ZQA + h * 64 + ls * 8), kv = *(const u32x4*)(zr + ZKA + h * 64 + ls * 8);
    const u32x4 v0 = *(const u32x4*)(zr + ZVA + h * 128 + ls * 8), v1 = *(const u32x4*)(zr + ZVA + h * 128 + 64 + ls * 8);
    const u32x4 oc0 = *(const u32x4*)(zr + ZOA + h * 128 + ls * 16), oc1 = *(const u32x4*)(zr + ZOA + h * 128 + ls * 16 + 8);
    const bf16_t* cin = (const bf16_t*)(F.ws + WS_CIN) + (size_t)u * 8192;
    const u32x4 c0 = *(const u32x4*)(cin + tid * 8), c1 = *(const u32x4*)(cin + 4096 + tid * 8);
    const float* msc = (const float*)(F.ws + WS_MSC) + (size_t)u * 4;
    const float mstate = msc[2], gi_raw = gates[(tok0 + lane) * 16 + h], gf_raw = gates[(tok0 + lane) * 16 + 8 + h], big = a.in[I_BIG][h], bfg = a.in[I_BFG][h];
    const float nin_l = ((const float*)(F.ws + WS_NIN))[(size_t)u * 64 + lane];
    float gmo_r[4];
#pragma unroll
    for (int d4 = 0; d4 < 4; ++d4) gmo_r[d4] = gmo[16 * (4 * hf + d4) + l15];
    __syncthreads();
    if (w == 0) {
        const ChunkGates G = chunk_gates(gi_raw, gf_raw, big, bfg, lane);
        const float M = fmaxf(mstate, G.pmx);
        fl[lane] = -M; fl[64 + lane] = G.u; fl[128 + lane] = __expf(mstate - M); fl[192 + lane] = __expf(-(G.bcs + M));
    }
    if (w == 1) fl[640 + lane] = nin_l;
    *(LAS u32x4*)(L + QS + lr * RS + ls * 16) = qv; *(LAS u32x4*)(L + KS + lr * RS + ls * 16) = kv;
    *(LAS u32x4*)(L + VS + lr * VR + ls * 16) = v0; *(LAS u32x4*)(L + VS + lr * VR + 128 + ls * 16) = v1;
    *(LAS u32x4*)(L + CB + lr * RS + ls * 16) = c0; *(LAS u32x4*)(L + CB + (64 + lr) * RS + ls * 16) = c1;
    __syncthreads();
    { const LAS float* nv = fl + 640 + ls * 8;
      float s = bf_lo(qv.x) * nv[0] + bf_hi(qv.x) * nv[1] + bf_lo(qv.y) * nv[2] + bf_hi(qv.y) * nv[3] + bf_lo(qv.z) * nv[4] + bf_hi(qv.z) * nv[5] + bf_lo(qv.w) * nv[6] + bf_hi(qv.w) * nv[7];
      s = sum8_(s);
      if (ls == 0) fl[320 + lr] = s * 0.125f; }
    { bf16x8 aq[2];
#pragma unroll
      for (int ks = 0; ks < 2; ++ks) aq[ks] = *(const LAS bf16x8*)(L + QS + (16 * jt + l15) * RS + (32 * ks + 8 * g4) * 2);
      float rsum[4] = {0.f, 0.f, 0.f, 0.f};
#pragma unroll
      for (int st2 = 0; st2 < 2; ++st2) { const int st = 2 * hf + st2; f32x4 s = {0.f, 0.f, 0.f, 0.f};
          if (st <= jt) {
#pragma unroll
              for (int ks = 0; ks < 2; ++ks) { const bf16x8 bk = *(const LAS bf16x8*)(L + KS + (16 * st + l15) * RS + (32 * ks + 8 * g4) * 2); s = MFMA16(aq[ks], bk, s); } }
          const int scol = 16 * st + l15; const float cf = fl[64 + scol];
#pragma unroll
          for (int r = 0; r < 4; ++r) { const int j = 16 * jt + 4 * g4 + r;
              const float val = (scol <= j) ? s[r] * 0.125f * __expf(fl[j] + cf) : 0.f; rsum[r] += val;
              *(LAS bf16_t*)(L + SB + j * RS + scol * 2) = f2bf(val); } }
#pragma unroll
      for (int r = 0; r < 4; ++r) { float t = sum16_(rsum[r]);
          if (l15 == 0) fl[384 + hf * 64 + 16 * jt + 4 * g4 + r] = t; } }
    __syncthreads();
    float hv[4][4];
    { bf16x8 as_[2], aq[2];
#pragma unroll
      for (int ks = 0; ks < 2; ++ks) { as_[ks] = *(const LAS bf16x8*)(L + SB + (16 * jt + l15) * RS + (32 * ks + 8 * g4) * 2); aq[ks] = *(const LAS bf16x8*)(L + QS + (16 * jt + l15) * RS + (32 * ks + 8 * g4) * 2); }
      float si[4], dn[4], en[4], ss[4] = {0.f, 0.f, 0.f, 0.f};
#pragma unroll
      for (int r = 0; r < 4; ++r) { const int j = 16 * jt + 4 * g4 + r; si[r] = fl[128 + j]; dn[r] = fl[384 + j] + fl[448 + j] + si[r] * fl[320 + j]; en[r] = fl[192 + j]; si[r] *= 0.125f; }
#pragma unroll
      for (int d4 = 0; d4 < 4; ++d4) { const int dt = 4 * hf + d4; f32x4 nacc = {0.f, 0.f, 0.f, 0.f}, iacc = nacc;
#pragma unroll
          for (int ks = 0; ks < 2; ++ks) {
              LAS unsigned char* vp = L + VS + (32 * ks + 8 * g4 + (l15 >> 2)) * VR + (16 * dt + 4 * (l15 & 3)) * 2;
              nacc = MFMA16(as_[ks], cat8(tr16(vp), tr16(vp + 4 * VR)), nacc);
              const bf16x8 bc = *(const LAS bf16x8*)(L + CB + (16 * dt + l15) * RS + (32 * ks + 8 * g4) * 2);
              iacc = MFMA16(aq[ks], bc, iacc); }
#pragma unroll
          for (int r = 0; r < 4; ++r) { const float num = nacc[r] + si[r] * iacc[r]; const float hvv = num * __builtin_amdgcn_rcpf(fmaxf(fabsf(dn[r]), en[r])); hv[d4][r] = hvv; ss[r] += hvv * hvv; } }
#pragma unroll
      for (int r = 0; r < 4; ++r) { float t = sum16_(ss[r]);
          if (l15 == 0) fl[512 + hf * 64 + 16 * jt + 4 * g4 + r] = t; } }
    __syncthreads();
    { float rinv[4];
#pragma unroll
      for (int r = 0; r < 4; ++r) { const int j = 16 * jt + 4 * g4 + r; rinv[r] = rsqrtf((fl[512 + j] + fl[576 + j]) * (1.0f / 128.0f) + EPS); }
#pragma unroll
      for (int d4 = 0; d4 < 4; ++d4) { const int d = 16 * (4 * hf + d4) + l15; const float gg = gmo_r[d4];
#pragma unroll
          for (int r = 0; r < 4; ++r) *(LAS bf16_t*)(L + HO + (16 * jt + 4 * g4 + r) * VR + d * 2) = f2bf(hv[d4][r] * rinv[r] * gg); } }
    __syncthreads();
    { const u32x4 h0 = *(const LAS u32x4*)(L + HO + lr * VR + ls * 32), h1 = *(const LAS u32x4*)(L + HO + lr * VR + ls * 32 + 16);
#define HG(hw, ow, lo) ((lo ? bf_lo(hw) : bf_hi(hw)) * sigmoidf_(lo ? bf_lo(ow) : bf_hi(ow)) * H8_SCALE)
      u32x4 r;
      r.x = pk4_fp8(HG(h0.x, oc0.x, 1), HG(h0.x, oc0.x, 0), HG(h0.y, oc0.y, 1), HG(h0.y, oc0.y, 0));
      r.y = pk4_fp8(HG(h0.z, oc0.z, 1), HG(h0.z, oc0.z, 0), HG(h0.w, oc0.w, 1), HG(h0.w, oc0.w, 0));
      r.z = pk4_fp8(HG(h1.x, oc1.x, 1), HG(h1.x, oc1.x, 0), HG(h1.y, oc1.y, 1), HG(h1.y, oc1.y, 0));
      r.w = pk4_fp8(HG(h1.z, oc1.z, 1), HG(h1.z, oc1.z, 0), HG(h1.w, oc1.w, 1), HG(h1.w, oc1.w, 0));
#undef HG
      *(u32x4*)(hm + (tok0 + lr) * 1024 + h * 128 + ls * 16) = r; }
}

__device__ __forceinline__ void mlstm_passC2(Frame& F, const Args& a, int ua, int ub) {
    constexpr int QS = 0, KS = 9216, VS = 18432, SB = 35840, CB = 45056, HO = 0, FLO = 63488, CH = 66560, RS = ML_RS, VR = ML_VR;
    const bf16_t* z = (const bf16_t*)(F.ws + WS_Z); const float* gates = (const float*)(F.ws + WS_GATES);
    unsigned char* hm = F.ws + WS_HM;
    int tid = F.tid; asm volatile("" : "+v"(tid));
    const int lane = tid & 63, w = F.wave, l15 = lane & 15, g4 = lane >> 4;
    const int lr = tid >> 3, ls = tid & 7, jt = w & 3, hf = w >> 2;
    u32x4 qv[2], kv[2], v0[2], v1[2], oc0[2], oc1[2], c0[2], c1[2];
    float mstate[2], gi_raw[2], gf_raw[2], big[2], bfg[2], nin_l[2], gmo_r[2][4];
    size_t tok0[2]; int hh[2];
#pragma unroll
    for (int k = 0; k < 2; ++k) {
        const int u = k ? ub : ua, c = u & 31, h = (u >> 5) & 7, b = u >> 8;
        hh[k] = h; tok0[k] = (size_t)b * SEQ + c * 64;
        const bf16_t* zr = z + (tok0[k] + lr) * ZP;
        qv[k] = *(const u32x4*)(zr + ZQA + h * 64 + ls * 8); kv[k] = *(const u32x4*)(zr + ZKA + h * 64 + ls * 8);
        v0[k] = *(const u32x4*)(zr + ZVA + h * 128 + ls * 8); v1[k] = *(const u32x4*)(zr + ZVA + h * 128 + 64 + ls * 8);
        oc0[k] = *(const u32x4*)(zr + ZOA + h * 128 + ls * 16); oc1[k] = *(const u32x4*)(zr + ZOA + h * 128 + ls * 16 + 8);
        const bf16_t* cin = (const bf16_t*)(F.ws + WS_CIN) + (size_t)u * 8192;
        c0[k] = *(const u32x4*)(cin + tid * 8); c1[k] = *(const u32x4*)(cin + 4096 + tid * 8);
        const float* msc = (const float*)(F.ws + WS_MSC) + (size_t)u * 4;
        mstate[k] = msc[2]; gi_raw[k] = gates[(tok0[k] + lane) * 16 + h]; gf_raw[k] = gates[(tok0[k] + lane) * 16 + 8 + h]; big[k] = a.in[I_BIG][h]; bfg[k] = a.in[I_BFG][h];
        nin_l[k] = ((const float*)(F.ws + WS_NIN))[(size_t)u * 64 + lane];
        const float* gmo = a.in[I_GMO] + h * 128;
#pragma unroll
        for (int d4 = 0; d4 < 4; ++d4) gmo_r[k][d4] = gmo[16 * (4 * hf + d4) + l15];
    }
    __syncthreads();
#pragma unroll
    for (int k = 0; k < 2; ++k) {
        LAS unsigned char* L = F.lds + k * CH; LAS float* fl = (LAS float*)(L + FLO);
        if (w == k) {
            const ChunkGates G = chunk_gates(gi_raw[k], gf_raw[k], big[k], bfg[k], lane);
            const float M = fmaxf(mstate[k], G.pmx);
            fl[lane] = -M; fl[64 + lane] = G.u; fl[128 + lane] = __expf(mstate[k] - M); fl[192 + lane] = __expf(-(G.bcs + M));
        }
        if (w == 2 + k) fl[640 + lane] = nin_l[k];
        *(LAS u32x4*)(L + QS + lr * RS + ls * 16) = qv[k]; *(LAS u32x4*)(L + KS + lr * RS + ls * 16) = kv[k];
        *(LAS u32x4*)(L + VS + lr * VR + ls * 16) = v0[k]; *(LAS u32x4*)(L + VS + lr * VR + 128 + ls * 16) = v1[k];
        *(LAS u32x4*)(L + CB + lr * RS + ls * 16) = c0[k]; *(LAS u32x4*)(L + CB + (64 + lr) * RS + ls * 16) = c1[k];
    }
    __syncthreads();
#pragma unroll
    for (int k = 0; k < 2; ++k) {
        LAS unsigned char* L = F.lds + k * CH; LAS float* fl = (LAS float*)(L + FLO);
        { const LAS float* nv = fl + 640 + ls * 8; const u32x4 q = qv[k];
          float s = bf_lo(q.x) * nv[0] + bf_hi(q.x) * nv[1] + bf_lo(q.y) * nv[2] + bf_hi(q.y) * nv[3] + bf_lo(q.z) * nv[4] + bf_hi(q.z) * nv[5] + bf_lo(q.w) * nv[6] + bf_hi(q.w) * nv[7];
          s = sum8_(s);
          if (ls == 0) fl[320 + lr] = s * 0.125f; }
        { bf16x8 aq[2];
#pragma unroll
          for (int ks = 0; ks < 2; ++ks) aq[ks] = *(const LAS bf16x8*)(L + QS + (16 * jt + l15) * RS + (32 * ks + 8 * g4) * 2);
          float rsum[4] = {0.f, 0.f, 0.f, 0.f};
#pragma unroll
          for (int st2 = 0; st2 < 2; ++st2) { const int st = 2 * hf + st2; f32x4 s = {0.f, 0.f, 0.f, 0.f};
              if (st <= jt) {
#pragma unroll
                  for (int ks = 0; ks < 2; ++ks) { const bf16x8 bk = *(const LAS bf16x8*)(L + KS + (16 * st + l15) * RS + (32 * ks + 8 * g4) * 2); s = MFMA16(aq[ks], bk, s); } }
              const int scol = 16 * st + l15; const float cf = fl[64 + scol];
#pragma unroll
              for (int r = 0; r < 4; ++r) { const int j = 16 * jt + 4 * g4 + r;
                  const float val = (scol <= j) ? s[r] * 0.125f * __expf(fl[j] + cf) : 0.f; rsum[r] += val;
                  *(LAS bf16_t*)(L + SB + j * RS + scol * 2) = f2bf(val); } }
#pragma unroll
          for (int r = 0; r < 4; ++r) { float t = sum16_(rsum[r]);
              if (l15 == 0) fl[384 + hf * 64 + 16 * jt + 4 * g4 + r] = t; } }
    }
    __syncthreads();
    float hv[2][4][4];
#pragma unroll
    for (int k = 0; k < 2; ++k) {
        LAS unsigned char* L = F.lds + k * CH; LAS float* fl = (LAS float*)(L + FLO);
        bf16x8 as_[2], aq[2];
#pragma unroll
        for (int ks = 0; ks < 2; ++ks) { as_[ks] = *(const LAS bf16x8*)(L + SB + (16 * jt + l15) * RS + (32 * ks + 8 * g4) * 2); aq[ks] = *(const LAS bf16x8*)(L + QS + (16 * jt + l15) * RS + (32 * ks + 8 * g4) * 2); }
        float si[4], dn[4], en[4], ss[4] = {0.f, 0.f, 0.f, 0.f};
#pragma unroll
        for (int r = 0; r < 4; ++r) { const int j = 16 * jt + 4 * g4 + r; si[r] = fl[128 + j]; dn[r] = fl[384 + j] + fl[448 + j] + si[r] * fl[320 + j]; en[r] = fl[192 + j]; si[r] *= 0.125f; }
#pragma unroll
        for (int d4 = 0; d4 < 4; ++d4) { const int dt = 4 * hf + d4; f32x4 nacc = {0.f, 0.f, 0.f, 0.f}, iacc = nacc;
#pragma unroll
            for (int ks = 0; ks < 2; ++ks) {
                LAS unsigned char* vp = L + VS + (32 * ks + 8 * g4 + (l15 >> 2)) * VR + (16 * dt + 4 * (l15 & 3)) * 2;
                nacc = MFMA16(as_[ks], cat8(tr16(vp), tr16(vp + 4 * VR)), nacc);
                const bf16x8 bc = *(const LAS bf16x8*)(L + CB + (16 * dt + l15) * RS + (32 * ks + 8 * g4) * 2);
                iacc = MFMA16(aq[ks], bc, iacc); }
#pragma unroll
            for (int r = 0; r < 4; ++r) { const float num = nacc[r] + si[r] * iacc[r]; const float hvv = num * __builtin_amdgcn_rcpf(fmaxf(fabsf(dn[r]), en[r])); hv[k][d4][r] = hvv; ss[r] += hvv * hvv; } }
#pragma unroll
        for (int r = 0; r < 4; ++r) { float t = sum16_(ss[r]);
            if (l15 == 0) fl[512 + hf * 64 + 16 * jt + 4 * g4 + r] = t; }
    }
    __syncthreads();
#pragma unroll
    for (int k = 0; k < 2; ++k) {
        LAS unsigned char* L = F.lds + k * CH; LAS float* fl = (LAS float*)(L + FLO);
        float rinv[4];
#pragma unroll
        for (int r = 0; r < 4; ++r) { const int j = 16 * jt + 4 * g4 + r; rinv[r] = rsqrtf((fl[512 + j] + fl[576 + j]) * (1.0f / 128.0f) + EPS); }
#pragma unroll
        for (int d4 = 0; d4 < 4; ++d4) { const int d = 16 * (4 * hf + d4) + l15; const float gg = gmo_r[k][d4];
#pragma unroll
            for (int r = 0; r < 4; ++r) *(LAS bf16_t*)(L + HO + (16 * jt + 4 * g4 + r) * VR + d * 2) = f2bf(hv[k][d4][r] * rinv[r] * gg); }
    }
    __syncthreads();
#pragma unroll
    for (int k = 0; k < 2; ++k) {
        LAS unsigned char* L = F.lds + k * CH;
        const u32x4 h0 = *(const LAS u32x4*)(L + HO + lr * VR + ls * 32), h1 = *(const LAS u32x4*)(L + HO + lr * VR + ls * 32 + 16);
        const u32x4 o0 = oc0[k], o1 = oc1[k];
#define HG(hw, ow, lo) ((lo ? bf_lo(hw) : bf_hi(hw)) * sigmoidf_(lo ? bf_lo(ow) : bf_hi(ow)) * H8_SCALE)
        u32x4 r;
        r.x = pk4_fp8(HG(h0.x, o0.x, 1), HG(h0.x, o0.x, 0), HG(h0.y, o0.y, 1), HG(h0.y, o0.y, 0));
        r.y = pk4_fp8(HG(h0.z, o0.z, 1), HG(h0.z, o0.z, 0), HG(h0.w, o0.w, 1), HG(h0.w, o0.w, 0));
        r.z = pk4_fp8(HG(h1.x, o1.x, 1), HG(h1.x, o1.x, 0), HG(h1.y, o1.y, 1), HG(h1.y, o1.y, 0));
        r.w = pk4_fp8(HG(h1.z, o1.z, 1), HG(h1.z, o1.z, 0), HG(h1.w, o1.w, 1), HG(h1.w, o1.w, 0));
#undef HG
        *(u32x4*)(hm + (tok0[k] + lr) * 1024 + hh[k] * 128 + ls * 16) = r;
    }
}

template <bool FIXED>
__device__ __forceinline__ void moba_unit(Frame& F, const Args& a, int b, int h, int qb, const float B2) {
    constexpr int KT = 0, VT = 34816, KM = 88064, TS = 17408, VR = 272;
    LAS unsigned char* L = F.lds;
    const bf16_t* z = (const bf16_t*)(F.ws + WS_Z);
    const float* kmean = (const float*)(F.ws + WS_KMEAN) + ((size_t)b * 8 + h) * 8 * 128;
    unsigned char* ob = F.ws + WS_OB;
    int tid = F.tid; asm volatile("" : "+v"(tid));
    const int lane = tid & 63, w = F.wave, l15 = lane & 15, g4 = lane >> 4;
    const int q0 = qb * 256, blk = qb, ntile = 4 * qb + 4;
    const size_t tokb = (size_t)b * SEQ;
    __syncthreads();
    if (tid < 256) *(LAS f32x4*)(L + KM + tid * 16) = *(const f32x4*)(kmean + tid * 4);
    bf16x8 qf[2][4];
#pragma unroll
    for (int g = 0; g < 2; ++g) { const bf16_t* qr = z + (tokb + q0 + 32 * w + 16 * g + l15) * ZP + ZQB + h * 128 + 8 * g4;
#pragma unroll
        for (int ks = 0; ks < 4; ++ks) qf[g][ks] = *(const bf16x8*)(qr + 32 * ks); }
    const int key0 = tid >> 4, seg = tid & 15;
    const bf16_t* kbase = z + (tokb + key0) * ZP + ZKB + h * 128 + seg * 8;
    const bf16_t* vbase = z + (tokb + key0) * ZP + ZVB + h * 128 + seg * 8;
    u32x4 kA0 = *(const u32x4*)kbase, kA1 = *(const u32x4*)(kbase + (size_t)32 * ZP), vA0 = *(const u32x4*)vbase, vA1 = *(const u32x4*)(vbase + (size_t)32 * ZP);
    u32x4 kB0 = *(const u32x4*)(kbase + (size_t)64 * ZP), kB1 = *(const u32x4*)(kbase + (size_t)96 * ZP), vB0 = *(const u32x4*)(vbase + (size_t)64 * ZP), vB1 = *(const u32x4*)(vbase + (size_t)96 * ZP);
    __syncthreads();
    unsigned mymask[2];
#pragma unroll
    for (int g = 0; g < 2; ++g) {
        if (blk <= 3) mymask[g] = (1u << blk) - 1u;
        else {
            float gate[7];
#pragma unroll
            for (int n = 0; n < 7; ++n) { float s = 0.f;
                if (n < blk) {
#pragma unroll
                    for (int ks = 0; ks < 4; ++ks) { const LAS float* km = (const LAS float*)(L + KM) + n * 128 + 32 * ks + 8 * g4;
#pragma unroll
                        for (int j = 0; j < 8; ++j) s += bf1((bf16_t)qf[g][ks][j]) * km[j]; }
                    s += __shfl_xor(s, 16); s += __shfl_xor(s, 32); }
                gate[n] = (n < blk) ? s : -3.0e38f; }
            unsigned mm = 0u;
#pragma unroll
            for (int t = 0; t < 3; ++t) { float best = -3.0e38f; int bi = 0;
#pragma unroll
                for (int n = 0; n < 7; ++n) { const bool take = (n < blk) && !((mm >> n) & 1u) && (gate[n] > best); best = take ? gate[n] : best; bi = take ? n : bi; }
                mm |= 1u << bi; }
            mymask[g] = mm;
        }
    }
    f32x4 O[2][8];
#pragma unroll
    for (int g = 0; g < 2; ++g)
#pragma unroll
        for (int dt = 0; dt < 8; ++dt) O[g][dt] = (f32x4){0.f, 0.f, 0.f, 0.f};
    float mrun[2] = {-1.0e30f, -1.0e30f}, lsum[2] = {0.f, 0.f};
    const float SC = 0.08838834764831845f * 1.4426950408889634f;
#pragma unroll 1
    for (int kt2 = 0; kt2 < ntile; kt2 += 2) {
#pragma unroll
      for (int buf = 0; buf < 2; ++buf) {
        const int kt = kt2 + buf;
        { LAS unsigned char* kd = L + KT + buf * TS + key0 * VR + seg * 16; LAS unsigned char* vd = L + VT + buf * TS + key0 * VR + seg * 16;
          const int t2 = (kt + 2 < ntile) ? kt + 2 : ntile - 1;
          const size_t adv = (size_t)t2 * 64 * ZP;
          if (buf == 0) { *(LAS u32x4*)kd = kA0; *(LAS u32x4*)(kd + 32 * VR) = kA1; *(LAS u32x4*)vd = vA0; *(LAS u32x4*)(vd + 32 * VR) = vA1;
              kA0 = *(const u32x4*)(kbase + adv); kA1 = *(const u32x4*)(kbase + adv + (size_t)32 * ZP); vA0 = *(const u32x4*)(vbase + adv); vA1 = *(const u32x4*)(vbase + adv + (size_t)32 * ZP); }
          else { *(LAS u32x4*)kd = kB0; *(LAS u32x4*)(kd + 32 * VR) = kB1; *(LAS u32x4*)vd = vB0; *(LAS u32x4*)(vd + 32 * VR) = vB1;
              kB0 = *(const u32x4*)(kbase + adv); kB1 = *(const u32x4*)(kbase + adv + (size_t)32 * ZP); vB0 = *(const u32x4*)(vbase + adv); vB1 = *(const u32x4*)(vbase + adv + (size_t)32 * ZP); } }
        __syncthreads();
        const int kb = kt >> 2; const bool past = kb < blk;
        const int kmin = 64 * kt;
        int cls[2];
#pragma unroll
        for (int g = 0; g < 2; ++g) { const int qmin = q0 + 32 * w + 16 * g; cls[g] = past ? 1 : ((kmin + 63 <= qmin) ? 1 : ((kmin > qmin + 15) ? 0 : 2)); }
        if ((cls[0] | cls[1]) != 0) {
            f32x4 st[2][4];
#pragma unroll
            for (int nt = 0; nt < 4; ++nt) { st[0][nt] = (f32x4){0.f, 0.f, 0.f, 0.f}; st[1][nt] = st[0][nt];
                bf16x8 bk[4];
#pragma unroll
                for (int ks = 0; ks < 4; ++ks) bk[ks] = *(const LAS bf16x8*)(L + KT + buf * TS + (16 * nt + l15) * VR + (32 * ks + 8 * g4) * 2);
                __builtin_amdgcn_sched_barrier(0);
#pragma unroll
                for (int ks = 0; ks < 4; ++ks) { st[0][nt] = MFMA16(bk[ks], qf[0][ks], st[0][nt]); st[1][nt] = MFMA16(bk[ks], qf[1][ks], st[1][nt]); }
                __builtin_amdgcn_sched_barrier(0); }
            bf16x8 pf[2][2];
#pragma unroll
            for (int g = 0; g < 2; ++g) {
                float pv[4][4]; float mnew = 0.f, alpha = 1.0f;
                if (FIXED) {
                    if (cls[g] == 1) {
                        const bool sel = past ? (((mymask[g] >> kb) & 1u) != 0u) : true;
                        const float nb = sel ? -B2 : -1.0e30f;
#pragma unroll
                        for (int nt = 0; nt < 4; ++nt)
#pragma unroll
                            for (int r = 0; r < 4; ++r) pv[nt][r] = __builtin_amdgcn_exp2f(fmaf(st[g][nt][r], SC, nb));
                    } else if (cls[g] == 2) {
                        const int qpos = q0 + 32 * w + 16 * g + l15;
#pragma unroll
                        for (int nt = 0; nt < 4; ++nt)
#pragma unroll
                            for (int r = 0; r < 4; ++r) { const bool ok = (kmin + 16 * nt + 4 * g4 + r) <= qpos; pv[nt][r] = __builtin_amdgcn_exp2f(ok ? fmaf(st[g][nt][r], SC, -B2) : -1.0e30f); }
                    } else {
#pragma unroll
                        for (int nt = 0; nt < 4; ++nt)
#pragma unroll
                            for (int r = 0; r < 4; ++r) pv[nt][r] = 0.f;
                    }
                } else if (cls[g] == 1) {
                    const bool sel = past ? (((mymask[g] >> kb) & 1u) != 0u) : true;
                    float mx = fmaxf(fmaxf(fmaxf(st[g][0][0], st[g][0][1]), fmaxf(st[g][0][2], st[g][0][3])), fmaxf(fmaxf(st[g][1][0], st[g][1][1]), fmaxf(st[g][1][2], st[g][1][3])));
                    mx = fmaxf(mx, fmaxf(fmaxf(fmaxf(st[g][2][0], st[g][2][1]), fmaxf(st[g][2][2], st[g][2][3])), fmaxf(fmaxf(st[g][3][0], st[g][3][1]), fmaxf(st[g][3][2], st[g][3][3]))));
                    mx = sel ? mx * SC : -1.0e30f;
                    mx = fmaxf(mx, __shfl_xor(mx, 16)); mx = fmaxf(mx, __shfl_xor(mx, 32));
                    mnew = fmaxf(mrun[g], mx); alpha = __builtin_amdgcn_exp2f(mrun[g] - mnew);
                    const float nb = sel ? -mnew : -1.0e30f;
#pragma unroll
                    for (int nt = 0; nt < 4; ++nt)
#pragma unroll
                        for (int r = 0; r < 4; ++r) pv[nt][r] = __builtin_amdgcn_exp2f(fmaf(st[g][nt][r], SC, nb));
                } else if (cls[g] == 2) {
                    const int qpos = q0 + 32 * w + 16 * g + l15; float sv[4][4]; float mx = -1.0e30f;
#pragma unroll
                    for (int nt = 0; nt < 4; ++nt)
#pragma unroll
                        for (int r = 0; r < 4; ++r) { const bool ok = (kmin + 16 * nt + 4 * g4 + r) <= qpos; sv[nt][r] = ok ? st[g][nt][r] * SC : -1.0e30f; mx = fmaxf(mx, sv[nt][r]); }
                    mx = fmaxf(mx, __shfl_xor(mx, 16)); mx = fmaxf(mx, __shfl_xor(mx, 32));
                    mnew = fmaxf(mrun[g], mx); alpha = __builtin_amdgcn_exp2f(mrun[g] - mnew);
#pragma unroll
                    for (int nt = 0; nt < 4; ++nt)
#pragma unroll
                        for (int r = 0; r < 4; ++r) pv[nt][r] = (sv[nt][r] > -1.0e29f) ? __builtin_amdgcn_exp2f(sv[nt][r] - mnew) : 0.f;
                } else {
                    mnew = mrun[g]; alpha = 1.0f;
#pragma unroll
                    for (int nt = 0; nt < 4; ++nt)
#pragma unroll
                        for (int r = 0; r < 4; ++r) pv[nt][r] = 0.f;
                }
                float ps = 0.f;
#pragma unroll
                for (int nt = 0; nt < 4; ++nt) ps += (pv[nt][0] + pv[nt][1]) + (pv[nt][2] + pv[nt][3]);
                if (FIXED) lsum[g] += ps;
                else { mrun[g] = mnew; lsum[g] = lsum[g] * alpha + ps;
#pragma unroll
                    for (int dt = 0; dt < 8; ++dt) O[g][dt] *= alpha; }
#pragma unroll
                for (int k2 = 0; k2 < 2; ++k2) {
                    u32x4 pw4; pw4.x = pk2(pv[2 * k2][0], pv[2 * k2][1]); pw4.y = pk2(pv[2 * k2][2], pv[2 * k2][3]); pw4.z = pk2(pv[2 * k2 + 1][0], pv[2 * k2 + 1][1]); pw4.w = pk2(pv[2 * k2 + 1][2], pv[2 * k2 + 1][3]);
                    pf[g][k2] = __builtin_bit_cast(bf16x8, pw4); }
            }
            bf16x8 vf[2][4];
#define MOBA_VREAD(bq, slot) do { _Pragma("unroll") for (int d = 0; d < 4; ++d) { const int k2_ = (bq) >> 1, dt_ = 4 * ((bq) & 1) + d; \
                LAS unsigned char* vp = L + VT + buf * TS + (32 * k2_ + 4 * g4 + (l15 >> 2)) * VR + (16 * dt_ + 4 * (l15 & 3)) * 2; vf[slot][d] = cat8(tr16(vp), tr16(vp + 16 * VR)); } } while (0)
            MOBA_VREAD(0, 0);
#pragma unroll
            for (int bq = 0; bq < 4; ++bq) {
                if (bq + 1 < 4) MOBA_VREAD(bq + 1, (bq + 1) & 1);
                __builtin_amdgcn_sched_barrier(0);
#pragma unroll
                for (int d = 0; d < 4; ++d) { const int k2 = bq >> 1, dt = 4 * (bq & 1) + d;
                    O[0][dt] = MFMA16(vf[bq & 1][d], pf[0][k2], O[0][dt]); O[1][dt] = MFMA16(vf[bq & 1][d], pf[1][k2], O[1][dt]); }
                __builtin_amdgcn_sched_barrier(0);
            }
#undef MOBA_VREAD
        }
      }
    }
#pragma unroll
    for (int g = 0; g < 2; ++g) { float t = lsum[g]; t += __shfl_xor(t, 16); t += __shfl_xor(t, 32);
      const float inv = O8_SCALE / t; unsigned char* op = ob + (tokb + q0 + 32 * w + 16 * g + l15) * 1024 + h * 128 + 4 * g4;
#pragma unroll
      for (int dt = 0; dt < 8; ++dt) *(unsigned*)(op + 16 * dt) = pk4_fp8(O[g][dt][0] * inv, O[g][dt][1] * inv, O[g][dt][2] * inv, O[g][dt][3] * inv); }
}

__device__ __forceinline__ void p4_mixers(Frame& F, const Args& a, bool with_cvt) {
    LAS int* qslot = (LAS int*)(F.lds + 140032);
    const int total = with_cvt ? 768 + 256 : 768;
    const float B2 = __builtin_bit_cast(float, __builtin_amdgcn_readfirstlane((int)__hip_atomic_load(F.ctl + CW_MISC, __ATOMIC_RELAXED, __HIP_MEMORY_SCOPE_AGENT)));
    const bool fixed_ok = B2 <= 40.0f;
    for (;;) {
        __syncthreads();
        if (F.tid == 0) *qslot = (int)__hip_atomic_fetch_add(F.ctl + CW_QUEUE, 1u, __ATOMIC_RELAXED, __HIP_MEMORY_SCOPE_AGENT);
        __syncthreads();
        const int idx = *qslot;
        __syncthreads();
        if (idx >= total) break;
        int it = idx;
        if (with_cvt) { const int g = idx >> 2, r = idx & 3; if (r == 3) { cvt8_item(F, a, 512 + g); continue; } it = 3 * g + r; }
        if (it < 256) { if (fixed_ok) moba_unit<true>(F, a, (it & 31) >> 3, it & 7, 7 - (it >> 5), B2); else moba_unit<false>(F, a, (it & 31) >> 3, it & 7, 7 - (it >> 5), B2); }
        else mlstm_passC2(F, a, it - 256, it - 256 + 512);
    }
}

__device__ __forceinline__ void p7_router(Frame& F, const Args& a) {
    unsigned char* ws = F.ws;
    const float* modf = (const float*)(ws + WS_MODF);
    const bf16_t* wrf = (const bf16_t*)(ws + WS_WRF);
    int* toke = (int*)(ws + WS_TOKE); float* tokw = (float*)(ws + WS_TOKW); int* toks = (int*)(ws + WS_TOKS); float* roww = (float*)(ws + WS_ROWW);
    unsigned char* tA = ws + WS_TA;
    LAS float* part = (LAS float*)(F.lds + PART_OFF);
    LAS float* logit = (LAS float*)(F.lds + LOGIT_OFF);
    LAS int* dstl = (LAS int*)(F.lds + DST_OFF);
    LAS int* lcnt = (LAS int*)(F.lds + DST_OFF + 512);
    const int lane = F.lane, l15 = lane & 15, g4 = lane >> 4;
    for (int rb = F.wg; rb < T / 32; rb += F.G) {
        norm_rows_32_b(F, (const bf16_t*)(ws + WS_X1), a.in[I_GFFN], modf, 3, rb);
        { const int rg = F.wave & 1, ct = (F.wave >> 1) & 1, kh = F.wave >> 2; f32x4 acc = {0.f, 0.f, 0.f, 0.f};
          bf16x8 bvv[32];
          __builtin_amdgcn_sched_barrier(0);
          const bf16_t* wq = wrf + ((size_t)ct * 4096 + (size_t)(32 * kh) * 64 + lane) * 8; asm volatile("" : "+v"(wq));
#pragma unroll
          for (int s = 0; s < 32; ++s) bvv[s] = *(const bf16x8*)(wq + (size_t)s * 512);
          __syncthreads();
#pragma unroll
          for (int s = 0; s < 32; ++s) { const int ks = 32 * kh + s;
              const bf16x8 av = *(const LAS bf16x8*)(F.lds + (16 * rg + l15) * HL_STRIDE + (32 * ks + 8 * g4) * 2);
              acc = __builtin_amdgcn_mfma_f32_16x16x32_bf16(av, bvv[s], acc, 0, 0, 0); }
#pragma unroll
          for (int r = 0; r < 4; ++r) part[((kh * 2 + rg) * 2 + ct) * 256 + (4 * g4 + r) * 16 + l15] = acc[r]; }
        __syncthreads();
#pragma unroll
        for (int q = 0; q < 2; ++q) { const int o = F.tid + 512 * q, row = o >> 5, e = o & 31, rg = row >> 4, ct = e >> 4;
            logit[o] = part[((0 * 2 + rg) * 2 + ct) * 256 + (row & 15) * 16 + (e & 15)] + part[((1 * 2 + rg) * 2 + ct) * 256 + (row & 15) * 16 + (e & 15)] + a.in[I_BR][e]; }
        __syncthreads();
        if (F.tid < 32) {
            const int row = F.tid; const size_t tok = (size_t)rb * 32 + row;
            lcnt[row] = 0;
            float v[NE];
#pragma unroll
            for (int e = 0; e < NE; ++e) v[e] = logit[row * NE + e];
            float tv[4]; int ti[4]; unsigned used = 0u;
#pragma unroll
            for (int k = 0; k < 4; ++k) { float best = -3.0e38f; int bi = 0;
#pragma unroll
                for (int e = 0; e < NE; ++e) { const bool take = !((used >> e) & 1u) && (v[e] > best); best = take ? v[e] : best; bi = take ? e : bi; }
                used |= 1u << bi; tv[k] = best; ti[k] = bi; }
            float ex[4], sum = 0.f;
#pragma unroll
            for (int k = 0; k < 4; ++k) { ex[k] = __expf(tv[k] - tv[0]); sum += ex[k]; }
            const float inv = 1.0f / sum;
            int lr[4];
#pragma unroll
            for (int k = 0; k < 4; ++k) lr[k] = __hip_atomic_fetch_add(lcnt + ti[k], 1, __ATOMIC_RELAXED, __HIP_MEMORY_SCOPE_WORKGROUP);
            __builtin_amdgcn_wave_barrier();
            { const int mine = lcnt[row];
              int base = 0; if (mine > 0) base = (int)__hip_atomic_fetch_add(F.ctl + CW_CNT + 64 * row, (unsigned)mine, __ATOMIC_RELAXED, __HIP_MEMORY_SCOPE_AGENT);
              lcnt[32 + row] = base; }
            __builtin_amdgcn_wave_barrier();
#pragma unroll
            for (int k = 0; k < 4; ++k) {
                const int slot = lcnt[32 + ti[k]] + lr[k];
                const float wk = ex[k] * inv;
                toke[tok * 4 + k] = ti[k]; tokw[tok * 4 + k] = wk; toks[tok * 4 + k] = slot;
                roww[(size_t)ti[k] * ECAP + slot] = wk;
                dstl[row * 4 + k] = ti[k] * ECAP + slot;
            }
        }
        __syncthreads();
#pragma unroll 1
        for (int i = 0; i < 4; ++i) { const int r = 4 * F.wave + i;
            u32x4 q8[2];
#pragma unroll
            for (int cidx = 0; cidx < 2; ++cidx) { const int ch = lane + 64 * cidx;
                const u32x4 lo = *(const LAS u32x4*)(F.lds + r * HL_STRIDE + ch * 32), hi = *(const LAS u32x4*)(F.lds + r * HL_STRIDE + ch * 32 + 16);
                q8[cidx].x = pk4_fp8(bf_lo(lo.x), bf_hi(lo.x), bf_lo(lo.y), bf_hi(lo.y)); q8[cidx].y = pk4_fp8(bf_lo(lo.z), bf_hi(lo.z), bf_lo(lo.w), bf_hi(lo.w));
                q8[cidx].z = pk4_fp8(bf_lo(hi.x), bf_hi(hi.x), bf_lo(hi.y), bf_hi(hi.y)); q8[cidx].w = pk4_fp8(bf_lo(hi.z), bf_hi(hi.z), bf_lo(hi.w), bf_hi(hi.w)); }
#pragma unroll
            for (int k = 0; k < 4; ++k) { unsigned char* dp = tA + (size_t)dstl[r * 4 + k] * D;
#pragma unroll
                for (int cidx = 0; cidx < 2; ++cidx) *(u32x4*)(dp + (lane + 64 * cidx) * 16) = q8[cidx]; } }
        __syncthreads();
    }
}

__device__ __forceinline__ void moe_tables(Frame& F) {
    LAS int* tb = (LAS int*)(F.lds + LDS_TABS);
    __syncthreads();
    if (F.wave == 0) {
        const int e = F.lane & 31;
        const int cnt = (int)__hip_atomic_load(F.ctl + CW_CNT + 64 * e, __ATOMIC_RELAXED, __HIP_MEMORY_SCOPE_AGENT);
        const int tl = (cnt + 255) >> 8;
        int inc = tl;
#pragma unroll
        for (int o = 1; o < 32; o <<= 1) { const int t = __shfl_up(inc, o); if (e >= o) inc += t; }
        const int exc = inc - tl;
        if (F.lane < 32) {
            tb[e] = tl; tb[32 + e] = exc * 256; tb[64 + e] = e * ECAP; tb[96 + e] = exc * 16; tb[160 + e] = exc * 8;
            if (e == NE - 1) { tb[96 + NE] = inc * 16; tb[160 + NE] = inc * 8; }
        }
    }
    __syncthreads();
}

__device__ __forceinline__ void p10_combine(Frame& F, const Args& a) {
    unsigned char* ws = F.ws;
    const bf16_t* x1 = (const bf16_t*)(ws + WS_X1); const unsigned char* ydn = ws + WS_YDN; const float* modf = (const float*)(ws + WS_MODF);
    const int* toke = (const int*)(ws + WS_TOKE); const int* toks = (const int*)(ws + WS_TOKS);
    const LAS int* tb = (const LAS int*)(F.lds + LDS_TABS);
    int tz = threadIdx.x; asm volatile("" : "+v"(tz));
    const int gw = F.vcu * 8 + F.wave, NGW = F.G * 8, lane = tz & 63;
    for (int tok = gw; tok < T; tok += NGW) {
        const float* gt = modf + (size_t)(tok >> 11) * (6 * D) + 5 * D;
        const unsigned char* yr[4];
#pragma unroll
        for (int k = 0; k < 4; ++k) yr[k] = ydn + (size_t)(tb[32 + toke[tok * 4 + k]] + toks[tok * 4 + k]) * D;
        u32x2 y[4][4]; u32x4 xq[4]; f32x4 g0[4], g1[4];
#pragma unroll
        for (int j = 0; j < 4; ++j) { const int col = 8 * (lane + 64 * j);
#pragma unroll
            for (int k = 0; k < 4; ++k) y[j][k] = __builtin_nontemporal_load((const u32x2*)(yr[k] + col));
            xq[j] = __builtin_nontemporal_load((const u32x4*)(x1 + (size_t)tok * D + col));
            g0[j] = *(const f32x4*)(gt + col); g1[j] = *(const f32x4*)(gt + col + 4); }
        __builtin_amdgcn_sched_barrier(0);
#pragma unroll
        for (int j = 0; j < 4; ++j) { const int col = 8 * (lane + 64 * j);
            f32x4 s0 = {0.f, 0.f, 0.f, 0.f}, s1 = s0;
#pragma unroll
            for (int k = 0; k < 4; ++k) {
                const f32x2 p0 = __builtin_amdgcn_cvt_pk_f32_fp8((int)y[j][k].x, false), p1 = __builtin_amdgcn_cvt_pk_f32_fp8((int)y[j][k].x, true);
                const f32x2 p2 = __builtin_amdgcn_cvt_pk_f32_fp8((int)y[j][k].y, false), p3 = __builtin_amdgcn_cvt_pk_f32_fp8((int)y[j][k].y, true);
                s0[0] += p0[0]; s0[1] += p0[1]; s0[2] += p1[0]; s0[3] += p1[1]; s1[0] += p2[0]; s1[1] += p2[1]; s1[2] += p3[0]; s1[3] += p3[1]; }
            const size_t o = (size_t)tok * D + col;
            const f32x4 xa = {bf_lo(xq[j].x), bf_hi(xq[j].x), bf_lo(xq[j].y), bf_hi(xq[j].y)}, xb = {bf_lo(xq[j].z), bf_hi(xq[j].z), bf_lo(xq[j].w), bf_hi(xq[j].w)};
            __builtin_nontemporal_store(xa + g0[j] * (s0 * (1.0f / YD_SCALE)), (f32x4*)(a.out + o));
            __builtin_nontemporal_store(xb + g1[j] * (s1 * (1.0f / YD_SCALE)), (f32x4*)(a.out + o + 4)); }
    }
}

__global__ void __launch_bounds__(512, 2) hybrid_fwd(Args args) {
    extern __shared__ __attribute__((aligned(16))) unsigned char lds_raw[];
    Frame F;
    F.lds = (LAS unsigned char*)lds_raw; F.ws = args.ws; F.ctl = (unsigned*)(args.ws + WS_CTL);
    F.tid = threadIdx.x; F.lane = F.tid & 63; F.wave = __builtin_amdgcn_readfirstlane(F.tid >> 6);
    F.G = gridDim.x; F.wg = blockIdx.x; F.vcu = (F.G % 8 == 0) ? (F.wg % 8) * (F.G / 8) + F.wg / 8 : F.wg;
    if (F.tid < 4) ((LAS unsigned*)(F.lds + LDS_XB))[F.tid] = 0u;
    __syncthreads();
    XcdBarrier bar; bar.bar = F.ctl + CW_BAR; bar.x = 0; bar.st = nullptr;
#if !MK_PER_PHASE
    bar = xcd_barrier_post(F.ctl + CW_BAR, (volatile LAS unsigned*)(F.lds + LDS_XB));
#endif
    const int lo = args.ph_lo, hi = args.ph_hi;
#define IN(k) (lo <= (k) && (k) < hi)
#define SEAM(k) do { if (IN(k) && IN((k) + 1)) xcd_barrier(bar); } while (0)
    unsigned char* ws = args.ws;

    if (IN(0)) { p0_prologue(F, args); } SEAM(0);
    if (IN(1)) { p1_rows(F, args); } SEAM(1);
    const bool cv_ok = (F.G == 256);
    if (IN(2)) {
        pg8::DenseOrder S0; S0.init(ws + WS_HBUF8, ws + WS_WIN8, T, ZP, F.G, F.wg);
        EpiZT<true> E{(bf16_t*)(ws + WS_Z), ZP, args.in[I_GQ], args.in[I_GK], (float*)(ws + WS_KMEAN), F.lds + 131072};
        unsigned gaps = 0u;
        if (cv_ok) { int c = F.wg % 15, g0 = 0; while (c >= 5 - g0) { c -= 5 - g0; ++g0; } gaps = (1u << g0) | (1u << (g0 + 1 + c)); }
        int cvn = F.wg * 2;
        if (!cv_ok) { for (int idx = F.wg; idx < 1536; idx += F.G) cvt8_item(F, args, idx); }
        int lo = 0;
#pragma unroll 1
        for (int seg = 0; seg < 3; ++seg) {
            if ((gaps >> lo) & 1u) { cvt8_item(F, args, cvn++); gaps &= ~(1u << lo); }
            int hi = lo + 1; while (hi < 5 && !((gaps >> hi) & 1u)) ++hi;
            if (lo < 5) { pg8::SubOrder<pg8::DenseOrder> S{S0, lo, hi - lo}; pg8::gemm_phase<EpiZT<true>, pg8::SubOrder<pg8::DenseOrder>, true>(F.lds, D / 2, S, E); }
            lo = hi;
        }
        if (gaps & 32u) cvt8_item(F, args, cvn++);
    } SEAM(2);
    if (IN(3) && F.G == 256) { mlstm_passA4(F, args); }
    else if (IN(3)) {
        PassAIn cur = mlstm_passA_load(F, F.wg < 1024 ? F.wg : 0);
        for (int u = F.wg; u < 1024; u += F.G) { const int un = u + F.G; const PassAIn nxt = mlstm_passA_load(F, un < 1024 ? un : u); mlstm_passA(F, args, u, cur); cur = nxt; }
    } SEAM(3);
    if (IN(11)) { for (int it = F.wg; it < 256; it += F.G) mlstm_passB(F, it); }
    if (IN(3) && IN(4)) xcd_barrier(bar);
    if (IN(4)) { p4_mixers(F, args, F.G == 256); } SEAM(4);
    if (IN(5)) {
        if (cv_ok && (F.wg & 1) == 0) cvt8_item(F, args, 768 + F.wg);
        { pg8::PairOrder S; S.d.init(ws + WS_HM, ws + WS_WA, T, D, F.G, F.wg); S.A2 = (const char*)(ws + WS_OB); S.Bt2 = (const char*)(ws + WS_WB);
          EpiBranchAB E{(const bf16_t*)(ws + WS_Z), ws + WS_YBUF8};
          pg8::gemm_phase<EpiBranchAB, pg8::PairOrder, true>(F.lds, 512, S, E); }
        if (cv_ok && (F.wg & 1) == 1) cvt8_item(F, args, 768 + F.wg);
    } SEAM(5);
    if (IN(6)) {
        if (cv_ok && (F.wg & 1) == 0) cvt8_item(F, args, 1024 + F.wg);
        pg8::DenseOrder S; S.init(ws + WS_YBUF8, ws + WS_WOUT8, T, D, F.G, F.wg);
        EpiOut E{args.in[I_X], (const float*)(ws + WS_MODF), (bf16_t*)(ws + WS_X1)};
        pg8::gemm_phase<EpiOut, pg8::DenseOrder, true>(F.lds, D / 2, S, E);
        if (cv_ok && (F.wg & 1) == 1) cvt8_item(F, args, 1024 + F.wg);
    } SEAM(6);
    if (IN(7)) { p7_router(F, args); } SEAM(7);
    if (IN(8)) {
        moe_tables(F);
        const LAS int* tb = (const LAS int*)(F.lds + LDS_TABS);
        pg8::MoeOrder S{(const char*)(ws + WS_TA), (const char*)(ws + WS_WUP), tb, tb + 64, tb + 96, 16, F.G, F.vcu, (size_t)(2 * D) * D, __builtin_amdgcn_readfirstlane(tb[96 + NE]), nullptr, 0u};
        EpiUpT<true> E{ws + WS_ACT, args.in[I_BUP], tb + 32, F.ctl + CW_UPD};
        const int cut = cv_ok ? (F.wg & 7) : 0;
        if (cut > 0) { pg8::SubOrder<pg8::MoeOrder> S1{S, 0, cut}; pg8::gemm_phase<EpiUpT<true>, pg8::SubOrder<pg8::MoeOrder>, true>(F.lds, D / 2, S1, E); }
        if (cv_ok) cvt8_item_signal(F, args, 1280 + F.wg, F.ctl + CW_UPD);
        { pg8::SubOrder<pg8::MoeOrder> S2{S, cut, 1 << 20}; pg8::gemm_phase<EpiUpT<true>, pg8::SubOrder<pg8::MoeOrder>, true>(F.lds, D / 2, S2, E); }
    }
    if (IN(9)) {
        if (!IN(8)) moe_tables(F);
        const LAS int* tb = (const LAS int*)(F.lds + LDS_TABS);
        const int utot = __builtin_amdgcn_readfirstlane(tb[96 + NE]);
        pg8::MoeDepOrder S{(const char*)(ws + WS_ACT), (const char*)(ws + WS_WDN), tb, tb + 32, tb + 160, 8, F.G, (F.vcu - utot % F.G + F.G) % F.G, (size_t)D * D, __builtin_amdgcn_readfirstlane(tb[160 + NE]), F.ctl + CW_UPD, cv_ok ? 16u : 0u};
        EpiDown E{ws + WS_YDN, args.in[I_BDN], (const float*)(ws + WS_ROWW), tb + 32};
        pg8::gemm_phase<EpiDown, pg8::MoeDepOrder, true>(F.lds, D / 2, S, E);
    } SEAM(9);
    if (IN(10)) { if (!IN(8) && !IN(9)) moe_tables(F); p10_combine(F, args); }
#undef IN
#undef SEAM
}

constexpr int N_PHASES = 12;
extern "C" void kernel_launch(void* const* d_in, const int* in_sizes, int n_in, void* d_out, int out_size, void* d_ws, size_t ws_size, hipStream_t stream) {
    static int grid = 0;
    if (grid == 0) {
        if (n_in != 21 || out_size != T * D || ws_size < WS_END) { fprintf(stderr, "kernel_launch: unexpected problem (n_in %d out %d ws %zu)\n", n_in, out_size, ws_size); grid = -1; return; }
        int dev = 0, cus = 0, per_cu = 0;
        if (hipGetDevice(&dev) != hipSuccess || hipDeviceGetAttribute(&cus, hipDeviceAttributeMultiprocessorCount, dev) != hipSuccess) { grid = -1; return; }
        if (hipFuncSetAttribute((const void*)hybrid_fwd, hipFuncAttributeMaxDynamicSharedMemorySize, LDS_BYTES) != hipSuccess) { fprintf(stderr, "kernel_launch: hipFuncSetAttribute failed\n"); grid = -1; return; }
        if (hipOccupancyMaxActiveBlocksPerMultiprocessor(&per_cu, (const void*)hybrid_fwd, 512, LDS_BYTES) != hipSuccess || per_cu < 1) fprintf(stderr, "kernel_launch: occupancy query says %d\n", per_cu);
        (void)hipGetLastError();
        grid = cus;
    }
    if (grid < 0) return;
    if (hipMemsetAsync((char*)d_ws + WS_CTL, 0, CTL_BYTES, stream) != hipSuccess) return;
    Args a{};
    for (int i = 0; i < 21; ++i) a.in[i] = (const float*)d_in[i];
    a.out = (float*)d_out; a.ws = (unsigned char*)d_ws;
#if MK_PER_PHASE
    for (int p = 0; p < N_PHASES; ++p) { a.ph_lo = p; a.ph_hi = p + 1; hipLaunchKernelGGL(hybrid_fwd, dim3(grid), dim3(512), LDS_BYTES, stream, a); }
#else
    a.ph_lo = 0; a.ph_hi = N_PHASES;
    hipLaunchKernelGGL(hybrid_fwd, dim3(grid), dim3(512), LDS_BYTES, stream, a);
#endif
}
```

```cpp
#include <hip/hip_runtime.h>
#include <cstdio>
#include <cstdint>

#ifndef MK_PER_PHASE
#define MK_PER_PHASE 0
#endif

#define LAS __attribute__((address_space(3)))
#define GAS __attribute__((address_space(1)))
typedef unsigned short bf16_t;
typedef short bf16x8 __attribute__((ext_vector_type(8)));
typedef short s16x4 __attribute__((ext_vector_type(4)));
typedef float f32x4 __attribute__((ext_vector_type(4)));
typedef float f32x2 __attribute__((ext_vector_type(2)));
typedef unsigned u32x4 __attribute__((ext_vector_type(4)));
typedef unsigned u32x2 __attribute__((ext_vector_type(2)));
typedef int i32x8 __attribute__((ext_vector_type(8)));
typedef int i32x4 __attribute__((ext_vector_type(4)));

constexpr int D = 2048, NB = 4, SEQ = 2048, T = NB * SEQ;
constexpr int DIN = 10256, ZP = 10240;
constexpr int ZQA = 0, ZKA = 512, ZVA = 1024, ZOA = 2048, ZQB = 3072, ZKB = 4096, ZVB = 5120, ZGA = 6144, ZGB = 8192;
constexpr int GATE_COL = 3072;
constexpr int NE = 32, TOPK = 4, ECAP = 8192, CROWS = 40960;
constexpr float EPS = 1e-6f;

constexpr size_t MiB = 1ull << 20;
constexpr size_t WS_CTL = 0, CTL_BYTES = 1 * MiB;
constexpr size_t WS_MODP = 1 * MiB;
constexpr size_t WS_GATES = 2 * MiB;
constexpr size_t WS_KMEAN = 3 * MiB;
constexpr size_t WS_WGF = 3 * MiB + 512 * 1024;
constexpr size_t WS_WRF = 3 * MiB + 640 * 1024;
constexpr size_t WS_MODF = 4 * MiB;
constexpr size_t WS_TOKE = 5 * MiB;
constexpr size_t WS_TOKW = 5 * MiB + 256 * 1024;
constexpr size_t WS_TOKS = 5 * MiB + 512 * 1024;
constexpr size_t WS_ROWW = 6 * MiB;
constexpr size_t WS_WIN = 8 * MiB;
constexpr size_t WS_WOUT8 = 8 * MiB;
constexpr size_t WS_WA = 48 * MiB, WS_WB = 52 * MiB, WS_WOUT = 56 * MiB;
constexpr size_t WS_HBUF = 64 * MiB;
constexpr size_t WS_YBUF8 = 64 * MiB;
constexpr float Y8_SCALE = 8.0f;
constexpr float YD_SCALE = 16.0f;
constexpr float H8_SCALE = 8.0f, O8_SCALE = 32.0f;
constexpr size_t WS_Z = 96 * MiB;
constexpr size_t WS_HM = 256 * MiB, WS_OB = 272 * MiB;
constexpr size_t WS_TMPF = 288 * MiB;
constexpr size_t WS_YBUF = 352 * MiB;
constexpr size_t WS_X1 = 384 * MiB;
constexpr size_t WS_ACT = 448 * MiB;
constexpr size_t WS_YDN = 608 * MiB;
constexpr size_t WS_CLOC = 928 * MiB;
constexpr size_t WS_CIN = 960 * MiB;
constexpr size_t WS_NLOC = 976 * MiB, WS_NIN = 977 * MiB, WS_MSC = 978 * MiB;
constexpr size_t WS_HBUF8 = 980 * MiB;
constexpr size_t WS_WIN8 = 996 * MiB;
constexpr size_t WS_WUP = 1024 * MiB;
constexpr size_t WS_WDN = 1536 * MiB;
constexpr size_t WS_TA = 2048 * MiB;
constexpr size_t WS_END = 3072 * MiB;
constexpr int CW_BAR = 4096;
constexpr int CW_CNT = 16384;
constexpr int CW_QUEUE = 32768;
constexpr int CW_MISC = 49152;
constexpr int CW_UPD = 65536;
constexpr int CW_MQ = 32768 + 64;
constexpr int CW_CUD = 36864, CW_CDD = 40960, CW_GUD = 45056;

constexpr int LDS_BYTES = 157696;
constexpr int LDS_XB = 157568;
constexpr int LDS_TABS = 147456;

__device__ __forceinline__ float bf_lo(unsigned u) { return __uint_as_float(u << 16); }
__device__ __forceinline__ float bf_hi(unsigned u) { return __uint_as_float(u & 0xffff0000u); }
__device__ __forceinline__ float bf1(bf16_t v) { return __uint_as_float(((unsigned)v) << 16); }
__device__ __forceinline__ unsigned pk2(float lo, float hi) { unsigned r; asm("v_cvt_pk_bf16_f32 %0, %1, %2" : "=v"(r) : "v"(lo), "v"(hi)); return r; }
__device__ __forceinline__ bf16_t f2bf(float f) { return (bf16_t)(pk2(f, 0.f) & 0xffffu); }
__device__ __forceinline__ float wave_sum(float v) {
#pragma unroll
    for (int o = 1; o < 64; o <<= 1) v += __shfl_xor(v, o);
    return v;
}
__device__ __forceinline__ void store16_sc1(void* p, u32x4 v) { asm volatile("global_store_dwordx4 %0, %1, off sc1\n\ts_nop 1" :: "v"(p), "v"(v) : "memory"); }
__device__ __forceinline__ void store8_sc1(void* p, u32x2 v) { asm volatile("global_store_dwordx2 %0, %1, off sc1\n\ts_nop 1" :: "v"(p), "v"(v) : "memory"); }
__device__ __forceinline__ unsigned pk4_fp8(float a, float b, float c, float d) {
    a = __builtin_amdgcn_fmed3f(a, -448.0f, 448.0f); b = __builtin_amdgcn_fmed3f(b, -448.0f, 448.0f); c = __builtin_amdgcn_fmed3f(c, -448.0f, 448.0f); d = __builtin_amdgcn_fmed3f(d, -448.0f, 448.0f);
    int r = __builtin_amdgcn_cvt_pk_fp8_f32(a, b, 0, false); r = __builtin_amdgcn_cvt_pk_fp8_f32(c, d, r, true); return (unsigned)r; }
__device__ __forceinline__ unsigned pk4_fp8_ns(float a, float b, float c, float d) { int r = __builtin_amdgcn_cvt_pk_fp8_f32(a, b, 0, false); r = __builtin_amdgcn_cvt_pk_fp8_f32(c, d, r, true); return (unsigned)r; }
constexpr float W8_SCALE = 256.0f, W8_INV = 1.0f / 256.0f;
__device__ __forceinline__ float sigmoidf_(float x) { return __builtin_amdgcn_rcpf(1.f + __expf(-x)); }
#define DPP_ADD(t, CTRL) ((t) + __builtin_bit_cast(float, __builtin_amdgcn_update_dpp(0, __builtin_bit_cast(int, (t)), (CTRL), 0xf, 0xf, false)))
__device__ __forceinline__ float sum8_(float t) { t = DPP_ADD(t, 0xB1); t = DPP_ADD(t, 0x4E); t = DPP_ADD(t, 0x141); return t; }
__device__ __forceinline__ float sum16_(float t) { t = sum8_(t); t = DPP_ADD(t, 0x140); return t; }

namespace pg8 {
constexpr int BM = 256, BK = 64, HALF = 128, HTB = HALF * BK * 2, STAGE_BYTES = 8 * HTB, NXCD = 8, WGM = 8;
__host__ __device__ __forceinline__ int lds_byte(int r, int c) { const int st = (r >> 4) * 2 + (c >> 5), rr = r & 15, cc = c & 31, ob = rr * 64 + cc * 2; return st * 1024 + (ob ^ (((ob >> 9) & 1) << 5)); }
__host__ __device__ __forceinline__ void stage_rc(int b, int& R, int& C) { const int st = b / 1024, sb = b % 1024, swz = sb ^ (((sb >> 9) & 1) << 5); R = (st >> 1) * 16 + swz / 64; C = (st & 1) * 32 + (swz % 64) / 2; }
__host__ __device__ __forceinline__ int perm32(int rho) { const int n = rho >> 4, i = rho & 15; return 8 * (i >> 2) + 4 * n + (i & 3); }

struct Unit { int pm, pn, e; };

struct DenseOrder {
    static constexpr bool HAS_DEP = false;
    const char* A; const char* Bt; int nM, nN, nwg, G, c;
    __device__ void init(const void* A_, const void* Bt_, int M, int N, int G_, int c_) { A = (const char*)A_; Bt = (const char*)Bt_; nM = M / BM; nN = N / BM; nwg = nM * nN; G = G_; c = c_; }
    __device__ bool next(int i, Unit& u) const {
        const long L = (long)i * G + c; if (L >= nwg) return false;
        int wgid = (int)L; { const int q = nwg / NXCD, r = nwg % NXCD, xcd = wgid % NXCD, off = wgid / NXCD; wgid = (xcd < r ? xcd * (q + 1) : r * (q + 1) + (xcd - r) * q) + off; }
        const int nig = WGM * nN, gid = wgid / nig, fm = gid * WGM, gsz = (nM - fm) < WGM ? (nM - fm) : WGM;
        u.pm = fm + ((wgid % nig) % gsz); u.pn = (wgid % nig) / gsz; u.e = 0; return true;
    }
    __device__ __forceinline__ const char* a_ptr(const Unit& u, size_t tstep) const { return A + (size_t)u.pm * tstep; }
    __device__ __forceinline__ const char* b_ptr(const Unit& u, size_t tstep) const { return Bt + (size_t)u.pn * tstep; }
};

constexpr unsigned DEP_NEED = 16u;
template <bool DEP>
struct MoeOrderT {
    static constexpr bool HAS_DEP = DEP;
    const char* A; const char* Bt; const LAS int* tiles; const LAS int* arow; const LAS int* ub; int nN, G, c; size_t estepB; int total; unsigned* dep; unsigned need_hi;
    __device__ bool next(int i, Unit& u) const {
        const int L = i * G + c; if (L >= total) return false;
        unsigned zz = 0u; asm volatile("" : "+v"(zz));
        const int ln = (int)__builtin_amdgcn_mbcnt_hi(~0u, __builtin_amdgcn_mbcnt_lo(~0u, zz));
        const int ubv = ub[(ln < NE ? ln : NE - 1) + 1];
        const int e = __builtin_popcountll(__ballot(ln < NE && L >= ubv));
        const int r = L - __builtin_amdgcn_readfirstlane(ub[e]), te = __builtin_amdgcn_readfirstlane(tiles[e]);
        u.e = e; u.pm = r % te; u.pn = r / te; return true;
    }
    __device__ __forceinline__ unsigned dep_issue(int i) const {
        Unit u; if (!next(i, u)) return 0xffffffffu;
        return __hip_atomic_load(dep + (u.e * 32 + u.pm) * 16, __ATOMIC_RELAXED, __HIP_MEMORY_SCOPE_AGENT);
    }
    __device__ __forceinline__ void dep_confirm(const Unit& u, unsigned v) const {
        const unsigned* ctr = dep + (u.e * 32 + u.pm) * 16;
        const unsigned need = DEP_NEED + (u.e >= 16 ? need_hi : 0u);
        while ((unsigned)__builtin_amdgcn_readfirstlane((int)v) < need) { __builtin_amdgcn_s_sleep(2); v = __hip_atomic_load(ctr, __ATOMIC_RELAXED, __HIP_MEMORY_SCOPE_AGENT); }
        asm volatile("" ::: "memory");
    }
    __device__ __forceinline__ const char* a_ptr(const Unit& u, size_t tstep) const { return A + ((size_t)arow[u.e] / 256 + (size_t)u.pm) * tstep; }
    __device__ __forceinline__ const char* b_ptr(const Unit& u, size_t tstep) const { return Bt + (size_t)u.e * estepB + (size_t)u.pn * tstep; }
};
typedef MoeOrderT<false> MoeOrder;
typedef MoeOrderT<true> MoeDepOrder;

template <class Base> struct SubOrder {
    static constexpr bool HAS_DEP = false;
    Base b; int i0, n;
    __device__ bool next(int i, Unit& u) const { if (i >= n) return false; return b.next(i0 + i, u); }
    __device__ __forceinline__ const char* a_ptr(const Unit& u, size_t tstep) const { return b.a_ptr(u, tstep); }
    __device__ __forceinline__ const char* b_ptr(const Unit& u, size_t tstep) const { return b.b_ptr(u, tstep); }
};
struct OneUnit {
    static constexpr bool HAS_DEP = false;
    const char* A; const char* Bt; Unit u;
    __device__ bool next(int i, Unit& o) const { if (i > 0) return false; o = u; return true; }
    __device__ __forceinline__ const char* a_ptr(const Unit&, size_t) const { return A; }
    __device__ __forceinline__ const char* b_ptr(const Unit&, size_t) const { return Bt; }
};

struct PairOrder {
    static constexpr bool HAS_DEP = false;
    DenseOrder d; const char* A2; const char* Bt2;
    __device__ bool next(int i, Unit& u) const { if (!d.next(i >> 1, u)) return false; u.e = i & 1; return true; }
    __device__ __forceinline__ const char* a_ptr(const Unit& u, size_t tstep) const { return (u.e ? A2 : d.A) + (size_t)u.pm * tstep; }
    __device__ __forceinline__ const char* b_ptr(const Unit& u, size_t tstep) const { return (u.e ? Bt2 : d.Bt) + (size_t)u.pn * tstep; }
};

template <class Epi, class Sched, bool FP8 = false>
__device__ __forceinline__ void gemm_phase(LAS unsigned char* lds, const int K, const Sched& S, const Epi& E) {
    int tid = threadIdx.x; asm volatile("" : "+v"(tid));
    const int wid = __builtin_amdgcn_readfirstlane(tid >> 6), lane = tid & 63, wr = wid >> 2, wc = wid & 3, fr = lane & 15, fq = lane >> 4;
    const int nt = K / BK;
    unsigned voffA, voffB;
    { int R, C; stage_rc(tid * 16, R, C); const int Rb = Epi::PERM ? ((R & ~31) + perm32(R & 31)) : R;
      voffA = (unsigned)(R * K + C) * 2u; voffB = (unsigned)(Rb * K + C) * 2u; }
    const size_t pstep = (size_t)64 * K * 2;
    const size_t kstep = (size_t)(BK * 2);
    const size_t hstep = (size_t)HALF * K * 2;
    const size_t tstep = 2 * hstep;
    const unsigned ldsw = (unsigned)wid * 1024u;
    int lanex;
    { unsigned _z = 0u; asm volatile("" : "+v"(_z)); const int _ln = (int)__builtin_amdgcn_mbcnt_hi(~0u, __builtin_amdgcn_mbcnt_lo(~0u, _z)); lanex = lds_byte(_ln & 15, (_ln >> 4) * 8); }
#define PG8_LANE_OFFS asm volatile("" : "+v"(lanex)); const int aoff = lanex + wr * 8192, boff = lanex + wc * 4096; (void)aoff; (void)boff
#define PG8_SA(b, h) (((b) * 2 + (h)) * HTB)
#define PG8_SB(b, h) ((4 + (b) * 2 + (h)) * HTB)
#define PG8_STAGE(bufoff, gbase, voff) do { asm volatile("" : "+v"(voff)); _Pragma("unroll") for (int _i = 0; _i < 2; ++_i) \
        __builtin_amdgcn_global_load_lds((const unsigned*)((const char*)(gbase) + _i * pstep + (voff)), (LAS unsigned*)(lds + (bufoff) + ldsw + _i * 8192), 16, 0, 0); } while (0)
#define PG8_LDA(dst, b, h) do { _Pragma("unroll") for (int m = 0; m < 4; ++m) { const i32x4 _l = *(const LAS i32x4*)(lds + PG8_SA(b, h) + aoff + m * 2048), _h = *(const LAS i32x4*)(lds + PG8_SA(b, h) + aoff + m * 2048 + 1024); \
        dst[m] = __builtin_shufflevector(_l, _h, 0, 1, 2, 3, 4, 5, 6, 7); } } while (0)
#define PG8_LDB(dst, b, h) do { _Pragma("unroll") for (int n = 0; n < 2; ++n) { const i32x4 _l = *(const LAS i32x4*)(lds + PG8_SB(b, h) + boff + n * 2048), _h = *(const LAS i32x4*)(lds + PG8_SB(b, h) + boff + n * 2048 + 1024); \
        dst[n] = __builtin_shufflevector(_l, _h, 0, 1, 2, 3, 4, 5, 6, 7); } } while (0)
#define PG8_LO(x) __builtin_bit_cast(bf16x8, __builtin_shufflevector((x), (x), 0, 1, 2, 3))
#define PG8_HI(x) __builtin_bit_cast(bf16x8, __builtin_shufflevector((x), (x), 4, 5, 6, 7))
#define PG8_MMA(ai, bj, At, Bt) do { __builtin_amdgcn_s_setprio(1); \
        if constexpr (FP8) { _Pragma("unroll") for (int m = 0; m < 4; ++m) _Pragma("unroll") for (int n = 0; n < 2; ++n) \
            acc[ai][bj][m][n] = __builtin_amdgcn_mfma_scale_f32_16x16x128_f8f6f4(Bt[n], At[m], acc[ai][bj][m][n], 0, 0, 0, 0x7f7f7f7f, 0, 0x7f7f7f7f); } \
        else { _Pragma("unroll") for (int m = 0; m < 4; ++m) _Pragma("unroll") for (int n = 0; n < 2; ++n) { \
            acc[ai][bj][m][n] = __builtin_amdgcn_mfma_f32_16x16x32_bf16(PG8_LO(Bt[n]), PG8_LO(At[m]), acc[ai][bj][m][n], 0, 0, 0); \
            acc[ai][bj][m][n] = __builtin_amdgcn_mfma_f32_16x16x32_bf16(PG8_HI(Bt[n]), PG8_HI(At[m]), acc[ai][bj][m][n], 0, 0, 0); } } \
        __builtin_amdgcn_s_setprio(0); } while (0)
#define PG8_WAIT_V(n) asm volatile("s_waitcnt vmcnt(" #n ")" ::: "memory")
#define PG8_WAIT_L(n) asm volatile("s_waitcnt lgkmcnt(" #n ")" ::: "memory")
#define PG8_BAR __builtin_amdgcn_s_barrier()
#define PG8_SCHED __builtin_amdgcn_sched_barrier(0)
    Unit cur, nxt, prv; int ui = 0; prv.pm = prv.pn = prv.e = 0; (void)prv;
    if (!S.next(0, cur)) return;
    unsigned depv = 0u; (void)depv;
    if constexpr (Sched::HAS_DEP) { S.dep_confirm(cur, S.dep_issue(0)); depv = S.dep_issue(1); }
    f32x4 acc[2][2][4][2];
#define PG8_ACC_INIT(U) do { f32x4 _bi[2][2]; \
        if constexpr (Epi::ACC_INIT) { unsigned _zz = 0u; asm volatile("" : "+v"(_zz)); const int _ln = (int)__builtin_amdgcn_mbcnt_hi(~0u, __builtin_amdgcn_mbcnt_lo(~0u, _zz)); E.acc_bias((U), wc, _ln >> 4, _bi); } \
        else { _bi[0][0] = (f32x4){0.f, 0.f, 0.f, 0.f}; _bi[0][1] = _bi[0][0]; _bi[1][0] = _bi[0][0]; _bi[1][1] = _bi[0][0]; } \
        _Pragma("unroll") for (int a = 0; a < 2; ++a) _Pragma("unroll") for (int b = 0; b < 2; ++b) _Pragma("unroll") for (int m = 0; m < 4; ++m) _Pragma("unroll") for (int n = 0; n < 2; ++n) acc[a][b][m][n] = _bi[b][n]; } while (0)
    PG8_ACC_INIT(cur);
    i32x8 At[4], B0[2], B1[2];
    const char* cA = S.a_ptr(cur, tstep); const char* cB = S.b_ptr(cur, tstep);
    PG8_STAGE(PG8_SB(0, 0), cB, voffB); PG8_STAGE(PG8_SB(0, 1), cB + hstep, voffB); PG8_STAGE(PG8_SA(0, 0), cA, voffA); PG8_STAGE(PG8_SA(0, 1), cA + hstep, voffA);
    if (wr == 1) PG8_BAR;
    PG8_WAIT_V(2); PG8_BAR;
    PG8_STAGE(PG8_SB(1, 0), cB + kstep, voffB); PG8_STAGE(PG8_SA(1, 0), cA + kstep, voffA); PG8_STAGE(PG8_SB(1, 1), cB + hstep + kstep, voffB);
    PG8_WAIT_V(6); PG8_BAR;
    for (;;) {
        const bool has_next = S.next(ui + 1, nxt);
        if constexpr (Sched::HAS_DEP) { if (has_next) S.dep_confirm(nxt, depv); }
        const char* nA = has_next ? S.a_ptr(nxt, tstep) : cA; const char* nB = has_next ? S.b_ptr(nxt, tstep) : cB;
#pragma unroll 1
        for (int t = 0; t < nt; t += 2) {
            const bool last = (t == nt - 2);
            const char* a1 = cA + (size_t)(t + 1) * kstep;
            const char* a2 = last ? nA : cA + (size_t)(t + 2) * kstep; const char* b2 = last ? nB : cB + (size_t)(t + 2) * kstep;
            const char* a3 = a2 + kstep; const char* b3 = b2 + kstep;
            { PG8_LANE_OFFS; PG8_LDB(B0, 0, 0); PG8_LDB(B1, 0, 1); PG8_SCHED; PG8_LDA(At, 0, 0); PG8_STAGE(PG8_SA(1, 1), a1 + hstep, voffA); }
            PG8_WAIT_V(8); PG8_WAIT_L(0); PG8_BAR; PG8_MMA(0, 0, At, B0); PG8_MMA(0, 1, At, B1); PG8_BAR; PG8_SCHED;
            { PG8_LANE_OFFS; PG8_LDA(At, 0, 1); PG8_STAGE(PG8_SB(0, 0), b2, voffB); PG8_STAGE(PG8_SB(0, 1), b2 + hstep, voffB); PG8_STAGE(PG8_SA(0, 0), a2, voffA); }
            PG8_WAIT_V(8); PG8_WAIT_L(0); PG8_BAR; PG8_MMA(1, 0, At, B0); PG8_MMA(1, 1, At, B1); PG8_BAR; PG8_SCHED;
            { PG8_LANE_OFFS; PG8_LDB(B0, 1, 0); PG8_LDB(B1, 1, 1); PG8_SCHED; PG8_LDA(At, 1, 0); PG8_STAGE(PG8_SA(0, 1), a2 + hstep, voffA); }
            PG8_WAIT_V(8); PG8_WAIT_L(0); PG8_BAR; PG8_MMA(0, 0, At, B0); PG8_MMA(0, 1, At, B1); PG8_BAR; PG8_SCHED;
            { PG8_LANE_OFFS; PG8_LDA(At, 1, 1); PG8_STAGE(PG8_SB(1, 0), b3, voffB); PG8_STAGE(PG8_SB(1, 1), b3 + hstep, voffB); PG8_STAGE(PG8_SA(1, 0), a3, voffA); }
            PG8_WAIT_V(8); PG8_WAIT_L(0); PG8_BAR; PG8_MMA(1, 0, At, B0); PG8_MMA(1, 1, At, B1); PG8_BAR; PG8_SCHED;
        }
        if (wr == 0) PG8_BAR;
        if constexpr (Sched::HAS_DEP) depv = S.dep_issue(ui + 2);
        if constexpr (Epi::SIGNALS) { if (ui > 0) { PG8_WAIT_V(8); PG8_BAR; E.signal(prv, tid == 0); } }
        { unsigned zz = 0u; asm volatile("" : "+v"(zz));
          const int ln = (int)__builtin_amdgcn_mbcnt_hi(~0u, __builtin_amdgcn_mbcnt_lo(~0u, zz));
          E(acc, cur, wr, wc, ln & 15, ln >> 4); }
        if (!has_next) break;
        if (!(Epi::CHAIN && cur.e == 0)) { PG8_ACC_INIT(nxt); }
        prv = cur; cur = nxt; cA = nA; cB = nB; ++ui;
        if (wr == 1) PG8_BAR;
    }
    PG8_WAIT_V(0);
    PG8_BAR;
    if constexpr (Epi::SIGNALS) E.signal(cur, tid == 0);
#undef PG8_SA
#undef PG8_ACC_INIT
#undef PG8_SB
#undef PG8_STAGE
#undef PG8_LDA
#undef PG8_LDB
#undef PG8_MMA
#undef PG8_LO
#undef PG8_LANE_OFFS
#undef PG8_HI
#undef PG8_WAIT_V
#undef PG8_WAIT_L
#undef PG8_BAR
#undef PG8_SCHED
}
}

using pg8::Unit;
template <bool F8>
struct EpiZT {
    static constexpr bool PERM = true;
    static constexpr bool SIGNALS = false;
    static constexpr bool CHAIN = false;
    static constexpr bool ACC_INIT = false;
    static constexpr float ASC = F8 ? W8_INV : 1.0f;
    bf16_t* O; int ldc; const float* gq; const float* gk; float* kmean; LAS unsigned char* xl;
    __device__ __forceinline__ void operator()(const f32x4 (&acc)[2][2][4][2], const Unit& u, int wr, int wc, int fr, int fq) const {
        const int row0 = u.pm * 256 + wr * 64 + fr, col0 = u.pn * 256 + wc * 32 + 8 * fq;
        if (u.pn < 12 || u.pn >= 20) {
#pragma unroll
            for (int ai = 0; ai < 2; ++ai)
#pragma unroll
                for (int m = 0; m < 4; ++m) { bf16_t* rowp = O + (size_t)(row0 + ai * 128 + m * 16) * ldc + col0;
#pragma unroll
                    for (int bj = 0; bj < 2; ++bj) { const f32x4 v0 = acc[ai][bj][m][0] * ASC, v1 = acc[ai][bj][m][1] * ASC;
                        u32x4 w; w.x = pk2(v0[0], v0[1]); w.y = pk2(v0[2], v0[3]); w.z = pk2(v1[0], v1[1]); w.w = pk2(v1[2], v1[3]);
                        *(u32x4*)(rowp + bj * 128) = w; } }
            return;
        }
        LAS float* P = (LAS float*)xl;
        LAS float* Cs = (LAS float*)(xl + 8192);
#pragma unroll
        for (int ai = 0; ai < 2; ++ai)
#pragma unroll
            for (int m = 0; m < 4; ++m)
#pragma unroll
                for (int bj = 0; bj < 2; ++bj) { const f32x4 v0 = acc[ai][bj][m][0], v1 = acc[ai][bj][m][1];
                    float ss = (v0[0] * v0[0] + v0[1] * v0[1]) + (v0[2] * v0[2] + v0[3] * v0[3]) + (v1[0] * v1[0] + v1[1] * v1[1]) + (v1[2] * v1[2] + v1[3] * v1[3]);
                    ss += __shfl_xor(ss, 16); ss += __shfl_xor(ss, 32);
                    if (fq == 0) P[((ai * 128 + wr * 64 + m * 16 + fr) * 2 + bj) * 4 + wc] = ss; asm volatile("" ::: "memory"); }
        __syncthreads();
        const bool isk = u.pn >= 16;
        const float* gv = (isk ? gk : gq) + wc * 32 + 8 * fq;
        const f32x4 g0 = *(const f32x4*)gv, g1 = *(const f32x4*)(gv + 4);
        f32x4 cs[2][2];
#pragma unroll
        for (int bj = 0; bj < 2; ++bj) { cs[bj][0] = (f32x4){0.f, 0.f, 0.f, 0.f}; cs[bj][1] = cs[bj][0]; }
#pragma unroll
        for (int ai = 0; ai < 2; ++ai)
#pragma unroll
            for (int m = 0; m < 4; ++m) { const int rl = ai * 128 + wr * 64 + m * 16 + fr; bf16_t* rowp = O + (size_t)(u.pm * 256 + rl) * ldc + col0;
#pragma unroll
                for (int bj = 0; bj < 2; ++bj) { const f32x4 pp = *(const LAS f32x4*)(P + (rl * 2 + bj) * 4);
                    const float rinv = rsqrtf(((pp[0] + pp[1]) + (pp[2] + pp[3])) * (ASC * ASC / 128.0f) + EPS) * ASC;
                    const f32x4 y0 = acc[ai][bj][m][0] * rinv * g0, y1 = acc[ai][bj][m][1] * rinv * g1;
                    cs[bj][0] += y0; cs[bj][1] += y1;
                    u32x4 w; w.x = pk2(y0[0], y0[1]); w.y = pk2(y0[2], y0[3]); w.z = pk2(y1[0], y1[1]); w.w = pk2(y1[2], y1[3]);
                    *(u32x4*)(rowp + bj * 128) = w; }
                asm volatile("" : "+v"(cs[0][0]), "+v"(cs[0][1]), "+v"(cs[1][0]), "+v"(cs[1][1]) :: "memory"); }
        if (isk) {
#pragma unroll
            for (int bj = 0; bj < 2; ++bj)
#pragma unroll
                for (int n = 0; n < 2; ++n)
#pragma unroll
                    for (int j = 0; j < 4; ++j) { float t = sum16_(cs[bj][n][j]);
                        if (fr == 0) Cs[(wr * 2 + bj) * 128 + wc * 32 + 8 * fq + 4 * n + j] = t; }
            __syncthreads();
            const int t = (wr * 4 + wc) * 64 + fq * 16 + fr;
            if (t < 256) { const int bj = t >> 7, d = t & 127, hd = (u.pn - 16) * 2 + bj;
                kmean[((((size_t)(u.pm >> 3) * 8 + hd) * 8) + (u.pm & 7)) * 128 + d] = (Cs[bj * 128 + d] + Cs[(2 + bj) * 128 + d]) * (1.0f / 256.0f); }
        }
    }
};
typedef EpiZT<false> EpiZ;
struct EpiZ8 {
    static constexpr bool PERM = true;
    static constexpr bool SIGNALS = false;
    static constexpr bool CHAIN = false;
    static constexpr bool ACC_INIT = false;
    bf16_t* O; int ldc, col_off;
    __device__ __forceinline__ void operator()(const f32x4 (&acc)[2][2][4][2], const Unit& u, int wr, int wc, int fr, int fq) const {
        const int row0 = u.pm * 256 + wr * 64 + fr, col0 = col_off + u.pn * 256 + wc * 32 + 8 * fq;
#pragma unroll
        for (int ai = 0; ai < 2; ++ai)
#pragma unroll
            for (int m = 0; m < 4; ++m) { bf16_t* rowp = O + (size_t)(row0 + ai * 128 + m * 16) * ldc + col0;
#pragma unroll
                for (int bj = 0; bj < 2; ++bj) { const f32x4 v0 = acc[ai][bj][m][0] * W8_INV, v1 = acc[ai][bj][m][1] * W8_INV;
                    u32x4 w; w.x = pk2(v0[0], v0[1]); w.y = pk2(v0[2], v0[3]); w.z = pk2(v1[0], v1[1]); w.w = pk2(v1[2], v1[3]);
                    *(u32x4*)(rowp + bj * 128) = w; } }
    }
};
struct EpiBranchA {
    static constexpr bool PERM = true;
    static constexpr bool SIGNALS = false;
    static constexpr bool CHAIN = false;
    static constexpr bool ACC_INIT = false;
    float* tmp; const bf16_t* z;
    __device__ __forceinline__ void operator()(const f32x4 (&acc)[2][2][4][2], const Unit& u, int wr, int wc, int fr, int fq) const {
        const int row0 = u.pm * 256 + wr * 64 + fr, col0 = u.pn * 256 + wc * 32 + 8 * fq;
#pragma unroll
        for (int ai = 0; ai < 2; ++ai)
#pragma unroll
            for (int m = 0; m < 4; ++m) { const size_t row = (size_t)(row0 + ai * 128 + m * 16);
#pragma unroll
                for (int bj = 0; bj < 2; ++bj) { const int col = col0 + bj * 128;
                    const u32x4 g = *(const u32x4*)(z + row * ZP + ZGA + col);
                    const f32x4 v0 = acc[ai][bj][m][0] * (W8_INV / H8_SCALE), v1 = acc[ai][bj][m][1] * (W8_INV / H8_SCALE);
                    f32x4 o0, o1;
                    o0[0] = v0[0] * sigmoidf_(bf_lo(g.x)); o0[1] = v0[1] * sigmoidf_(bf_hi(g.x)); o0[2] = v0[2] * sigmoidf_(bf_lo(g.y)); o0[3] = v0[3] * sigmoidf_(bf_hi(g.y));
                    o1[0] = v1[0] * sigmoidf_(bf_lo(g.z)); o1[1] = v1[1] * sigmoidf_(bf_hi(g.z)); o1[2] = v1[2] * sigmoidf_(bf_lo(g.w)); o1[3] = v1[3] * sigmoidf_(bf_hi(g.w));
                    float* p = tmp + row * D + col; *(f32x4*)p = o0; *(f32x4*)(p + 4) = o1; } }
    }
};
struct EpiBranchB {
    static constexpr bool PERM = true;
    static constexpr bool SIGNALS = false;
    static constexpr bool CHAIN = false;
    static constexpr bool ACC_INIT = false;
    const float* tmp; const bf16_t* z; unsigned char* y;
    __device__ __forceinline__ void operator()(const f32x4 (&acc)[2][2][4][2], const Unit& u, int wr, int wc, int fr, int fq) const {
        const int row0 = u.pm * 256 + wr * 64 + fr, col0 = u.pn * 256 + wc * 32 + 8 * fq;
#pragma unroll
        for (int ai = 0; ai < 2; ++ai)
#pragma unroll
            for (int m = 0; m < 4; ++m) { const size_t row = (size_t)(row0 + ai * 128 + m * 16);
#pragma unroll
                for (int bj = 0; bj < 2; ++bj) { const int col = col0 + bj * 128;
                    const u32x4 g = *(const u32x4*)(z + row * ZP + ZGB + col);
                    const float* p = tmp + row * D + col; const f32x4 t0 = *(const f32x4*)p, t1 = *(const f32x4*)(p + 4);
                    const f32x4 v0 = acc[ai][bj][m][0] * (W8_INV / O8_SCALE), v1 = acc[ai][bj][m][1] * (W8_INV / O8_SCALE);
                    f32x4 o0, o1;
                    o0[0] = t0[0] + v0[0] * sigmoidf_(bf_lo(g.x)); o0[1] = t0[1] + v0[1] * sigmoidf_(bf_hi(g.x)); o0[2] = t0[2] + v0[2] * sigmoidf_(bf_lo(g.y)); o0[3] = t0[3] + v0[3] * sigmoidf_(bf_hi(g.y));
                    o1[0] = t1[0] + v1[0] * sigmoidf_(bf_lo(g.z)); o1[1] = t1[1] + v1[1] * sigmoidf_(bf_hi(g.z)); o1[2] = t1[2] + v1[2] * sigmoidf_(bf_lo(g.w)); o1[3] = t1[3] + v1[3] * sigmoidf_(bf_hi(g.w));
                    o0 *= Y8_SCALE; o1 *= Y8_SCALE;
                    u32x2 w; w.x = pk4_fp8(o0[0], o0[1], o0[2], o0[3]); w.y = pk4_fp8(o1[0], o1[1], o1[2], o1[3]);
                    *(u32x2*)(y + row * D + col) = w; } }
    }
};
struct EpiBranchAB {
    static constexpr bool PERM = true;
    static constexpr bool SIGNALS = false;
    static constexpr bool CHAIN = true;
    static constexpr bool ACC_INIT = false;
    const bf16_t* z; unsigned char* y;
    __device__ __forceinline__ void operator()(f32x4 (&acc)[2][2][4][2], const Unit& u, int wr, int wc, int fr, int fq) const {
        const int row0 = u.pm * 256 + wr * 64 + fr, col0 = u.pn * 256 + wc * 32 + 8 * fq;
        if (u.e == 0) {
#pragma unroll
            for (int ai = 0; ai < 2; ++ai) {
                u32x4 ga[4][2], gb[4][2];
#pragma unroll
                for (int m = 0; m < 4; ++m)
#pragma unroll
                    for (int bj = 0; bj < 2; ++bj) { const bf16_t* zp = z + (size_t)(row0 + ai * 128 + m * 16) * ZP + col0 + bj * 128; ga[m][bj] = *(const u32x4*)(zp + ZGA); gb[m][bj] = *(const u32x4*)(zp + ZGB); }
                __builtin_amdgcn_sched_barrier(0);
#pragma unroll
                for (int m = 0; m < 4; ++m)
#pragma unroll
                    for (int bj = 0; bj < 2; ++bj) { const u32x4 a_ = ga[m][bj], b_ = gb[m][bj];
#define RHO(aw, bw, lo) ((O8_SCALE / H8_SCALE) * (1.0f + __expf(-(lo ? bf_lo(bw) : bf_hi(bw)))) * __builtin_amdgcn_rcpf(1.0f + __expf(-(lo ? bf_lo(aw) : bf_hi(aw)))))
                        f32x4 r0, r1;
                        r0[0] = RHO(a_.x, b_.x, 1); r0[1] = RHO(a_.x, b_.x, 0); r0[2] = RHO(a_.y, b_.y, 1); r0[3] = RHO(a_.y, b_.y, 0);
                        r1[0] = RHO(a_.z, b_.z, 1); r1[1] = RHO(a_.z, b_.z, 0); r1[2] = RHO(a_.w, b_.w, 1); r1[3] = RHO(a_.w, b_.w, 0);
#undef RHO
                        acc[ai][bj][m][0] *= r0; acc[ai][bj][m][1] *= r1; }
                __builtin_amdgcn_sched_barrier(0);
            }
        } else {
            u32x4 gb[2][4][2];
#pragma unroll
            for (int ai = 0; ai < 2; ++ai)
#pragma unroll
                for (int m = 0; m < 4; ++m)
#pragma unroll
                    for (int bj = 0; bj < 2; ++bj) gb[ai][m][bj] = *(const u32x4*)(z + (size_t)(row0 + ai * 128 + m * 16) * ZP + ZGB + col0 + bj * 128);
            __builtin_amdgcn_sched_barrier(0);
#pragma unroll
            for (int ai = 0; ai < 2; ++ai)
#pragma unroll
                for (int m = 0; m < 4; ++m) { const size_t row = (size_t)(row0 + ai * 128 + m * 16);
#pragma unroll
                    for (int bj = 0; bj < 2; ++bj) { const int col = col0 + bj * 128;
                        const u32x4 g = gb[ai][m][bj];
                        const f32x4 v0 = acc[ai][bj][m][0] * (W8_INV / O8_SCALE * Y8_SCALE), v1 = acc[ai][bj][m][1] * (W8_INV / O8_SCALE * Y8_SCALE);
                        u32x2 w;
                        w.x = pk4_fp8(v0[0] * sigmoidf_(bf_lo(g.x)), v0[1] * sigmoidf_(bf_hi(g.x)), v0[2] * sigmoidf_(bf_lo(g.y)), v0[3] * sigmoidf_(bf_hi(g.y)));
                        w.y = pk4_fp8(v1[0] * sigmoidf_(bf_lo(g.z)), v1[1] * sigmoidf_(bf_hi(g.z)), v1[2] * sigmoidf_(bf_lo(g.w)), v1[3] * sigmoidf_(bf_hi(g.w)));
                        *(u32x2*)(y + row * D + col) = w; } }
        }
    }
};
struct EpiOut {
    static constexpr bool PERM = false;
    static constexpr bool SIGNALS = false;
    static constexpr bool CHAIN = false;
    static constexpr bool ACC_INIT = false;
    const float* x; const float* modf; bf16_t* x1;
    __device__ __forceinline__ void operator()(const f32x4 (&acc)[2][2][4][2], const Unit& u, int wr, int wc, int fr, int fq) const {
        const int row0 = u.pm * 256 + wr * 64 + fr, col0 = u.pn * 256 + wc * 32 + 4 * fq;
        const float* gt = modf + (size_t)(u.pm >> 3) * (6 * D) + 2 * D;
        f32x4 gv[2][2];
#pragma unroll
        for (int bj = 0; bj < 2; ++bj)
#pragma unroll
            for (int n = 0; n < 2; ++n) gv[bj][n] = *(const f32x4*)(gt + col0 + bj * 128 + n * 16);
#pragma unroll
        for (int ai = 0; ai < 2; ++ai) {
            f32x4 xv[4][2][2];
#pragma unroll
            for (int m = 0; m < 4; ++m)
#pragma unroll
                for (int bj = 0; bj < 2; ++bj)
#pragma unroll
                    for (int n = 0; n < 2; ++n) xv[m][bj][n] = *(const f32x4*)(x + (size_t)(row0 + ai * 128 + m * 16) * D + col0 + bj * 128 + n * 16);
            __builtin_amdgcn_sched_barrier(0);
#pragma unroll
            for (int m = 0; m < 4; ++m) { const size_t off = (size_t)(row0 + ai * 128 + m * 16) * D + col0;
#pragma unroll
                for (int bj = 0; bj < 2; ++bj)
#pragma unroll
                    for (int n = 0; n < 2; ++n) {
                        const f32x4 v = xv[m][bj][n] + gv[bj][n] * (acc[ai][bj][m][n] * (W8_INV / Y8_SCALE));
                        u32x2 o; o.x = pk2(v[0], v[1]); o.y = pk2(v[2], v[3]);
                        *(u32x2*)(x1 + off + bj * 128 + n * 16) = o; } }
            __builtin_amdgcn_sched_barrier(0);
        }
    }
};
template <bool SC1>
struct EpiUpT {
    static constexpr bool PERM = true;
    static constexpr bool CHAIN = false;
    static constexpr bool ACC_INIT = true;
    static constexpr bool SIGNALS = SC1;
    unsigned char* act; const float* b_up; const LAS int* cbase; unsigned* upd;
    __device__ __forceinline__ void operator()(const f32x4 (&acc)[2][2][4][2], const Unit& u, int wr, int wc, int fr, int fq) const {
        const int row0 = cbase[u.e] + u.pm * 256 + wr * 64 + fr, colh = u.pn * 128 + wc * 32 + 8 * fq;
#pragma unroll
        for (int ai = 0; ai < 2; ++ai)
#pragma unroll
            for (int m = 0; m < 4; ++m) {
                const f32x4 g0 = acc[ai][0][m][0], g1 = acc[ai][0][m][1], l0 = acc[ai][1][m][0], l1 = acc[ai][1][m][1];
                constexpr float KE = 1.702f * 1.4426950408889634f * W8_INV, GC = 7.0f * W8_SCALE, OS = W8_INV * W8_INV;
                float o[8];
#pragma unroll
                for (int j = 0; j < 4; ++j) {
                    float g = fminf(g0[j], GC), l = __builtin_amdgcn_fmed3f(l0[j], -GC, GC); o[j] = (g * OS) * __builtin_amdgcn_rcpf(1.0f + __builtin_amdgcn_exp2f(g * -KE)) * (l + W8_SCALE);
                    g = fminf(g1[j], GC); l = __builtin_amdgcn_fmed3f(l1[j], -GC, GC); o[4 + j] = (g * OS) * __builtin_amdgcn_rcpf(1.0f + __builtin_amdgcn_exp2f(g * -KE)) * (l + W8_SCALE); }
                u32x2 w; w.x = pk4_fp8_ns(o[0], o[1], o[2], o[3]); w.y = pk4_fp8_ns(o[4], o[5], o[6], o[7]);
                if (SC1) store8_sc1(act + (size_t)(row0 + ai * 128 + m * 16) * D + colh, w); else *(u32x2*)(act + (size_t)(row0 + ai * 128 + m * 16) * D + colh) = w; }
    }
    __device__ __forceinline__ void acc_bias(const Unit& u, int wc, int fq, f32x4 (&bi)[2][2]) const {
        const float* bg = b_up + (size_t)u.e * (2 * D) + u.pn * 128 + wc * 32 + 8 * fq;
#pragma unroll
        for (int n = 0; n < 2; ++n) { bi[0][n] = *(const f32x4*)(bg + 4 * n) * W8_SCALE; bi[1][n] = *(const f32x4*)(bg + D + 4 * n) * W8_SCALE; }
    }
    __device__ __forceinline__ void signal(const Unit& u, bool first_lane) const { if (first_lane) __hip_atomic_fetch_add(upd + (u.e * 32 + u.pm) * 16, 1u, __ATOMIC_RELAXED, __HIP_MEMORY_SCOPE_AGENT); }
};
typedef EpiUpT<true> EpiUp;
struct EpiDown {
    static constexpr bool PERM = true;
    static constexpr bool SIGNALS = false;
    static constexpr bool CHAIN = false;
    static constexpr bool ACC_INIT = true;
    __device__ __forceinline__ void acc_bias(const Unit& u, int wc, int fq, f32x4 (&bi)[2][2]) const {
        const float* bd = b_dn + (size_t)u.e * D + u.pn * 256 + wc * 32 + 8 * fq;
#pragma unroll
        for (int bj = 0; bj < 2; ++bj)
#pragma unroll
            for (int n = 0; n < 2; ++n) bi[bj][n] = *(const f32x4*)(bd + bj * 128 + 4 * n) * W8_SCALE;
    }
    unsigned char* ydn; const float* b_dn; const float* roww; const LAS int* cbase;
    __device__ __forceinline__ void operator()(const f32x4 (&acc)[2][2][4][2], const Unit& u, int wr, int wc, int fr, int fq) const {
        const int rl = u.pm * 256 + wr * 64 + fr, row0 = cbase[u.e] + rl, col0 = u.pn * 256 + wc * 32 + 8 * fq;
        float wv[2][4];
#pragma unroll
        for (int ai = 0; ai < 2; ++ai)
#pragma unroll
            for (int m = 0; m < 4; ++m) wv[ai][m] = roww[(size_t)u.e * ECAP + rl + ai * 128 + m * 16];
        __builtin_amdgcn_sched_barrier(0);
#pragma unroll
        for (int ai = 0; ai < 2; ++ai)
#pragma unroll
            for (int m = 0; m < 4; ++m) { const float w = wv[ai][m] * YD_SCALE; unsigned char* p = ydn + (size_t)(row0 + ai * 128 + m * 16) * D + col0;
#pragma unroll
                for (int bj = 0; bj < 2; ++bj) {
                    const f32x4 v0 = acc[ai][bj][m][0] * (W8_INV * w), v1 = acc[ai][bj][m][1] * (W8_INV * w);
                    u32x2 o; o.x = pk4_fp8(v0[0], v0[1], v0[2], v0[3]); o.y = pk4_fp8(v1[0], v1[1], v1[2], v1[3]);
                    *(u32x2*)(p + bj * 128) = o; } }
    }
};

#define XB_TMO      128
#define XB_XCNT(j)  (256  + 64 * (j))
#define XB_XSUB(j)  (1280 + 64 * (j))
#define XB_XGEN(j)  (2304 + 64 * (j))
#define XB_TOP      3328
#define XB_TOPGEN   3392
#define XCD_BAR_WORDS 3456
#define XB_SPIN_CAP (1u << 18)
__device__ __forceinline__ unsigned xb_ld(unsigned* p)              { return __hip_atomic_load(p, __ATOMIC_RELAXED, __HIP_MEMORY_SCOPE_AGENT); }
__device__ __forceinline__ unsigned xb_add(unsigned* p, unsigned v) { return __hip_atomic_fetch_add(p, v, __ATOMIC_RELAXED, __HIP_MEMORY_SCOPE_AGENT); }
__device__ __forceinline__ unsigned xb_xcc_id() { return (unsigned)__builtin_amdgcn_s_getreg((3 << 11) | 20) & 0xFu; }
#define XB_SPIN(cond, bar) do { unsigned _sp = 0; while (cond) { __builtin_amdgcn_s_sleep(1); \
    if ((++_sp & 255u) == 0u) { if (xb_ld(&(bar)[XB_TMO])) break; if (_sp > XB_SPIN_CAP) { atomicAdd(&(bar)[XB_TMO], 1u); break; } } } } while (0)
struct XcdBarrier { unsigned* bar; unsigned x; volatile LAS unsigned* st; };
__device__ __forceinline__ XcdBarrier xcd_barrier_post(unsigned* bar, volatile LAS unsigned* st) {
    XcdBarrier b; b.bar = bar; b.x = xb_xcc_id(); b.st = st;
    if (threadIdx.x == 0) (void)xb_add(&bar[XB_XCNT(b.x)], 1u);
    return b;
}
__device__ __forceinline__ void xcd_barrier_complete(unsigned* bar, unsigned x, unsigned& nloc, unsigned& nx) {
    const unsigned G = gridDim.x * gridDim.y * gridDim.z;
    unsigned sum, cnt, mine, sp = 0u;
    for (;;) {
        sum = 0u; cnt = 0u; mine = 0u;
#pragma unroll
        for (unsigned j = 0; j < 16; ++j) { const unsigned c = xb_ld(&bar[XB_XCNT(j)]); sum += c; cnt += (c > 0u) ? 1u : 0u; mine = (j == x) ? c : mine; }
        if (sum == G) break;
        __builtin_amdgcn_s_sleep(1);
        if ((++sp & 255u) == 0u) { if (xb_ld(&bar[XB_TMO])) break; if (sp > XB_SPIN_CAP) { atomicAdd(&bar[XB_TMO], 1u); break; } }
    }
    nloc = mine > 0u ? mine : 1u; nx = cnt > 0u ? cnt : 1u;
}
__device__ __forceinline__ void xcd_barrier(const XcdBarrier& b) {
    asm volatile("s_waitcnt vmcnt(0)" ::: "memory");
    __syncthreads();
    if (threadIdx.x == 0) {
        unsigned* bar = b.bar;
        __builtin_amdgcn_s_waitcnt(0);
        unsigned nloc = b.st[0], nx = b.st[1];
        if (nloc == 0u) { xcd_barrier_complete(bar, b.x, nloc, nx); b.st[0] = nloc; b.st[1] = nx; }
        const unsigned old = xb_add(&bar[XB_XSUB(b.x)], 1u);
        const unsigned gen = old / nloc;
        if (old + 1u == (gen + 1u) * nloc) {
            __builtin_amdgcn_fence(__ATOMIC_RELEASE, "agent");
            asm volatile("s_waitcnt vmcnt(0)" ::: "memory");
            const unsigned og = xb_add(&bar[XB_TOP], 1u);
            const unsigned tg = og / nx;
            if (og + 1u == (tg + 1u) * nx) xb_add(&bar[XB_TOPGEN], 1u);
            else XB_SPIN(xb_ld(&bar[XB_TOPGEN]) == tg, bar);
            __builtin_amdgcn_fence(__ATOMIC_ACQUIRE, "agent");
            xb_add(&bar[XB_XGEN(b.x)], 1u);
            asm volatile("s_waitcnt vmcnt(0)" ::: "memory");
        } else {
            XB_SPIN(xb_ld(&bar[XB_XGEN(b.x)]) == gen, bar);
            __builtin_amdgcn_fence(__ATOMIC_ACQUIRE, "agent");
            asm volatile("s_waitcnt vmcnt(0)" ::: "memory");
        }
    }
    __syncthreads();
}

struct Args { const float* in[21]; float* out; unsigned char* ws; int ph_lo, ph_hi; };
enum { I_X = 0, I_C, I_WADA, I_BADA, I_GMIX, I_WIN, I_BIG, I_BFG, I_GMO, I_GQ, I_GK, I_WBA, I_WBB, I_WOUT, I_GFFN, I_WR, I_BR, I_WUP, I_BUP, I_WDN, I_BDN };

struct Frame {
    LAS unsigned char* lds; unsigned char* ws; unsigned* ctl;
    int tid, lane, wave, G, wg, vcu;
};

__device__ __forceinline__ void p0_mod_partial(Frame& F, const float* c, const float* w_ada, float* modp, int item) {
    const int cg = item % 48, ks = item / 48;
    LAS float* sS = (LAS float*)F.lds;
    LAS float* red = (LAS float*)(F.lds + 8192);
    {
        const int k = F.tid;
#pragma unroll
        for (int b = 0; b < 4; ++b) { const float v = c[b * D + ks * 512 + k]; sS[b * 512 + k] = v * sigmoidf_(v); }
    }
    __syncthreads();
    f32x4 a0 = {0.f, 0.f, 0.f, 0.f}, a1 = a0, a2 = a0, a3 = a0;
    const float* wp = w_ada + (size_t)(ks * 512 + F.wave) * (6 * D) + cg * 256 + 4 * F.lane;
#pragma unroll 8
    for (int i = 0; i < 64; ++i) {
        const f32x4 w = *(const f32x4*)(wp + (size_t)(8 * i) * (6 * D));
        const int kk = F.wave + 8 * i;
        a0 += w * sS[kk]; a1 += w * sS[512 + kk]; a2 += w * sS[1024 + kk]; a3 += w * sS[1536 + kk];
    }
    *(LAS f32x4*)(red + (F.wave * 4 + 0) * 256 + 4 * F.lane) = a0;
    *(LAS f32x4*)(red + (F.wave * 4 + 1) * 256 + 4 * F.lane) = a1;
    *(LAS f32x4*)(red + (F.wave * 4 + 2) * 256 + 4 * F.lane) = a2;
    *(LAS f32x4*)(red + (F.wave * 4 + 3) * 256 + 4 * F.lane) = a3;
    __syncthreads();
#pragma unroll
    for (int r = 0; r < 2; ++r) {
        const int o = F.tid + 512 * r, b = o >> 8, col = o & 255;
        float s = 0.f;
#pragma unroll
        for (int w = 0; w < 8; ++w) s += red[(w * 4 + b) * 256 + col];
        modp[((size_t)ks * 4 + b) * (6 * D) + cg * 256 + col] = s;
    }
    __syncthreads();
}
__device__ __forceinline__ void p0_frag_item(const float* W, int ldw, int col0, bf16_t* dst, int p) {
    const int s = p >> 6, lane = p & 63;
    const float* src = W + (size_t)(32 * s + 8 * (lane >> 4)) * ldw + col0 + (lane & 15);
    u32x4 o; o.x = pk2(src[0], src[ldw]); o.y = pk2(src[2 * (size_t)ldw], src[3 * (size_t)ldw]); o.z = pk2(src[4 * (size_t)ldw], src[5 * (size_t)ldw]); o.w = pk2(src[6 * (size_t)ldw], src[7 * (size_t)ldw]);
    *(u32x4*)(dst + (size_t)p * 8) = o;
}
constexpr int CV_RS = 528, CV_BUF = 128 * CV_RS;
struct CvtItem { const float* src; bf16_t* dst; int K, ldw; };
__device__ __forceinline__ CvtItem cvt_decode(const Args& a, unsigned char* ws, int it) {
    constexpr int N_IN = 0, N_A = 4 * 16, N_O = 8 * 16, N_UP = 8 * 32, N_DN = 8 * 16;
    CvtItem c; int r = it;
    if (r < N_IN) { const int kb = r / 48, nb = r % 48, n0 = nb * 128; c.K = D; c.ldw = DIN; c.src = a.in[I_WIN] + (size_t)(kb * 256) * DIN + n0 + (n0 >= 3072 ? 16 : 0); c.dst = (bf16_t*)(ws + WS_WIN) + (size_t)n0 * D + kb * 256; return c; } r -= N_IN;
    if (r < N_A) { const int kb = r / 16, nb = r % 16; c.K = 1024; c.ldw = D; c.src = a.in[I_WBA] + (size_t)(kb * 256) * D + nb * 128; c.dst = (bf16_t*)(ws + WS_WA) + (size_t)(nb * 128) * 1024 + kb * 256; return c; } r -= N_A;
    if (r < N_A) { const int kb = r / 16, nb = r % 16; c.K = 1024; c.ldw = D; c.src = a.in[I_WBB] + (size_t)(kb * 256) * D + nb * 128; c.dst = (bf16_t*)(ws + WS_WB) + (size_t)(nb * 128) * 1024 + kb * 256; return c; } r -= N_A;
    if (r < N_O) { const int kb = r / 16, nb = r % 16; c.K = D; c.ldw = D; c.src = a.in[I_WOUT] + (size_t)(kb * 256) * D + nb * 128; c.dst = (bf16_t*)(ws + WS_WOUT) + (size_t)(nb * 128) * D + kb * 256; return c; } r -= N_O;
    const int e = r / (N_UP + N_DN); r -= e * (N_UP + N_DN);
    if (r < N_UP) { const int kb = r / 32, nb = r % 32, t = nb >> 1; c.K = D; c.ldw = 2 * D;
        c.src = a.in[I_WUP] + (size_t)e * D * (2 * D) + (size_t)(kb * 256) * (2 * D) + ((nb & 1) ? 2048 + 128 * t : 128 * t);
        c.dst = (bf16_t*)(ws + WS_WUP) + (size_t)e * (2 * D) * D + (size_t)(nb * 128) * D + kb * 256; return c; }
    r -= N_UP; { const int kb = r / 16, nb = r % 16; c.K = D; c.ldw = D; c.src = a.in[I_WDN] + (size_t)e * D * D + (size_t)(kb * 256) * D + nb * 128; c.dst = (bf16_t*)(ws + WS_WDN) + (size_t)e * D * D + (size_t)(nb * 128) * D + kb * 256; }
    return c;
}
constexpr int CVT_DENSE_ITEMS = 2 * 4 * 16 + 8 * 16;
__device__ __forceinline__ CvtItem cvt_decode_moe(const Args& a, unsigned char* ws, int e, int which, int j, int kb) {
    CvtItem c; c.K = D;
    if (which == 0) { const int t = j >> 1; c.ldw = 2 * D;
        c.src = a.in[I_WUP] + (size_t)e * D * (2 * D) + (size_t)(kb * 256) * (2 * D) + ((j & 1) ? 2048 + 128 * t : 128 * t);
        c.dst = (bf16_t*)(ws + WS_WUP) + (size_t)e * (2 * D) * D + (size_t)(j * 128) * D + kb * 256; }
    else { c.ldw = D; c.src = a.in[I_WDN] + (size_t)e * D * D + (size_t)(kb * 256) * D + j * 128; c.dst = (bf16_t*)(ws + WS_WDN) + (size_t)e * D * D + (size_t)(j * 128) * D + kb * 256; }
    return c;
}
__device__ __forceinline__ void cvt_load(const CvtItem& c, f32x4 (&v)[16], int wave, int lane) {
    const float* p = c.src + (size_t)(32 * wave + 16 * (lane >> 5)) * c.ldw + 4 * (lane & 31);
#pragma unroll
    for (int i = 0; i < 16; ++i) v[i] = __builtin_nontemporal_load((const f32x4*)(p + (size_t)i * c.ldw));
}
__device__ __forceinline__ void cvt_to_lds(const f32x4 (&v)[16], LAS unsigned char* buf, int wave, int lane) {
    const int n4 = lane & 31, hh = lane >> 5;
#pragma unroll
    for (int g = 0; g < 2; ++g)
#pragma unroll
        for (int j = 0; j < 4; ++j) {
            u32x4 o; o.x = pk2(v[8 * g + 0][j], v[8 * g + 1][j]); o.y = pk2(v[8 * g + 2][j], v[8 * g + 3][j]); o.z = pk2(v[8 * g + 4][j], v[8 * g + 5][j]); o.w = pk2(v[8 * g + 6][j], v[8 * g + 7][j]);
            *(LAS u32x4*)(buf + (4 * n4 + j) * CV_RS + (4 * wave + 2 * hh + g) * 16) = o; }
}
template <bool SC1>
__device__ __forceinline__ void cvt_store(const CvtItem& c, const LAS unsigned char* buf, int tid) {
#pragma unroll
    for (int i = 0; i < 8; ++i) { const int id = tid + 512 * i, row = id >> 5, ch = id & 31;
        const u32x4 v = *(const LAS u32x4*)(buf + row * CV_RS + ch * 16);
        if (SC1) store16_sc1(c.dst + (size_t)row * c.K + ch * 8, v); else *(u32x4*)(c.dst + (size_t)row * c.K + ch * 8) = v; }
}
template <bool SC1, class Dec>
__device__ __forceinline__ void cvt_stream(Frame& F, const Dec& dec, int first, int n, int step) {
    int it = first;
    if (it >= n) return;
    int tid = threadIdx.x; asm volatile("" : "+v"(tid));
    const int wave = __builtin_amdgcn_readfirstlane(tid >> 6), lane = tid & 63;
    f32x4 v[16];
    CvtItem cur = dec(it);
    cvt_load(cur, v, wave, lane);
    cvt_to_lds(v, F.lds, wave, lane);
    __syncthreads();
#pragma unroll 1
    for (int i = 0;; ++i) {
        const int nx = it + step; const bool has_next = nx < n;
        CvtItem nxt = cur;
        if (has_next) { nxt = dec(nx); cvt_load(nxt, v, wave, lane); }
        cvt_store<SC1>(cur, F.lds + (i & 1) * CV_BUF, tid);
        if (has_next) cvt_to_lds(v, F.lds + ((i + 1) & 1) * CV_BUF, wave, lane);
        __syncthreads();
        if (!has_next) break;
        cur = nxt; it = nx;
    }
}
constexpr int C8_RS = 272, C8_BUF = 128 * C8_RS;
struct Cvt8Item { const float* src; unsigned char* dst; int ldw; };
__device__ __forceinline__ Cvt8Item cvt8_decode(const Args& a, unsigned char* ws, int e, int which, int j, int kb) {
    Cvt8Item c;
    if (which == 0) { const int t = j >> 1; c.ldw = 2 * D;
        c.src = a.in[I_WUP] + (size_t)e * D * (2 * D) + (size_t)(kb * 256) * (2 * D) + ((j & 1) ? 2048 + 128 * t : 128 * t);
        c.dst = ws + WS_WUP + ((size_t)e * (2 * D) + (size_t)(j * 128)) * D + kb * 256; }
    else { c.ldw = D; c.src = a.in[I_WDN] + (size_t)e * D * D + (size_t)(kb * 256) * D + j * 128; c.dst = ws + WS_WDN + ((size_t)e * D + (size_t)(j * 128)) * D + kb * 256; }
    return c;
}
__device__ __forceinline__ void cvt8_load(const Cvt8Item& c, f32x4 (&v)[16], int wave, int lane) {
    const float* p = c.src + (size_t)(32 * wave + 16 * (lane >> 5)) * c.ldw + 4 * (lane & 31);
#pragma unroll
    for (int i = 0; i < 16; ++i) v[i] = __builtin_nontemporal_load((const f32x4*)(p + (size_t)i * c.ldw));
}
__device__ __forceinline__ void cvt8_to_lds(const f32x4 (&v)[16], LAS unsigned char* buf, int wave, int lane) {
    const int n4 = lane & 31, hh = lane >> 5;
#pragma unroll
    for (int j = 0; j < 4; ++j) {
        u32x4 o;
        o.x = pk4_fp8(v[0][j] * W8_SCALE, v[1][j] * W8_SCALE, v[2][j] * W8_SCALE, v[3][j] * W8_SCALE);
        o.y = pk4_fp8(v[4][j] * W8_SCALE, v[5][j] * W8_SCALE, v[6][j] * W8_SCALE, v[7][j] * W8_SCALE);
        o.z = pk4_fp8(v[8][j] * W8_SCALE, v[9][j] * W8_SCALE, v[10][j] * W8_SCALE, v[11][j] * W8_SCALE);
        o.w = pk4_fp8(v[12][j] * W8_SCALE, v[13][j] * W8_SCALE, v[14][j] * W8_SCALE, v[15][j] * W8_SCALE);
        *(LAS u32x4*)(buf + (4 * n4 + j) * C8_RS + (2 * wave + hh) * 16) = o; }
}
__device__ __forceinline__ void cvt8_store(const Cvt8Item& c, const LAS unsigned char* buf, int tid) {
#pragma unroll
    for (int i = 0; i < 4; ++i) { const int id = tid + 512 * i, row = id >> 4, ch = id & 15;
        store16_sc1(c.dst + (size_t)row * D + ch * 16, *(const LAS u32x4*)(buf + row * C8_RS + ch * 16)); }
}
__device__ __forceinline__ void cvt8_store_keep(const Cvt8Item& c, const LAS unsigned char* buf, int tid) {
#pragma unroll
    for (int i = 0; i < 4; ++i) { const int id = tid + 512 * i, row = id >> 4, ch = id & 15;
        *(u32x4*)(c.dst + (size_t)row * D + ch * 16) = *(const LAS u32x4*)(buf + row * C8_RS + ch * 16); }
}
template <bool SC1>
__device__ __forceinline__ void cvt8_store_t(const Cvt8Item& c, const LAS unsigned char* buf, int tid) {
#pragma unroll
    for (int i = 0; i < 4; ++i) { const int id = tid + 512 * i, row = id >> 4, ch = id & 15;
        const u32x4 v = *(const LAS u32x4*)(buf + row * C8_RS + ch * 16);
        if (SC1) store16_sc1(c.dst + (size_t)row * D + ch * 16, v); else __builtin_nontemporal_store(v, (u32x4*)(c.dst + (size_t)row * D + ch * 16)); }
}
__device__ __forceinline__ Cvt8Item cvt8_decode_lin(const Args& a, unsigned char* ws, int idx) {
    const int e = idx / 384; int r = idx - e * 384; int which = 0;
    if (r >= 256) { r -= 256; which = 1; }
    return cvt8_decode(a, ws, e, which, r >> 3, r & 7);
}
__device__ __forceinline__ void cvt8_all(Frame& F, const Args& a, unsigned char* ws) {
    constexpr int N = NE * 384;
    int it = F.vcu;
    if (it >= N) return;
    int tid = threadIdx.x; asm volatile("" : "+v"(tid));
    const int wave = __builtin_amdgcn_readfirstlane(tid >> 6), lane = tid & 63;
    f32x4 v[16];
    Cvt8Item cur = cvt8_decode_lin(a, ws, it);
    cvt8_load(cur, v, wave, lane);
    cvt8_to_lds(v, F.lds, wave, lane);
    __syncthreads();
#pragma unroll 1
    for (int i = 0;; ++i) {
        const int nx = it + F.G; const bool has_next = nx < N;
        Cvt8Item nxt = cur;
        if (has_next) { nxt = cvt8_decode_lin(a, ws, nx); cvt8_load(nxt, v, wave, lane); }
        cvt8_store_t<false>(cur, F.lds + (i & 1) * C8_BUF, tid);
        if (has_next) cvt8_to_lds(v, F.lds + ((i + 1) & 1) * C8_BUF, wave, lane);
        __syncthreads();
        if (!has_next) break;
        cur = nxt; it = nx;
    }
}
__device__ __forceinline__ void cvt8_item(Frame& F, const Args& a, int idx);
template <bool SC1>
__device__ __forceinline__ void cvt8_stream(Frame& F, const Args& a, unsigned char* ws, int e, int which, int j) {
    int tid = threadIdx.x; asm volatile("" : "+v"(tid));
    const int wave = __builtin_amdgcn_readfirstlane(tid >> 6), lane = tid & 63;
    f32x4 va[16], vb[16];
    Cvt8Item c0 = cvt8_decode(a, ws, e, which, j, 0), c1 = cvt8_decode(a, ws, e, which, j, 1);
    cvt8_load(c0, va, wave, lane);
    cvt8_load(c1, vb, wave, lane);
    __builtin_amdgcn_sched_barrier(0);
    cvt8_to_lds(va, F.lds, wave, lane);
    __syncthreads();
#pragma unroll
    for (int k = 0; k < 8; k += 2) {
        Cvt8Item c2 = c0, c3 = c1;
        __builtin_amdgcn_sched_barrier(0);
        if (k + 2 < 8) { c2 = cvt8_decode(a, ws, e, which, j, k + 2); cvt8_load(c2, va, wave, lane); }
        __builtin_amdgcn_sched_barrier(0);
        cvt8_store_t<SC1>(c0, F.lds, tid);
        __builtin_amdgcn_sched_barrier(0);
        cvt8_to_lds(vb, F.lds + C8_BUF, wave, lane);
        __syncthreads();
        __builtin_amdgcn_sched_barrier(0);
        if (k + 3 < 8) { c3 = cvt8_decode(a, ws, e, which, j, k + 3); cvt8_load(c3, vb, wave, lane); }
        __builtin_amdgcn_sched_barrier(0);
        cvt8_store_t<SC1>(c1, F.lds + C8_BUF, tid);
        __builtin_amdgcn_sched_barrier(0);
        if (k + 2 < 8) cvt8_to_lds(va, F.lds, wave, lane);
        __syncthreads();
        c0 = c2; c1 = c3;
    }
}
__device__ __forceinline__ void cvt8_win_sub(Frame& F, const Args& a, int q) {
    int tid = threadIdx.x; asm volatile("" : "+v"(tid));
    const int wave = __builtin_amdgcn_readfirstlane(tid >> 6), lane = tid & 63, j = q >> 3, kb = q & 7;
    Cvt8Item c; c.ldw = DIN; c.src = a.in[I_WIN] + (size_t)(kb * 256) * DIN + j * 128 + (j >= 24 ? 16 : 0); c.dst = F.ws + WS_WIN8 + (size_t)(j * 128) * D + kb * 256;
    f32x4 v[16];
    __syncthreads();
    cvt8_load(c, v, wave, lane);
    cvt8_to_lds(v, F.lds, wave, lane);
    __syncthreads();
    cvt8_store_keep(c, F.lds, tid);
    __syncthreads();
}
__device__ __forceinline__ void cvt8_wout_sub(Frame& F, const Args& a, int q) {
    int tid = threadIdx.x; asm volatile("" : "+v"(tid));
    const int wave = __builtin_amdgcn_readfirstlane(tid >> 6), lane = tid & 63, j = q >> 3, kb = q & 7;
    Cvt8Item c; c.ldw = D; c.src = a.in[I_WOUT] + (size_t)(kb * 256) * D + j * 128; c.dst = F.ws + WS_WOUT8 + (size_t)(j * 128) * D + kb * 256;
    f32x4 v[16];
    __syncthreads();
    cvt8_load(c, v, wave, lane);
    cvt8_to_lds(v, F.lds, wave, lane);
    __syncthreads();
    cvt8_store_keep(c, F.lds, tid);
    __syncthreads();
}
__device__ __forceinline__ void cvt8_wbr_sub(Frame& F, const Args& a, int q) {
    int tid = threadIdx.x; asm volatile("" : "+v"(tid));
    const int wave = __builtin_amdgcn_readfirstlane(tid >> 6), lane = tid & 63, which = q >> 6, j = (q >> 2) & 15, kb = q & 3;
    Cvt8Item c; c.ldw = D; c.src = (which ? a.in[I_WBB] : a.in[I_WBA]) + (size_t)(kb * 256) * D + j * 128; c.dst = F.ws + (which ? WS_WB : WS_WA) + (size_t)(j * 128) * 1024 + kb * 256;
    f32x4 v[16];
    __syncthreads();
    cvt8_load(c, v, wave, lane);
    cvt8_to_lds(v, F.lds, wave, lane);
    __syncthreads();
#pragma unroll
    for (int i = 0; i < 4; ++i) { const int id = tid + 512 * i, row = id >> 4, ch = id & 15;
        *(u32x4*)(c.dst + (size_t)row * 1024 + ch * 16) = *(const LAS u32x4*)(F.lds + row * C8_RS + ch * 16); }
    __syncthreads();
}
__device__ __forceinline__ void cvt8_item(Frame& F, const Args& a, int idx) {
    if (idx < 1024) cvt8_stream<false>(F, a, F.ws, idx >> 5, 0, idx & 31);
    else cvt8_stream<false>(F, a, F.ws, (idx - 1024) >> 4, 1, (idx - 1024) & 15);
}
__device__ __forceinline__ void cvt8_item_signal(Frame& F, const Args& a, int idx, unsigned* upd) {
    const int e = (idx - 1024) >> 4;
    cvt8_stream<true>(F, a, F.ws, e, 1, (idx - 1024) & 15);
    asm volatile("s_waitcnt vmcnt(0)" ::: "memory");
    __syncthreads();
    if (F.tid < 32) __hip_atomic_fetch_add(upd + (e * 32 + F.tid) * 16, 1u, __ATOMIC_RELAXED, __HIP_MEMORY_SCOPE_AGENT);
}
struct DenseDec { const Args* a; unsigned char* ws; __device__ __forceinline__ CvtItem operator()(int it) const { return cvt_decode(*a, ws, it); } };
struct MoeDec { const Args* a; unsigned char* ws; int e, which, j; __device__ __forceinline__ CvtItem operator()(int kb) const { return cvt_decode_moe(*a, ws, e, which, j, kb); } };
__device__ __forceinline__ void p0_prologue(Frame& F, const Args& a) {
    unsigned char* ws = F.ws;
    for (int it = F.wg; it < 192; it += F.G) p0_mod_partial(F, a.in[I_C], a.in[I_WADA], (float*)(ws + WS_MODP), it);
    for (int p = (F.G - 1 - F.wg) * 512 + F.tid; p < 4096 + 8192; p += F.G * 512) {
        if (p < 4096) p0_frag_item(a.in[I_WIN], DIN, GATE_COL, (bf16_t*)(ws + WS_WGF), p);
        else { const int q = p - 4096, ct = q >> 12; p0_frag_item(a.in[I_WR], NE, 16 * ct, (bf16_t*)(ws + WS_WRF) + (size_t)ct * 4096 * 8, q & 4095); }
    }
    __syncthreads();
    for (int q = F.vcu; q < 640; q += F.G) cvt8_win_sub(F, a, q);
    for (int q = F.G - 1 - F.vcu; q < 256; q += F.G) { if (q < 128) cvt8_wout_sub(F, a, q); else cvt8_wbr_sub(F, a, q - 128); }
}

constexpr int HL_STRIDE = 4112;
constexpr int HL_BYTES = 32 * HL_STRIDE;
constexpr int PART_OFF = 132096;
constexpr int LOGIT_OFF = PART_OFF + 8192;
constexpr int DST_OFF = LOGIT_OFF + 4096;

__device__ __forceinline__ f32x4 mod4(const float* modp, const float* b_ada, int b, int idx) {
    f32x4 s = *(const f32x4*)(b_ada + idx);
#pragma unroll
    for (int ks = 0; ks < 4; ++ks) s += *(const f32x4*)(modp + ((size_t)ks * 4 + b) * (6 * D) + idx);
    return s;
}
template <bool FROM_PARTIALS>
__device__ __forceinline__ void norm_rows_32(Frame& F, const float* xin, const float* gvec, const float* modsrc, const float* b_ada, int chunk_sh, int rb, bf16_t* gout, unsigned char* gout8 = nullptr) {
    const int b = rb >> 6; int lane = F.lane; asm volatile("" : "+v"(lane));
    f32x4 xa[8], xb[8];
    const float* xr = xin + ((size_t)rb * 32 + 4 * F.wave) * D + 4 * lane;
#pragma unroll
    for (int j = 0; j < 8; ++j) xa[j] = *(const f32x4*)(xr + 256 * j);
#pragma unroll
    for (int j = 0; j < 8; ++j) xb[j] = *(const f32x4*)(xr + D + 256 * j);
    f32x4 xc[8], xd[8];
    if (!FROM_PARTIALS) {
#pragma unroll
        for (int j = 0; j < 8; ++j) xc[j] = *(const f32x4*)(xr + 2 * D + 256 * j);
#pragma unroll
        for (int j = 0; j < 8; ++j) xd[j] = *(const f32x4*)(xr + 3 * D + 256 * j);
    }
    f32x4 gsc[8], shv[8];
#pragma unroll
    for (int j = 0; j < 8; ++j) {
        const int col = 4 * (lane + 64 * j);
        f32x4 sh, sc;
        if (FROM_PARTIALS) { sh = mod4(modsrc, b_ada, b, chunk_sh * D + col); sc = mod4(modsrc, b_ada, b, (chunk_sh + 1) * D + col); }
        else { sh = *(const f32x4*)(modsrc + (size_t)b * (6 * D) + chunk_sh * D + col); sc = *(const f32x4*)(modsrc + (size_t)b * (6 * D) + (chunk_sh + 1) * D + col); }
        const f32x4 g = *(const f32x4*)(gvec + col);
        gsc[j] = g * (sc + 1.0f); shv[j] = sh;
        if (j & 1) __builtin_amdgcn_sched_barrier(0);
    }
#pragma unroll
    for (int i = 0; i < 4; ++i) {
        const int r = 4 * F.wave + i; const size_t row = (size_t)rb * 32 + r;
        f32x4 xv[8]; float ss = 0.f;
#pragma unroll
        for (int j = 0; j < 8; ++j) { xv[j] = FROM_PARTIALS ? ((i & 1) ? xb[j] : xa[j]) : (i == 0 ? xa[j] : i == 1 ? xb[j] : i == 2 ? xc[j] : xd[j]); ss += (xv[j][0] * xv[j][0] + xv[j][1] * xv[j][1]) + (xv[j][2] * xv[j][2] + xv[j][3] * xv[j][3]); }
        if (FROM_PARTIALS && i < 2) {
#pragma unroll
            for (int j = 0; j < 8; ++j) { const f32x4 nx = *(const f32x4*)(xr + (size_t)(i + 2) * D + 256 * j); if (i & 1) xb[j] = nx; else xa[j] = nx; }
        }
        __builtin_amdgcn_sched_barrier(0);
        const float rinv = rsqrtf(wave_sum(ss) * (1.0f / D) + EPS);
        int ls = lane; asm volatile("" : "+v"(ls));
        const size_t so = row * D + 4 * (size_t)ls;
#pragma unroll
        for (int j = 0; j < 8; ++j) {
            const f32x4 hv = xv[j] * rinv * gsc[j] + shv[j];
            u32x2 p; p.x = pk2(hv[0], hv[1]); p.y = pk2(hv[2], hv[3]);
            *(LAS u32x2*)(F.lds + r * HL_STRIDE + 8 * ls + 512 * j) = p;
            if (gout) *(u32x2*)(gout + so + 256 * j) = p;
            if (gout8) *(unsigned*)(gout8 + so + 256 * j) = pk4_fp8(hv[0], hv[1], hv[2], hv[3]);
        }
        __builtin_amdgcn_sched_barrier(0);
    }
}
__device__ __forceinline__ void norm_rows_32_b(Frame& F, const bf16_t* xin, const float* gvec, const float* modsrc, int chunk_sh, int rb) {
    const int b = rb >> 6; int lane = F.lane; asm volatile("" : "+v"(lane));
    u32x2 xr_[4][8];
    const bf16_t* xr = xin + ((size_t)rb * 32 + 4 * F.wave) * D + 4 * lane;
#pragma unroll
    for (int i = 0; i < 4; ++i)
#pragma unroll
        for (int j = 0; j < 8; ++j) xr_[i][j] = *(const u32x2*)(xr + (size_t)i * D + 256 * j);
    f32x4 gsc[8], shv[8];
#pragma unroll
    for (int j = 0; j < 8; ++j) {
        const int col = 4 * (lane + 64 * j);
        const f32x4 sh = *(const f32x4*)(modsrc + (size_t)b * (6 * D) + chunk_sh * D + col), sc = *(const f32x4*)(modsrc + (size_t)b * (6 * D) + (chunk_sh + 1) * D + col);
        const f32x4 g = *(const f32x4*)(gvec + col);
        gsc[j] = g * (sc + 1.0f); shv[j] = sh;
    }
#pragma unroll
    for (int i = 0; i < 4; ++i) {
        const int r = 4 * F.wave + i;
        f32x4 xv[8]; float ss = 0.f;
#pragma unroll
        for (int j = 0; j < 8; ++j) { const u32x2 q = xr_[i][j]; xv[j] = (f32x4){bf_lo(q.x), bf_hi(q.x), bf_lo(q.y), bf_hi(q.y)}; ss += (xv[j][0] * xv[j][0] + xv[j][1] * xv[j][1]) + (xv[j][2] * xv[j][2] + xv[j][3] * xv[j][3]); }
        const float rinv = rsqrtf(wave_sum(ss) * (1.0f / D) + EPS);
#pragma unroll
        for (int j = 0; j < 8; ++j) {
            const f32x4 hv = xv[j] * rinv * gsc[j] + shv[j];
            u32x2 p; p.x = pk2(hv[0], hv[1]); p.y = pk2(hv[2], hv[3]);
            *(LAS u32x2*)(F.lds + r * HL_STRIDE + 8 * lane + 512 * j) = p;
        }
    }
}
__device__ __forceinline__ void p1_rows(Frame& F, const Args& a) {
    unsigned char* ws = F.ws;
    const float* modp = (const float*)(ws + WS_MODP);
    { float* modf = (float*)(ws + WS_MODF);
      for (int i = F.wg * 512 + F.tid; i < NB * 6 * D; i += F.G * 512) { const int b = i / (6 * D), idx = i % (6 * D); float s = a.in[I_BADA][idx];
#pragma unroll
          for (int ks = 0; ks < 4; ++ks) s += modp[((size_t)ks * 4 + b) * (6 * D) + idx];
          modf[i] = s; } }
    if (F.wg == 0 && F.wave == 0) {
        float mq = fmaxf(fabsf(a.in[I_GQ][2 * F.lane]), fabsf(a.in[I_GQ][2 * F.lane + 1])), mk = fmaxf(fabsf(a.in[I_GK][2 * F.lane]), fabsf(a.in[I_GK][2 * F.lane + 1]));
#pragma unroll
        for (int o = 1; o < 64; o <<= 1) { mq = fmaxf(mq, __shfl_xor(mq, o)); mk = fmaxf(mk, __shfl_xor(mk, o)); }
        if (F.lane == 0) ((float*)F.ctl)[CW_MISC] = 16.3223f * 1.01f * mq * mk;
    }
    const bf16_t* wgf = (const bf16_t*)(ws + WS_WGF);
    float* gates = (float*)(ws + WS_GATES);
    LAS float* part = (LAS float*)(F.lds + PART_OFF);
    const int lane = F.lane, l15 = lane & 15, g4 = lane >> 4;
    for (int rb = F.wg; rb < T / 32; rb += F.G) {
        norm_rows_32<true>(F, a.in[I_X], a.in[I_GMIX], modp, a.in[I_BADA], 0, rb, nullptr, ws + WS_HBUF8);
        { const int rg = F.wave & 1, kq = F.wave >> 1; f32x4 acc = {0.f, 0.f, 0.f, 0.f};
          bf16x8 bvv[16];
          __builtin_amdgcn_sched_barrier(0);
          const bf16_t* wq = wgf + ((size_t)(16 * kq) * 64 + lane) * 8; asm volatile("" : "+v"(wq));
#pragma unroll
          for (int s = 0; s < 16; ++s) bvv[s] = *(const bf16x8*)(wq + (size_t)s * 512);
          __syncthreads();
#pragma unroll
          for (int s = 0; s < 16; ++s) { const int ks = 16 * kq + s;
              const bf16x8 av = *(const LAS bf16x8*)(F.lds + (16 * rg + l15) * HL_STRIDE + (32 * ks + 8 * g4) * 2);
              acc = __builtin_amdgcn_mfma_f32_16x16x32_bf16(av, bvv[s], acc, 0, 0, 0); }
#pragma unroll
          for (int r = 0; r < 4; ++r) part[(kq * 2 + rg) * 256 + (4 * g4 + r) * 16 + l15] = acc[r]; }
        __syncthreads();
        { const int rg = F.tid >> 8, rc = F.tid & 255; float s = 0.f;
#pragma unroll
          for (int kq = 0; kq < 4; ++kq) s += part[(kq * 2 + rg) * 256 + rc];
          gates[((size_t)rb * 32 + 16 * rg + (rc >> 4)) * 16 + (rc & 15)] = s; }
        __syncthreads();
    }
}

__device__ __forceinline__ void p3_qknorm(Frame& F, const Args& a) {
    bf16_t* z = (bf16_t*)(F.ws + WS_Z); float* kmean = (float*)(F.ws + WS_KMEAN);
    LAS float* cs = (LAS float*)F.lds;
    const int lane = F.lane;
    for (int u = F.wg; u < 512; u += F.G) {
        const int which = u & 1, h = (u >> 1) & 7, blk = (u >> 4) & 7, b = u >> 7;
        const float* gv = which ? a.in[I_GK] : a.in[I_GQ];
        const float g0 = gv[2 * lane], g1 = gv[2 * lane + 1];
        bf16_t* base = z + ((size_t)b * SEQ + blk * 256 + 32 * F.wave) * ZP + (which ? ZKB : ZQB) + h * 128 + 2 * lane;
        unsigned v[32];
#pragma unroll
        for (int i = 0; i < 32; ++i) v[i] = *(const unsigned*)(base + (size_t)i * ZP);
        float c0 = 0.f, c1 = 0.f;
#pragma unroll
        for (int i = 0; i < 32; ++i) {
            const float f0 = bf_lo(v[i]), f1 = bf_hi(v[i]);
            const float rinv = rsqrtf(wave_sum(f0 * f0 + f1 * f1) * (1.0f / 128.0f) + EPS);
            const float y0 = f0 * rinv * g0, y1 = f1 * rinv * g1;
            *(unsigned*)(base + (size_t)i * ZP) = pk2(y0, y1);
            c0 += y0; c1 += y1;
        }
        if (which) {
            cs[F.wave * 128 + 2 * lane] = c0; cs[F.wave * 128 + 2 * lane + 1] = c1;
            __syncthreads();
            if (F.tid < 128) { float s = 0.f;
#pragma unroll
                for (int w = 0; w < 8; ++w) s += cs[w * 128 + F.tid];
                kmean[(((size_t)b * 8 + h) * 8 + blk) * 128 + F.tid] = s * (1.0f / 256.0f); }
            __syncthreads();
        }
    }
}

__device__ __forceinline__ s16x4 tr16(LAS unsigned char* p) { return __builtin_amdgcn_ds_read_tr16_b64_v4i16((LAS s16x4*)p); }
__device__ __forceinline__ bf16x8 cat8(s16x4 a, s16x4 b) { return (bf16x8){a[0], a[1], a[2], a[3], b[0], b[1], b[2], b[3]}; }
#define MFMA16(a, b, c) __builtin_amdgcn_mfma_f32_16x16x32_bf16((a), (b), (c), 0, 0, 0)

struct ChunkGates { float li, bcs, u, pmx, g, umax; };
__device__ __forceinline__ ChunkGates chunk_gates(float gi_raw, float gf_raw, float bi, float bfg, int lane) {
    ChunkGates G;
    const float ti = __expf((gi_raw + bi) * (2.0f / 15.0f)), tf = __expf((gf_raw + bfg) * (2.0f / 15.0f));
    G.li = 15.0f - 30.0f * __builtin_amdgcn_rcpf(ti + 1.0f);
    const float xf = 15.0f - 30.0f * __builtin_amdgcn_rcpf(tf + 1.0f);
    const float lf = fminf(xf, 0.f) - __logf(1.0f + __expf(-fabsf(xf)));
    float bcs = lf;
#pragma unroll
    for (int o = 1; o < 64; o <<= 1) { const float t = __shfl_up(bcs, o); if (lane >= o) bcs += t; }
    G.bcs = bcs; G.g = __shfl(bcs, 63); G.u = G.li - bcs;
    float pmx = G.u;
#pragma unroll
    for (int o = 1; o < 64; o <<= 1) { const float t = __shfl_up(pmx, o); if (lane >= o) pmx = fmaxf(pmx, t); }
    G.pmx = pmx; G.umax = __shfl(pmx, 63);
    return G;
}
constexpr int ML_QS = 0, ML_KS = 9216, ML_KW = 18432, ML_VS = 27648, ML_SB = 45056, ML_CB = 54272, ML_HO = 72704, ML_FLO = 90112, ML_RS = 144, ML_VR = 272;

struct PassAIn { u32x4 kv, v0, v1; float gi, gf; };
__device__ __forceinline__ PassAIn mlstm_passA_load(Frame& F, int u) {
    const bf16_t* z = (const bf16_t*)(F.ws + WS_Z); const float* gates = (const float*)(F.ws + WS_GATES);
    const int c = u & 31, h = (u >> 5) & 7, b = u >> 8;
    const size_t tok0 = (size_t)b * SEQ + c * 64;
    const int lr = F.tid >> 3, ls = F.tid & 7;
    const bf16_t* zr = z + (tok0 + lr) * ZP;
    PassAIn I;
    I.kv = *(const u32x4*)(zr + ZKA + h * 64 + ls * 8);
    I.v0 = *(const u32x4*)(zr + ZVA + h * 128 + ls * 8); I.v1 = *(const u32x4*)(zr + ZVA + h * 128 + 64 + ls * 8);
    I.gi = gates[(tok0 + F.lane) * 16 + h]; I.gf = gates[(tok0 + F.lane) * 16 + 8 + h];
    return I;
}
__device__ __forceinline__ void mlstm_passA(Frame& F, const Args& a, int u, const PassAIn& I) {
    LAS unsigned char* L = F.lds; LAS float* fl = (LAS float*)(L + ML_FLO);
    float* cloc = (float*)(F.ws + WS_CLOC) + (size_t)u * 8192; float* nloc = (float*)(F.ws + WS_NLOC) + (size_t)u * 64; float* msc = (float*)(F.ws + WS_MSC) + (size_t)u * 4;
    const int tid = F.tid, lane = F.lane, w = F.wave, l15 = lane & 15, g4 = lane >> 4;
    const int h = (u >> 5) & 7;
    const int lr = tid >> 3, ls = tid & 7;
    const u32x4 kv = I.kv, v0 = I.v0, v1 = I.v1;
    __syncthreads();
    if (w == 0) {
        const ChunkGates G = chunk_gates(I.gi, I.gf, a.in[I_BIG][h], a.in[I_BFG][h], lane);
        fl[256 + lane] = __expf(G.u - G.umax);
        if (lane == 0) { msc[0] = G.g + G.umax; msc[1] = G.g; }
    }
    *(LAS u32x4*)(L + ML_VS + lr * ML_VR + ls * 16) = v0; *(LAS u32x4*)(L + ML_VS + lr * ML_VR + 128 + ls * 16) = v1;
    __syncthreads();
    { const float wr_ = fl[256 + lr];
      u32x4 o; o.x = pk2(bf_lo(kv.x) * wr_, bf_hi(kv.x) * wr_); o.y = pk2(bf_lo(kv.y) * wr_, bf_hi(kv.y) * wr_); o.z = pk2(bf_lo(kv.z) * wr_, bf_hi(kv.z) * wr_); o.w = pk2(bf_lo(kv.w) * wr_, bf_hi(kv.w) * wr_);
      *(LAS u32x4*)(L + ML_KW + lr * ML_RS + ls * 16) = o; }
    __syncthreads();
    f32x4 Cacc[4];
#pragma unroll
    for (int et = 0; et < 4; ++et) Cacc[et] = (f32x4){0.f, 0.f, 0.f, 0.f};
#pragma unroll
    for (int ks = 0; ks < 2; ++ks) {
        LAS unsigned char* vp = L + ML_VS + (32 * ks + 8 * g4 + (l15 >> 2)) * ML_VR + (16 * w + 4 * (l15 & 3)) * 2;
        const bf16x8 av = cat8(tr16(vp), tr16(vp + 4 * ML_VR));
#pragma unroll
        for (int et = 0; et < 4; ++et) {
            LAS unsigned char* kp = L + ML_KW + (32 * ks + 8 * g4 + (l15 >> 2)) * ML_RS + (16 * et + 4 * (l15 & 3)) * 2;
            Cacc[et] = MFMA16(av, cat8(tr16(kp), tr16(kp + 4 * ML_RS)), Cacc[et]); } }
#pragma unroll
    for (int et = 0; et < 4; ++et)
#pragma unroll
        for (int r = 0; r < 4; ++r) cloc[(16 * w + 4 * g4 + r) * 64 + 16 * et + l15] = Cacc[et][r];
    { const int e = tid >> 3, part = tid & 7; float sacc = 0.f;
#pragma unroll
      for (int i = 0; i < 8; ++i) sacc += bf1(*(const LAS bf16_t*)(L + ML_KW + (8 * part + i) * ML_RS + e * 2));
      sacc = sum8_(sacc);
      if (part == 0) nloc[e] = sacc; }
}

__device__ __forceinline__ void mlstm_passA4(Frame& F, const Args& a) {
    constexpr int CH = 27648, VS = 0, KW = 17408, FL = 26624;
    const bf16_t* z = (const bf16_t*)(F.ws + WS_Z); const float* gates = (const float*)(F.ws + WS_GATES);
    int tid = F.tid; asm volatile("" : "+v"(tid));
    const int lane = tid & 63, w = F.wave, l15 = lane & 15, g4 = lane >> 4, lr = tid >> 3, ls = tid & 7;
    u32x4 kv[4], v0[4], v1[4]; float gi[4], gf[4];
#pragma unroll
    for (int k = 0; k < 4; ++k) {
        const int u = F.wg + 256 * k, c = u & 31, h = (u >> 5) & 7, b = u >> 8;
        const size_t tok0 = (size_t)b * SEQ + c * 64;
        const bf16_t* zr = z + (tok0 + lr) * ZP;
        kv[k] = *(const u32x4*)(zr + ZKA + h * 64 + ls * 8);
        v0[k] = *(const u32x4*)(zr + ZVA + h * 128 + ls * 8); v1[k] = *(const u32x4*)(zr + ZVA + h * 128 + 64 + ls * 8);
        gi[k] = gates[(tok0 + lane) * 16 + h]; gf[k] = gates[(tok0 + lane) * 16 + 8 + h];
    }
    __syncthreads();
#pragma unroll
    for (int k = 0; k < 4; ++k) {
        const int u = F.wg + 256 * k, h = (u >> 5) & 7;
        LAS unsigned char* L = F.lds + k * CH; LAS float* fl = (LAS float*)(L + FL);
        if (w == k) {
            const ChunkGates G = chunk_gates(gi[k], gf[k], a.in[I_BIG][h], a.in[I_BFG][h], lane);
            fl[lane] = __expf(G.u - G.umax);
            if (lane == 0) { float* msc = (float*)(F.ws + WS_MSC) + (size_t)u * 4; msc[0] = G.g + G.umax; msc[1] = G.g; }
        }
        *(LAS u32x4*)(L + VS + lr * ML_VR + ls * 16) = v0[k]; *(LAS u32x4*)(L + VS + lr * ML_VR + 128 + ls * 16) = v1[k];
    }
    __syncthreads();
#pragma unroll
    for (int k = 0; k < 4; ++k) {
        LAS unsigned char* L = F.lds + k * CH; const LAS float* fl = (const LAS float*)(L + FL);
        const float wr_ = fl[lr]; const u32x4 q = kv[k];
        u32x4 o; o.x = pk2(bf_lo(q.x) * wr_, bf_hi(q.x) * wr_); o.y = pk2(bf_lo(q.y) * wr_, bf_hi(q.y) * wr_); o.z = pk2(bf_lo(q.z) * wr_, bf_hi(q.z) * wr_); o.w = pk2(bf_lo(q.w) * wr_, bf_hi(q.w) * wr_);
        *(LAS u32x4*)(L + KW + lr * ML_RS + ls * 16) = o;
    }
    __syncthreads();
#pragma unroll
    for (int k = 0; k < 4; ++k) {
        const int u = F.wg + 256 * k;
        LAS unsigned char* L = F.lds + k * CH;
        float* cloc = (float*)(F.ws + WS_CLOC) + (size_t)u * 8192; float* nloc = (float*)(F.ws + WS_NLOC) + (size_t)u * 64;
        f32x4 Cacc[4];
#pragma unroll
        for (int et = 0; et < 4; ++et) Cacc[et] = (f32x4){0.f, 0.f, 0.f, 0.f};
#pragma unroll
        for (int ks = 0; ks < 2; ++ks) {
            LAS unsigned char* vp = L + VS + (32 * ks + 8 * g4 + (l15 >> 2)) * ML_VR + (16 * w + 4 * (l15 & 3)) * 2;
            const bf16x8 av = cat8(tr16(vp), tr16(vp + 4 * ML_VR));
#pragma unroll
            for (int et = 0; et < 4; ++et) {
                LAS unsigned char* kp = L + KW + (32 * ks + 8 * g4 + (l15 >> 2)) * ML_RS + (16 * et + 4 * (l15 & 3)) * 2;
                Cacc[et] = MFMA16(av, cat8(tr16(kp), tr16(kp + 4 * ML_RS)), Cacc[et]); } }
#pragma unroll
        for (int et = 0; et < 4; ++et)
#pragma unroll
            for (int r = 0; r < 4; ++r) cloc[(16 * w + 4 * g4 + r) * 64 + 16 * et + l15] = Cacc[et][r];
        { const int e = tid >> 3, part = tid & 7; float sacc = 0.f;
#pragma unroll
          for (int i = 0; i < 8; ++i) sacc += bf1(*(const LAS bf16_t*)(L + KW + (8 * part + i) * ML_RS + e * 2));
          sacc = sum8_(sacc);
          if (part == 0) nloc[e] = sacc; }
    }
}

__device__ __forceinline__ void mlstm_passB(Frame& F, int item) {
    const int bh = item >> 3, slice = item & 7, tid = F.tid;
    const float* cloc = (const float*)(F.ws + WS_CLOC) + (size_t)bh * 32 * 8192 + slice * 1024 + 2 * tid;
    bf16_t* cin = (bf16_t*)(F.ws + WS_CIN) + (size_t)bh * 32 * 8192 + slice * 1024 + 2 * tid;
    const float* nloc = (const float*)(F.ws + WS_NLOC) + (size_t)bh * 32 * 64 + 2 * tid;
    float* nin = (float*)(F.ws + WS_NIN) + (size_t)bh * 32 * 64 + 2 * tid;
    float* msc = (float*)(F.ws + WS_MSC) + (size_t)bh * 32 * 4;
    const bool do_n = (slice == 0) && (tid < 32);
    f32x2 cl[32], nl[32], mg[32];
#pragma unroll
    for (int c = 0; c < 32; ++c) { cl[c] = *(const f32x2*)(cloc + (size_t)c * 8192); nl[c] = do_n ? *(const f32x2*)(nloc + c * 64) : (f32x2){0.f, 0.f}; mg[c] = *(const f32x2*)(msc + c * 4); }
    __builtin_amdgcn_sched_barrier(0);
    float m = 0.f; f32x2 C = {0.f, 0.f}, N = {0.f, 0.f};
#pragma unroll
    for (int c = 0; c < 32; ++c) {
        *(unsigned*)(cin + (size_t)c * 8192) = pk2(C[0], C[1]);
        if (do_n) *(f32x2*)(nin + c * 64) = N;
        if (slice == 0 && tid == 0) msc[c * 4 + 2] = m;
        const float mloc = mg[c][0], g = mg[c][1];
        const float m_new = fmaxf(g + m, mloc), sp = __expf(g + m - m_new), sl = __expf(mloc - m_new);
        C = C * sp + cl[c] * sl; N = N * sp + nl[c] * sl; m = m_new;
    }
}

__device__ __forceinline__ void mlstm_passC(Frame& F, const Args& a, int u) {
    constexpr int QS = ML_QS, KS = ML_KS, VS = ML_VS, SB = ML_SB, CB = ML_CB, HO = ML_HO, RS = ML_RS, VR = ML_VR;
    LAS unsigned char* L = F.lds; LAS float* fl = (LAS float*)(L + ML_FLO);
    const bf16_t* z = (const bf16_t*)(F.ws + WS_Z); const float* gates = (const float*)(F.ws + WS_GATES);
    unsigned char* hm = F.ws + WS_HM;
    int tid = F.tid; asm volatile("" : "+v"(tid));
    const int lane = tid & 63, w = F.wave, l15 = lane & 15, g4 = lane >> 4;
    const int c = u & 31, h = (u >> 5) & 7, b = u >> 8;
    const float* gmo = a.in[I_GMO] + h * 128;
    const size_t tok0 = (size_t)b * SEQ + c * 64;
    const int lr = tid >> 3, ls = tid & 7, jt = w & 3, hf = w >> 2;
    const bf16_t* zr = z + (tok0 + lr) * ZP;
    const u32x4 qv = *(const u32x4*)(zr + ZQA + h * 64 + ls * 8), kv = *(const u32x4*)(zr + ZKA + h * 64 + ls * 8);
    const u32x4 v0 = *(const u32x4*)(zr + ZVA + h * 128 + ls * 8), v1 = *(const u32x4*)(zr + ZVA + h * 128 + 64 + ls * 8);
    const u32x4 oc0 = *(const u32x4*)(zr + ZOA + h * 128 + ls * 16), oc1 = *(const u32x4*)(zr + ZOA + h * 128 + ls * 16 + 8);
    const bf16_t* cin = (const bf16_t*)(F.ws + WS_CIN) + (size_t)u * 8192;
    const u32x4 c0 = *(const u32x4*)(cin + tid * 8), c1 = *(const u32x4*)(cin + 4096 + tid * 8);
    const float* msc = (const float*)(F.ws + WS_MSC) + (size_t)u * 4;
    const float mstate = msc[2], gi_raw = gates[(tok0 + lane) * 16 + h], gf_raw = gates[(tok0 + lane) * 16 + 8 + h], big = a.in[I_BIG][h], bfg = a.in[I_BFG][h];
    const float nin_l = ((const float*)(F.ws + WS_NIN))[(size_t)u * 64 + lane];
    float gmo_r[4];
#pragma unroll
    for (int d4 = 0; d4 < 4; ++d4) gmo_r[d4] = gmo[16 * (4 * hf + d4) + l15];
    __syncthreads();
    if (w == 0) {
        const ChunkGates G = chunk_gates(gi_raw, gf_raw, big, bfg, lane);
        const float M = fmaxf(mstate, G.pmx);
        fl[lane] = -M; fl[64 + lane] = G.u; fl[128 + lane] = __expf(mstate - M); fl[192 + lane] = __expf(-(G.bcs + M));
    }
    if (w == 1) fl[640 + lane] = nin_l;
    *(LAS u32x4*)(L + QS + lr * RS + ls * 16) = qv; *(LAS u32x4*)(L + KS + lr * RS + ls * 16) = kv;
    *(LAS u32x4*)(L + VS + lr * VR + ls * 16) = v0; *(LAS u32x4*)(L + VS + lr * VR + 128 + ls * 16) = v1;
    *(LAS u32x4*)(L + CB + lr * RS + ls * 16) = c0; *(LAS u32x4*)(L + CB + (64 + lr) * RS + ls * 16) = c1;
    __syncthreads();
    { const LAS float* nv = fl + 640 + ls * 8;
      float s = bf_lo(qv.x) * nv[0] + bf_hi(qv.x) * nv[1] + bf_lo(qv.y) * nv[2] + bf_hi(qv.y) * nv[3] + bf_lo(qv.z) * nv[4] + bf_hi(qv.z) * nv[5] + bf_lo(qv.w) * nv[6] + bf_hi(qv.w) * nv[7];
      s = sum8_(s);
      if (ls == 0) fl[320 + lr] = s * 0.125f; }
    { bf16x8 aq[2];
#pragma unroll
      for (int ks = 0; ks < 2; ++ks) aq[ks] = *(const LAS bf16x8*)(L + QS + (16 * jt + l15) * RS + (32 * ks + 8 * g4) * 2);
      float rsum[4] = {0.f, 0.f, 0.f, 0.f};
#pragma unroll
      for (int st2 = 0; st2 < 2; ++st2) { const int st = 2 * hf + st2; f32x4 s = {0.f, 0.f, 0.f, 0.f};
          if (st <= jt) {
#pragma unroll
              for (int ks = 0; ks < 2; ++ks) { const bf16x8 bk = *(const LAS bf16x8*)(L + KS + (16 * st + l15) * RS + (32 * ks + 8 * g4) * 2); s = MFMA16(aq[ks], bk, s); } }
          const int scol = 16 * st + l15; const float cf = fl[64 + scol];
#pragma unroll
          for (int r = 0; r < 4; ++r) { const int j = 16 * jt + 4 * g4 + r;
              const float val = (scol <= j) ? s[r] * 0.125f * __expf(fl[j] + cf) : 0.f; rsum[r] += val;
              *(LAS bf16_t*)(L + SB + j * RS + scol * 2) = f2bf(val); } }
#pragma unroll
      for (int r = 0; r < 4; ++r) { float t = sum16_(rsum[r]);
          if (l15 == 0) fl[384 + hf * 64 + 16 * jt + 4 * g4 + r] = t; } }
    __syncthreads();
    float hv[4][4];
    { bf16x8 as_[2], aq[2];
#pragma unroll
      for (int ks = 0; ks < 2; ++ks) { as_[ks] = *(const LAS bf16x8*)(L + SB + (16 * jt + l15) * RS + (32 * ks + 8 * g4) * 2); aq[ks] = *(const LAS bf16x8*)(L + QS + (16 * jt + l15) * RS + (32 * ks + 8 * g4) * 2); }
      float si[4], dn[4], en[4], ss[4] = {0.f, 0.f, 0.f, 0.f};
#pragma unroll
      for (int r = 0; r < 4; ++r) { const int j = 16 * jt + 4 * g4 + r; si[r] = fl[128 + j]; dn[r] = fl[384 + j] + fl[448 + j] + si[r] * fl[320 + j]; en[r] = fl[192 + j]; si[r] *= 0.125f; }
#pragma unroll
      for (int d4 = 0; d4 < 4; ++d4) { const int dt = 4 * hf + d4; f32x4 nacc = {0.f, 0.f, 0.f, 0.f}, iacc = nacc;
#pragma unroll
          for (int ks = 0; ks < 2; ++ks) {
              LAS unsigned char* vp = L + VS + (32 * ks + 8 * g4 + (l15 >> 2)) * VR + (16 * dt + 4 * (l15 & 3)) * 2;
              nacc = MFMA16(as_[ks], cat8(tr16(vp), tr16(vp + 4 * VR)), nacc);
              const bf16x8 bc = *(const LAS bf16x8*)(L + CB + (16 * dt + l15) * RS + (32 * ks + 8 * g4) * 2);
              iacc = MFMA16(aq[ks], bc, iacc); }
#pragma unroll
          for (int r = 0; r < 4; ++r) { const float num = nacc[r] + si[r] * iacc[r]; const float hvv = num * __builtin_amdgcn_rcpf(fmaxf(fabsf(dn[r]), en[r])); hv[d4][r] = hvv; ss[r] += hvv * hvv; } }
#pragma unroll
      for (int r = 0; r < 4; ++r) { float t = sum16_(ss[r]);
          if (l15 == 0) fl[512 + hf * 64 + 16 * jt + 4 * g4 + r] = t; } }
    __syncthreads();
    { float rinv[4];
#pragma unroll
      for (int r = 0; r < 4; ++r) { const int j = 16 * jt + 4 * g4 + r; rinv[r] = rsqrtf((fl[512 + j] + fl[576 + j]) * (1.0f / 128.0f) + EPS); }
#pragma unroll
      for (int d4 = 0; d4 < 4; ++d4) { const int d = 16 * (4 * hf + d4) + l15; const float gg = gmo_r[d4];
#pragma unroll
          for (int r = 0; r < 4; ++r) *(LAS bf16_t*)(L + HO + (16 * jt + 4 * g4 + r) * VR + d * 2) = f2bf(hv[d4][r] * rinv[r] * gg); } }
    __syncthreads();
    { const u32x4 h0 = *(const LAS u32x4*)(L + HO + lr * VR + ls * 32), h1 = *(const LAS u32x4*)(L + HO + lr * VR + ls * 32 + 16);
#define HG(hw, ow, lo) ((lo ? bf_lo(hw) : bf_hi(hw)) * sigmoidf_(lo ? bf_lo(ow) : bf_hi(ow)) * H8_SCALE)
      u32x4 r;
      r.x = pk4_fp8(HG(h0.x, oc0.x, 1), HG(h0.x, oc0.x, 0), HG(h0.y, oc0.y, 1), HG(h0.y, oc0.y, 0));
      r.y = pk4_fp8(HG(h0.z, oc0.z, 1), HG(h0.z, oc0.z, 0), HG(h0.w, oc0.w, 1), HG(h0.w, oc0.w, 0));
      r.z = pk4_fp8(HG(h1.x, oc1.x, 1), HG(h1.x, oc1.x, 0), HG(h1.y, oc1.y, 1), HG(h1.y, oc1.y, 0));
      r.w = pk4_fp8(HG(h1.z, oc1.z, 1), HG(h1.z, oc1.z, 0), HG(h1.w, oc1.w, 1), HG(h1.w, oc1.w, 0));
#undef HG
      *(u32x4*)(hm + (tok0 + lr) * 1024 + h * 128 + ls * 16) = r; }
}

__device__ __forceinline__ void mlstm_passC2(Frame& F, const Args& a, int ua, int ub) {
    constexpr int QS = 0, KS = 9216, VS = 18432, SB = 35840, CB = 45056, HO = 0, FLO = 63488, CH = 66560, RS = ML_RS, VR = ML_VR;
    const bf16_t* z = (const bf16_t*)(F.ws + WS_Z); const float* gates = (const float*)(F.ws + WS_GATES);
    unsigned char* hm = F.ws + WS_HM;
    int tid = F.tid; asm volatile("" : "+v"(tid));
    const int lane = tid & 63, w = F.wave, l15 = lane & 15, g4 = lane >> 4;
    const int lr = tid >> 3, ls = tid & 7, jt = w & 3, hf = w >> 2;
    u32x4 qv[2], kv[2], v0[2], v1[2], oc0[2], oc1[2], c0[2], c1[2];
    float mstate[2], gi_raw[2], gf_raw[2], big[2], bfg[2], nin_l[2], gmo_r[2][4];
    size_t tok0[2]; int hh[2];
#pragma unroll
    for (int k = 0; k < 2; ++k) {
        const int u = k ? ub : ua, c = u & 31, h = (u >> 5) & 7, b = u >> 8;
        hh[k] = h; tok0[k] = (size_t)b * SEQ + c * 64;
        const bf16_t* zr = z + (tok0[k] + lr) * ZP;
        qv[k] = *(const u32x4*)(zr + ZQA + h * 64 + ls * 8); kv[k] = *(const u32x4*)(zr + ZKA + h * 64 + ls * 8);
        v0[k] = *(const u32x4*)(zr + ZVA + h * 128 + ls * 8); v1[k] = *(const u32x4*)(zr + ZVA + h * 128 + 64 + ls * 8);
        oc0[k] = *(const u32x4*)(zr + ZOA + h * 128 + ls * 16); oc1[k] = *(const u32x4*)(zr + ZOA + h * 128 + ls * 16 + 8);
        const bf16_t* cin = (const bf16_t*)(F.ws + WS_CIN) + (size_t)u * 8192;
        c0[k] = *(const u32x4*)(cin + tid * 8); c1[k] = *(const u32x4*)(cin + 4096 + tid * 8);
        const float* msc = (const float*)(F.ws + WS_MSC) + (size_t)u * 4;
        mstate[k] = msc[2]; gi_raw[k] = gates[(tok0[k] + lane) * 16 + h]; gf_raw[k] = gates[(tok0[k] + lane) * 16 + 8 + h]; big[k] = a.in[I_BIG][h]; bfg[k] = a.in[I_BFG][h];
        nin_l[k] = ((const float*)(F.ws + WS_NIN))[(size_t)u * 64 + lane];
        const float* gmo = a.in[I_GMO] + h * 128;
#pragma unroll
        for (int d4 = 0; d4 < 4; ++d4) gmo_r[k][d4] = gmo[16 * (4 * hf + d4) + l15];
    }
    __syncthreads();
#pragma unroll
    for (int k = 0; k < 2; ++k) {
        LAS unsigned char* L = F.lds + k * CH; LAS float* fl = (LAS float*)(L + FLO);
        if (w == k) {
            const ChunkGates G = chunk_gates(gi_raw[k], gf_raw[k], big[k], bfg[k], lane);
            const float M = fmaxf(mstate[k], G.pmx);
            fl[lane] = -M; fl[64 + lane] = G.u; fl[128 + lane] = __expf(mstate[k] - M); fl[192 + lane] = __expf(-(G.bcs + M));
        }
        if (w == 2 + k) fl[640 + lane] = nin_l[k];
        *(LAS u32x4*)(L + QS + lr * RS + ls * 16) = qv[k]; *(LAS u32x4*)(L + KS + lr * RS + ls * 16) = kv[k];
        *(LAS u32x4*)(L + VS + lr * VR + ls * 16) = v0[k]; *(LAS u32x4*)(L + VS + lr * VR + 128 + ls * 16) = v1[k];
        *(LAS u32x4*)(L + CB + lr * RS + ls * 16) = c0[k]; *(LAS u32x4*)(L + CB + (64 + lr) * RS + ls * 16) = c1[k];
    }
    __syncthreads();
#pragma unroll
    for (int k = 0; k < 2; ++k) {
        LAS unsigned char* L = F.lds + k * CH; LAS float* fl = (LAS float*)(L + FLO);
        { const LAS float* nv = fl + 640 + ls * 8; const u32x4 q = qv[k];
          float s = bf_lo(q.x) * nv[0] + bf_hi(q.x) * nv[1] + bf_lo(q.y) * nv[2] + bf_hi(q.y) * nv[3] + bf_lo(q.z) * nv[4] + bf_hi(q.z) * nv[5] + bf_lo(q.w) * nv[6] + bf_hi(q.w) * nv[7];
          s = sum8_(s);
          if (ls == 0) fl[320 + lr] = s * 0.125f; }
        { bf16x8 aq[2];
#pragma unroll
          for (int ks = 0; ks < 2; ++ks) aq[ks] = *(const LAS bf16x8*)(L + QS + (16 * jt + l15) * RS + (32 * ks + 8 * g4) * 2);
          float rsum[4] = {0.f, 0.f, 0.f, 0.f};
#pragma unroll
          for (int st2 = 0; st2 < 2; ++st2) { const int st = 2 * hf + st2; f32x4 s = {0.f, 0.f, 0.f, 0.f};
              if (st <= jt) {
#pragma unroll
                  for (int ks = 0; ks < 2; ++ks) { const bf16x8 bk = *(const LAS bf16x8*)(L + KS + (16 * st + l15) * RS + (32 * ks + 8 * g4) * 2); s = MFMA16(aq[ks], bk, s); } }
              const int scol = 16 * st + l15; const float cf = fl[64 + scol];
#pragma unroll
              for (int r = 0; r < 4; ++r) { const int j = 16 * jt + 4 * g4 + r;
                  const float val = (scol <= j) ? s[r] * 0.125f * __expf(fl[j] + cf) : 0.f; rsum[r] += val;
                  *(LAS bf16_t*)(L + SB + j * RS + scol * 2) = f2bf(val); } }
#pragma unroll
          for (int r = 0; r < 4; ++r) { float t = sum16_(rsum[r]);
              if (l15 == 0) fl[384 + hf * 64 + 16 * jt + 4 * g4 + r] = t; } }
    }
    __syncthreads();
    float hv[2][4][4];
#pragma unroll
    for (int k = 0; k < 2; ++k) {
        LAS unsigned char* L = F.lds + k * CH; LAS float* fl = (LAS float*)(L + FLO);
        bf16x8 as_[2], aq[2];
#pragma unroll
        for (int ks = 0; ks < 2; ++ks) { as_[ks] = *(const LAS bf16x8*)(L + SB + (16 * jt + l15) * RS + (32 * ks + 8 * g4) * 2); aq[ks] = *(const LAS bf16x8*)(L + QS + (16 * jt + l15) * RS + (32 * ks + 8 * g4) * 2); }
        float si[4], dn[4], en[4], ss[4] = {0.f, 0.f, 0.f, 0.f};
#pragma unroll
        for (int r = 0; r < 4; ++r) { const int j = 16 * jt + 4 * g4 + r; si[r] = fl[128 + j]; dn[r] = fl[384 + j] + fl[448 + j] + si[r] * fl[320 + j]; en[r] = fl[192 + j]; si[r] *= 0.125f; }
#pragma unroll
        for (int d4 = 0; d4 < 4; ++d4) { const int dt = 4 * hf + d4; f32x4 nacc = {0.f, 0.f, 0.f, 0.f}, iacc = nacc;
#pragma unroll
            for (int ks = 0; ks < 2; ++ks) {
                LAS unsigned char* vp = L + VS + (32 * ks + 8 * g4 + (l15 >> 2)) * VR + (16 * dt + 4 * (l15 & 3)) * 2;
                nacc = MFMA16(as_[ks], cat8(tr16(vp), tr16(vp + 4 * VR)), nacc);
                const bf16x8 bc = *(const LAS bf16x8*)(L + CB + (16 * dt + l15) * RS + (32 * ks + 8 * g4) * 2);
                iacc = MFMA16(aq[ks], bc, iacc); }
#pragma unroll
            for (int r = 0; r < 4; ++r) { const float num = nacc[r] + si[r] * iacc[r]; const float hvv = num * __builtin_amdgcn_rcpf(fmaxf(fabsf(dn[r]), en[r])); hv[k][d4][r] = hvv; ss[r] += hvv * hvv; } }
#pragma unroll
        for (int r = 0; r < 4; ++r) { float t = sum16_(ss[r]);
            if (l15 == 0) fl[512 + hf * 64 + 16 * jt + 4 * g4 + r] = t; }
    }
    __syncthreads();
#pragma unroll
    for (int k = 0; k < 2; ++k) {
        LAS unsigned char* L = F.lds + k * CH; LAS float* fl = (LAS float*)(L + FLO);
        float rinv[4];
#pragma unroll
        for (int r = 0; r < 4; ++r) { const int j = 16 * jt + 4 * g4 + r; rinv[r] = rsqrtf((fl[512 + j] + fl[576 + j]) * (1.0f / 128.0f) + EPS); }
#pragma unroll
        for (int d4 = 0; d4 < 4; ++d4) { const int d = 16 * (4 * hf + d4) + l15; const float gg = gmo_r[k][d4];
#pragma unroll
            for (int r = 0; r < 4; ++r) *(LAS bf16_t*)(L + HO + (16 * jt + 4 * g4 + r) * VR + d * 2) = f2bf(hv[k][d4][r] * rinv[r] * gg); }
    }
    __syncthreads();
#pragma unroll
    for (int k = 0; k < 2; ++k) {
        LAS unsigned char* L = F.lds + k * CH;
        const u32x4 h0 = *(const LAS u32x4*)(L + HO + lr * VR + ls * 32), h1 = *(const LAS u32x4*)(L + HO + lr * VR + ls * 32 + 16);
        const u32x4 o0 = oc0[k], o1 = oc1[k];
#define HG(hw, ow, lo) ((lo ? bf_lo(hw) : bf_hi(hw)) * sigmoidf_(lo ? bf_lo(ow) : bf_hi(ow)) * H8_SCALE)
        u32x4 r;
        r.x = pk4_fp8(HG(h0.x, o0.x, 1), HG(h0.x, o0.x, 0), HG(h0.y, o0.y, 1), HG(h0.y, o0.y, 0));
        r.y = pk4_fp8(HG(h0.z, o0.z, 1), HG(h0.z, o0.z, 0), HG(h0.w, o0.w, 1), HG(h0.w, o0.w, 0));
        r.z = pk4_fp8(HG(h1.x, o1.x, 1), HG(h1.x, o1.x, 0), HG(h1.y, o1.y, 1), HG(h1.y, o1.y, 0));
        r.w = pk4_fp8(HG(h1.z, o1.z, 1), HG(h1.z, o1.z, 0), HG(h1.w, o1.w, 1), HG(h1.w, o1.w, 0));
#undef HG
        *(u32x4*)(hm + (tok0[k] + lr) * 1024 + hh[k] * 128 + ls * 16) = r;
    }
}

template <bool FIXED>
__device__ __forceinline__ void moba_unit(Frame& F, const Args& a, int b, int h, int qb, const float B2) {
    constexpr int KT = 0, VT = 34816, KM = 88064, TS = 17408, VR = 272;
    LAS unsigned char* L = F.lds;
    const bf16_t* z = (const bf16_t*)(F.ws + WS_Z);
    const float* kmean = (const float*)(F.ws + WS_KMEAN) + ((size_t)b * 8 + h) * 8 * 128;
    unsigned char* ob = F.ws + WS_OB;
    int tid = F.tid; asm volatile("" : "+v"(tid));
    const int lane = tid & 63, w = F.wave, l15 = lane & 15, g4 = lane >> 4;
    const int q0 = qb * 256, blk = qb, ntile = 4 * qb + 4;
    const size_t tokb = (size_t)b * SEQ;
    __syncthreads();
    if (tid < 256) *(LAS f32x4*)(L + KM + tid * 16) = *(const f32x4*)(kmean + tid * 4);
    bf16x8 qf[2][4];
#pragma unroll
    for (int g = 0; g < 2; ++g) { const bf16_t* qr = z + (tokb + q0 + 32 * w + 16 * g + l15) * ZP + ZQB + h * 128 + 8 * g4;
#pragma unroll
        for (int ks = 0; ks < 4; ++ks) qf[g][ks] = *(const bf16x8*)(qr + 32 * ks); }
    const int key0 = tid >> 4, seg = tid & 15;
    const bf16_t* kbase = z + (tokb + key0) * ZP + ZKB + h * 128 + seg * 8;
    const bf16_t* vbase = z + (tokb + key0) * ZP + ZVB + h * 128 + seg * 8;
    u32x4 kA0 = *(const u32x4*)kbase, kA1 = *(const u32x4*)(kbase + (size_t)32 * ZP), vA0 = *(const u32x4*)vbase, vA1 = *(const u32x4*)(vbase + (size_t)32 * ZP);
    u32x4 kB0 = *(const u32x4*)(kbase + (size_t)64 * ZP), kB1 = *(const u32x4*)(kbase + (size_t)96 * ZP), vB0 = *(const u32x4*)(vbase + (size_t)64 * ZP), vB1 = *(const u32x4*)(vbase + (size_t)96 * ZP);
    __syncthreads();
    unsigned mymask[2];
#pragma unroll
    for (int g = 0; g < 2; ++g) {
        if (blk <= 3) mymask[g] = (1u << blk) - 1u;
        else {
            float gate[7];
#pragma unroll
            for (int n = 0; n < 7; ++n) { float s = 0.f;
                if (n < blk) {
#pragma unroll
                    for (int ks = 0; ks < 4; ++ks) { const LAS float* km = (const LAS float*)(L + KM) + n * 128 + 32 * ks + 8 * g4;
#pragma unroll
                        for (int j = 0; j < 8; ++j) s += bf1((bf16_t)qf[g][ks][j]) * km[j]; }
                    s += __shfl_xor(s, 16); s += __shfl_xor(s, 32); }
                gate[n] = (n < blk) ? s : -3.0e38f; }
            unsigned mm = 0u;
#pragma unroll
            for (int t = 0; t < 3; ++t) { float best = -3.0e38f; int bi = 0;
#pragma unroll
                for (int n = 0; n < 7; ++n) { const bool take = (n < blk) && !((mm >> n) & 1u) && (gate[n] > best); best = take ? gate[n] : best; bi = take ? n : bi; }
                mm |= 1u << bi; }
            mymask[g] = mm;
        }
    }
    f32x4 O[2][8];
#pragma unroll
    for (int g = 0; g < 2; ++g)
#pragma unroll
        for (int dt = 0; dt < 8; ++dt) O[g][dt] = (f32x4){0.f, 0.f, 0.f, 0.f};
    float mrun[2] = {-1.0e30f, -1.0e30f}, lsum[2] = {0.f, 0.f};
    const float SC = 0.08838834764831845f * 1.4426950408889634f;
#pragma unroll 1
    for (int kt2 = 0; kt2 < ntile; kt2 += 2) {
#pragma unroll
      for (int buf = 0; buf < 2; ++buf) {
        const int kt = kt2 + buf;
        { LAS unsigned char* kd = L + KT + buf * TS + key0 * VR + seg * 16; LAS unsigned char* vd = L + VT + buf * TS + key0 * VR + seg * 16;
          const int t2 = (kt + 2 < ntile) ? kt + 2 : ntile - 1;
          const size_t adv = (size_t)t2 * 64 * ZP;
          if (buf == 0) { *(LAS u32x4*)kd = kA0; *(LAS u32x4*)(kd + 32 * VR) = kA1; *(LAS u32x4*)vd = vA0; *(LAS u32x4*)(vd + 32 * VR) = vA1;
              kA0 = *(const u32x4*)(kbase + adv); kA1 = *(const u32x4*)(kbase + adv + (size_t)32 * ZP); vA0 = *(const u32x4*)(vbase + adv); vA1 = *(const u32x4*)(vbase + adv + (size_t)32 * ZP); }
          else { *(LAS u32x4*)kd = kB0; *(LAS u32x4*)(kd + 32 * VR) = kB1; *(LAS u32x4*)vd = vB0; *(LAS u32x4*)(vd + 32 * VR) = vB1;
              kB0 = *(const u32x4*)(kbase + adv); kB1 = *(const u32x4*)(kbase + adv + (size_t)32 * ZP); vB0 = *(const u32x4*)(vbase + adv); vB1 = *(const u32x4*)(vbase + adv + (size_t)32 * ZP); } }
        __syncthreads();
        const int kb = kt >> 2; const bool past = kb < blk;
        const int kmin = 64 * kt;
        int cls[2];
#pragma unroll
        for (int g = 0; g < 2; ++g) { const int qmin = q0 + 32 * w + 16 * g; cls[g] = past ? 1 : ((kmin + 63 <= qmin) ? 1 : ((kmin > qmin + 15) ? 0 : 2)); }
        if ((cls[0] | cls[1]) != 0) {
            f32x4 st[2][4];
#pragma unroll
            for (int nt = 0; nt < 4; ++nt) { st[0][nt] = (f32x4){0.f, 0.f, 0.f, 0.f}; st[1][nt] = st[0][nt];
                bf16x8 bk[4];
#pragma unroll
                for (int ks = 0; ks < 4; ++ks) bk[ks] = *(const LAS bf16x8*)(L + KT + buf * TS + (16 * nt + l15) * VR + (32 * ks + 8 * g4) * 2);
                __builtin_amdgcn_sched_barrier(0);
#pragma unroll
                for (int ks = 0; ks < 4; ++ks) { st[0][nt] = MFMA16(bk[ks], qf[0][ks], st[0][nt]); st[1][nt] = MFMA16(bk[ks], qf[1][ks], st[1][nt]); }
                __builtin_amdgcn_sched_barrier(0); }
            bf16x8 pf[2][2];
#pragma unroll
            for (int g = 0; g < 2; ++g) {
                float pv[4][4]; float mnew = 0.f, alpha = 1.0f;
                if (FIXED) {
                    if (cls[g] == 1) {
                        const bool sel = past ? (((mymask[g] >> kb) & 1u) != 0u) : true;
                        const float nb = sel ? -B2 : -1.0e30f;
#pragma unroll
                        for (int nt = 0; nt < 4; ++nt)
#pragma unroll
                            for (int r = 0; r < 4; ++r) pv[nt][r] = __builtin_amdgcn_exp2f(fmaf(st[g][nt][r], SC, nb));
                    } else if (cls[g] == 2) {
                        const int qpos = q0 + 32 * w + 16 * g + l15;
#pragma unroll
                        for (int nt = 0; nt < 4; ++nt)
#pragma unroll
                            for (int r = 0; r < 4; ++r) { const bool ok = (kmin + 16 * nt + 4 * g4 + r) <= qpos; pv[nt][r] = __builtin_amdgcn_exp2f(ok ? fmaf(st[g][nt][r], SC, -B2) : -1.0e30f); }
                    } else {
#pragma unroll
                        for (int nt = 0; nt < 4; ++nt)
#pragma unroll
                            for (int r = 0; r < 4; ++r) pv[nt][r] = 0.f;
                    }
                } else if (cls[g] == 1) {
                    const bool sel = past ? (((mymask[g] >> kb) & 1u) != 0u) : true;
                    float mx = fmaxf(fmaxf(fmaxf(st[g][0][0], st[g][0][1]), fmaxf(st[g][0][2], st[g][0][3])), fmaxf(fmaxf(st[g][1][0], st[g][1][1]), fmaxf(st[g][1][2], st[g][1][3])));
                    mx = fmaxf(mx, fmaxf(fmaxf(fmaxf(st[g][2][0], st[g][2][1]), fmaxf(st[g][2][2], st[g][2][3])), fmaxf(fmaxf(st[g][3][0], st[g][3][1]), fmaxf(st[g][3][2], st[g][3][3]))));
                    mx = sel ? mx * SC : -1.0e30f;
                    mx = fmaxf(mx, __shfl_xor(mx, 16)); mx = fmaxf(mx, __shfl_xor(mx, 32));
                    mnew = fmaxf(mrun[g], mx); alpha = __builtin_amdgcn_exp2f(mrun[g] - mnew);
                    const float nb = sel ? -mnew : -1.0e30f;
#pragma unroll
                    for (int nt = 0; nt < 4; ++nt)
#pragma unroll
                        for (int r = 0; r < 4; ++r) pv[nt][r] = __builtin_amdgcn_exp2f(fmaf(st[g][nt][r], SC, nb));
                } else if (cls[g] == 2) {
                    const int qpos = q0 + 32 * w + 16 * g + l15; float sv[4][4]; float mx = -1.0e30f;
#pragma unroll
                    for (int nt = 0; nt < 4; ++nt)
#pragma unroll
                        for (int r = 0; r < 4; ++r) { const bool ok = (kmin + 16 * nt + 4 * g4 + r) <= qpos; sv[nt][r] = ok ? st[g][nt][r] * SC : -1.0e30f; mx = fmaxf(mx, sv[nt][r]); }
                    mx = fmaxf(mx, __shfl_xor(mx, 16)); mx = fmaxf(mx, __shfl_xor(mx, 32));
                    mnew = fmaxf(mrun[g], mx); alpha = __builtin_amdgcn_exp2f(mrun[g] - mnew);
#pragma unroll
                    for (int nt = 0; nt < 4; ++nt)
#pragma unroll
                        for (int r = 0; r < 4; ++r) pv[nt][r] = (sv[nt][r] > -1.0e29f) ? __builtin_amdgcn_exp2f(sv[nt][r] - mnew) : 0.f;
                } else {
                    mnew = mrun[g]; alpha = 1.0f;
#pragma unroll
                    for (int nt = 0; nt < 4; ++nt)
#pragma unroll
                        for (int r = 0; r < 4; ++r) pv[nt][r] = 0.f;
                }
                float ps = 0.f;
#pragma unroll
                for (int nt = 0; nt < 4; ++nt) ps += (pv[nt][0] + pv[nt][1]) + (pv[nt][2] + pv[nt][3]);
                if (FIXED) lsum[g] += ps;
                else { mrun[g] = mnew; lsum[g] = lsum[g] * alpha + ps;
#pragma unroll
                    for (int dt = 0; dt < 8; ++dt) O[g][dt] *= alpha; }
#pragma unroll
                for (int k2 = 0; k2 < 2; ++k2) {
                    u32x4 pw4; pw4.x = pk2(pv[2 * k2][0], pv[2 * k2][1]); pw4.y = pk2(pv[2 * k2][2], pv[2 * k2][3]); pw4.z = pk2(pv[2 * k2 + 1][0], pv[2 * k2 + 1][1]); pw4.w = pk2(pv[2 * k2 + 1][2], pv[2 * k2 + 1][3]);
                    pf[g][k2] = __builtin_bit_cast(bf16x8, pw4); }
            }
            bf16x8 vf[2][4];
#define MOBA_VREAD(bq, slot) do { _Pragma("unroll") for (int d = 0; d < 4; ++d) { const int k2_ = (bq) >> 1, dt_ = 4 * ((bq) & 1) + d; \
                LAS unsigned char* vp = L + VT + buf * TS + (32 * k2_ + 4 * g4 + (l15 >> 2)) * VR + (16 * dt_ + 4 * (l15 & 3)) * 2; vf[slot][d] = cat8(tr16(vp), tr16(vp + 16 * VR)); } } while (0)
            MOBA_VREAD(0, 0);
#pragma unroll
            for (int bq = 0; bq < 4; ++bq) {
                if (bq + 1 < 4) MOBA_VREAD(bq + 1, (bq + 1) & 1);
                __builtin_amdgcn_sched_barrier(0);
#pragma unroll
                for (int d = 0; d < 4; ++d) { const int k2 = bq >> 1, dt = 4 * (bq & 1) + d;
                    O[0][dt] = MFMA16(vf[bq & 1][d], pf[0][k2], O[0][dt]); O[1][dt] = MFMA16(vf[bq & 1][d], pf[1][k2], O[1][dt]); }
                __builtin_amdgcn_sched_barrier(0);
            }
#undef MOBA_VREAD
        }
      }
    }
#pragma unroll
    for (int g = 0; g < 2; ++g) { float t = lsum[g]; t += __shfl_xor(t, 16); t += __shfl_xor(t, 32);
      const float inv = O8_SCALE / t; unsigned char* op = ob + (tokb + q0 + 32 * w + 16 * g + l15) * 1024 + h * 128 + 4 * g4;
#pragma unroll
      for (int dt = 0; dt < 8; ++dt) *(unsigned*)(op + 16 * dt) = pk4_fp8(O[g][dt][0] * inv, O[g][dt][1] * inv, O[g][dt][2] * inv, O[g][dt][3] * inv); }
}

__device__ __forceinline__ void p4_mixers(Frame& F, const Args& a, bool with_cvt) {
    LAS int* qslot = (LAS int*)(F.lds + 140032);
    const int total = with_cvt ? 768 + 256 : 768;
    const float B2 = __builtin_bit_cast(float, __builtin_amdgcn_readfirstlane((int)__hip_atomic_load(F.ctl + CW_MISC, __ATOMIC_RELAXED, __HIP_MEMORY_SCOPE_AGENT)));
    const bool fixed_ok = B2 <= 40.0f;
    for (;;) {
        __syncthreads();
        if (F.tid == 0) *qslot = (int)__hip_atomic_fetch_add(F.ctl + CW_QUEUE, 1u, __ATOMIC_RELAXED, __HIP_MEMORY_SCOPE_AGENT);
        __syncthreads();
        const int idx = *qslot;
        __syncthreads();
        if (idx >= total) break;
        int it = idx;
        if (with_cvt) { const int g = idx >> 2, r = idx & 3; if (r == 3) { cvt8_item(F, a, 512 + g); continue; } it = 3 * g + r; }
        if (it < 256) { if (fixed_ok) moba_unit<true>(F, a, (it & 31) >> 3, it & 7, 7 - (it >> 5), B2); else moba_unit<false>(F, a, (it & 31) >> 3, it & 7, 7 - (it >> 5), B2); }
        else mlstm_passC2(F, a, it - 256, it - 256 + 512);
    }
}

__device__ __forceinline__ void p7_router(Frame& F, const Args& a) {
    unsigned char* ws = F.ws;
    const float* modf = (const float*)(ws + WS_MODF);
    const bf16_t* wrf = (const bf16_t*)(ws + WS_WRF);
    int* toke = (int*)(ws + WS_TOKE); float* tokw = (float*)(ws + WS_TOKW); int* toks = (int*)(ws + WS_TOKS); float* roww = (float*)(ws + WS_ROWW);
    unsigned char* tA = ws + WS_TA;
    LAS float* part = (LAS float*)(F.lds + PART_OFF);
    LAS float* logit = (LAS float*)(F.lds + LOGIT_OFF);
    LAS int* dstl = (LAS int*)(F.lds + DST_OFF);
    LAS int* lcnt = (LAS int*)(F.lds + DST_OFF + 512);
    const int lane = F.lane, l15 = lane & 15, g4 = lane >> 4;
    for (int rb = F.wg; rb < T / 32; rb += F.G) {
        norm_rows_32_b(F, (const bf16_t*)(ws + WS_X1), a.in[I_GFFN], modf, 3, rb);
        { const int rg = F.wave & 1, ct = (F.wave >> 1) & 1, kh = F.wave >> 2; f32x4 acc = {0.f, 0.f, 0.f, 0.f};
          bf16x8 bvv[32];
          __builtin_amdgcn_sched_barrier(0);
          const bf16_t* wq = wrf + ((size_t)ct * 4096 + (size_t)(32 * kh) * 64 + lane) * 8; asm volatile("" : "+v"(wq));
#pragma unroll
          for (int s = 0; s < 32; ++s) bvv[s] = *(const bf16x8*)(wq + (size_t)s * 512);
          __syncthreads();
#pragma unroll
          for (int s = 0; s < 32; ++s) { const int ks = 32 * kh + s;
              const bf16x8 av = *(const LAS bf16x8*)(F.lds + (16 * rg + l15) * HL_STRIDE + (32 * ks + 8 * g4) * 2);
              acc = __builtin_amdgcn_mfma_f32_16x16x32_bf16(av, bvv[s], acc, 0, 0, 0); }
#pragma unroll
          for (int r = 0; r < 4; ++r) part[((kh * 2 + rg) * 2 + ct) * 256 + (4 * g4 + r) * 16 + l15] = acc[r]; }
        __syncthreads();
#pragma unroll
        for (int q = 0; q < 2; ++q) { const int o = F.tid + 512 * q, row = o >> 5, e = o & 31, rg = row >> 4, ct = e >> 4;
            logit[o] = part[((0 * 2 + rg) * 2 + ct) * 256 + (row & 15) * 16 + (e & 15)] + part[((1 * 2 + rg) * 2 + ct) * 256 + (row & 15) * 16 + (e & 15)] + a.in[I_BR][e]; }
        __syncthreads();
        if (F.tid < 32) {
            const int row = F.tid; const size_t tok = (size_t)rb * 32 + row;
            lcnt[row] = 0;
            float v[NE];
#pragma unroll
            for (int e = 0; e < NE; ++e) v[e] = logit[row * NE + e];
            float tv[4]; int ti[4]; unsigned used = 0u;
#pragma unroll
            for (int k = 0; k < 4; ++k) { float best = -3.0e38f; int bi = 0;
#pragma unroll
                for (int e = 0; e < NE; ++e) { const bool take = !((used >> e) & 1u) && (v[e] > best); best = take ? v[e] : best; bi = take ? e : bi; }
                used |= 1u << bi; tv[k] = best; ti[k] = bi; }
            float ex[4], sum = 0.f;
#pragma unroll
            for (int k = 0; k < 4; ++k) { ex[k] = __expf(tv[k] - tv[0]); sum += ex[k]; }
            const float inv = 1.0f / sum;
            int lr[4];
#pragma unroll
            for (int k = 0; k < 4; ++k) lr[k] = __hip_atomic_fetch_add(lcnt + ti[k], 1, __ATOMIC_RELAXED, __HIP_MEMORY_SCOPE_WORKGROUP);
            __builtin_amdgcn_wave_barrier();
            { const int mine = lcnt[row];
              int base = 0; if (mine > 0) base = (int)__hip_atomic_fetch_add(F.ctl + CW_CNT + 64 * row, (unsigned)mine, __ATOMIC_RELAXED, __HIP_MEMORY_SCOPE_AGENT);
              lcnt[32 + row] = base; }
            __builtin_amdgcn_wave_barrier();
#pragma unroll
            for (int k = 0; k < 4; ++k) {
                const int slot = lcnt[32 + ti[k]] + lr[k];
                const float wk = ex[k] * inv;
                toke[tok * 4 + k] = ti[k]; tokw[tok * 4 + k] = wk; toks[tok * 4 + k] = slot;
                roww[(size_t)ti[k] * ECAP + slot] = wk;
                dstl[row * 4 + k] = ti[k] * ECAP + slot;
            }
        }
        __syncthreads();
#pragma unroll 1
        for (int i = 0; i < 4; ++i) { const int r = 4 * F.wave + i;
            u32x4 q8[2];
#pragma unroll
            for (int cidx = 0; cidx < 2; ++cidx) { const int ch = lane + 64 * cidx;
                const u32x4 lo = *(const LAS u32x4*)(F.lds + r * HL_STRIDE + ch * 32), hi = *(const LAS u32x4*)(F.lds + r * HL_STRIDE + ch * 32 + 16);
                q8[cidx].x = pk4_fp8(bf_lo(lo.x), bf_hi(lo.x), bf_lo(lo.y), bf_hi(lo.y)); q8[cidx].y = pk4_fp8(bf_lo(lo.z), bf_hi(lo.z), bf_lo(lo.w), bf_hi(lo.w));
                q8[cidx].z = pk4_fp8(bf_lo(hi.x), bf_hi(hi.x), bf_lo(hi.y), bf_hi(hi.y)); q8[cidx].w = pk4_fp8(bf_lo(hi.z), bf_hi(hi.z), bf_lo(hi.w), bf_hi(hi.w)); }
#pragma unroll
            for (int k = 0; k < 4; ++k) { unsigned char* dp = tA + (size_t)dstl[r * 4 + k] * D;
#pragma unroll
                for (int cidx = 0; cidx < 2; ++cidx) *(u32x4*)(dp + (lane + 64 * cidx) * 16) = q8[cidx]; } }
        __syncthreads();
    }
}

__device__ __forceinline__ void moe_tables(Frame& F) {
    LAS int* tb = (LAS int*)(F.lds + LDS_TABS);
    __syncthreads();
    if (F.wave == 0) {
        const int e = F.lane & 31;
        const int cnt = (int)__hip_atomic_load(F.ctl + CW_CNT + 64 * e, __ATOMIC_RELAXED, __HIP_MEMORY_SCOPE_AGENT);
        const int tl = (cnt + 255) >> 8;
        int inc = tl;
#pragma unroll
        for (int o = 1; o < 32; o <<= 1) { const int t = __shfl_up(inc, o); if (e >= o) inc += t; }
        const int exc = inc - tl;
        if (F.lane < 32) {
            tb[e] = tl; tb[32 + e] = exc * 256; tb[64 + e] = e * ECAP; tb[96 + e] = exc * 16; tb[160 + e] = exc * 8;
            if (e == NE - 1) { tb[96 + NE] = inc * 16; tb[160 + NE] = inc * 8; }
        }
    }
    __syncthreads();
}

__device__ __forceinline__ void p10_combine(Frame& F, const Args& a) {
    unsigned char* ws = F.ws;
    const bf16_t* x1 = (const bf16_t*)(ws + WS_X1); const unsigned char* ydn = ws + WS_YDN; const float* modf = (const float*)(ws + WS_MODF);
    const int* toke = (const int*)(ws + WS_TOKE); const int* toks = (const int*)(ws + WS_TOKS);
    const LAS int* tb = (const LAS int*)(F.lds + LDS_TABS);
    int tz = threadIdx.x; asm volatile("" : "+v"(tz));
    const int gw = F.vcu * 8 + F.wave, NGW = F.G * 8, lane = tz & 63;
    for (int tok = gw; tok < T; tok += NGW) {
        const float* gt = modf + (size_t)(tok >> 11) * (6 * D) + 5 * D;
        const unsigned char* yr[4];
#pragma unroll
        for (int k = 0; k < 4; ++k) yr[k] = ydn + (size_t)(tb[32 + toke[tok * 4 + k]] + toks[tok * 4 + k]) * D;
        u32x2 y[4][4]; u32x4 xq[4]; f32x4 g0[4], g1[4];
#pragma unroll
        for (int j = 0; j < 4; ++j) { const int col = 8 * (lane + 64 * j);
#pragma unroll
            for (int k = 0; k < 4; ++k) y[j][k] = __builtin_nontemporal_load((const u32x2*)(yr[k] + col));
            xq[j] = __builtin_nontemporal_load((const u32x4*)(x1 + (size_t)tok * D + col));
            g0[j] = *(const f32x4*)(gt + col); g1[j] = *(const f32x4*)(gt + col + 4); }
        __builtin_amdgcn_sched_barrier(0);
#pragma unroll
        for (int j = 0; j < 4; ++j) { const int col = 8 * (lane + 64 * j);
            f32x4 s0 = {0.f, 0.f, 0.f, 0.f}, s1 = s0;
#pragma unroll
            for (int k = 0; k < 4; ++k) {
                const f32x2 p0 = __builtin_amdgcn_cvt_pk_f32_fp8((int)y[j][k].x, false), p1 = __builtin_amdgcn_cvt_pk_f32_fp8((int)y[j][k].x, true);
                const f32x2 p2 = __builtin_amdgcn_cvt_pk_f32_fp8((int)y[j][k].y, false), p3 = __builtin_amdgcn_cvt_pk_f32_fp8((int)y[j][k].y, true);
                s0[0] += p0[0]; s0[1] += p0[1]; s0[2] += p1[0]; s0[3] += p1[1]; s1[0] += p2[0]; s1[1] += p2[1]; s1[2] += p3[0]; s1[3] += p3[1]; }
            const size_t o = (size_t)tok * D + col;
            const f32x4 xa = {bf_lo(xq[j].x), bf_hi(xq[j].x), bf_lo(xq[j].y), bf_hi(xq[j].y)}, xb = {bf_lo(xq[j].z), bf_hi(xq[j].z), bf_lo(xq[j].w), bf_hi(xq[j].w)};
            __builtin_nontemporal_store(xa + g0[j] * (s0 * (1.0f / YD_SCALE)), (f32x4*)(a.out + o));
            __builtin_nontemporal_store(xb + g1[j] * (s1 * (1.0f / YD_SCALE)), (f32x4*)(a.out + o + 4)); }
    }
}

__global__ void __launch_bounds__(512, 2) hybrid_fwd(Args args) {
    extern __shared__ __attribute__((aligned(16))) unsigned char lds_raw[];
    Frame F;
    F.lds = (LAS unsigned char*)lds_raw; F.ws = args.ws; F.ctl = (unsigned*)(args.ws + WS_CTL);
    F.tid = threadIdx.x; F.lane = F.tid & 63; F.wave = __builtin_amdgcn_readfirstlane(F.tid >> 6);
    F.G = gridDim.x; F.wg = blockIdx.x; F.vcu = (F.G % 8 == 0) ? (F.wg % 8) * (F.G / 8) + F.wg / 8 : F.wg;
    if (F.tid < 4) ((LAS unsigned*)(F.lds + LDS_XB))[F.tid] = 0u;
    __syncthreads();
    XcdBarrier bar; bar.bar = F.ctl + CW_BAR; bar.x = 0; bar.st = nullptr;
#if !MK_PER_PHASE
    bar = xcd_barrier_post(F.ctl + CW_BAR, (volatile LAS unsigned*)(F.lds + LDS_XB));
#endif
    const int lo = args.ph_lo, hi = args.ph_hi;
#define IN(k) (lo <= (k) && (k) < hi)
#define SEAM(k) do { if (IN(k) && IN((k) + 1)) xcd_barrier(bar); } while (0)
    unsigned char* ws = args.ws;

    if (IN(0)) { p0_prologue(F, args); } SEAM(0);
    if (IN(1)) { p1_rows(F, args); } SEAM(1);
    const bool cv_ok = (F.G == 256);
    if (IN(2)) {
        pg8::DenseOrder S0; S0.init(ws + WS_HBUF8, ws + WS_WIN8, T, ZP, F.G, F.wg);
        EpiZT<true> E{(bf16_t*)(ws + WS_Z), ZP, args.in[I_GQ], args.in[I_GK], (float*)(ws + WS_KMEAN), F.lds + 131072};
        unsigned gaps = 0u;
        if (cv_ok) { int c = F.wg % 15, g0 = 0; while (c >= 5 - g0) { c -= 5 - g0; ++g0; } gaps = (1u << g0) | (1u << (g0 + 1 + c)); }
        int cvn = F.wg * 2;
        if (!cv_ok) { for (int idx = F.wg; idx < 1536; idx += F.G) cvt8_item(F, args, idx); }
        int lo = 0;
#pragma unroll 1
        for (int seg = 0; seg < 3; ++seg) {
            if ((gaps >> lo) & 1u) { cvt8_item(F, args, cvn++); gaps &= ~(1u << lo); }
            int hi = lo + 1; while (hi < 5 && !((gaps >> hi) & 1u)) ++hi;
            if (lo < 5) { pg8::SubOrder<pg8::DenseOrder> S{S0, lo, hi - lo}; pg8::gemm_phase<EpiZT<true>, pg8::SubOrder<pg8::DenseOrder>, true>(F.lds, D / 2, S, E); }
            lo = hi;
        }
        if (gaps & 32u) cvt8_item(F, args, cvn++);
    } SEAM(2);
    if (IN(3) && F.G == 256) { mlstm_passA4(F, args); }
    else if (IN(3)) {
        PassAIn cur = mlstm_passA_load(F, F.wg < 1024 ? F.wg : 0);
        for (int u = F.wg; u < 1024; u += F.G) { const int un = u + F.G; const PassAIn nxt = mlstm_passA_load(F, un < 1024 ? un : u); mlstm_passA(F, args, u, cur); cur = nxt; }
    } SEAM(3);
    if (IN(11)) { for (int it = F.wg; it < 256; it += F.G) mlstm_passB(F, it); }
    if (IN(3) && IN(4)) xcd_barrier(bar);
    if (IN(4)) { p4_mixers(F, args, F.G == 256); } SEAM(4);
    if (IN(5)) {
        if (cv_ok && (F.wg & 1) == 0) cvt8_item(F, args, 768 + F.wg);
        { pg8::PairOrder S; S.d.init(ws + WS_HM, ws + WS_WA, T, D, F.G, F.wg); S.A2 = (const char*)(ws + WS_OB); S.Bt2 = (const char*)(ws + WS_WB);
          EpiBranchAB E{(const bf16_t*)(ws + WS_Z), ws + WS_YBUF8};
          pg8::gemm_phase<EpiBranchAB, pg8::PairOrder, true>(F.lds, 512, S, E); }
        if (cv_ok && (F.wg & 1) == 1) cvt8_item(F, args, 768 + F.wg);
    } SEAM(5);
    if (IN(6)) {
        if (cv_ok && (F.wg & 1) == 0) cvt8_item(F, args, 1024 + F.wg);
        pg8::DenseOrder S; S.init(ws + WS_YBUF8, ws + WS_WOUT8, T, D, F.G, F.wg);
        EpiOut E{args.in[I_X], (const float*)(ws + WS_MODF), (bf16_t*)(ws + WS_X1)};
        pg8::gemm_phase<EpiOut, pg8::DenseOrder, true>(F.lds, D / 2, S, E);
        if (cv_ok && (F.wg & 1) == 1) cvt8_item(F, args, 1024 + F.wg);
    } SEAM(6);
    if (IN(7)) { p7_router(F, args); } SEAM(7);
    if (IN(8)) {
        moe_tables(F);
        const LAS int* tb = (const LAS int*)(F.lds + LDS_TABS);
        pg8::MoeOrder S{(const char*)(ws + WS_TA), (const char*)(ws + WS_WUP), tb, tb + 64, tb + 96, 16, F.G, F.vcu, (size_t)(2 * D) * D, __builtin_amdgcn_readfirstlane(tb[96 + NE]), nullptr, 0u};
        EpiUpT<true> E{ws + WS_ACT, args.in[I_BUP], tb + 32, F.ctl + CW_UPD};
        const int cut = cv_ok ? (F.wg & 7) : 0;
        if (cut > 0) { pg8::SubOrder<pg8::MoeOrder> S1{S, 0, cut}; pg8::gemm_phase<EpiUpT<true>, pg8::SubOrder<pg8::MoeOrder>, true>(F.lds, D / 2, S1, E); }
        if (cv_ok) cvt8_item_signal(F, args, 1280 + F.wg, F.ctl + CW_UPD);
        { pg8::SubOrder<pg8::MoeOrder> S2{S, cut, 1 << 20}; pg8::gemm_phase<EpiUpT<true>, pg8::SubOrder<pg8::MoeOrder>, true>(F.lds, D / 2, S2, E); }
    }
    if (IN(9)) {
        if (!IN(8)) moe_tables(F);
        const LAS int* tb = (const LAS int*)(F.lds + LDS_TABS);
        const int utot = __builtin_amdgcn_readfirstlane(tb[96 + NE]);
        pg8::MoeDepOrder S{(const char*)(ws + WS_ACT), (const char*)(ws + WS_WDN), tb, tb + 32, tb + 160, 8, F.G, (F.vcu - utot % F.G + F.G) % F.G, (size_t)D * D, __builtin_amdgcn_readfirstlane(tb[160 + NE]), F.ctl + CW_UPD, cv_ok ? 16u : 0u};
        EpiDown E{ws + WS_YDN, args.in[I_BDN], (const float*)(ws + WS_ROWW), tb + 32};
        pg8::gemm_phase<EpiDown, pg8::MoeDepOrder, true>(F.lds, D / 2, S, E);
    } SEAM(9);
    if (IN(10)) { if (!IN(8) && !IN(9)) moe_tables(F); p10_combine(F, args); }
#undef IN
#undef SEAM
}

constexpr int N_PHASES = 12;
extern "C" void kernel_launch(void* const* d_in, const int* in_sizes, int n_in, void* d_out, int out_size, void* d_ws, size_t ws_size, hipStream_t stream) {
    static int grid = 0;
    if (grid == 0) {
        if (n_in != 21 || out_size != T * D || ws_size < WS_END) { fprintf(stderr, "kernel_launch: unexpected problem (n_in %d out %d ws %zu)\n", n_in, out_size, ws_size); grid = -1; return; }
        int dev = 0, cus = 0, per_cu = 0;
        if (hipGetDevice(&dev) != hipSuccess || hipDeviceGetAttribute(&cus, hipDeviceAttributeMultiprocessorCount, dev) != hipSuccess) { grid = -1; return; }
        if (hipFuncSetAttribute((const void*)hybrid_fwd, hipFuncAttributeMaxDynamicSharedMemorySize, LDS_BYTES) != hipSuccess) { fprintf(stderr, "kernel_launch: hipFuncSetAttribute failed\n"); grid = -1; return; }
        if (hipOccupancyMaxActiveBlocksPerMultiprocessor(&per_cu, (const void*)hybrid_fwd, 512, LDS_BYTES) != hipSuccess || per_cu < 1) fprintf(stderr, "kernel_launch: occupancy query says %d\n", per_cu);
        (void)hipGetLastError();
        grid = cus;
    }
    if (grid < 0) return;
    if (hipMemsetAsync((char*)d_ws + WS_CTL, 0, CTL_BYTES, stream) != hipSuccess) return;
    Args a{};
    for (int i = 0; i < 21; ++i) a.in[i] = (const float*)d_in[i];
    a.out = (float*)d_out; a.ws = (unsigned char*)d_ws;
#if MK_PER_PHASE
    for (int p = 0; p < N_PHASES; ++p) { a.ph_lo = p; a.ph_hi = p + 1; hipLaunchKernelGGL(hybrid_fwd, dim3(grid), dim3(512), LDS_BYTES, stream, a); }
#else
    a.ph_lo = 0; a.ph_hi = N_PHASES;
    hipLaunchKernelGGL(hybrid_fwd, dim3(grid), dim3(512), LDS_BYTES, stream, a);
#endif
}
```

```cpp
#include <hip/hip_runtime.h>
#include <cstdio>
#include <cstdint>

#ifndef MK_PER_PHASE
#define MK_PER_PHASE 0
#endif

#define LAS __attribute__((address_space(3)))
#define GAS __attribute__((address_space(1)))
typedef unsigned short bf16_t;
typedef short bf16x8 __attribute__((ext_vector_type(8)));
typedef short s16x4 __attribute__((ext_vector_type(4)));
typedef float f32x4 __attribute__((ext_vector_type(4)));
typedef float f32x2 __attribute__((ext_vector_type(2)));
typedef unsigned u32x4 __attribute__((ext_vector_type(4)));
typedef unsigned u32x2 __attribute__((ext_vector_type(2)));
typedef int i32x8 __attribute__((ext_vector_type(8)));
typedef int i32x4 __attribute__((ext_vector_type(4)));

constexpr int D = 2048, NB = 4, SEQ = 2048, T = NB * SEQ;
constexpr int DIN = 10256, ZP = 10240;
constexpr int ZQA = 0, ZKA = 512, ZVA = 1024, ZOA = 2048, ZQB = 3072, ZKB = 4096, ZVB = 5120, ZGA = 6144, ZGB = 8192;
constexpr int GATE_COL = 3072;
constexpr int NE = 32, TOPK = 4, ECAP = 8192, CROWS = 40960;
constexpr float EPS = 1e-6f;

constexpr size_t MiB = 1ull << 20;
constexpr size_t WS_CTL = 0, CTL_BYTES = 1 * MiB;
constexpr size_t WS_MODP = 1 * MiB;
constexpr size_t WS_GATES = 2 * MiB;
constexpr size_t WS_KMEAN = 3 * MiB;
constexpr size_t WS_WGF = 3 * MiB + 512 * 1024;
constexpr size_t WS_WRF = 3 * MiB + 640 * 1024;
constexpr size_t WS_MODF = 4 * MiB;
constexpr size_t WS_TOKE = 5 * MiB;
constexpr size_t WS_TOKW = 5 * MiB + 256 * 1024;
constexpr size_t WS_TOKS = 5 * MiB + 512 * 1024;
constexpr size_t WS_ROWW = 6 * MiB;
constexpr size_t WS_WIN = 8 * MiB;
constexpr size_t WS_WOUT8 = 8 * MiB;
constexpr size_t WS_WA = 48 * MiB, WS_WB = 52 * MiB, WS_WOUT = 56 * MiB;
constexpr size_t WS_HBUF = 64 * MiB;
constexpr size_t WS_YBUF8 = 64 * MiB;
constexpr float Y8_SCALE = 8.0f;
constexpr float YD_SCALE = 16.0f;
constexpr float H8_SCALE = 8.0f, O8_SCALE = 32.0f;
constexpr size_t WS_Z = 96 * MiB;
constexpr size_t WS_HM = 256 * MiB, WS_OB = 272 * MiB;
constexpr size_t WS_TMPF = 288 * MiB;
constexpr size_t WS_YBUF = 352 * MiB;
constexpr size_t WS_X1 = 384 * MiB;
constexpr size_t WS_ACT = 448 * MiB;
constexpr size_t WS_YDN = 608 * MiB;
constexpr size_t WS_CLOC = 928 * MiB;
constexpr size_t WS_CIN = 960 * MiB;
constexpr size_t WS_NLOC = 976 * MiB, WS_NIN = 977 * MiB, WS_MSC = 978 * MiB;
constexpr size_t WS_HBUF8 = 980 * MiB;
constexpr size_t WS_WIN8 = 996 * MiB;
constexpr size_t WS_WUP = 1024 * MiB;
constexpr size_t WS_WDN = 1536 * MiB;
constexpr size_t WS_TA = 2048 * MiB;
constexpr size_t WS_END = 3072 * MiB;
constexpr int CW_BAR = 4096;
constexpr int CW_CNT = 16384;
constexpr int CW_QUEUE = 32768;
constexpr int CW_MISC = 49152;
constexpr int CW_UPD = 65536;
constexpr int CW_MQ = 32768 + 64;
constexpr int CW_CUD = 36864, CW_CDD = 40960, CW_GUD = 45056;

constexpr int LDS_BYTES = 157696;
constexpr int LDS_XB = 157568;
constexpr int LDS_TABS = 147456;

__device__ __forceinline__ float bf_lo(unsigned u) { return __uint_as_float(u << 16); }
__device__ __forceinline__ float bf_hi(unsigned u) { return __uint_as_float(u & 0xffff0000u); }
__device__ __forceinline__ float bf1(bf16_t v) { return __uint_as_float(((unsigned)v) << 16); }
__device__ __forceinline__ unsigned pk2(float lo, float hi) { unsigned r; asm("v_cvt_pk_bf16_f32 %0, %1, %2" : "=v"(r) : "v"(lo), "v"(hi)); return r; }
__device__ __forceinline__ bf16_t f2bf(float f) { return (bf16_t)(pk2(f, 0.f) & 0xffffu); }
__device__ __forceinline__ float wave_sum(float v) {
#pragma unroll
    for (int o = 1; o < 64; o <<= 1) v += __shfl_xor(v, o);
    return v;
}
__device__ __forceinline__ void store16_sc1(void* p, u32x4 v) { asm volatile("global_store_dwordx4 %0, %1, off sc1\n\ts_nop 1" :: "v"(p), "v"(v) : "memory"); }
__device__ __forceinline__ void store8_sc1(void* p, u32x2 v) { asm volatile("global_store_dwordx2 %0, %1, off sc1\n\ts_nop 1" :: "v"(p), "v"(v) : "memory"); }
__device__ __forceinline__ unsigned pk4_fp8(float a, float b, float c, float d) {
    a = __builtin_amdgcn_fmed3f(a, -448.0f, 448.0f); b = __builtin_amdgcn_fmed3f(b, -448.0f, 448.0f); c = __builtin_amdgcn_fmed3f(c, -448.0f, 448.0f); d = __builtin_amdgcn_fmed3f(d, -448.0f, 448.0f);
    int r = __builtin_amdgcn_cvt_pk_fp8_f32(a, b, 0, false); r = __builtin_amdgcn_cvt_pk_fp8_f32(c, d, r, true); return (unsigned)r; }
__device__ __forceinline__ unsigned pk4_fp8_ns(float a, float b, float c, float d) { int r = __builtin_amdgcn_cvt_pk_fp8_f32(a, b, 0, false); r = __builtin_amdgcn_cvt_pk_fp8_f32(c, d, r, true); return (unsigned)r; }
constexpr float W8_SCALE = 256.0f, W8_INV = 1.0f / 256.0f;
__device__ __forceinline__ float sigmoidf_(float x) { return __builtin_amdgcn_rcpf(1.f + __expf(-x)); }
#define DPP_ADD(t, CTRL) ((t) + __builtin_bit_cast(float, __builtin_amdgcn_update_dpp(0, __builtin_bit_cast(int, (t)), (CTRL), 0xf, 0xf, false)))
__device__ __forceinline__ float sum8_(float t) { t = DPP_ADD(t, 0xB1); t = DPP_ADD(t, 0x4E); t = DPP_ADD(t, 0x141); return t; }
__device__ __forceinline__ float sum16_(float t) { t = sum8_(t); t = DPP_ADD(t, 0x140); return t; }

namespace pg8 {
constexpr int BM = 256, BK = 64, HALF = 128, HTB = HALF * BK * 2, STAGE_BYTES = 8 * HTB, NXCD = 8, WGM = 8;
__host__ __device__ __forceinline__ int lds_byte(int r, int c) { const int st = (r >> 4) * 2 + (c >> 5), rr = r & 15, cc = c & 31, ob = rr * 64 + cc * 2; return st * 1024 + (ob ^ (((ob >> 9) & 1) << 5)); }
__host__ __device__ __forceinline__ void stage_rc(int b, int& R, int& C) { const int st = b / 1024, sb = b % 1024, swz = sb ^ (((sb >> 9) & 1) << 5); R = (st >> 1) * 16 + swz / 64; C = (st & 1) * 32 + (swz % 64) / 2; }
__host__ __device__ __forceinline__ int perm32(int rho) { const int n = rho >> 4, i = rho & 15; return 8 * (i >> 2) + 4 * n + (i & 3); }

struct Unit { int pm, pn, e; };

struct DenseOrder {
    static constexpr bool HAS_DEP = false;
    const char* A; const char* Bt; int nM, nN, nwg, G, c;
    __device__ void init(const void* A_, const void* Bt_, int M, int N, int G_, int c_) { A = (const char*)A_; Bt = (const char*)Bt_; nM = M / BM; nN = N / BM; nwg = nM * nN; G = G_; c = c_; }
    __device__ bool next(int i, Unit& u) const {
        const long L = (long)i * G + c; if (L >= nwg) return false;
        int wgid = (int)L; { const int q = nwg / NXCD, r = nwg % NXCD, xcd = wgid % NXCD, off = wgid / NXCD; wgid = (xcd < r ? xcd * (q + 1) : r * (q + 1) + (xcd - r) * q) + off; }
        const int nig = WGM * nN, gid = wgid / nig, fm = gid * WGM, gsz = (nM - fm) < WGM ? (nM - fm) : WGM;
        u.pm = fm + ((wgid % nig) % gsz); u.pn = (wgid % nig) / gsz; u.e = 0; return true;
    }
    __device__ __forceinline__ const char* a_ptr(const Unit& u, size_t tstep) const { return A + (size_t)u.pm * tstep; }
    __device__ __forceinline__ const char* b_ptr(const Unit& u, size_t tstep) const { return Bt + (size_t)u.pn * tstep; }
};

constexpr unsigned DEP_NEED = 16u;
template <bool DEP>
struct MoeOrderT {
    static constexpr bool HAS_DEP = DEP;
    const char* A; const char* Bt; const LAS int* tiles; const LAS int* arow; const LAS int* ub; int nN, G, c; size_t estepB; int total; unsigned* dep; unsigned need_hi;
    __device__ bool next(int i, Unit& u) const {
        const int L = i * G + c; if (L >= total) return false;
        unsigned zz = 0u; asm volatile("" : "+v"(zz));
        const int ln = (int)__builtin_amdgcn_mbcnt_hi(~0u, __builtin_amdgcn_mbcnt_lo(~0u, zz));
        const int ubv = ub[(ln < NE ? ln : NE - 1) + 1];
        const int e = __builtin_popcountll(__ballot(ln < NE && L >= ubv));
        const int r = L - __builtin_amdgcn_readfirstlane(ub[e]), te = __builtin_amdgcn_readfirstlane(tiles[e]);
        u.e = e; u.pm = r % te; u.pn = r / te; return true;
    }
    __device__ __forceinline__ unsigned dep_issue(int i) const {
        Unit u; if (!next(i, u)) return 0xffffffffu;
        return __hip_atomic_load(dep + (u.e * 32 + u.pm) * 16, __ATOMIC_RELAXED, __HIP_MEMORY_SCOPE_AGENT);
    }
    __device__ __forceinline__ void dep_confirm(const Unit& u, unsigned v) const {
        const unsigned* ctr = dep + (u.e * 32 + u.pm) * 16;
        const unsigned need = DEP_NEED + (u.e >= 16 ? need_hi : 0u);
        while ((unsigned)__builtin_amdgcn_readfirstlane((int)v) < need) { __builtin_amdgcn_s_sleep(2); v = __hip_atomic_load(ctr, __ATOMIC_RELAXED, __HIP_MEMORY_SCOPE_AGENT); }
        asm volatile("" ::: "memory");
    }
    __device__ __forceinline__ const char* a_ptr(const Unit& u, size_t tstep) const { return A + ((size_t)arow[u.e] / 256 + (size_t)u.pm) * tstep; }
    __device__ __forceinline__ const char* b_ptr(const Unit& u, size_t tstep) const { return Bt + (size_t)u.e * estepB + (size_t)u.pn * tstep; }
};
typedef MoeOrderT<false> MoeOrder;
typedef MoeOrderT<true> MoeDepOrder;

template <class Base> struct SubOrder {
    static constexpr bool HAS_DEP = false;
    Base b; int i0, n;
    __device__ bool next(int i, Unit& u) const { if (i >= n) return false; return b.next(i0 + i, u); }
    __device__ __forceinline__ const char* a_ptr(const Unit& u, size_t tstep) const { return b.a_ptr(u, tstep); }
    __device__ __forceinline__ const char* b_ptr(const Unit& u, size_t tstep) const { return b.b_ptr(u, tstep); }
};
struct OneUnit {
    static constexpr bool HAS_DEP = false;
    const char* A; const char* Bt; Unit u;
    __device__ bool next(int i, Unit& o) const { if (i > 0) return false; o = u; return true; }
    __device__ __forceinline__ const char* a_ptr(const Unit&, size_t) const { return A; }
    __device__ __forceinline__ const char* b_ptr(const Unit&, size_t) const { return Bt; }
};

struct PairOrder {
    static constexpr bool HAS_DEP = false;
    DenseOrder d; const char* A2; const char* Bt2;
    __device__ bool next(int i, Unit& u) const { if (!d.next(i >> 1, u)) return false; u.e = i & 1; return true; }
    __device__ __forceinline__ const char* a_ptr(const Unit& u, size_t tstep) const { return (u.e ? A2 : d.A) + (size_t)u.pm * tstep; }
    __device__ __forceinline__ const char* b_ptr(const Unit& u, size_t tstep) const { return (u.e ? Bt2 : d.Bt) + (size_t)u.pn * tstep; }
};

template <class Epi, class Sched, bool FP8 = false>
__device__ __forceinline__ void gemm_phase(LAS unsigned char* lds, const int K, const Sched& S, const Epi& E) {
    int tid = threadIdx.x; asm volatile("" : "+v"(tid));
    const int wid = __builtin_amdgcn_readfirstlane(tid >> 6), lane = tid & 63, wr = wid >> 2, wc = wid & 3, fr = lane & 15, fq = lane >> 4;
    const int nt = K / BK;
    unsigned voffA, voffB;
    { int R, C; stage_rc(tid * 16, R, C); const int Rb = Epi::PERM ? ((R & ~31) + perm32(R & 31)) : R;
      voffA = (unsigned)(R * K + C) * 2u; voffB = (unsigned)(Rb * K + C) * 2u; }
    const size_t pstep = (size_t)64 * K * 2;
    const size_t kstep = (size_t)(BK * 2);
    const size_t hstep = (size_t)HALF * K * 2;
    const size_t tstep = 2 * hstep;
    const unsigned ldsw = (unsigned)wid * 1024u;
    int lanex;
    { unsigned _z = 0u; asm volatile("" : "+v"(_z)); const int _ln = (int)__builtin_amdgcn_mbcnt_hi(~0u, __builtin_amdgcn_mbcnt_lo(~0u, _z)); lanex = lds_byte(_ln & 15, (_ln >> 4) * 8); }
#define PG8_LANE_OFFS asm volatile("" : "+v"(lanex)); const int aoff = lanex + wr * 8192, boff = lanex + wc * 4096; (void)aoff; (void)boff
#define PG8_SA(b, h) (((b) * 2 + (h)) * HTB)
#define PG8_SB(b, h) ((4 + (b) * 2 + (h)) * HTB)
#define PG8_STAGE(bufoff, gbase, voff) do { asm volatile("" : "+v"(voff)); _Pragma("unroll") for (int _i = 0; _i < 2; ++_i) \
        __builtin_amdgcn_global_load_lds((const unsigned*)((const char*)(gbase) + _i * pstep + (voff)), (LAS unsigned*)(lds + (bufoff) + ldsw + _i * 8192), 16, 0, 0); } while (0)
#define PG8_LDA(dst, b, h) do { _Pragma("unroll") for (int m = 0; m < 4; ++m) { const i32x4 _l = *(const LAS i32x4*)(lds + PG8_SA(b, h) + aoff + m * 2048), _h = *(const LAS i32x4*)(lds + PG8_SA(b, h) + aoff + m * 2048 + 1024); \
        dst[m] = __builtin_shufflevector(_l, _h, 0, 1, 2, 3, 4, 5, 6, 7); } } while (0)
#define PG8_LDB(dst, b, h) do { _Pragma("unroll") for (int n = 0; n < 2; ++n) { const i32x4 _l = *(const LAS i32x4*)(lds + PG8_SB(b, h) + boff + n * 2048), _h = *(const LAS i32x4*)(lds + PG8_SB(b, h) + boff + n * 2048 + 1024); \
        dst[n] = __builtin_shufflevector(_l, _h, 0, 1, 2, 3, 4, 5, 6, 7); } } while (0)
#define PG8_LO(x) __builtin_bit_cast(bf16x8, __builtin_shufflevector((x), (x), 0, 1, 2, 3))
#define PG8_HI(x) __builtin_bit_cast(bf16x8, __builtin_shufflevector((x), (x), 4, 5, 6, 7))
#define PG8_MMA(ai, bj, At, Bt) do { __builtin_amdgcn_s_setprio(1); \
        if constexpr (FP8) { _Pragma("unroll") for (int m = 0; m < 4; ++m) _Pragma("unroll") for (int n = 0; n < 2; ++n) \
            acc[ai][bj][m][n] = __builtin_amdgcn_mfma_scale_f32_16x16x128_f8f6f4(Bt[n], At[m], acc[ai][bj][m][n], 0, 0, 0, 0x7f7f7f7f, 0, 0x7f7f7f7f); } \
        else { _Pragma("unroll") for (int m = 0; m < 4; ++m) _Pragma("unroll") for (int n = 0; n < 2; ++n) { \
            acc[ai][bj][m][n] = __builtin_amdgcn_mfma_f32_16x16x32_bf16(PG8_LO(Bt[n]), PG8_LO(At[m]), acc[ai][bj][m][n], 0, 0, 0); \
            acc[ai][bj][m][n] = __builtin_amdgcn_mfma_f32_16x16x32_bf16(PG8_HI(Bt[n]), PG8_HI(At[m]), acc[ai][bj][m][n], 0, 0, 0); } } \
        __builtin_amdgcn_s_setprio(0); } while (0)
#define PG8_WAIT_V(n) asm volatile("s_waitcnt vmcnt(" #n ")" ::: "memory")
#define PG8_WAIT_L(n) asm volatile("s_waitcnt lgkmcnt(" #n ")" ::: "memory")
#define PG8_BAR __builtin_amdgcn_s_barrier()
#define PG8_SCHED __builtin_amdgcn_sched_barrier(0)
    Unit cur, nxt, prv; int ui = 0; prv.pm = prv.pn = prv.e = 0; (void)prv;
    if (!S.next(0, cur)) return;
    unsigned depv = 0u; (void)depv;
    if constexpr (Sched::HAS_DEP) { S.dep_confirm(cur, S.dep_issue(0)); depv = S.dep_issue(1); }
    f32x4 acc[2][2][4][2];
#define PG8_ACC_INIT(U) do { f32x4 _bi[2][2]; \
        if constexpr (Epi::ACC_INIT) { unsigned _zz = 0u; asm volatile("" : "+v"(_zz)); const int _ln = (int)__builtin_amdgcn_mbcnt_hi(~0u, __builtin_amdgcn_mbcnt_lo(~0u, _zz)); E.acc_bias((U), wc, _ln >> 4, _bi); } \
        else { _bi[0][0] = (f32x4){0.f, 0.f, 0.f, 0.f}; _bi[0][1] = _bi[0][0]; _bi[1][0] = _bi[0][0]; _bi[1][1] = _bi[0][0]; } \
        _Pragma("unroll") for (int a = 0; a < 2; ++a) _Pragma("unroll") for (int b = 0; b < 2; ++b) _Pragma("unroll") for (int m = 0; m < 4; ++m) _Pragma("unroll") for (int n = 0; n < 2; ++n) acc[a][b][m][n] = _bi[b][n]; } while (0)
    PG8_ACC_INIT(cur);
    i32x8 At[4], B0[2], B1[2];
    const char* cA = S.a_ptr(cur, tstep); const char* cB = S.b_ptr(cur, tstep);
    PG8_STAGE(PG8_SB(0, 0), cB, voffB); PG8_STAGE(PG8_SB(0, 1), cB + hstep, voffB); PG8_STAGE(PG8_SA(0, 0), cA, voffA); PG8_STAGE(PG8_SA(0, 1), cA + hstep, voffA);
    if (wr == 1) PG8_BAR;
    PG8_WAIT_V(2); PG8_BAR;
    PG8_STAGE(PG8_SB(1, 0), cB + kstep, voffB); PG8_STAGE(PG8_SA(1, 0), cA + kstep, voffA); PG8_STAGE(PG8_SB(1, 1), cB + hstep + kstep, voffB);
    PG8_WAIT_V(6); PG8_BAR;
    for (;;) {
        const bool has_next = S.next(ui + 1, nxt);
        if constexpr (Sched::HAS_DEP) { if (has_next) S.dep_confirm(nxt, depv); }
        const char* nA = has_next ? S.a_ptr(nxt, tstep) : cA; const char* nB = has_next ? S.b_ptr(nxt, tstep) : cB;
#pragma unroll 1
        for (int t = 0; t < nt; t += 2) {
            const bool last = (t == nt - 2);
            const char* a1 = cA + (size_t)(t + 1) * kstep;
            const char* a2 = last ? nA : cA + (size_t)(t + 2) * kstep; const char* b2 = last ? nB : cB + (size_t)(t + 2) * kstep;
            const char* a3 = a2 + kstep; const char* b3 = b2 + kstep;
            { PG8_LANE_OFFS; PG8_LDB(B0, 0, 0); PG8_LDB(B1, 0, 1); PG8_SCHED; PG8_LDA(At, 0, 0); PG8_STAGE(PG8_SA(1, 1), a1 + hstep, voffA); }
            PG8_WAIT_V(8); PG8_WAIT_L(0); PG8_BAR; PG8_MMA(0, 0, At, B0); PG8_MMA(0, 1, At, B1); PG8_BAR; PG8_SCHED;
            { PG8_LANE_OFFS; PG8_LDA(At, 0, 1); PG8_STAGE(PG8_SB(0, 0), b2, voffB); PG8_STAGE(PG8_SB(0, 1), b2 + hstep, voffB); PG8_STAGE(PG8_SA(0, 0), a2, voffA); }
            PG8_WAIT_V(8); PG8_WAIT_L(0); PG8_BAR; PG8_MMA(1, 0, At, B0); PG8_MMA(1, 1, At, B1); PG8_BAR; PG8_SCHED;
            { PG8_LANE_OFFS; PG8_LDB(B0, 1, 0); PG8_LDB(B1, 1, 1); PG8_SCHED; PG8_LDA(At, 1, 0); PG8_STAGE(PG8_SA(0, 1), a2 + hstep, voffA); }
            PG8_WAIT_V(8); PG8_WAIT_L(0); PG8_BAR; PG8_MMA(0, 0, At, B0); PG8_MMA(0, 1, At, B1); PG8_BAR; PG8_SCHED;
            { PG8_LANE_OFFS; PG8_LDA(At, 1, 1); PG8_STAGE(PG8_SB(1, 0), b3, voffB); PG8_STAGE(PG8_SB(1, 1), b3 + hstep, voffB); PG8_STAGE(PG8_SA(1, 0), a3, voffA); }
            PG8_WAIT_V(8); PG8_WAIT_L(0); PG8_BAR; PG8_MMA(1, 0, At, B0); PG8_MMA(1, 1, At, B1); PG8_BAR; PG8_SCHED;
        }
        if (wr == 0) PG8_BAR;
        if constexpr (Sched::HAS_DEP) depv = S.dep_issue(ui + 2);
        if constexpr (Epi::SIGNALS) { if (ui > 0) { PG8_WAIT_V(8); PG8_BAR; E.signal(prv, tid == 0); } }
        { unsigned zz = 0u; asm volatile("" : "+v"(zz));
          const int ln = (int)__builtin_amdgcn_mbcnt_hi(~0u, __builtin_amdgcn_mbcnt_lo(~0u, zz));
          E(acc, cur, wr, wc, ln & 15, ln >> 4); }
        if (!has_next) break;
        if (!(Epi::CHAIN && cur.e == 0)) { PG8_ACC_INIT(nxt); }
        prv = cur; cur = nxt; cA = nA; cB = nB; ++ui;
        if (wr == 1) PG8_BAR;
    }
    PG8_WAIT_V(0);
    PG8_BAR;
    if constexpr (Epi::SIGNALS) E.signal(cur, tid == 0);
#undef PG8_SA
#undef PG8_ACC_INIT
#undef PG8_SB
#undef PG8_STAGE
#undef PG8_LDA
#undef PG8_LDB
#undef PG8_MMA
#undef PG8_LO
#undef PG8_LANE_OFFS
#undef PG8_HI
#undef PG8_WAIT_V
#undef PG8_WAIT_L
#undef PG8_BAR
#undef PG8_SCHED
}
}

using pg8::Unit;
template <bool F8>
struct EpiZT {
    static constexpr bool PERM = true;
    static constexpr bool SIGNALS = false;
    static constexpr bool CHAIN = false;
    static constexpr bool ACC_INIT = false;
    static constexpr float ASC = F8 ? W8_INV : 1.0f;
    bf16_t* O; int ldc; const float* gq; const float* gk; float* kmean; LAS unsigned char* xl;
    __device__ __forceinline__ void operator()(const f32x4 (&acc)[2][2][4][2], const Unit& u, int wr, int wc, int fr, int fq) const {
        const int row0 = u.pm * 256 + wr * 64 + fr, col0 = u.pn * 256 + wc * 32 + 8 * fq;
        if (u.pn < 12 || u.pn >= 20) {
#pragma unroll
            for (int ai = 0; ai < 2; ++ai)
#pragma unroll
                for (int m = 0; m < 4; ++m) { bf16_t* rowp = O + (size_t)(row0 + ai * 128 + m * 16) * ldc + col0;
#pragma unroll
                    for (int bj = 0; bj < 2; ++bj) { const f32x4 v0 = acc[ai][bj][m][0] * ASC, v1 = acc[ai][bj][m][1] * ASC;
                        u32x4 w; w.x = pk2(v0[0], v0[1]); w.y = pk2(v0[2], v0[3]); w.z = pk2(v1[0], v1[1]); w.w = pk2(v1[2], v1[3]);
                        *(u32x4*)(rowp + bj * 128) = w; } }
            return;
        }
        LAS float* P = (LAS float*)xl;
        LAS float* Cs = (LAS float*)(xl + 8192);
#pragma unroll
        for (int ai = 0; ai < 2; ++ai)
#pragma unroll
            for (int m = 0; m < 4; ++m)
#pragma unroll
                for (int bj = 0; bj < 2; ++bj) { const f32x4 v0 = acc[ai][bj][m][0], v1 = acc[ai][bj][m][1];
                    float ss = (v0[0] * v0[0] + v0[1] * v0[1]) + (v0[2] * v0[2] + v0[3] * v0[3]) + (v1[0] * v1[0] + v1[1] * v1[1]) + (v1[2] * v1[2] + v1[3] * v1[3]);
                    ss += __shfl_xor(ss, 16); ss += __shfl_xor(ss, 32);
                    if (fq == 0) P[((ai * 128 + wr * 64 + m * 16 + fr) * 2 + bj) * 4 + wc] = ss; asm volatile("" ::: "memory"); }
        __syncthreads();
        const bool isk = u.pn >= 16;
        const float* gv = (isk ? gk : gq) + wc * 32 + 8 * fq;
        const f32x4 g0 = *(const f32x4*)gv, g1 = *(const f32x4*)(gv + 4);
        f32x4 cs[2][2];
#pragma unroll
        for (int bj = 0; bj < 2; ++bj) { cs[bj][0] = (f32x4){0.f, 0.f, 0.f, 0.f}; cs[bj][1] = cs[bj][0]; }
#pragma unroll
        for (int ai = 0; ai < 2; ++ai)
#pragma unroll
            for (int m = 0; m < 4; ++m) { const int rl = ai * 128 + wr * 64 + m * 16 + fr; bf16_t* rowp = O + (size_t)(u.pm * 256 + rl) * ldc + col0;
#pragma unroll
                for (int bj = 0; bj < 2; ++bj) { const f32x4 pp = *(const LAS f32x4*)(P + (rl * 2 + bj) * 4);
                    const float rinv = rsqrtf(((pp[0] + pp[1]) + (pp[2] + pp[3])) * (ASC * ASC / 128.0f) + EPS) * ASC;
                    const f32x4 y0 = acc[ai][bj][m][0] * rinv * g0, y1 = acc[ai][bj][m][1] * rinv * g1;
                    cs[bj][0] += y0; cs[bj][1] += y1;
                    u32x4 w; w.x = pk2(y0[0], y0[1]); w.y = pk2(y0[2], y0[3]); w.z = pk2(y1[0], y1[1]); w.w = pk2(y1[2], y1[3]);
                    *(u32x4*)(rowp + bj * 128) = w; }
                asm volatile("" : "+v"(cs[0][0]), "+v"(cs[0][1]), "+v"(cs[1][0]), "+v"(cs[1][1]) :: "memory"); }
        if (isk) {
#pragma unroll
            for (int bj = 0; bj < 2; ++bj)
#pragma unroll
                for (int n = 0; n < 2; ++n)
#pragma unroll
                    for (int j = 0; j < 4; ++j) { float t = sum16_(cs[bj][n][j]);
                        if (fr == 0) Cs[(wr * 2 + bj) * 128 + wc * 32 + 8 * fq + 4 * n + j] = t; }
            __syncthreads();
            const int t = (wr * 4 + wc) * 64 + fq * 16 + fr;
            if (t < 256) { const int bj = t >> 7, d = t & 127, hd = (u.pn - 16) * 2 + bj;
                kmean[((((size_t)(u.pm >> 3) * 8 + hd) * 8) + (u.pm & 7)) * 128 + d] = (Cs[bj * 128 + d] + Cs[(2 + bj) * 128 + d]) * (1.0f / 256.0f); }
        }
    }
};
typedef EpiZT<false> EpiZ;
struct EpiZ8 {
    static constexpr bool PERM = true;
    static constexpr bool SIGNALS = false;
    static constexpr bool CHAIN = false;
    static constexpr bool ACC_INIT = false;
    bf16_t* O; int ldc, col_off;
    __device__ __forceinline__ void operator()(const f32x4 (&acc)[2][2][4][2], const Unit& u, int wr, int wc, int fr, int fq) const {
        const int row0 = u.pm * 256 + wr * 64 + fr, col0 = col_off + u.pn * 256 + wc * 32 + 8 * fq;
#pragma unroll
        for (int ai = 0; ai < 2; ++ai)
#pragma unroll
            for (int m = 0; m < 4; ++m) { bf16_t* rowp = O + (size_t)(row0 + ai * 128 + m * 16) * ldc + col0;
#pragma unroll
                for (int bj = 0; bj < 2; ++bj) { const f32x4 v0 = acc[ai][bj][m][0] * W8_INV, v1 = acc[ai][bj][m][1] * W8_INV;
                    u32x4 w; w.x = pk2(v0[0], v0[1]); w.y = pk2(v0[2], v0[3]); w.z = pk2(v1[0], v1[1]); w.w = pk2(v1[2], v1[3]);
                    *(u32x4*)(rowp + bj * 128) = w; } }
    }
};
struct EpiBranchA {
    static constexpr bool PERM = true;
    static constexpr bool SIGNALS = false;
    static constexpr bool CHAIN = false;
    static constexpr bool ACC_INIT = false;
    float* tmp; const bf16_t* z;
    __device__ __forceinline__ void operator()(const f32x4 (&acc)[2][2][4][2], const Unit& u, int wr, int wc, int fr, int fq) const {
        const int row0 = u.pm * 256 + wr * 64 + fr, col0 = u.pn * 256 + wc * 32 + 8 * fq;
#pragma unroll
        for (int ai = 0; ai < 2; ++ai)
#pragma unroll
            for (int m = 0; m < 4; ++m) { const size_t row = (size_t)(row0 + ai * 128 + m * 16);
#pragma unroll
                for (int bj = 0; bj < 2; ++bj) { const int col = col0 + bj * 128;
                    const u32x4 g = *(const u32x4*)(z + row * ZP + ZGA + col);
                    const f32x4 v0 = acc[ai][bj][m][0] * (W8_INV / H8_SCALE), v1 = acc[ai][bj][m][1] * (W8_INV / H8_SCALE);
                    f32x4 o0, o1;
                    o0[0] = v0[0] * sigmoidf_(bf_lo(g.x)); o0[1] = v0[1] * sigmoidf_(bf_hi(g.x)); o0[2] = v0[2] * sigmoidf_(bf_lo(g.y)); o0[3] = v0[3] * sigmoidf_(bf_hi(g.y));
                    o1[0] = v1[0] * sigmoidf_(bf_lo(g.z)); o1[1] = v1[1] * sigmoidf_(bf_hi(g.z)); o1[2] = v1[2] * sigmoidf_(bf_lo(g.w)); o1[3] = v1[3] * sigmoidf_(bf_hi(g.w));
                    float* p = tmp + row * D + col; *(f32x4*)p = o0; *(f32x4*)(p + 4) = o1; } }
    }
};
struct EpiBranchB {
    static constexpr bool PERM = true;
    static constexpr bool SIGNALS = false;
    static constexpr bool CHAIN = false;
    static constexpr bool ACC_INIT = false;
    const float* tmp; const bf16_t* z; unsigned char* y;
    __device__ __forceinline__ void operator()(const f32x4 (&acc)[2][2][4][2], const Unit& u, int wr, int wc, int fr, int fq) const {
        const int row0 = u.pm * 256 + wr * 64 + fr, col0 = u.pn * 256 + wc * 32 + 8 * fq;
#pragma unroll
        for (int ai = 0; ai < 2; ++ai)
#pragma unroll
            for (int m = 0; m < 4; ++m) { const size_t row = (size_t)(row0 + ai * 128 + m * 16);
#pragma unroll
                for (int bj = 0; bj < 2; ++bj) { const int col = col0 + bj * 128;
                    const u32x4 g = *(const u32x4*)(z + row * ZP + ZGB + col);
                    const float* p = tmp + row * D + col; const f32x4 t0 = *(const f32x4*)p, t1 = *(const f32x4*)(p + 4);
                    const f32x4 v0 = acc[ai][bj][m][0] * (W8_INV / O8_SCALE), v1 = acc[ai][bj][m][1] * (W8_INV / O8_SCALE);
                    f32x4 o0, o1;
                    o0[0] = t0[0] + v0[0] * sigmoidf_(bf_lo(g.x)); o0[1] = t0[1] + v0[1] * sigmoidf_(bf_hi(g.x)); o0[2] = t0[2] + v0[2] * sigmoidf_(bf_lo(g.y)); o0[3] = t0[3] + v0[3] * sigmoidf_(bf_hi(g.y));
                    o1[0] = t1[0] + v1[0] * sigmoidf_(bf_lo(g.z)); o1[1] = t1[1] + v1[1] * sigmoidf_(bf_hi(g.z)); o1[2] = t1[2] + v1[2] * sigmoidf_(bf_lo(g.w)); o1[3] = t1[3] + v1[3] * sigmoidf_(bf_hi(g.w));
                    o0 *= Y8_SCALE; o1 *= Y8_SCALE;
                    u32x2 w; w.x = pk4_fp8(o0[0], o0[1], o0[2], o0[3]); w.y = pk4_fp8(o1[0], o1[1], o1[2], o1[3]);
                    *(u32x2*)(y + row * D + col) = w; } }
    }
};
struct EpiBranchAB {
    static constexpr bool PERM = true;
    static constexpr bool SIGNALS = false;
    static constexpr bool CHAIN = true;
    static constexpr bool ACC_INIT = false;
    const bf16_t* z; unsigned char* y;
    __device__ __forceinline__ void operator()(f32x4 (&acc)[2][2][4][2], const Unit& u, int wr, int wc, int fr, int fq) const {
        const int row0 = u.pm * 256 + wr * 64 + fr, col0 = u.pn * 256 + wc * 32 + 8 * fq;
        if (u.e == 0) {
#pragma unroll
            for (int ai = 0; ai < 2; ++ai) {
                u32x4 ga[4][2], gb[4][2];
#pragma unroll
                for (int m = 0; m < 4; ++m)
#pragma unroll
                    for (int bj = 0; bj < 2; ++bj) { const bf16_t* zp = z + (size_t)(row0 + ai * 128 + m * 16) * ZP + col0 + bj * 128; ga[m][bj] = *(const u32x4*)(zp + ZGA); gb[m][bj] = *(const u32x4*)(zp + ZGB); }
                __builtin_amdgcn_sched_barrier(0);
#pragma unroll
                for (int m = 0; m < 4; ++m)
#pragma unroll
                    for (int bj = 0; bj < 2; ++bj) { const u32x4 a_ = ga[m][bj], b_ = gb[m][bj];
#define RHO(aw, bw, lo) ((O8_SCALE / H8_SCALE) * (1.0f + __expf(-(lo ? bf_lo(bw) : bf_hi(bw)))) * __builtin_amdgcn_rcpf(1.0f + __expf(-(lo ? bf_lo(aw) : bf_hi(aw)))))
                        f32x4 r0, r1;
                        r0[0] = RHO(a_.x, b_.x, 1); r0[1] = RHO(a_.x, b_.x, 0); r0[2] = RHO(a_.y, b_.y, 1); r0[3] = RHO(a_.y, b_.y, 0);
                        r1[0] = RHO(a_.z, b_.z, 1); r1[1] = RHO(a_.z, b_.z, 0); r1[2] = RHO(a_.w, b_.w, 1); r1[3] = RHO(a_.w, b_.w, 0);
#undef RHO
                        acc[ai][bj][m][0] *= r0; acc[ai][bj][m][1] *= r1; }
                __builtin_amdgcn_sched_barrier(0);
            }
        } else {
            u32x4 gb[2][4][2];
#pragma unroll
            for (int ai = 0; ai < 2; ++ai)
#pragma unroll
                for (int m = 0; m < 4; ++m)
#pragma unroll
                    for (int bj = 0; bj < 2; ++bj) gb[ai][m][bj] = *(const u32x4*)(z + (size_t)(row0 + ai * 128 + m * 16) * ZP + ZGB + col0 + bj * 128);
            __builtin_amdgcn_sched_barrier(0);
#pragma unroll
            for (int ai = 0; ai < 2; ++ai)
#pragma unroll
                for (int m = 0; m < 4; ++m) { const size_t row = (size_t)(row0 + ai * 128 + m * 16);
#pragma unroll
                    for (int bj = 0; bj < 2; ++bj) { const int col = col0 + bj * 128;
                        const u32x4 g = gb[ai][m][bj];
                        const f32x4 v0 = acc[ai][bj][m][0] * (W8_INV / O8_SCALE * Y8_SCALE), v1 = acc[ai][bj][m][1] * (W8_INV / O8_SCALE * Y8_SCALE);
                        u32x2 w;
                        w.x = pk4_fp8(v0[0] * sigmoidf_(bf_lo(g.x)), v0[1] * sigmoidf_(bf_hi(g.x)), v0[2] * sigmoidf_(bf_lo(g.y)), v0[3] * sigmoidf_(bf_hi(g.y)));
                        w.y = pk4_fp8(v1[0] * sigmoidf_(bf_lo(g.z)), v1[1] * sigmoidf_(bf_hi(g.z)), v1[2] * sigmoidf_(bf_lo(g.w)), v1[3] * sigmoidf_(bf_hi(g.w)));
                        *(u32x2*)(y + row * D + col) = w; } }
        }
    }
};
struct EpiOut {
    static constexpr bool PERM = false;
    static constexpr bool SIGNALS = false;
    static constexpr bool CHAIN = false;
    static constexpr bool ACC_INIT = false;
    const float* x; const float* modf; bf16_t* x1;
    __device__ __forceinline__ void operator()(const f32x4 (&acc)[2][2][4][2], const Unit& u, int wr, int wc, int fr, int fq) const {
        const int row0 = u.pm * 256 + wr * 64 + fr, col0 = u.pn * 256 + wc * 32 + 4 * fq;
        const float* gt = modf + (size_t)(u.pm >> 3) * (6 * D) + 2 * D;
        f32x4 gv[2][2];
#pragma unroll
        for (int bj = 0; bj < 2; ++bj)
#pragma unroll
            for (int n = 0; n < 2; ++n) gv[bj][n] = *(const f32x4*)(gt + col0 + bj * 128 + n * 16);
#pragma unroll
        for (int ai = 0; ai < 2; ++ai) {
            f32x4 xv[4][2][2];
#pragma unroll
            for (int m = 0; m < 4; ++m)
#pragma unroll
                for (int bj = 0; bj < 2; ++bj)
#pragma unroll
                    for (int n = 0; n < 2; ++n) xv[m][bj][n] = *(const f32x4*)(x + (size_t)(row0 + ai * 128 + m * 16) * D + col0 + bj * 128 + n * 16);
            __builtin_amdgcn_sched_barrier(0);
#pragma unroll
            for (int m = 0; m < 4; ++m) { const size_t off = (size_t)(row0 + ai * 128 + m * 16) * D + col0;
#pragma unroll
                for (int bj = 0; bj < 2; ++bj)
#pragma unroll
                    for (int n = 0; n < 2; ++n) {
                        const f32x4 v = xv[m][bj][n] + gv[bj][n] * (acc[ai][bj][m][n] * (W8_INV / Y8_SCALE));
                        u32x2 o; o.x = pk2(v[0], v[1]); o.y = pk2(v[2], v[3]);
                        *(u32x2*)(x1 + off + bj * 128 + n * 16) = o; } }
            __builtin_amdgcn_sched_barrier(0);
        }
    }
};
template <bool SC1>
struct EpiUpT {
    static constexpr bool PERM = true;
    static constexpr bool CHAIN = false;
    static constexpr bool ACC_INIT = true;
    static constexpr bool SIGNALS = SC1;
    unsigned char* act; const float* b_up; const LAS int* cbase; unsigned* upd;
    __device__ __forceinline__ void operator()(const f32x4 (&acc)[2][2][4][2], const Unit& u, int wr, int wc, int fr, int fq) const {
        const int row0 = cbase[u.e] + u.pm * 256 + wr * 64 + fr, colh = u.pn * 128 + wc * 32 + 8 * fq;
#pragma unroll
        for (int ai = 0; ai < 2; ++ai)
#pragma unroll
            for (int m = 0; m < 4; ++m) {
                const f32x4 g0 = acc[ai][0][m][0], g1 = acc[ai][0][m][1], l0 = acc[ai][1][m][0], l1 = acc[ai][1][m][1];
                constexpr float KE = 1.702f * 1.4426950408889634f * W8_INV, GC = 7.0f * W8_SCALE, OS = W8_INV * W8_INV;
                float o[8];
#pragma unroll
                for (int j = 0; j < 4; ++j) {
                    float g = fminf(g0[j], GC), l = __builtin_amdgcn_fmed3f(l0[j], -GC, GC); o[j] = (g * OS) * __builtin_amdgcn_rcpf(1.0f + __builtin_amdgcn_exp2f(g * -KE)) * (l + W8_SCALE);
                    g = fminf(g1[j], GC); l = __builtin_amdgcn_fmed3f(l1[j], -GC, GC); o[4 + j] = (g * OS) * __builtin_amdgcn_rcpf(1.0f + __builtin_amdgcn_exp2f(g * -KE)) * (l + W8_SCALE); }
                u32x2 w; w.x = pk4_fp8_ns(o[0], o[1], o[2], o[3]); w.y = pk4_fp8_ns(o[4], o[5], o[6], o[7]);
                if (SC1) store8_sc1(act + (size_t)(row0 + ai * 128 + m * 16) * D + colh, w); else *(u32x2*)(act + (size_t)(row0 + ai * 128 + m * 16) * D + colh) = w; }
    }
    __device__ __forceinline__ void acc_bias(const Unit& u, int wc, int fq, f32x4 (&bi)[2][2]) const {
        const float* bg = b_up + (size_t)u.e * (2 * D) + u.pn * 128 + wc * 32 + 8 * fq;
#pragma unroll
        for (int n = 0; n < 2; ++n) { bi[0][n] = *(const f32x4*)(bg + 4 * n) * W8_SCALE; bi[1][n] = *(const f32x4*)(bg + D + 4 * n) * W8_SCALE; }
    }
    __device__ __forceinline__ void signal(const Unit& u, bool first_lane) const { if (first_lane) __hip_atomic_fetch_add(upd + (u.e * 32 + u.pm) * 16, 1u, __ATOMIC_RELAXED, __HIP_MEMORY_SCOPE_AGENT); }
};
typedef EpiUpT<true> EpiUp;
struct EpiDown {
    static constexpr bool PERM = true;
    static constexpr bool SIGNALS = false;
    static constexpr bool CHAIN = false;
    static constexpr bool ACC_INIT = true;
    __device__ __forceinline__ void acc_bias(const Unit& u, int wc, int fq, f32x4 (&bi)[2][2]) const {
        const float* bd = b_dn + (size_t)u.e * D + u.pn * 256 + wc * 32 + 8 * fq;
#pragma unroll
        for (int bj = 0; bj < 2; ++bj)
#pragma unroll
            for (int n = 0; n < 2; ++n) bi[bj][n] = *(const f32x4*)(bd + bj * 128 + 4 * n) * W8_SCALE;
    }
    unsigned char* ydn; const float* b_dn; const float* roww; const LAS int* cbase;
    __device__ __forceinline__ void operator()(const f32x4 (&acc)[2][2][4][2], const Unit& u, int wr, int wc, int fr, int fq) const {
        const int rl = u.pm * 256 + wr * 64 + fr, row0 = cbase[u.e] + rl, col0 = u.pn * 256 + wc * 32 + 8 * fq;
        float wv[2][4];
#pragma unroll
        for (int ai = 0; ai < 2; ++ai)
#pragma unroll
            for (int m = 0; m < 4; ++m) wv[ai][m] = roww[(size_t)u.e * ECAP + rl + ai * 128 + m * 16];
        __builtin_amdgcn_sched_barrier(0);
#pragma unroll
        for (int ai = 0; ai < 2; ++ai)
#pragma unroll
            for (int m = 0; m < 4; ++m) { const float w = wv[ai][m] * YD_SCALE; unsigned char* p = ydn + (size_t)(row0 + ai * 128 + m * 16) * D + col0;
#pragma unroll
                for (int bj = 0; bj < 2; ++bj) {
                    const f32x4 v0 = acc[ai][bj][m][0] * (W8_INV * w), v1 = acc[ai][bj][m][1] * (W8_INV * w);
                    u32x2 o; o.x = pk4_fp8(v0[0], v0[1], v0[2], v0[3]); o.y = pk4_fp8(v1[0], v1[1], v1[2], v1[3]);
                    *(u32x2*)(p + bj * 128) = o; } }
    }
};

#define XB_TMO      128
#define XB_XCNT(j)  (256  + 64 * (j))
#define XB_XSUB(j)  (1280 + 64 * (j))
#define XB_XGEN(j)  (2304 + 64 * (j))
#define XB_TOP      3328
#define XB_TOPGEN   3392
#define XCD_BAR_WORDS 3456
#define XB_SPIN_CAP (1u << 18)
__device__ __forceinline__ unsigned xb_ld(unsigned* p)              { return __hip_atomic_load(p, __ATOMIC_RELAXED, __HIP_MEMORY_SCOPE_AGENT); }
__device__ __forceinline__ unsigned xb_add(unsigned* p, unsigned v) { return __hip_atomic_fetch_add(p, v, __ATOMIC_RELAXED, __HIP_MEMORY_SCOPE_AGENT); }
__device__ __forceinline__ unsigned xb_xcc_id() { return (unsigned)__builtin_amdgcn_s_getreg((3 << 11) | 20) & 0xFu; }
#define XB_SPIN(cond, bar) do { unsigned _sp = 0; while (cond) { __builtin_amdgcn_s_sleep(1); \
    if ((++_sp & 255u) == 0u) { if (xb_ld(&(bar)[XB_TMO])) break; if (_sp > XB_SPIN_CAP) { atomicAdd(&(bar)[XB_TMO], 1u); break; } } } } while (0)
struct XcdBarrier { unsigned* bar; unsigned x; volatile LAS unsigned* st; };
__device__ __forceinline__ XcdBarrier xcd_barrier_post(unsigned* bar, volatile LAS unsigned* st) {
    XcdBarrier b; b.bar = bar; b.x = xb_xcc_id(); b.st = st;
    if (threadIdx.x == 0) (void)xb_add(&bar[XB_XCNT(b.x)], 1u);
    return b;
}
__device__ __forceinline__ void xcd_barrier_complete(unsigned* bar, unsigned x, unsigned& nloc, unsigned& nx) {
    const unsigned G = gridDim.x * gridDim.y * gridDim.z;
    unsigned sum, cnt, mine, sp = 0u;
    for (;;) {
        sum = 0u; cnt = 0u; mine = 0u;
#pragma unroll
        for (unsigned j = 0; j < 16; ++j) { const unsigned c = xb_ld(&bar[XB_XCNT(j)]); sum += c; cnt += (c > 0u) ? 1u : 0u; mine = (j == x) ? c : mine; }
        if (sum == G) break;
        __builtin_amdgcn_s_sleep(1);
        if ((++sp & 255u) == 0u) { if (xb_ld(&bar[XB_TMO])) break; if (sp > XB_SPIN_CAP) { atomicAdd(&bar[XB_TMO], 1u); break; } }
    }
    nloc = mine > 0u ? mine : 1u; nx = cnt > 0u ? cnt : 1u;
}
__device__ __forceinline__ void xcd_barrier(const XcdBarrier& b) {
    asm volatile("s_waitcnt vmcnt(0)" ::: "memory");
    __syncthreads();
    if (threadIdx.x == 0) {
        unsigned* bar = b.bar;
        __builtin_amdgcn_s_waitcnt(0);
        unsigned nloc = b.st[0], nx = b.st[1];
        if (nloc == 0u) { xcd_barrier_complete(bar, b.x, nloc, nx); b.st[0] = nloc; b.st[1] = nx; }
        const unsigned old = xb_add(&bar[XB_XSUB(b.x)], 1u);
        const unsigned gen = old / nloc;
        if (old + 1u == (gen + 1u) * nloc) {
            __builtin_amdgcn_fence(__ATOMIC_RELEASE, "agent");
            asm volatile("s_waitcnt vmcnt(0)" ::: "memory");
            const unsigned og = xb_add(&bar[XB_TOP], 1u);
            const unsigned tg = og / nx;
            if (og + 1u == (tg + 1u) * nx) xb_add(&bar[XB_TOPGEN], 1u);
            else XB_SPIN(xb_ld(&bar[XB_TOPGEN]) == tg, bar);
            __builtin_amdgcn_fence(__ATOMIC_ACQUIRE, "agent");
            xb_add(&bar[XB_XGEN(b.x)], 1u);
            asm volatile("s_waitcnt vmcnt(0)" ::: "memory");
        } else {
            XB_SPIN(xb_ld(&bar[XB_XGEN(b.x)]) == gen, bar);
            __builtin_amdgcn_fence(__ATOMIC_ACQUIRE, "agent");
            asm volatile("s_waitcnt vmcnt(0)" ::: "memory");
        }
    }
    __syncthreads();
}

struct Args { const float* in[21]; float* out; unsigned char* ws; int ph_lo, ph_hi; };
enum { I_X = 0, I_C, I_WADA, I_BADA, I_GMIX, I_WIN, I_BIG, I_BFG, I_GMO, I_GQ, I_GK, I_WBA, I_WBB, I_WOUT, I_GFFN, I_WR, I_BR, I_WUP, I_BUP, I_WDN, I_BDN };

struct Frame {
    LAS unsigned char* lds; unsigned char* ws; unsigned* ctl;
    int tid, lane, wave, G, wg, vcu;
};

__device__ __forceinline__ void p0_mod_partial(Frame& F, const float* c, const float* w_ada, float* modp, int item) {
    const int cg = item % 48, ks = item / 48;
    LAS float* sS = (LAS float*)F.lds;
    LAS float* red = (LAS float*)(F.lds + 8192);
    {
        const int k = F.tid;
#pragma unroll
        for (int b = 0; b < 4; ++b) { const float v = c[b * D + ks * 512 + k]; sS[b * 512 + k] = v * sigmoidf_(v); }
    }
    __syncthreads();
    f32x4 a0 = {0.f, 0.f, 0.f, 0.f}, a1 = a0, a2 = a0, a3 = a0;
    const float* wp = w_ada + (size_t)(ks * 512 + F.wave) * (6 * D) + cg * 256 + 4 * F.lane;
#pragma unroll 8
    for (int i = 0; i < 64; ++i) {
        const f32x4 w = *(const f32x4*)(wp + (size_t)(8 * i) * (6 * D));
        const int kk = F.wave + 8 * i;
        a0 += w * sS[kk]; a1 += w * sS[512 + kk]; a2 += w * sS[1024 + kk]; a3 += w * sS[1536 + kk];
    }
    *(LAS f32x4*)(red + (F.wave * 4 + 0) * 256 + 4 * F.lane) = a0;
    *(LAS f32x4*)(red + (F.wave * 4 + 1) * 256 + 4 * F.lane) = a1;
    *(LAS f32x4*)(red + (F.wave * 4 + 2) * 256 + 4 * F.lane) = a2;
    *(LAS f32x4*)(red + (F.wave * 4 + 3) * 256 + 4 * F.lane) = a3;
    __syncthreads();
#pragma unroll
    for (int r = 0; r < 2; ++r) {
        const int o = F.tid + 512 * r, b = o >> 8, col = o & 255;
        float s = 0.f;
#pragma unroll
        for (int w = 0; w < 8; ++w) s += red[(w * 4 + b) * 256 + col];
        modp[((size_t)ks * 4 + b) * (6 * D) + cg * 256 + col] = s;
    }
    __syncthreads();
}
__device__ __forceinline__ void p0_frag_item(const float* W, int ldw, int col0, bf16_t* dst, int p) {
    const int s = p >> 6, lane = p & 63;
    const float* src = W + (size_t)(32 * s + 8 * (lane >> 4)) * ldw + col0 + (lane & 15);
    u32x4 o; o.x = pk2(src[0], src[ldw]); o.y = pk2(src[2 * (size_t)ldw], src[3 * (size_t)ldw]); o.z = pk2(src[4 * (size_t)ldw], src[5 * (size_t)ldw]); o.w = pk2(src[6 * (size_t)ldw], src[7 * (size_t)ldw]);
    *(u32x4*)(dst + (size_t)p * 8) = o;
}
constexpr int CV_RS = 528, CV_BUF = 128 * CV_RS;
struct CvtItem { const float* src; bf16_t* dst; int K, ldw; };
__device__ __forceinline__ CvtItem cvt_decode(const Args& a, unsigned char* ws, int it) {
    constexpr int N_IN = 0, N_A = 4 * 16, N_O = 8 * 16, N_UP = 8 * 32, N_DN = 8 * 16;
    CvtItem c; int r = it;
    if (r < N_IN) { const int kb = r / 48, nb = r % 48, n0 = nb * 128; c.K = D; c.ldw = DIN; c.src = a.in[I_WIN] + (size_t)(kb * 256) * DIN + n0 + (n0 >= 3072 ? 16 : 0); c.dst = (bf16_t*)(ws + WS_WIN) + (size_t)n0 * D + kb * 256; return c; } r -= N_IN;
    if (r < N_A) { const int kb = r / 16, nb = r % 16; c.K = 1024; c.ldw = D; c.src = a.in[I_WBA] + (size_t)(kb * 256) * D + nb * 128; c.dst = (bf16_t*)(ws + WS_WA) + (size_t)(nb * 128) * 1024 + kb * 256; return c; } r -= N_A;
    if (r < N_A) { const int kb = r / 16, nb = r % 16; c.K = 1024; c.ldw = D; c.src = a.in[I_WBB] + (size_t)(kb * 256) * D + nb * 128; c.dst = (bf16_t*)(ws + WS_WB) + (size_t)(nb * 128) * 1024 + kb * 256; return c; } r -= N_A;
    if (r < N_O) { const int kb = r / 16, nb = r % 16; c.K = D; c.ldw = D; c.src = a.in[I_WOUT] + (size_t)(kb * 256) * D + nb * 128; c.dst = (bf16_t*)(ws + WS_WOUT) + (size_t)(nb * 128) * D + kb * 256; return c; } r -= N_O;
    const int e = r / (N_UP + N_DN); r -= e * (N_UP + N_DN);
    if (r < N_UP) { const int kb = r / 32, nb = r % 32, t = nb >> 1; c.K = D; c.ldw = 2 * D;
        c.src = a.in[I_WUP] + (size_t)e * D * (2 * D) + (size_t)(kb * 256) * (2 * D) + ((nb & 1) ? 2048 + 128 * t : 128 * t);
        c.dst = (bf16_t*)(ws + WS_WUP) + (size_t)e * (2 * D) * D + (size_t)(nb * 128) * D + kb * 256; return c; }
    r -= N_UP; { const int kb = r / 16, nb = r % 16; c.K = D; c.ldw = D; c.src = a.in[I_WDN] + (size_t)e * D * D + (size_t)(kb * 256) * D + nb * 128; c.dst = (bf16_t*)(ws + WS_WDN) + (size_t)e * D * D + (size_t)(nb * 128) * D + kb * 256; }
    return c;
}
constexpr int CVT_DENSE_ITEMS = 2 * 4 * 16 + 8 * 16;
__device__ __forceinline__ CvtItem cvt_decode_moe(const Args& a, unsigned char* ws, int e, int which, int j, int kb) {
    CvtItem c; c.K = D;
    if (which == 0) { const int t = j >> 1; c.ldw = 2 * D;
        c.src = a.in[I_WUP] + (size_t)e * D * (2 * D) + (size_t)(kb * 256) * (2 * D) + ((j & 1) ? 2048 + 128 * t : 128 * t);
        c.dst = (bf16_t*)(ws + WS_WUP) + (size_t)e * (2 * D) * D + (size_t)(j * 128) * D + kb * 256; }
    else { c.ldw = D; c.src = a.in[I_WDN] + (size_t)e * D * D + (size_t)(kb * 256) * D + j * 128; c.dst = (bf16_t*)(ws + WS_WDN) + (size_t)e * D * D + (size_t)(j * 128) * D + kb * 256; }
    return c;
}
__device__ __forceinline__ void cvt_load(const CvtItem& c, f32x4 (&v)[16], int wave, int lane) {
    const float* p = c.src + (size_t)(32 * wave + 16 * (lane >> 5)) * c.ldw + 4 * (lane & 31);
#pragma unroll
    for (int i = 0; i < 16; ++i) v[i] = __builtin_nontemporal_load((const f32x4*)(p + (size_t)i * c.ldw));
}
__device__ __forceinline__ void cvt_to_lds(const f32x4 (&v)[16], LAS unsigned char* buf, int wave, int lane) {
    const int n4 = lane & 31, hh = lane >> 5;
#pragma unroll
    for (int g = 0; g < 2; ++g)
#pragma unroll
        for (int j = 0; j < 4; ++j) {
            u32x4 o; o.x = pk2(v[8 * g + 0][j], v[8 * g + 1][j]); o.y = pk2(v[8 * g + 2][j], v[8 * g + 3][j]); o.z = pk2(v[8 * g + 4][j], v[8 * g + 5][j]); o.w = pk2(v[8 * g + 6][j], v[8 * g + 7][j]);
            *(LAS u32x4*)(buf + (4 * n4 + j) * CV_RS + (4 * wave + 2 * hh + g) * 16) = o; }
}
template <bool SC1>
__device__ __forceinline__ void cvt_store(const CvtItem& c, const LAS unsigned char* buf, int tid) {
#pragma unroll
    for (int i = 0; i < 8; ++i) { const int id = tid + 512 * i, row = id >> 5, ch = id & 31;
        const u32x4 v = *(const LAS u32x4*)(buf + row * CV_RS + ch * 16);
        if (SC1) store16_sc1(c.dst + (size_t)row * c.K + ch * 8, v); else *(u32x4*)(c.dst + (size_t)row * c.K + ch * 8) = v; }
}
template <bool SC1, class Dec>
__device__ __forceinline__ void cvt_stream(Frame& F, const Dec& dec, int first, int n, int step) {
    int it = first;
    if (it >= n) return;
    int tid = threadIdx.x; asm volatile("" : "+v"(tid));
    const int wave = __builtin_amdgcn_readfirstlane(tid >> 6), lane = tid & 63;
    f32x4 v[16];
    CvtItem cur = dec(it);
    cvt_load(cur, v, wave, lane);
    cvt_to_lds(v, F.lds, wave, lane);
    __syncthreads();
#pragma unroll 1
    for (int i = 0;; ++i) {
        const int nx = it + step; const bool has_next = nx < n;
        CvtItem nxt = cur;
        if (has_next) { nxt = dec(nx); cvt_load(nxt, v, wave, lane); }
        cvt_store<SC1>(cur, F.lds + (i & 1) * CV_BUF, tid);
        if (has_next) cvt_to_lds(v, F.lds + ((i + 1) & 1) * CV_BUF, wave, lane);
        __syncthreads();
        if (!has_next) break;
        cur = nxt; it = nx;
    }
}
constexpr int C8_RS = 272, C8_BUF = 128 * C8_RS;
struct Cvt8Item { const float* src; unsigned char* dst; int ldw; };
__device__ __forceinline__ Cvt8Item cvt8_decode(const Args& a, unsigned char* ws, int e, int which, int j, int kb) {
    Cvt8Item c;
    if (which == 0) { const int t = j >> 1; c.ldw = 2 * D;
        c.src = a.in[I_WUP] + (size_t)e * D * (2 * D) + (size_t)(kb * 256) * (2 * D) + ((j & 1) ? 2048 + 128 * t : 128 * t);
        c.dst = ws + WS_WUP + ((size_t)e * (2 * D) + (size_t)(j * 128)) * D + kb * 256; }
    else { c.ldw = D; c.src = a.in[I_WDN] + (size_t)e * D * D + (size_t)(kb * 256) * D + j * 128; c.dst = ws + WS_WDN + ((size_t)e * D + (size_t)(j * 128)) * D + kb * 256; }
    return c;
}
__device__ __forceinline__ void cvt8_load(const Cvt8Item& c, f32x4 (&v)[16], int wave, int lane) {
    const float* p = c.src + (size_t)(32 * wave + 16 * (lane >> 5)) * c.ldw + 4 * (lane & 31);
#pragma unroll
    for (int i = 0; i < 16; ++i) v[i] = __builtin_nontemporal_load((const f32x4*)(p + (size_t)i * c.ldw));
}
__device__ __forceinline__ void cvt8_to_lds(const f32x4 (&v)[16], LAS unsigned char* buf, int wave, int lane) {
    const int n4 = lane & 31, hh = lane >> 5;
#pragma unroll
    for (int j = 0; j < 4; ++j) {
        u32x4 o;
        o.x = pk4_fp8(v[0][j] * W8_SCALE, v[1][j] * W8_SCALE, v[2][j] * W8_SCALE, v[3][j] * W8_SCALE);
        o.y = pk4_fp8(v[4][j] * W8_SCALE, v[5][j] * W8_SCALE, v[6][j] * W8_SCALE, v[7][j] * W8_SCALE);
        o.z = pk4_fp8(v[8][j] * W8_SCALE, v[9][j] * W8_SCALE, v[10][j] * W8_SCALE, v[11][j] * W8_SCALE);
        o.w = pk4_fp8(v[12][j] * W8_SCALE, v[13][j] * W8_SCALE, v[14][j] * W8_SCALE, v[15][j] * W8_SCALE);
        *(LAS u32x4*)(buf + (4 * n4 + j) * C8_RS + (2 * wave + hh) * 16) = o; }
}
__device__ __forceinline__ void cvt8_store(const Cvt8Item& c, const LAS unsigned char* buf, int tid) {
#pragma unroll
    for (int i = 0; i < 4; ++i) { const int id = tid + 512 * i, row = id >> 4, ch = id & 15;
        store16_sc1(c.dst + (size_t)row * D + ch * 16, *(const LAS u32x4*)(buf + row * C8_RS + ch * 16)); }
}
__device__ __forceinline__ void cvt8_store_keep(const Cvt8Item& c, const LAS unsigned char* buf, int tid) {
#pragma unroll
    for (int i = 0; i < 4; ++i) { const int id = tid + 512 * i, row = id >> 4, ch = id & 15;
        *(u32x4*)(c.dst + (size_t)row * D + ch * 16) = *(const LAS u32x4*)(buf + row * C8_RS + ch * 16); }
}
template <bool SC1>
__device__ __forceinline__ void cvt8_store_t(const Cvt8Item& c, const LAS unsigned char* buf, int tid) {
#pragma unroll
    for (int i = 0; i < 4; ++i) { const int id = tid + 512 * i, row = id >> 4, ch = id & 15;
        const u32x4 v = *(const LAS u32x4*)(buf + row * C8_RS + ch * 16);
        if (SC1) store16_sc1(c.dst + (size_t)row * D + ch * 16, v); else __builtin_nontemporal_store(v, (u32x4*)(c.dst + (size_t)row * D + ch * 16)); }
}
__device__ __forceinline__ Cvt8Item cvt8_decode_lin(const Args& a, unsigned char* ws, int idx) {
    const int e = idx / 384; int r = idx - e * 384; int which = 0;
    if (r >= 256) { r -= 256; which = 1; }
    return cvt8_decode(a, ws, e, which, r >> 3, r & 7);
}
__device__ __forceinline__ void cvt8_all(Frame& F, const Args& a, unsigned char* ws) {
    constexpr int N = NE * 384;
    int it = F.vcu;
    if (it >= N) return;
    int tid = threadIdx.x; asm volatile("" : "+v"(tid));
    const int wave = __builtin_amdgcn_readfirstlane(tid >> 6), lane = tid & 63;
    f32x4 v[16];
    Cvt8Item cur = cvt8_decode_lin(a, ws, it);
    cvt8_load(cur, v, wave, lane);
    cvt8_to_lds(v, F.lds, wave, lane);
    __syncthreads();
#pragma unroll 1
    for (int i = 0;; ++i) {
        const int nx = it + F.G; const bool has_next = nx < N;
        Cvt8Item nxt = cur;
        if (has_next) { nxt = cvt8_decode_lin(a, ws, nx); cvt8_load(nxt, v, wave, lane); }
        cvt8_store_t<false>(cur, F.lds + (i & 1) * C8_BUF, tid);
        if (has_next) cvt8_to_lds(v, F.lds + ((i + 1) & 1) * C8_BUF, wave, lane);
        __syncthreads();
        if (!has_next) break;
        cur = nxt; it = nx;
    }
}
__device__ __forceinline__ void cvt8_item(Frame& F, const Args& a, int idx);
template <bool SC1>
__device__ __forceinline__ void cvt8_stream(Frame& F, const Args& a, unsigned char* ws, int e, int which, int j) {
    int tid = threadIdx.x; asm volatile("" : "+v"(tid));
    const int wave = __builtin_amdgcn_readfirstlane(tid >> 6), lane = tid & 63;
    f32x4 va[16], vb[16];
    Cvt8Item c0 = cvt8_decode(a, ws, e, which, j, 0), c1 = cvt8_decode(a, ws, e, which, j, 1);
    cvt8_load(c0, va, wave, lane);
    cvt8_load(c1, vb, wave, lane);
    __builtin_amdgcn_sched_barrier(0);
    cvt8_to_lds(va, F.lds, wave, lane);
    __syncthreads();
#pragma unroll
    for (int k = 0; k < 8; k += 2) {
        Cvt8Item c2 = c0, c3 = c1;
        __builtin_amdgcn_sched_barrier(0);
        if (k + 2 < 8) { c2 = cvt8_decode(a, ws, e, which, j, k + 2); cvt8_load(c2, va, wave, lane); }
        __builtin_amdgcn_sched_barrier(0);
        cvt8_store_t<SC1>(c0, F.lds, tid);
        __builtin_amdgcn_sched_barrier(0);
        cvt8_to_lds(vb, F.lds + C8_BUF, wave, lane);
        __syncthreads();
        __builtin_amdgcn_sched_barrier(0);
        if (k + 3 < 8) { c3 = cvt8_decode(a, ws, e, which, j, k + 3); cvt8_load(c3, vb, wave, lane); }
        __builtin_amdgcn_sched_barrier(0);
        cvt8_store_t<SC1>(c1, F.lds + C8_BUF, tid);
        __builtin_amdgcn_sched_barrier(0);
        if (k + 2 < 8) cvt8_to_lds(va, F.lds, wave, lane);
        __syncthreads();
        c0 = c2; c1 = c3;
    }
}
__device__ __forceinline__ void cvt8_win_sub(Frame& F, const Args& a, int q) {
    int tid = threadIdx.x; asm volatile("" : "+v"(tid));
    const int wave = __builtin_amdgcn_readfirstlane(tid >> 6), lane = tid & 63, j = q >> 3, kb = q & 7;
    Cvt8Item c; c.ldw = DIN; c.src = a.in[I_WIN] + (size_t)(kb * 256) * DIN + j * 128 + (j >= 24 ? 16 : 0); c.dst = F.ws + WS_WIN8 + (size_t)(j * 128) * D + kb * 256;
    f32x4 v[16];
    __syncthreads();
    cvt8_load(c, v, wave, lane);
    cvt8_to_lds(v, F.lds, wave, lane);
    __syncthreads();
    cvt8_store_keep(c, F.lds, tid);
    __syncthreads();
}
__device__ __forceinline__ void cvt8_wout_sub(Frame& F, const Args& a, int q) {
    int tid = threadIdx.x; asm volatile("" : "+v"(tid));
    const int wave = __builtin_amdgcn_readfirstlane(tid >> 6), lane = tid & 63, j = q >> 3, kb = q & 7;
    Cvt8Item c; c.ldw = D; c.src = a.in[I_WOUT] + (size_t)(kb * 256) * D + j * 128; c.dst = F.ws + WS_WOUT8 + (size_t)(j * 128) * D + kb * 256;
    f32x4 v[16];
    __syncthreads();
    cvt8_load(c, v, wave, lane);
    cvt8_to_lds(v, F.lds, wave, lane);
    __syncthreads();
    cvt8_store_keep(c, F.lds, tid);
    __syncthreads();
}
__device__ __forceinline__ void cvt8_wbr_sub(Frame& F, const Args& a, int q) {
    int tid = threadIdx.x; asm volatile("" : "+v"(tid));
    const int wave = __builtin_amdgcn_readfirstlane(tid >> 6), lane = tid & 63, which = q >> 6, j = (q >> 2) & 15, kb = q & 3;
    Cvt8Item c; c.ldw = D; c.src = (which ? a.in[I_WBB] : a.in[I_WBA]) + (size_t)(kb * 256) * D + j * 128; c.dst = F.ws + (which ? WS_WB : WS_WA) + (size_t)(j * 128) * 1024 + kb * 256;
    f32x4 v[16];
    __syncthreads();
    cvt8_load(c, v, wave, lane);
    cvt8_to_lds(v, F.lds, wave, lane);
    __syncthreads();
#pragma unroll
    for (int i = 0; i < 4; ++i) { const int id = tid + 512 * i, row = id >> 4, ch = id & 15;
        *(u32x4*)(c.dst + (size_t)row * 1024 + ch * 16) = *(const LAS u32x4*)(F.lds + row * C8_RS + ch * 16); }
    __syncthreads();
}
__device__ __forceinline__ void cvt8_item(Frame& F, const Args& a, int idx) {
    if (idx < 1024) cvt8_stream<false>(F, a, F.ws, idx >> 5, 0, idx & 31);
    else cvt8_stream<false>(F, a, F.ws, (idx - 1024) >> 4, 1, (idx - 1024) & 15);
}
__device__ __forceinline__ void cvt8_item_signal(Frame& F, const Args& a, int idx, unsigned* upd) {
    const int e = (idx - 1024) >> 4;
    cvt8_stream<true>(F, a, F.ws, e, 1, (idx - 1024) & 15);
    asm volatile("s_waitcnt vmcnt(0)" ::: "memory");
    __syncthreads();
    if (F.tid < 32) __hip_atomic_fetch_add(upd + (e * 32 + F.tid) * 16, 1u, __ATOMIC_RELAXED, __HIP_MEMORY_SCOPE_AGENT);
}
struct DenseDec { const Args* a; unsigned char* ws; __device__ __forceinline__ CvtItem operator()(int it) const { return cvt_decode(*a, ws, it); } };
struct MoeDec { const Args* a; unsigned char* ws; int e, which, j; __device__ __forceinline__ CvtItem operator()(int kb) const { return cvt_decode_moe(*a, ws, e, which, j, kb); } };
__device__ __forceinline__ void p0_prologue(Frame& F, const Args& a) {
    unsigned char* ws = F.ws;
    for (int it = F.wg; it < 192; it += F.G) p0_mod_partial(F, a.in[I_C], a.in[I_WADA], (float*)(ws + WS_MODP), it);
    for (int p = (F.G - 1 - F.wg) * 512 + F.tid; p < 4096 + 8192; p += F.G * 512) {
        if (p < 4096) p0_frag_item(a.in[I_WIN], DIN, GATE_COL, (bf16_t*)(ws + WS_WGF), p);
        else { const int q = p - 4096, ct = q >> 12; p0_frag_item(a.in[I_WR], NE, 16 * ct, (bf16_t*)(ws + WS_WRF) + (size_t)ct * 4096 * 8, q & 4095); }
    }
    __syncthreads();
    for (int q = F.vcu; q < 640; q += F.G) cvt8_win_sub(F, a, q);
    if (F.G != 256) { for (int q = F.G - 1 - F.vcu; q < 256; q += F.G) { if (q < 128) cvt8_wout_sub(F, a, q); else cvt8_wbr_sub(F, a, q - 128); } }
}

constexpr int HL_STRIDE = 4112;
constexpr int HL_BYTES = 32 * HL_STRIDE;
constexpr int PART_OFF = 132096;
constexpr int LOGIT_OFF = PART_OFF + 8192;
constexpr int DST_OFF = LOGIT_OFF + 4096;

__device__ __forceinline__ f32x4 mod4(const float* modp, const float* b_ada, int b, int idx) {
    f32x4 s = *(const f32x4*)(b_ada + idx);
#pragma unroll
    for (int ks = 0; ks < 4; ++ks) s += *(const f32x4*)(modp + ((size_t)ks * 4 + b) * (6 * D) + idx);
    return s;
}
template <bool FROM_PARTIALS>
__device__ __forceinline__ void norm_rows_32(Frame& F, const float* xin, const float* gvec, const float* modsrc, const float* b_ada, int chunk_sh, int rb, bf16_t* gout, unsigned char* gout8 = nullptr) {
    const int b = rb >> 6; int lane = F.lane; asm volatile("" : "+v"(lane));
    f32x4 xa[8], xb[8];
    const float* xr = xin + ((size_t)rb * 32 + 4 * F.wave) * D + 4 * lane;
#pragma unroll
    for (int j = 0; j < 8; ++j) xa[j] = *(const f32x4*)(xr + 256 * j);
#pragma unroll
    for (int j = 0; j < 8; ++j) xb[j] = *(const f32x4*)(xr + D + 256 * j);
    f32x4 xc[8], xd[8];
    if (!FROM_PARTIALS) {
#pragma unroll
        for (int j = 0; j < 8; ++j) xc[j] = *(const f32x4*)(xr + 2 * D + 256 * j);
#pragma unroll
        for (int j = 0; j < 8; ++j) xd[j] = *(const f32x4*)(xr + 3 * D + 256 * j);
    }
    f32x4 gsc[8], shv[8];
#pragma unroll
    for (int j = 0; j < 8; ++j) {
        const int col = 4 * (lane + 64 * j);
        f32x4 sh, sc;
        if (FROM_PARTIALS) { sh = mod4(modsrc, b_ada, b, chunk_sh * D + col); sc = mod4(modsrc, b_ada, b, (chunk_sh + 1) * D + col); }
        else { sh = *(const f32x4*)(modsrc + (size_t)b * (6 * D) + chunk_sh * D + col); sc = *(const f32x4*)(modsrc + (size_t)b * (6 * D) + (chunk_sh + 1) * D + col); }
        const f32x4 g = *(const f32x4*)(gvec + col);
        gsc[j] = g * (sc + 1.0f); shv[j] = sh;
        if (j & 1) __builtin_amdgcn_sched_barrier(0);
    }
#pragma unroll
    for (int i = 0; i < 4; ++i) {
        const int r = 4 * F.wave + i; const size_t row = (size_t)rb * 32 + r;
        f32x4 xv[8]; float ss = 0.f;
#pragma unroll
        for (int j = 0; j < 8; ++j) { xv[j] = FROM_PARTIALS ? ((i & 1) ? xb[j] : xa[j]) : (i == 0 ? xa[j] : i == 1 ? xb[j] : i == 2 ? xc[j] : xd[j]); ss += (xv[j][0] * xv[j][0] + xv[j][1] * xv[j][1]) + (xv[j][2] * xv[j][2] + xv[j][3] * xv[j][3]); }
        if (FROM_PARTIALS && i < 2) {
#pragma unroll
            for (int j = 0; j < 8; ++j) { const f32x4 nx = *(const f32x4*)(xr + (size_t)(i + 2) * D + 256 * j); if (i & 1) xb[j] = nx; else xa[j] = nx; }
        }
        __builtin_amdgcn_sched_barrier(0);
        const float rinv = rsqrtf(wave_sum(ss) * (1.0f / D) + EPS);
        int ls = lane; asm volatile("" : "+v"(ls));
        const size_t so = row * D + 4 * (size_t)ls;
#pragma unroll
        for (int j = 0; j < 8; ++j) {
            const f32x4 hv = xv[j] * rinv * gsc[j] + shv[j];
            u32x2 p; p.x = pk2(hv[0], hv[1]); p.y = pk2(hv[2], hv[3]);
            *(LAS u32x2*)(F.lds + r * HL_STRIDE + 8 * ls + 512 * j) = p;
            if (gout) *(u32x2*)(gout + so + 256 * j) = p;
            if (gout8) *(unsigned*)(gout8 + so + 256 * j) = pk4_fp8(hv[0], hv[1], hv[2], hv[3]);
        }
        __builtin_amdgcn_sched_barrier(0);
    }
}
__device__ __forceinline__ void norm_rows_32_b(Frame& F, const bf16_t* xin, const float* gvec, const float* modsrc, int chunk_sh, int rb) {
    const int b = rb >> 6; int lane = F.lane; asm volatile("" : "+v"(lane));
    u32x2 xr_[4][8];
    const bf16_t* xr = xin + ((size_t)rb * 32 + 4 * F.wave) * D + 4 * lane;
#pragma unroll
    for (int i = 0; i < 4; ++i)
#pragma unroll
        for (int j = 0; j < 8; ++j) xr_[i][j] = *(const u32x2*)(xr + (size_t)i * D + 256 * j);
    f32x4 gsc[8], shv[8];
#pragma unroll
    for (int j = 0; j < 8; ++j) {
        const int col = 4 * (lane + 64 * j);
        const f32x4 sh = *(const f32x4*)(modsrc + (size_t)b * (6 * D) + chunk_sh * D + col), sc = *(const f32x4*)(modsrc + (size_t)b * (6 * D) + (chunk_sh + 1) * D + col);
        const f32x4 g = *(const f32x4*)(gvec + col);
        gsc[j] = g * (sc + 1.0f); shv[j] = sh;
    }
#pragma unroll
    for (int i = 0; i < 4; ++i) {
        const int r = 4 * F.wave + i;
        f32x4 xv[8]; float ss = 0.f;
#pragma unroll
        for (int j = 0; j < 8; ++j) { const u32x2 q = xr_[i][j]; xv[j] = (f32x4){bf_lo(q.x), bf_hi(q.x), bf_lo(q.y), bf_hi(q.y)}; ss += (xv[j][0] * xv[j][0] + xv[j][1] * xv[j][1]) + (xv[j][2] * xv[j][2] + xv[j][3] * xv[j][3]); }
        const float rinv = rsqrtf(wave_sum(ss) * (1.0f / D) + EPS);
#pragma unroll
        for (int j = 0; j < 8; ++j) {
            const f32x4 hv = xv[j] * rinv * gsc[j] + shv[j];
            u32x2 p; p.x = pk2(hv[0], hv[1]); p.y = pk2(hv[2], hv[3]);
            *(LAS u32x2*)(F.lds + r * HL_STRIDE + 8 * lane + 512 * j) = p;
        }
    }
}
__device__ __forceinline__ void p1_rows(Frame& F, const Args& a) {
    unsigned char* ws = F.ws;
    const float* modp = (const float*)(ws + WS_MODP);
    { float* modf = (float*)(ws + WS_MODF);
      for (int i = F.wg * 512 + F.tid; i < NB * 6 * D; i += F.G * 512) { const int b = i / (6 * D), idx = i % (6 * D); float s = a.in[I_BADA][idx];
#pragma unroll
          for (int ks = 0; ks < 4; ++ks) s += modp[((size_t)ks * 4 + b) * (6 * D) + idx];
          modf[i] = s; } }
    if (F.wg == 0 && F.wave == 0) {
        float mq = fmaxf(fabsf(a.in[I_GQ][2 * F.lane]), fabsf(a.in[I_GQ][2 * F.lane + 1])), mk = fmaxf(fabsf(a.in[I_GK][2 * F.lane]), fabsf(a.in[I_GK][2 * F.lane + 1]));
#pragma unroll
        for (int o = 1; o < 64; o <<= 1) { mq = fmaxf(mq, __shfl_xor(mq, o)); mk = fmaxf(mk, __shfl_xor(mk, o)); }
        if (F.lane == 0) ((float*)F.ctl)[CW_MISC] = 16.3223f * 1.01f * mq * mk;
    }
    const bf16_t* wgf = (const bf16_t*)(ws + WS_WGF);
    float* gates = (float*)(ws + WS_GATES);
    LAS float* part = (LAS float*)(F.lds + PART_OFF);
    const int lane = F.lane, l15 = lane & 15, g4 = lane >> 4;
    for (int rb = F.wg; rb < T / 32; rb += F.G) {
        norm_rows_32<true>(F, a.in[I_X], a.in[I_GMIX], modp, a.in[I_BADA], 0, rb, nullptr, ws + WS_HBUF8);
        { const int rg = F.wave & 1, kq = F.wave >> 1; f32x4 acc = {0.f, 0.f, 0.f, 0.f};
          bf16x8 bvv[16];
          __builtin_amdgcn_sched_barrier(0);
          const bf16_t* wq = wgf + ((size_t)(16 * kq) * 64 + lane) * 8; asm volatile("" : "+v"(wq));
#pragma unroll
          for (int s = 0; s < 16; ++s) bvv[s] = *(const bf16x8*)(wq + (size_t)s * 512);
          __syncthreads();
#pragma unroll
          for (int s = 0; s < 16; ++s) { const int ks = 16 * kq + s;
              const bf16x8 av = *(const LAS bf16x8*)(F.lds + (16 * rg + l15) * HL_STRIDE + (32 * ks + 8 * g4) * 2);
              acc = __builtin_amdgcn_mfma_f32_16x16x32_bf16(av, bvv[s], acc, 0, 0, 0); }
#pragma unroll
          for (int r = 0; r < 4; ++r) part[(kq * 2 + rg) * 256 + (4 * g4 + r) * 16 + l15] = acc[r]; }
        __syncthreads();
        { const int rg = F.tid >> 8, rc = F.tid & 255; float s = 0.f;
#pragma unroll
          for (int kq = 0; kq < 4; ++kq) s += part[(kq * 2 + rg) * 256 + rc];
          gates[((size_t)rb * 32 + 16 * rg + (rc >> 4)) * 16 + (rc & 15)] = s; }
        __syncthreads();
    }
}

__device__ __forceinline__ void p3_qknorm(Frame& F, const Args& a) {
    bf16_t* z = (bf16_t*)(F.ws + WS_Z); float* kmean = (float*)(F.ws + WS_KMEAN);
    LAS float* cs = (LAS float*)F.lds;
    const int lane = F.lane;
    for (int u = F.wg; u < 512; u += F.G) {
        const int which = u & 1, h = (u >> 1) & 7, blk = (u >> 4) & 7, b = u >> 7;
        const float* gv = which ? a.in[I_GK] : a.in[I_GQ];
        const float g0 = gv[2 * lane], g1 = gv[2 * lane + 1];
        bf16_t* base = z + ((size_t)b * SEQ + blk * 256 + 32 * F.wave) * ZP + (which ? ZKB : ZQB) + h * 128 + 2 * lane;
        unsigned v[32];
#pragma unroll
        for (int i = 0; i < 32; ++i) v[i] = *(const unsigned*)(base + (size_t)i * ZP);
        float c0 = 0.f, c1 = 0.f;
#pragma unroll
        for (int i = 0; i < 32; ++i) {
            const float f0 = bf_lo(v[i]), f1 = bf_hi(v[i]);
            const float rinv = rsqrtf(wave_sum(f0 * f0 + f1 * f1) * (1.0f / 128.0f) + EPS);
            const float y0 = f0 * rinv * g0, y1 = f1 * rinv * g1;
            *(unsigned*)(base + (size_t)i * ZP) = pk2(y0, y1);
            c0 += y0; c1 += y1;
        }
        if (which) {
            cs[F.wave * 128 + 2 * lane] = c0; cs[F.wave * 128 + 2 * lane + 1] = c1;
            __syncthreads();
            if (F.tid < 128) { float s = 0.f;
#pragma unroll
                for (int w = 0; w < 8; ++w) s += cs[w * 128 + F.tid];
                kmean[(((size_t)b * 8 + h) * 8 + blk) * 128 + F.tid] = s * (1.0f / 256.0f); }
            __syncthreads();
        }
    }
}

__device__ __forceinline__ s16x4 tr16(LAS unsigned char* p) { return __builtin_amdgcn_ds_read_tr16_b64_v4i16((LAS s16x4*)p); }
__device__ __forceinline__ bf16x8 cat8(s16x4 a, s16x4 b) { return (bf16x8){a[0], a[1], a[2], a[3], b[0], b[1], b[2], b[3]}; }
#define MFMA16(a, b, c) __builtin_amdgcn_mfma_f32_16x16x32_bf16((a), (b), (c), 0, 0, 0)

struct ChunkGates { float li, bcs, u, pmx, g, umax; };
__device__ __forceinline__ ChunkGates chunk_gates(float gi_raw, float gf_raw, float bi, float bfg, int lane) {
    ChunkGates G;
    const float ti = __expf((gi_raw + bi) * (2.0f / 15.0f)), tf = __expf((gf_raw + bfg) * (2.0f / 15.0f));
    G.li = 15.0f - 30.0f * __builtin_amdgcn_rcpf(ti + 1.0f);
    const float xf = 15.0f - 30.0f * __builtin_amdgcn_rcpf(tf + 1.0f);
    const float lf = fminf(xf, 0.f) - __logf(1.0f + __expf(-fabsf(xf)));
    float bcs = lf;
#pragma unroll
    for (int o = 1; o < 64; o <<= 1) { const float t = __shfl_up(bcs, o); if (lane >= o) bcs += t; }
    G.bcs = bcs; G.g = __shfl(bcs, 63); G.u = G.li - bcs;
    float pmx = G.u;
#pragma unroll
    for (int o = 1; o < 64; o <<= 1) { const float t = __shfl_up(pmx, o); if (lane >= o) pmx = fmaxf(pmx, t); }
    G.pmx = pmx; G.umax = __shfl(pmx, 63);
    return G;
}
constexpr int ML_QS = 0, ML_KS = 9216, ML_KW = 18432, ML_VS = 27648, ML_SB = 45056, ML_CB = 54272, ML_HO = 72704, ML_FLO = 90112, ML_RS = 144, ML_VR = 272;

struct PassAIn { u32x4 kv, v0, v1; float gi, gf; };
__device__ __forceinline__ PassAIn mlstm_passA_load(Frame& F, int u) {
    const bf16_t* z = (const bf16_t*)(F.ws + WS_Z); const float* gates = (const float*)(F.ws + WS_GATES);
    const int c = u & 31, h = (u >> 5) & 7, b = u >> 8;
    const size_t tok0 = (size_t)b * SEQ + c * 64;
    const int lr = F.tid >> 3, ls = F.tid & 7;
    const bf16_t* zr = z + (tok0 + lr) * ZP;
    PassAIn I;
    I.kv = *(const u32x4*)(zr + ZKA + h * 64 + ls * 8);
    I.v0 = *(const u32x4*)(zr + ZVA + h * 128 + ls * 8); I.v1 = *(const u32x4*)(zr + ZVA + h * 128 + 64 + ls * 8);
    I.gi = gates[(tok0 + F.lane) * 16 + h]; I.gf = gates[(tok0 + F.lane) * 16 + 8 + h];
    return I;
}
__device__ __forceinline__ void mlstm_passA(Frame& F, const Args& a, int u, const PassAIn& I) {
    LAS unsigned char* L = F.lds; LAS float* fl = (LAS float*)(L + ML_FLO);
    float* cloc = (float*)(F.ws + WS_CLOC) + (size_t)u * 8192; float* nloc = (float*)(F.ws + WS_NLOC) + (size_t)u * 64; float* msc = (float*)(F.ws + WS_MSC) + (size_t)u * 4;
    const int tid = F.tid, lane = F.lane, w = F.wave, l15 = lane & 15, g4 = lane >> 4;
    const int h = (u >> 5) & 7;
    const int lr = tid >> 3, ls = tid & 7;
    const u32x4 kv = I.kv, v0 = I.v0, v1 = I.v1;
    __syncthreads();
    if (w == 0) {
        const ChunkGates G = chunk_gates(I.gi, I.gf, a.in[I_BIG][h], a.in[I_BFG][h], lane);
        fl[256 + lane] = __expf(G.u - G.umax);
        if (lane == 0) { msc[0] = G.g + G.umax; msc[1] = G.g; }
    }
    *(LAS u32x4*)(L + ML_VS + lr * ML_VR + ls * 16) = v0; *(LAS u32x4*)(L + ML_VS + lr * ML_VR + 128 + ls * 16) = v1;
    __syncthreads();
    { const float wr_ = fl[256 + lr];
      u32x4 o; o.x = pk2(bf_lo(kv.x) * wr_, bf_hi(kv.x) * wr_); o.y = pk2(bf_lo(kv.y) * wr_, bf_hi(kv.y) * wr_); o.z = pk2(bf_lo(kv.z) * wr_, bf_hi(kv.z) * wr_); o.w = pk2(bf_lo(kv.w) * wr_, bf_hi(kv.w) * wr_);
      *(LAS u32x4*)(L + ML_KW + lr * ML_RS + ls * 16) = o; }
    __syncthreads();
    f32x4 Cacc[4];
#pragma unroll
    for (int et = 0; et < 4; ++et) Cacc[et] = (f32x4){0.f, 0.f, 0.f, 0.f};
#pragma unroll
    for (int ks = 0; ks < 2; ++ks) {
        LAS unsigned char* vp = L + ML_VS + (32 * ks + 8 * g4 + (l15 >> 2)) * ML_VR + (16 * w + 4 * (l15 & 3)) * 2;
        const bf16x8 av = cat8(tr16(vp), tr16(vp + 4 * ML_VR));
#pragma unroll
        for (int et = 0; et < 4; ++et) {
            LAS unsigned char* kp = L + ML_KW + (32 * ks + 8 * g4 + (l15 >> 2)) * ML_RS + (16 * et + 4 * (l15 & 3)) * 2;
            Cacc[et] = MFMA16(av, cat8(tr16(kp), tr16(kp + 4 * ML_RS)), Cacc[et]); } }
#pragma unroll
    for (int et = 0; et < 4; ++et)
#pragma unroll
        for (int r = 0; r < 4; ++r) cloc[(16 * w + 4 * g4 + r) * 64 + 16 * et + l15] = Cacc[et][r];
    { const int e = tid >> 3, part = tid & 7; float sacc = 0.f;
#pragma unroll
      for (int i = 0; i < 8; ++i) sacc += bf1(*(const LAS bf16_t*)(L + ML_KW + (8 * part + i) * ML_RS + e * 2));
      sacc = sum8_(sacc);
      if (part == 0) nloc[e] = sacc; }
}

__device__ __forceinline__ void mlstm_passA4(Frame& F, const Args& a) {
    constexpr int CH = 27648, VS = 0, KW = 17408, FL = 26624;
    const bf16_t* z = (const bf16_t*)(F.ws + WS_Z); const float* gates = (const float*)(F.ws + WS_GATES);
    int tid = F.tid; asm volatile("" : "+v"(tid));
    const int lane = tid & 63, w = F.wave, l15 = lane & 15, g4 = lane >> 4, lr = tid >> 3, ls = tid & 7;
    u32x4 kv[4], v0[4], v1[4]; float gi[4], gf[4];
#pragma unroll
    for (int k = 0; k < 4; ++k) {
        const int u = F.wg + 256 * k, c = u & 31, h = (u >> 5) & 7, b = u >> 8;
        const size_t tok0 = (size_t)b * SEQ + c * 64;
        const bf16_t* zr = z + (tok0 + lr) * ZP;
        kv[k] = *(const u32x4*)(zr + ZKA + h * 64 + ls * 8);
        v0[k] = *(const u32x4*)(zr + ZVA + h * 128 + ls * 8); v1[k] = *(const u32x4*)(zr + ZVA + h * 128 + 64 + ls * 8);
        gi[k] = gates[(tok0 + lane) * 16 + h]; gf[k] = gates[(tok0 + lane) * 16 + 8 + h];
    }
    __syncthreads();
#pragma unroll
    for (int k = 0; k < 4; ++k) {
        const int u = F.wg + 256 * k, h = (u >> 5) & 7;
        LAS unsigned char* L = F.lds + k * CH; LAS float* fl = (LAS float*)(L + FL);
        if (w == k) {
            const ChunkGates G = chunk_gates(gi[k], gf[k], a.in[I_BIG][h], a.in[I_BFG][h], lane);
            fl[lane] = __expf(G.u - G.umax);
            if (lane == 0) { float* msc = (float*)(F.ws + WS_MSC) + (size_t)u * 4; msc[0] = G.g + G.umax; msc[1] = G.g; }
        }
        *(LAS u32x4*)(L + VS + lr * ML_VR + ls * 16) = v0[k]; *(LAS u32x4*)(L + VS + lr * ML_VR + 128 + ls * 16) = v1[k];
    }
    __syncthreads();
#pragma unroll
    for (int k = 0; k < 4; ++k) {
        LAS unsigned char* L = F.lds + k * CH; const LAS float* fl = (const LAS float*)(L + FL);
        const float wr_ = fl[lr]; const u32x4 q = kv[k];
        u32x4 o; o.x = pk2(bf_lo(q.x) * wr_, bf_hi(q.x) * wr_); o.y = pk2(bf_lo(q.y) * wr_, bf_hi(q.y) * wr_); o.z = pk2(bf_lo(q.z) * wr_, bf_hi(q.z) * wr_); o.w = pk2(bf_lo(q.w) * wr_, bf_hi(q.w) * wr_);
        *(LAS u32x4*)(L + KW + lr * ML_RS + ls * 16) = o;
    }
    __syncthreads();
#pragma unroll
    for (int k = 0; k < 4; ++k) {
        const int u = F.wg + 256 * k;
        LAS unsigned char* L = F.lds + k * CH;
        float* cloc = (float*)(F.ws + WS_CLOC) + (size_t)u * 8192; float* nloc = (float*)(F.ws + WS_NLOC) + (size_t)u * 64;
        f32x4 Cacc[4];
#pragma unroll
        for (int et = 0; et < 4; ++et) Cacc[et] = (f32x4){0.f, 0.f, 0.f, 0.f};
#pragma unroll
        for (int ks = 0; ks < 2; ++ks) {
            LAS unsigned char* vp = L + VS + (32 * ks + 8 * g4 + (l15 >> 2)) * ML_VR + (16 * w + 4 * (l15 & 3)) * 2;
            const bf16x8 av = cat8(tr16(vp), tr16(vp + 4 * ML_VR));
#pragma unroll
            for (int et = 0; et < 4; ++et) {
                LAS unsigned char* kp = L + KW + (32 * ks + 8 * g4 + (l15 >> 2)) * ML_RS + (16 * et + 4 * (l15 & 3)) * 2;
                Cacc[et] = MFMA16(av, cat8(tr16(kp), tr16(kp + 4 * ML_RS)), Cacc[et]); } }
#pragma unroll
        for (int et = 0; et < 4; ++et)
#pragma unroll
            for (int r = 0; r < 4; ++r) cloc[(16 * w + 4 * g4 + r) * 64 + 16 * et + l15] = Cacc[et][r];
        { const int e = tid >> 3, part = tid & 7; float sacc = 0.f;
#pragma unroll
          for (int i = 0; i < 8; ++i) sacc += bf1(*(const LAS bf16_t*)(L + KW + (8 * part + i) * ML_RS + e * 2));
          sacc = sum8_(sacc);
          if (part == 0) nloc[e] = sacc; }
    }
}

__device__ __forceinline__ void mlstm_passB(Frame& F, int item) {
    const int bh = item >> 3, slice = item & 7, tid = F.tid;
    const float* cloc = (const float*)(F.ws + WS_CLOC) + (size_t)bh * 32 * 8192 + slice * 1024 + 2 * tid;
    bf16_t* cin = (bf16_t*)(F.ws + WS_CIN) + (size_t)bh * 32 * 8192 + slice * 1024 + 2 * tid;
    const float* nloc = (const float*)(F.ws + WS_NLOC) + (size_t)bh * 32 * 64 + 2 * tid;
    float* nin = (float*)(F.ws + WS_NIN) + (size_t)bh * 32 * 64 + 2 * tid;
    float* msc = (float*)(F.ws + WS_MSC) + (size_t)bh * 32 * 4;
    const bool do_n = (slice == 0) && (tid < 32);
    f32x2 cl[32], nl[32], mg[32];
#pragma unroll
    for (int c = 0; c < 32; ++c) { cl[c] = *(const f32x2*)(cloc + (size_t)c * 8192); nl[c] = do_n ? *(const f32x2*)(nloc + c * 64) : (f32x2){0.f, 0.f}; mg[c] = *(const f32x2*)(msc + c * 4); }
    __builtin_amdgcn_sched_barrier(0);
    float m = 0.f; f32x2 C = {0.f, 0.f}, N = {0.f, 0.f};
#pragma unroll
    for (int c = 0; c < 32; ++c) {
        *(unsigned*)(cin + (size_t)c * 8192) = pk2(C[0], C[1]);
        if (do_n) *(f32x2*)(nin + c * 64) = N;
        if (slice == 0 && tid == 0) msc[c * 4 + 2] = m;
        const float mloc = mg[c][0], g = mg[c][1];
        const float m_new = fmaxf(g + m, mloc), sp = __expf(g + m - m_new), sl = __expf(mloc - m_new);
        C = C * sp + cl[c] * sl; N = N * sp + nl[c] * sl; m = m_new;
    }
}

__device__ __forceinline__ void mlstm_passC(Frame& F, const Args& a, int u) {
    constexpr int QS = ML_QS, KS = ML_KS, VS = ML_VS, SB = ML_SB, CB = ML_CB, HO = ML_HO, RS = ML_RS, VR = ML_VR;
    LAS unsigned char* L = F.lds; LAS float* fl = (LAS float*)(L + ML_FLO);
    const bf16_t* z = (const bf16_t*)(F.ws + WS_Z); const float* gates = (const float*)(F.ws + WS_GATES);
    unsigned char* hm = F.ws + WS_HM;
    int tid = F.tid; asm volatile("" : "+v"(tid));
    const int lane = tid & 63, w = F.wave, l15 = lane & 15, g4 = lane >> 4;
    const int c = u & 31, h = (u >> 5) & 7, b = u >> 8;
    const float* gmo = a.in[I_GMO] + h * 128;
    const size_t tok0 = (size_t)b * SEQ + c * 64;
    const int lr = tid >> 3, ls = tid & 7, jt = w & 3, hf = w >> 2;
    const bf16_t* zr = z + (tok0 + lr) * ZP;
    const u32x4 qv = *(const u32x4*)(zr + ZQA + h * 64 + ls * 8), kv = *(const u32x4*)(zr + ZKA + h * 64 + ls * 8);
    const u32x4 v0 = *(const u32x4*)(zr + ZVA + h * 128 + ls * 8), v1 = *(const u32x4*)(zr + ZVA + h * 128 + 64 + ls * 8);
    const u32x4 oc0 = *(const u32x4*)(zr + ZOA + h * 128 + ls * 16), oc1 = *(const u32x4*)(zr + ZOA + h * 128 + ls * 16 + 8);
    const bf16_t* cin = (const bf16_t*)(F.ws + WS_CIN) + (size_t)u * 8192;
    const u32x4 c0 = *(const u32x4*)(cin + tid * 8), c1 = *(const u32x4*)(cin + 4096 + tid * 8);
    const float* msc = (const float*)(F.ws + WS_MSC) + (size_t)u * 4;
    const float mstate = msc[2], gi_raw = gates[(tok0 + lane) * 16 + h], gf_raw = gates[(tok0 + lane) * 16 + 8 + h], big = a.in[I_BIG][h], bfg = a.in[I_BFG][h];
    const float nin_l = ((const float*)(F.ws + WS_NIN))[(size_t)u * 64 + lane];
    float gmo_r[4];
#pragma unroll
    for (int d4 = 0; d4 < 4; ++d4) gmo_r[d4] = gmo[16 * (4 * hf + d4) + l15];
    __syncthreads();
    if (w == 0) {
        const ChunkGates G = chunk_gates(gi_raw, gf_raw, big, bfg, lane);
        const float M = fmaxf(mstate, G.pmx);
        fl[lane] = -M; fl[64 + lane] = G.u; fl[128 + lane] = __expf(mstate - M); fl[192 + lane] = __expf(-(G.bcs + M));
    }
    if (w == 1) fl[640 + lane] = nin_l;
    *(LAS u32x4*)(L + QS + lr * RS + ls * 16) = qv; *(LAS u32x4*)(L + KS + lr * RS + ls * 16) = kv;
    *(LAS u32x4*)(L + VS + lr * VR + ls * 16) = v0; *(LAS u32x4*)(L + VS + lr * VR + 128 + ls * 16) = v1;
    *(LAS u32x4*)(L + CB + lr * RS + ls * 16) = c0; *(LAS u32x4*)(L + CB + (64 + lr) * RS + ls * 16) = c1;
    __syncthreads();
    { const LAS float* nv = fl + 640 + ls * 8;
      float s = bf_lo(qv.x) * nv[0] + bf_hi(qv.x) * nv[1] + bf_lo(qv.y) * nv[2] + bf_hi(qv.y) * nv[3] + bf_lo(qv.z) * nv[4] + bf_hi(qv.z) * nv[5] + bf_lo(qv.w) * nv[6] + bf_hi(qv.w) * nv[7];
      s = sum8_(s);
      if (ls == 0) fl[320 + lr] = s * 0.125f; }
    { bf16x8 aq[2];
#pragma unroll
      for (int ks = 0; ks < 2; ++ks) aq[ks] = *(const LAS bf16x8*)(L + QS + (16 * jt + l15) * RS + (32 * ks + 8 * g4) * 2);
      float rsum[4] = {0.f, 0.f, 0.f, 0.f};
#pragma unroll
      for (int st2 = 0; st2 < 2; ++st2) { const int st = 2 * hf + st2; f32x4 s = {0.f, 0.f, 0.f, 0.f};
          if (st <= jt) {
#pragma unroll
              for (int ks = 0; ks < 2; ++ks) { const bf16x8 bk = *(const LAS bf16x8*)(L + KS + (16 * st + l15) * RS + (32 * ks + 8 * g4) * 2); s = MFMA16(aq[ks], bk, s); } }
          const int scol = 16 * st + l15; const float cf = fl[64 + scol];
#pragma unroll
          for (int r = 0; r < 4; ++r) { const int j = 16 * jt + 4 * g4 + r;
              const float val = (scol <= j) ? s[r] * 0.125f * __expf(fl[j] + cf) : 0.f; rsum[r] += val;
              *(LAS bf16_t*)(L + SB + j * RS + scol * 2) = f2bf(val); } }
#pragma unroll
      for (int r = 0; r < 4; ++r) { float t = sum16_(rsum[r]);
          if (l15 == 0) fl[384 + hf * 64 + 16 * jt + 4 * g4 + r] = t; } }
    __syncthreads();
    float hv[4][4];
    { bf16x8 as_[2], aq[2];
#pragma unroll
      for (int ks = 0; ks < 2; ++ks) { as_[ks] = *(const LAS bf16x8*)(L + SB + (16 * jt + l15) * RS + (32 * ks + 8 * g4) * 2); aq[ks] = *(const LAS bf16x8*)(L + QS + (16 * jt + l15) * RS + (32 * ks + 8 * g4) * 2); }
      float si[4], dn[4], en[4], ss[4] = {0.f, 0.f, 0.f, 0.f};
#pragma unroll
      for (int r = 0; r < 4; ++r) { const int j = 16 * jt + 4 * g4 + r; si[r] = fl[128 + j]; dn[r] = fl[384 + j] + fl[448 + j] + si[r] * fl[320 + j]; en[r] = fl[192 + j]; si[r] *= 0.125f; }
#pragma unroll
      for (int d4 = 0; d4 < 4; ++d4) { const int dt = 4 * hf + d4; f32x4 nacc = {0.f, 0.f, 0.f, 0.f}, iacc = nacc;
#pragma unroll
          for (int ks = 0; ks < 2; ++ks) {
              LAS unsigned char* vp = L + VS + (32 * ks + 8 * g4 + (l15 >> 2)) * VR + (16 * dt + 4 * (l15 & 3)) * 2;
              nacc = MFMA16(as_[ks], cat8(tr16(vp), tr16(vp + 4 * VR)), nacc);
              const bf16x8 bc = *(const LAS bf16x8*)(L + CB + (16 * dt + l15) * RS + (32 * ks + 8 * g4) * 2);
              iacc = MFMA16(aq[ks], bc, iacc); }
#pragma unroll
          for (int r = 0; r < 4; ++r) { const float num = nacc[r] + si[r] * iacc[r]; const float hvv = num * __builtin_amdgcn_rcpf(fmaxf(fabsf(dn[r]), en[r])); hv[d4][r] = hvv; ss[r] += hvv * hvv; } }
#pragma unroll
      for (int r = 0; r < 4; ++r) { float t = sum16_(ss[r]);
          if (l15 == 0) fl[512 + hf * 64 + 16 * jt + 4 * g4 + r] = t; } }
    __syncthreads();
    { float rinv[4];
#pragma unroll
      for (int r = 0; r < 4; ++r) { const int j = 16 * jt + 4 * g4 + r; rinv[r] = rsqrtf((fl[512 + j] + fl[576 + j]) * (1.0f / 128.0f) + EPS); }
#pragma unroll
      for (int d4 = 0; d4 < 4; ++d4) { const int d = 16 * (4 * hf + d4) + l15; const float gg = gmo_r[d4];
#pragma unroll
          for (int r = 0; r < 4; ++r) *(LAS bf16_t*)(L + HO + (16 * jt + 4 * g4 + r) * VR + d * 2) = f2bf(hv[d4][r] * rinv[r] * gg); } }
    __syncthreads();
    { const u32x4 h0 = *(const LAS u32x4*)(L + HO + lr * VR + ls * 32), h1 = *(const LAS u32x4*)(L + HO + lr * VR + ls * 32 + 16);
#define HG(hw, ow, lo) ((lo ? bf_lo(hw) : bf_hi(hw)) * sigmoidf_(lo ? bf_lo(ow) : bf_hi(ow)) * H8_SCALE)
      u32x4 r;
      r.x = pk4_fp8(HG(h0.x, oc0.x, 1), HG(h0.x, oc0.x, 0), HG(h0.y, oc0.y, 1), HG(h0.y, oc0.y, 0));
      r.y = pk4_fp8(HG(h0.z, oc0.z, 1), HG(h0.z, oc0.z, 0), HG(h0.w, oc0.w, 1), HG(h0.w, oc0.w, 0));
      r.z = pk4_fp8(HG(h1.x, oc1.x, 1), HG(h1.x, oc1.x, 0), HG(h1.y, oc1.y, 1), HG(h1.y, oc1.y, 0));
      r.w = pk4_fp8(HG(h1.z, oc1.z, 1), HG(h1.z, oc1.z, 0), HG(h1.w, oc1.w, 1), HG(h1.w, oc1.w, 0));
#undef HG
      *(u32x4*)(hm + (tok0 + lr) * 1024 + h * 128 + ls * 16) = r; }
}

__device__ __forceinline__ void mlstm_passC2(Frame& F, const Args& a, int ua, int ub) {
    constexpr int QS = 0, KS = 9216, VS = 18432, SB = 35840, CB = 45056, HO = 0, FLO = 63488, CH = 66560, RS = ML_RS, VR = ML_VR;
    const bf16_t* z = (const bf16_t*)(F.ws + WS_Z); const float* gates = (const float*)(F.ws + WS_GATES);
    unsigned char* hm = F.ws + WS_HM;
    int tid = F.tid; asm volatile("" : "+v"(tid));
    const int lane = tid & 63, w = F.wave, l15 = lane & 15, g4 = lane >> 4;
    const int lr = tid >> 3, ls = tid & 7, jt = w & 3, hf = w >> 2;
    u32x4 qv[2], kv[2], v0[2], v1[2], oc0[2], oc1[2], c0[2], c1[2];
    float mstate[2], gi_raw[2], gf_raw[2], big[2], bfg[2], nin_l[2], gmo_r[2][4];
    size_t tok0[2]; int hh[2];
#pragma unroll
    for (int k = 0; k < 2; ++k) {
        const int u = k ? ub : ua, c = u & 31, h = (u >> 5) & 7, b = u >> 8;
        hh[k] = h; tok0[k] = (size_t)b * SEQ + c * 64;
        const bf16_t* zr = z + (tok0[k] + lr) * ZP;
        qv[k] = *(const u32x4*)(zr + ZQA + h * 64 + ls * 8); kv[k] = *(const u32x4*)(zr + ZKA + h * 64 + ls * 8);
        v0[k] = *(const u32x4*)(zr + ZVA + h * 128 + ls * 8); v1[k] = *(const u32x4*)(zr + ZVA + h * 128 + 64 + ls * 8);
        oc0[k] = *(const u32x4*)(zr + ZOA + h * 128 + ls * 16); oc1[k] = *(const u32x4*)(zr + ZOA + h * 128 + ls * 16 + 8);
        const bf16_t* cin = (const bf16_t*)(F.ws + WS_CIN) + (size_t)u * 8192;
        c0[k] = *(const u32x4*)(cin + tid * 8); c1[k] = *(const u32x4*)(cin + 4096 + tid * 8);
        const float* msc = (const float*)(F.ws + WS_MSC) + (size_t)u * 4;
        mstate[k] = msc[2]; gi_raw[k] = gates[(tok0[k] + lane) * 16 + h]; gf_raw[k] = gates[(tok0[k] + lane) * 16 + 8 + h]; big[k] = a.in[I_BIG][h]; bfg[k] = a.in[I_BFG][h];
        nin_l[k] = ((const float*)(F.ws + WS_NIN))[(size_t)u * 64 + lane];
        const float* gmo = a.in[I_GMO] + h * 128;
#pragma unroll
        for (int d4 = 0; d4 < 4; ++d4) gmo_r[k][d4] = gmo[16 * (4 * hf + d4) + l15];
    }
    __syncthreads();
#pragma unroll
    for (int k = 0; k < 2; ++k) {
        LAS unsigned char* L = F.lds + k * CH; LAS float* fl = (LAS float*)(L + FLO);
        if (w == k) {
            const ChunkGates G = chunk_gates(gi_raw[k], gf_raw[k], big[k], bfg[k], lane);
            const float M = fmaxf(mstate[k], G.pmx);
            fl[lane] = -M; fl[64 + lane] = G.u; fl[128 + lane] = __expf(mstate[k] - M); fl[192 + lane] = __expf(-(G.bcs + M));
        }
        if (w == 2 + k) fl[640 + lane] = nin_l[k];
        *(LAS u32x4*)(L + QS + lr * RS + ls * 16) = qv[k]; *(LAS u32x4*)(L + KS + lr * RS + ls * 16) = kv[k];
        *(LAS u32x4*)(L + VS + lr * VR + ls * 16) = v0[k]; *(LAS u32x4*)(L + VS + lr * VR + 128 + ls * 16) = v1[k];
        *(LAS u32x4*)(L + CB + lr * RS + ls * 16) = c0[k]; *(LAS u32x4*)(L + CB + (64 + lr) * RS + ls * 16) = c1[k];
    }
    __syncthreads();
#pragma unroll
    for (int k = 0; k < 2; ++k) {
        LAS unsigned char* L = F.lds + k * CH; LAS float* fl = (LAS float*)(L + FLO);
        { const LAS float* nv = fl + 640 + ls * 8; const u32x4 q = qv[k];
          float s = bf_lo(q.x) * nv[0] + bf_hi(q.x) * nv[1] + bf_lo(q.y) * nv[2] + bf_hi(q.y) * nv[3] + bf_lo(q.z) * nv[4] + bf_hi(q.z) * nv[5] + bf_lo(q.w) * nv[6] + bf_hi(q.w) * nv[7];
          s = sum8_(s);
          if (ls == 0) fl[320 + lr] = s * 0.125f; }
        { bf16x8 aq[2];
#pragma unroll
          for (int ks = 0; ks < 2; ++ks) aq[ks] = *(const LAS bf16x8*)(L + QS + (16 * jt + l15) * RS + (32 * ks + 8 * g4) * 2);
          float rsum[4] = {0.f, 0.f, 0.f, 0.f};
#pragma unroll
          for (int st2 = 0; st2 < 2; ++st2) { const int st = 2 * hf + st2; f32x4 s = {0.f, 0.f, 0.f, 0.f};
              if (st <= jt) {
#pragma unroll
                  for (int ks = 0; ks < 2; ++ks) { const bf16x8 bk = *(const LAS bf16x8*)(L + KS + (16 * st + l15) * RS + (32 * ks + 8 * g4) * 2); s = MFMA16(aq[ks], bk, s); } }
              const int scol = 16 * st + l15; const float cf = fl[64 + scol];
#pragma unroll
              for (int r = 0; r < 4; ++r) { const int j = 16 * jt + 4 * g4 + r;
                  const float val = (scol <= j) ? s[r] * 0.125f * __expf(fl[j] + cf) : 0.f; rsum[r] += val;
                  *(LAS bf16_t*)(L + SB + j * RS + scol * 2) = f2bf(val); } }
#pragma unroll
          for (int r = 0; r < 4; ++r) { float t = sum16_(rsum[r]);
              if (l15 == 0) fl[384 + hf * 64 + 16 * jt + 4 * g4 + r] = t; } }
    }
    __syncthreads();
    float hv[2][4][4];
#pragma unroll
    for (int k = 0; k < 2; ++k) {
        LAS unsigned char* L = F.lds + k * CH; LAS float* fl = (LAS float*)(L + FLO);
        bf16x8 as_[2], aq[2];
#pragma unroll
        for (int ks = 0; ks < 2; ++ks) { as_[ks] = *(const LAS bf16x8*)(L + SB + (16 * jt + l15) * RS + (32 * ks + 8 * g4) * 2); aq[ks] = *(const LAS bf16x8*)(L + QS + (16 * jt + l15) * RS + (32 * ks + 8 * g4) * 2); }
        float si[4], dn[4], en[4], ss[4] = {0.f, 0.f, 0.f, 0.f};
#pragma unroll
        for (int r = 0; r < 4; ++r) { const int j = 16 * jt + 4 * g4 + r; si[r] = fl[128 + j]; dn[r] = fl[384 + j] + fl[448 + j] + si[r] * fl[320 + j]; en[r] = fl[192 + j]; si[r] *= 0.125f; }
#pragma unroll
        for (int d4 = 0; d4 < 4; ++d4) { const int dt = 4 * hf + d4; f32x4 nacc = {0.f, 0.f, 0.f, 0.f}, iacc = nacc;
#pragma unroll
            for (int ks = 0; ks < 2; ++ks) {
                LAS unsigned char* vp = L + VS + (32 * ks + 8 * g4 + (l15 >> 2)) * VR + (16 * dt + 4 * (l15 & 3)) * 2;
                nacc = MFMA16(as_[ks], cat8(tr16(vp), tr16(vp + 4 * VR)), nacc);
                const bf16x8 bc = *(const LAS bf16x8*)(L + CB + (16 * dt + l15) * RS + (32 * ks + 8 * g4) * 2);
                iacc = MFMA16(aq[ks], bc, iacc); }
#pragma unroll
            for (int r = 0; r < 4; ++r) { const float num = nacc[r] + si[r] * iacc[r]; const float hvv = num * __builtin_amdgcn_rcpf(fmaxf(fabsf(dn[r]), en[r])); hv[k][d4][r] = hvv; ss[r] += hvv * hvv; } }
#pragma unroll
        for (int r = 0; r < 4; ++r) { float t = sum16_(ss[r]);
            if (l15 == 0) fl[512 + hf * 64 + 16 * jt + 4 * g4 + r] = t; }
    }
    __syncthreads();
#pragma unroll
    for (int k = 0; k < 2; ++k) {
        LAS unsigned char* L = F.lds + k * CH; LAS float* fl = (LAS float*)(L + FLO);
        float rinv[4];
#pragma unroll
        for (int r = 0; r < 4; ++r) { const int j = 16 * jt + 4 * g4 + r; rinv[r] = rsqrtf((fl[512 + j] + fl[576 + j]) * (1.0f / 128.0f) + EPS); }
#pragma unroll
        for (int d4 = 0; d4 < 4; ++d4) { const int d = 16 * (4 * hf + d4) + l15; const float gg = gmo_r[k][d4];
#pragma unroll
            for (int r = 0; r < 4; ++r) *(LAS bf16_t*)(L + HO + (16 * jt + 4 * g4 + r) * VR + d * 2) = f2bf(hv[k][d4][r] * rinv[r] * gg); }
    }
    __syncthreads();
#pragma unroll
    for (int k = 0; k < 2; ++k) {
        LAS unsigned char* L = F.lds + k * CH;
        const u32x4 h0 = *(const LAS u32x4*)(L + HO + lr * VR + ls * 32), h1 = *(const LAS u32x4*)(L + HO + lr * VR + ls * 32 + 16);
        const u32x4 o0 = oc0[k], o1 = oc1[k];
#define HG(hw, ow, lo) ((lo ? bf_lo(hw) : bf_hi(hw)) * sigmoidf_(lo ? bf_lo(ow) : bf_hi(ow)) * H8_SCALE)
        u32x4 r;
        r.x = pk4_fp8(HG(h0.x, o0.x, 1), HG(h0.x, o0.x, 0), HG(h0.y, o0.y, 1), HG(h0.y, o0.y, 0));
        r.y = pk4_fp8(HG(h0.z, o0.z, 1), HG(h0.z, o0.z, 0), HG(h0.w, o0.w, 1), HG(h0.w, o0.w, 0));
        r.z = pk4_fp8(HG(h1.x, o1.x, 1), HG(h1.x, o1.x, 0), HG(h1.y, o1.y, 1), HG(h1.y, o1.y, 0));
        r.w = pk4_fp8(HG(h1.z, o1.z, 1), HG(h1.z, o1.z, 0), HG(h1.w, o1.w, 1), HG(h1.w, o1.w, 0));
#undef HG
        *(u32x4*)(hm + (tok0[k] + lr) * 1024 + hh[k] * 128 + ls * 16) = r;
    }
}

template <bool FIXED>
__device__ __forceinline__ void moba_unit(Frame& F, const Args& a, int b, int h, int qb, const float B2) {
    constexpr int KT = 0, VT = 34816, KM = 88064, TS = 17408, VR = 272;
    LAS unsigned char* L = F.lds;
    const bf16_t* z = (const bf16_t*)(F.ws + WS_Z);
    const float* kmean = (const float*)(F.ws + WS_KMEAN) + ((size_t)b * 8 + h) * 8 * 128;
    unsigned char* ob = F.ws + WS_OB;
    int tid = F.tid; asm volatile("" : "+v"(tid));
    const int lane = tid & 63, w = F.wave, l15 = lane & 15, g4 = lane >> 4;
    const int q0 = qb * 256, blk = qb, ntile = 4 * qb + 4;
    const size_t tokb = (size_t)b * SEQ;
    __syncthreads();
    if (tid < 256) *(LAS f32x4*)(L + KM + tid * 16) = *(const f32x4*)(kmean + tid * 4);
    bf16x8 qf[2][4];
#pragma unroll
    for (int g = 0; g < 2; ++g) { const bf16_t* qr = z + (tokb + q0 + 32 * w + 16 * g + l15) * ZP + ZQB + h * 128 + 8 * g4;
#pragma unroll
        for (int ks = 0; ks < 4; ++ks) qf[g][ks] = *(const bf16x8*)(qr + 32 * ks); }
    const int key0 = tid >> 4, seg = tid & 15;
    const bf16_t* kbase = z + (tokb + key0) * ZP + ZKB + h * 128 + seg * 8;
    const bf16_t* vbase = z + (tokb + key0) * ZP + ZVB + h * 128 + seg * 8;
    u32x4 kA0 = *(const u32x4*)kbase, kA1 = *(const u32x4*)(kbase + (size_t)32 * ZP), vA0 = *(const u32x4*)vbase, vA1 = *(const u32x4*)(vbase + (size_t)32 * ZP);
    u32x4 kB0 = *(const u32x4*)(kbase + (size_t)64 * ZP), kB1 = *(const u32x4*)(kbase + (size_t)96 * ZP), vB0 = *(const u32x4*)(vbase + (size_t)64 * ZP), vB1 = *(const u32x4*)(vbase + (size_t)96 * ZP);
    __syncthreads();
    unsigned mymask[2];
#pragma unroll
    for (int g = 0; g < 2; ++g) {
        if (blk <= 3) mymask[g] = (1u << blk) - 1u;
        else {
            float gate[7];
#pragma unroll
            for (int n = 0; n < 7; ++n) { float s = 0.f;
                if (n < blk) {
#pragma unroll
                    for (int ks = 0; ks < 4; ++ks) { const LAS float* km = (const LAS float*)(L + KM) + n * 128 + 32 * ks + 8 * g4;
#pragma unroll
                        for (int j = 0; j < 8; ++j) s += bf1((bf16_t)qf[g][ks][j]) * km[j]; }
                    s += __shfl_xor(s, 16); s += __shfl_xor(s, 32); }
                gate[n] = (n < blk) ? s : -3.0e38f; }
            unsigned mm = 0u;
#pragma unroll
            for (int t = 0; t < 3; ++t) { float best = -3.0e38f; int bi = 0;
#pragma unroll
                for (int n = 0; n < 7; ++n) { const bool take = (n < blk) && !((mm >> n) & 1u) && (gate[n] > best); best = take ? gate[n] : best; bi = take ? n : bi; }
                mm |= 1u << bi; }
            mymask[g] = mm;
        }
    }
    f32x4 O[2][8];
#pragma unroll
    for (int g = 0; g < 2; ++g)
#pragma unroll
        for (int dt = 0; dt < 8; ++dt) O[g][dt] = (f32x4){0.f, 0.f, 0.f, 0.f};
    float mrun[2] = {-1.0e30f, -1.0e30f}, lsum[2] = {0.f, 0.f};
    const float SC = 0.08838834764831845f * 1.4426950408889634f;
#pragma unroll 1
    for (int kt2 = 0; kt2 < ntile; kt2 += 2) {
#pragma unroll
      for (int buf = 0; buf < 2; ++buf) {
        const int kt = kt2 + buf;
        { LAS unsigned char* kd = L + KT + buf * TS + key0 * VR + seg * 16; LAS unsigned char* vd = L + VT + buf * TS + key0 * VR + seg * 16;
          const int t2 = (kt + 2 < ntile) ? kt + 2 : ntile - 1;
          const size_t adv = (size_t)t2 * 64 * ZP;
          if (buf == 0) { *(LAS u32x4*)kd = kA0; *(LAS u32x4*)(kd + 32 * VR) = kA1; *(LAS u32x4*)vd = vA0; *(LAS u32x4*)(vd + 32 * VR) = vA1;
              kA0 = *(const u32x4*)(kbase + adv); kA1 = *(const u32x4*)(kbase + adv + (size_t)32 * ZP); vA0 = *(const u32x4*)(vbase + adv); vA1 = *(const u32x4*)(vbase + adv + (size_t)32 * ZP); }
          else { *(LAS u32x4*)kd = kB0; *(LAS u32x4*)(kd + 32 * VR) = kB1; *(LAS u32x4*)vd = vB0; *(LAS u32x4*)(vd + 32 * VR) = vB1;
              kB0 = *(const u32x4*)(kbase + adv); kB1 = *(const u32x4*)(kbase + adv + (size_t)32 * ZP); vB0 = *(const u32x4*)(vbase + adv); vB1 = *(const u32x4*)(vbase + adv + (size_t)32 * ZP); } }
        __syncthreads();
        const int kb = kt >> 2; const bool past = kb < blk;
        const int kmin = 64 * kt;
        int cls[2];
#pragma unroll
        for (int g = 0; g < 2; ++g) { const int qmin = q0 + 32 * w + 16 * g; cls[g] = past ? 1 : ((kmin + 63 <= qmin) ? 1 : ((kmin > qmin + 15) ? 0 : 2)); }
        if ((cls[0] | cls[1]) != 0) {
            f32x4 st[2][4];
#pragma unroll
            for (int nt = 0; nt < 4; ++nt) { st[0][nt] = (f32x4){0.f, 0.f, 0.f, 0.f}; st[1][nt] = st[0][nt];
                bf16x8 bk[4];
#pragma unroll
                for (int ks = 0; ks < 4; ++ks) bk[ks] = *(const LAS bf16x8*)(L + KT + buf * TS + (16 * nt + l15) * VR + (32 * ks + 8 * g4) * 2);
                __builtin_amdgcn_sched_barrier(0);
#pragma unroll
                for (int ks = 0; ks < 4; ++ks) { st[0][nt] = MFMA16(bk[ks], qf[0][ks], st[0][nt]); st[1][nt] = MFMA16(bk[ks], qf[1][ks], st[1][nt]); }
                __builtin_amdgcn_sched_barrier(0); }
            bf16x8 pf[2][2];
#pragma unroll
            for (int g = 0; g < 2; ++g) {
                float pv[4][4]; float mnew = 0.f, alpha = 1.0f;
                if (FIXED) {
                    if (cls[g] == 1) {
                        const bool sel = past ? (((mymask[g] >> kb) & 1u) != 0u) : true;
                        const float nb = sel ? -B2 : -1.0e30f;
#pragma unroll
                        for (int nt = 0; nt < 4; ++nt)
#pragma unroll
                            for (int r = 0; r < 4; ++r) pv[nt][r] = __builtin_amdgcn_exp2f(fmaf(st[g][nt][r], SC, nb));
                    } else if (cls[g] == 2) {
                        const int qpos = q0 + 32 * w + 16 * g + l15;
#pragma unroll
                        for (int nt = 0; nt < 4; ++nt)
#pragma unroll
                            for (int r = 0; r < 4; ++r) { const bool ok = (kmin + 16 * nt + 4 * g4 + r) <= qpos; pv[nt][r] = __builtin_amdgcn_exp2f(ok ? fmaf(st[g][nt][r], SC, -B2) : -1.0e30f); }
                    } else {
#pragma unroll
                        for (int nt = 0; nt < 4; ++nt)
#pragma unroll
                            for (int r = 0; r < 4; ++r) pv[nt][r] = 0.f;
                    }
                } else if (cls[g] == 1) {
                    const bool sel = past ? (((mymask[g] >> kb) & 1u) != 0u) : true;
                    float mx = fmaxf(fmaxf(fmaxf(st[g][0][0], st[g][0][1]), fmaxf(st[g][0][2], st[g][0][3])), fmaxf(fmaxf(st[g][1][0], st[g][1][1]), fmaxf(st[g][1][2], st[g][1][3])));
                    mx = fmaxf(mx, fmaxf(fmaxf(fmaxf(st[g][2][0], st[g][2][1]), fmaxf(st[g][2][2], st[g][2][3])), fmaxf(fmaxf(st[g][3][0], st[g][3][1]), fmaxf(st[g][3][2], st[g][3][3]))));
                    mx = sel ? mx * SC : -1.0e30f;
                    mx = fmaxf(mx, __shfl_xor(mx, 16)); mx = fmaxf(mx, __shfl_xor(mx, 32));
                    mnew = fmaxf(mrun[g], mx); alpha = __builtin_amdgcn_exp2f(mrun[g] - mnew);
                    const float nb = sel ? -mnew : -1.0e30f;
#pragma unroll
                    for (int nt = 0; nt < 4; ++nt)
#pragma unroll
                        for (int r = 0; r < 4; ++r) pv[nt][r] = __builtin_amdgcn_exp2f(fmaf(st[g][nt][r], SC, nb));
                } else if (cls[g] == 2) {
                    const int qpos = q0 + 32 * w + 16 * g + l15; float sv[4][4]; float mx = -1.0e30f;
#pragma unroll
                    for (int nt = 0; nt < 4; ++nt)
#pragma unroll
                        for (int r = 0; r < 4; ++r) { const bool ok = (kmin + 16 * nt + 4 * g4 + r) <= qpos; sv[nt][r] = ok ? st[g][nt][r] * SC : -1.0e30f; mx = fmaxf(mx, sv[nt][r]); }
                    mx = fmaxf(mx, __shfl_xor(mx, 16)); mx = fmaxf(mx, __shfl_xor(mx, 32));
                    mnew = fmaxf(mrun[g], mx); alpha = __builtin_amdgcn_exp2f(mrun[g] - mnew);
#pragma unroll
                    for (int nt = 0; nt < 4; ++nt)
#pragma unroll
                        for (int r = 0; r < 4; ++r) pv[nt][r] = (sv[nt][r] > -1.0e29f) ? __builtin_amdgcn_exp2f(sv[nt][r] - mnew) : 0.f;
                } else {
                    mnew = mrun[g]; alpha = 1.0f;
#pragma unroll
                    for (int nt = 0; nt < 4; ++nt)
#pragma unroll
                        for (int r = 0; r < 4; ++r) pv[nt][r] = 0.f;
                }
                float ps = 0.f;
#pragma unroll
                for (int nt = 0; nt < 4; ++nt) ps += (pv[nt][0] + pv[nt][1]) + (pv[nt][2] + pv[nt][3]);
                if (FIXED) lsum[g] += ps;
                else { mrun[g] = mnew; lsum[g] = lsum[g] * alpha + ps;
#pragma unroll
                    for (int dt = 0; dt < 8; ++dt) O[g][dt] *= alpha; }
#pragma unroll
                for (int k2 = 0; k2 < 2; ++k2) {
                    u32x4 pw4; pw4.x = pk2(pv[2 * k2][0], pv[2 * k2][1]); pw4.y = pk2(pv[2 * k2][2], pv[2 * k2][3]); pw4.z = pk2(pv[2 * k2 + 1][0], pv[2 * k2 + 1][1]); pw4.w = pk2(pv[2 * k2 + 1][2], pv[2 * k2 + 1][3]);
                    pf[g][k2] = __builtin_bit_cast(bf16x8, pw4); }
            }
            bf16x8 vf[2][4];
#define MOBA_VREAD(bq, slot) do { _Pragma("unroll") for (int d = 0; d < 4; ++d) { const int k2_ = (bq) >> 1, dt_ = 4 * ((bq) & 1) + d; \
                LAS unsigned char* vp = L + VT + buf * TS + (32 * k2_ + 4 * g4 + (l15 >> 2)) * VR + (16 * dt_ + 4 * (l15 & 3)) * 2; vf[slot][d] = cat8(tr16(vp), tr16(vp + 16 * VR)); } } while (0)
            MOBA_VREAD(0, 0);
#pragma unroll
            for (int bq = 0; bq < 4; ++bq) {
                if (bq + 1 < 4) MOBA_VREAD(bq + 1, (bq + 1) & 1);
                __builtin_amdgcn_sched_barrier(0);
#pragma unroll
                for (int d = 0; d < 4; ++d) { const int k2 = bq >> 1, dt = 4 * (bq & 1) + d;
                    O[0][dt] = MFMA16(vf[bq & 1][d], pf[0][k2], O[0][dt]); O[1][dt] = MFMA16(vf[bq & 1][d], pf[1][k2], O[1][dt]); }
                __builtin_amdgcn_sched_barrier(0);
            }
#undef MOBA_VREAD
        }
      }
    }
#pragma unroll
    for (int g = 0; g < 2; ++g) { float t = lsum[g]; t += __shfl_xor(t, 16); t += __shfl_xor(t, 32);
      const float inv = O8_SCALE / t; unsigned char* op = ob + (tokb + q0 + 32 * w + 16 * g + l15) * 1024 + h * 128 + 4 * g4;
#pragma unroll
      for (int dt = 0; dt < 8; ++dt) *(unsigned*)(op + 16 * dt) = pk4_fp8(O[g][dt][0] * inv, O[g][dt][1] * inv, O[g][dt][2] * inv, O[g][dt][3] * inv); }
}

__device__ __forceinline__ void p4_mixers(Frame& F, const Args& a, bool with_cvt) {
    LAS int* qslot = (LAS int*)(F.lds + 140032);
    const int total = with_cvt ? 768 + 256 + 256 : 768;
    const float B2 = __builtin_bit_cast(float, __builtin_amdgcn_readfirstlane((int)__hip_atomic_load(F.ctl + CW_MISC, __ATOMIC_RELAXED, __HIP_MEMORY_SCOPE_AGENT)));
    const bool fixed_ok = B2 <= 40.0f;
    for (;;) {
        __syncthreads();
        if (F.tid == 0) *qslot = (int)__hip_atomic_fetch_add(F.ctl + CW_QUEUE, 1u, __ATOMIC_RELAXED, __HIP_MEMORY_SCOPE_AGENT);
        __syncthreads();
        const int idx = *qslot;
        __syncthreads();
        if (idx >= total) break;
        int it = idx;
        if (with_cvt) { const int g = idx / 5, r = idx - 5 * g; if (r == 3) { cvt8_item(F, a, 512 + g); continue; } if (r == 4) { if (g < 128) cvt8_wout_sub(F, a, g); else cvt8_wbr_sub(F, a, g - 128); continue; } it = 3 * g + r; }
        if (it < 256) { if (fixed_ok) moba_unit<true>(F, a, (it & 31) >> 3, it & 7, 7 - (it >> 5), B2); else moba_unit<false>(F, a, (it & 31) >> 3, it & 7, 7 - (it >> 5), B2); }
        else mlstm_passC2(F, a, it - 256, it - 256 + 512);
    }
}

__device__ __forceinline__ void p7_router(Frame& F, const Args& a) {
    unsigned char* ws = F.ws;
    const float* modf = (const float*)(ws + WS_MODF);
    const bf16_t* wrf = (const bf16_t*)(ws + WS_WRF);
    int* toke = (int*)(ws + WS_TOKE); float* tokw = (float*)(ws + WS_TOKW); int* toks = (int*)(ws + WS_TOKS); float* roww = (float*)(ws + WS_ROWW);
    unsigned char* tA = ws + WS_TA;
    LAS float* part = (LAS float*)(F.lds + PART_OFF);
    LAS float* logit = (LAS float*)(F.lds + LOGIT_OFF);
    LAS int* dstl = (LAS int*)(F.lds + DST_OFF);
    LAS int* lcnt = (LAS int*)(F.lds + DST_OFF + 512);
    const int lane = F.lane, l15 = lane & 15, g4 = lane >> 4;
    for (int rb = F.wg; rb < T / 32; rb += F.G) {
        norm_rows_32_b(F, (const bf16_t*)(ws + WS_X1), a.in[I_GFFN], modf, 3, rb);
        { const int rg = F.wave & 1, ct = (F.wave >> 1) & 1, kh = F.wave >> 2; f32x4 acc = {0.f, 0.f, 0.f, 0.f};
          bf16x8 bvv[32];
          __builtin_amdgcn_sched_barrier(0);
          const bf16_t* wq = wrf + ((size_t)ct * 4096 + (size_t)(32 * kh) * 64 + lane) * 8; asm volatile("" : "+v"(wq));
#pragma unroll
          for (int s = 0; s < 32; ++s) bvv[s] = *(const bf16x8*)(wq + (size_t)s * 512);
          __syncthreads();
#pragma unroll
          for (int s = 0; s < 32; ++s) { const int ks = 32 * kh + s;
              const bf16x8 av = *(const LAS bf16x8*)(F.lds + (16 * rg + l15) * HL_STRIDE + (32 * ks + 8 * g4) * 2);
              acc = __builtin_amdgcn_mfma_f32_16x16x32_bf16(av, bvv[s], acc, 0, 0, 0); }
#pragma unroll
          for (int r = 0; r < 4; ++r) part[((kh * 2 + rg) * 2 + ct) * 256 + (4 * g4 + r) * 16 + l15] = acc[r]; }
        __syncthreads();
#pragma unroll
        for (int q = 0; q < 2; ++q) { const int o = F.tid + 512 * q, row = o >> 5, e = o & 31, rg = row >> 4, ct = e >> 4;
            logit[o] = part[((0 * 2 + rg) * 2 + ct) * 256 + (row & 15) * 16 + (e & 15)] + part[((1 * 2 + rg) * 2 + ct) * 256 + (row & 15) * 16 + (e & 15)] + a.in[I_BR][e]; }
        __syncthreads();
        if (F.tid < 32) {
            const int row = F.tid; const size_t tok = (size_t)rb * 32 + row;
            lcnt[row] = 0;
            float v[NE];
#pragma unroll
            for (int e = 0; e < NE; ++e) v[e] = logit[row * NE + e];
            float tv[4]; int ti[4]; unsigned used = 0u;
#pragma unroll
            for (int k = 0; k < 4; ++k) { float best = -3.0e38f; int bi = 0;
#pragma unroll
                for (int e = 0; e < NE; ++e) { const bool take = !((used >> e) & 1u) && (v[e] > best); best = take ? v[e] : best; bi = take ? e : bi; }
                used |= 1u << bi; tv[k] = best; ti[k] = bi; }
            float ex[4], sum = 0.f;
#pragma unroll
            for (int k = 0; k < 4; ++k) { ex[k] = __expf(tv[k] - tv[0]); sum += ex[k]; }
            const float inv = 1.0f / sum;
            int lr[4];
#pragma unroll
            for (int k = 0; k < 4; ++k) lr[k] = __hip_atomic_fetch_add(lcnt + ti[k], 1, __ATOMIC_RELAXED, __HIP_MEMORY_SCOPE_WORKGROUP);
            __builtin_amdgcn_wave_barrier();
            { const int mine = lcnt[row];
              int base = 0; if (mine > 0) base = (int)__hip_atomic_fetch_add(F.ctl + CW_CNT + 64 * row, (unsigned)mine, __ATOMIC_RELAXED, __HIP_MEMORY_SCOPE_AGENT);
              lcnt[32 + row] = base; }
            __builtin_amdgcn_wave_barrier();
#pragma unroll
            for (int k = 0; k < 4; ++k) {
                const int slot = lcnt[32 + ti[k]] + lr[k];
                const float wk = ex[k] * inv;
                toke[tok * 4 + k] = ti[k]; tokw[tok * 4 + k] = wk; toks[tok * 4 + k] = slot;
                roww[(size_t)ti[k] * ECAP + slot] = wk;
                dstl[row * 4 + k] = ti[k] * ECAP + slot;
            }
        }
        __syncthreads();
#pragma unroll 1
        for (int i = 0; i < 4; ++i) { const int r = 4 * F.wave + i;
            u32x4 q8[2];
#pragma unroll
            for (int cidx = 0; cidx < 2; ++cidx) { const int ch = lane + 64 * cidx;
                const u32x4 lo = *(const LAS u32x4*)(F.lds + r * HL_STRIDE + ch * 32), hi = *(const LAS u32x4*)(F.lds + r * HL_STRIDE + ch * 32 + 16);
                q8[cidx].x = pk4_fp8(bf_lo(lo.x), bf_hi(lo.x), bf_lo(lo.y), bf_hi(lo.y)); q8[cidx].y = pk4_fp8(bf_lo(lo.z), bf_hi(lo.z), bf_lo(lo.w), bf_hi(lo.w));
                q8[cidx].z = pk4_fp8(bf_lo(hi.x), bf_hi(hi.x), bf_lo(hi.y), bf_hi(hi.y)); q8[cidx].w = pk4_fp8(bf_lo(hi.z), bf_hi(hi.z), bf_lo(hi.w), bf_hi(hi.w)); }
#pragma unroll
            for (int k = 0; k < 4; ++k) { unsigned char* dp = tA + (size_t)dstl[r * 4 + k] * D;
#pragma unroll
                for (int cidx = 0; cidx < 2; ++cidx) *(u32x4*)(dp + (lane + 64 * cidx) * 16) = q8[cidx]; } }
        __syncthreads();
    }
}

__device__ __forceinline__ void moe_tables(Frame& F) {
    LAS int* tb = (LAS int*)(F.lds + LDS_TABS);
    __syncthreads();
    if (F.wave == 0) {
        const int e = F.lane & 31;
        const int cnt = (int)__hip_atomic_load(F.ctl + CW_CNT + 64 * e, __ATOMIC_RELAXED, __HIP_MEMORY_SCOPE_AGENT);
        const int tl = (cnt + 255) >> 8;
        int inc = tl;
#pragma unroll
        for (int o = 1; o < 32; o <<= 1) { const int t = __shfl_up(inc, o); if (e >= o) inc += t; }
        const int exc = inc - tl;
        if (F.lane < 32) {
            tb[e] = tl; tb[32 + e] = exc * 256; tb[64 + e] = e * ECAP; tb[96 + e] = exc * 16; tb[160 + e] = exc * 8;
            if (e == NE - 1) { tb[96 + NE] = inc * 16; tb[160 + NE] = inc * 8; }
        }
    }
    __syncthreads();
}

__device__ __forceinline__ void p10_combine(Frame& F, const Args& a) {
    unsigned char* ws = F.ws;
    const bf16_t* x1 = (const bf16_t*)(ws + WS_X1); const unsigned char* ydn = ws + WS_YDN; const float* modf = (const float*)(ws + WS_MODF);
    const int* toke = (const int*)(ws + WS_TOKE); const int* toks = (const int*)(ws + WS_TOKS);
    const LAS int* tb = (const LAS int*)(F.lds + LDS_TABS);
    int tz = threadIdx.x; asm volatile("" : "+v"(tz));
    const int gw = F.vcu * 8 + F.wave, NGW = F.G * 8, lane = tz & 63;
    for (int tok = gw; tok < T; tok += NGW) {
        const float* gt = modf + (size_t)(tok >> 11) * (6 * D) + 5 * D;
        const unsigned char* yr[4];
#pragma unroll
        for (int k = 0; k < 4; ++k) yr[k] = ydn + (size_t)(tb[32 + toke[tok * 4 + k]] + toks[tok * 4 + k]) * D;
        u32x2 y[4][4]; u32x4 xq[4]; f32x4 g0[4], g1[4];
#pragma unroll
        for (int j = 0; j < 4; ++j) { const int col = 8 * (lane + 64 * j);
#pragma unroll
            for (int k = 0; k < 4; ++k) y[j][k] = __builtin_nontemporal_load((const u32x2*)(yr[k] + col));
            xq[j] = __builtin_nontemporal_load((const u32x4*)(x1 + (size_t)tok * D + col));
            g0[j] = *(const f32x4*)(gt + col); g1[j] = *(const f32x4*)(gt + col + 4); }
        __builtin_amdgcn_sched_barrier(0);
#pragma unroll
        for (int j = 0; j < 4; ++j) { const int col = 8 * (lane + 64 * j);
            f32x4 s0 = {0.f, 0.f, 0.f, 0.f}, s1 = s0;
#pragma unroll
            for (int k = 0; k < 4; ++k) {
                const f32x2 p0 = __builtin_amdgcn_cvt_pk_f32_fp8((int)y[j][k].x, false), p1 = __builtin_amdgcn_cvt_pk_f32_fp8((int)y[j][k].x, true);
                const f32x2 p2 = __builtin_amdgcn_cvt_pk_f32_fp8((int)y[j][k].y, false), p3 = __builtin_amdgcn_cvt_pk_f32_fp8((int)y[j][k].y, true);
                s0[0] += p0[0]; s0[1] += p0[1]; s0[2] += p1[0]; s0[3] += p1[1]; s1[0] += p2[0]; s1[1] += p2[1]; s1[2] += p3[0]; s1[3] += p3[1]; }
            const size_t o = (size_t)tok * D + col;
            const f32x4 xa = {bf_lo(xq[j].x), bf_hi(xq[j].x), bf_lo(xq[j].y), bf_hi(xq[j].y)}, xb = {bf_lo(xq[j].z), bf_hi(xq[j].z), bf_lo(xq[j].w), bf_hi(xq[j].w)};
            __builtin_nontemporal_store(xa + g0[j] * (s0 * (1.0f / YD_SCALE)), (f32x4*)(a.out + o));
            __builtin_nontemporal_store(xb + g1[j] * (s1 * (1.0f / YD_SCALE)), (f32x4*)(a.out + o + 4)); }
    }
}

__global__ void __launch_bounds__(512, 2) hybrid_fwd(Args args) {
    extern __shared__ __attribute__((aligned(16))) unsigned char lds_raw[];
    Frame F;
    F.lds = (LAS unsigned char*)lds_raw; F.ws = args.ws; F.ctl = (unsigned*)(args.ws + WS_CTL);
    F.tid = threadIdx.x; F.lane = F.tid & 63; F.wave = __builtin_amdgcn_readfirstlane(F.tid >> 6);
    F.G = gridDim.x; F.wg = blockIdx.x; F.vcu = (F.G % 8 == 0) ? (F.wg % 8) * (F.G / 8) + F.wg / 8 : F.wg;
    if (F.tid < 4) ((LAS unsigned*)(F.lds + LDS_XB))[F.tid] = 0u;
    __syncthreads();
    XcdBarrier bar; bar.bar = F.ctl + CW_BAR; bar.x = 0; bar.st = nullptr;
#if !MK_PER_PHASE
    bar = xcd_barrier_post(F.ctl + CW_BAR, (volatile LAS unsigned*)(F.lds + LDS_XB));
#endif
    const int lo = args.ph_lo, hi = args.ph_hi;
#define IN(k) (lo <= (k) && (k) < hi)
#define SEAM(k) do { if (IN(k) && IN((k) + 1)) xcd_barrier(bar); } while (0)
    unsigned char* ws = args.ws;

    if (IN(0)) { p0_prologue(F, args); } SEAM(0);
    if (IN(1)) { p1_rows(F, args); } SEAM(1);
    const bool cv_ok = (F.G == 256);
    if (IN(2)) {
        pg8::DenseOrder S0; S0.init(ws + WS_HBUF8, ws + WS_WIN8, T, ZP, F.G, F.wg);
        EpiZT<true> E{(bf16_t*)(ws + WS_Z), ZP, args.in[I_GQ], args.in[I_GK], (float*)(ws + WS_KMEAN), F.lds + 131072};
        unsigned gaps = 0u;
        if (cv_ok) { int c = F.wg % 15, g0 = 0; while (c >= 5 - g0) { c -= 5 - g0; ++g0; } gaps = (1u << g0) | (1u << (g0 + 1 + c)); }
        int cvn = F.wg * 2;
        if (!cv_ok) { for (int idx = F.wg; idx < 1536; idx += F.G) cvt8_item(F, args, idx); }
        int lo = 0;
#pragma unroll 1
        for (int seg = 0; seg < 3; ++seg) {
            if ((gaps >> lo) & 1u) { cvt8_item(F, args, cvn++); gaps &= ~(1u << lo); }
            int hi = lo + 1; while (hi < 5 && !((gaps >> hi) & 1u)) ++hi;
            if (lo < 5) { pg8::SubOrder<pg8::DenseOrder> S{S0, lo, hi - lo}; pg8::gemm_phase<EpiZT<true>, pg8::SubOrder<pg8::DenseOrder>, true>(F.lds, D / 2, S, E); }
            lo = hi;
        }
        if (gaps & 32u) cvt8_item(F, args, cvn++);
    } SEAM(2);
    if (IN(3) && F.G == 256) { mlstm_passA4(F, args); }
    else if (IN(3)) {
        PassAIn cur = mlstm_passA_load(F, F.wg < 1024 ? F.wg : 0);
        for (int u = F.wg; u < 1024; u += F.G) { const int un = u + F.G; const PassAIn nxt = mlstm_passA_load(F, un < 1024 ? un : u); mlstm_passA(F, args, u, cur); cur = nxt; }
    } SEAM(3);
    if (IN(11)) { for (int it = F.wg; it < 256; it += F.G) mlstm_passB(F, it); }
    if (IN(3) && IN(4)) xcd_barrier(bar);
    if (IN(4)) { p4_mixers(F, args, F.G == 256); } SEAM(4);
    if (IN(5)) {
        if (cv_ok && (F.wg & 1) == 0) cvt8_item(F, args, 768 + F.wg);
        { pg8::PairOrder S; S.d.init(ws + WS_HM, ws + WS_WA, T, D, F.G, F.wg); S.A2 = (const char*)(ws + WS_OB); S.Bt2 = (const char*)(ws + WS_WB);
          EpiBranchAB E{(const bf16_t*)(ws + WS_Z), ws + WS_YBUF8};
          pg8::gemm_phase<EpiBranchAB, pg8::PairOrder, true>(F.lds, 512, S, E); }
        if (cv_ok && (F.wg & 1) == 1) cvt8_item(F, args, 768 + F.wg);
    } SEAM(5);
    if (IN(6)) {
        if (cv_ok && (F.wg & 1) == 0) cvt8_item(F, args, 1024 + F.wg);
        pg8::DenseOrder S; S.init(ws + WS_YBUF8, ws + WS_WOUT8, T, D, F.G, F.wg);
        EpiOut E{args.in[I_X], (const float*)(ws + WS_MODF), (bf16_t*)(ws + WS_X1)};
        pg8::gemm_phase<EpiOut, pg8::DenseOrder, true>(F.lds, D / 2, S, E);
        if (cv_ok && (F.wg & 1) == 1) cvt8_item(F, args, 1024 + F.wg);
    } SEAM(6);
    if (IN(7)) { p7_router(F, args); } SEAM(7);
    if (IN(8)) {
        moe_tables(F);
        const LAS int* tb = (const LAS int*)(F.lds + LDS_TABS);
        pg8::MoeOrder S{(const char*)(ws + WS_TA), (const char*)(ws + WS_WUP), tb, tb + 64, tb + 96, 16, F.G, F.vcu, (size_t)(2 * D) * D, __builtin_amdgcn_readfirstlane(tb[96 + NE]), nullptr, 0u};
        EpiUpT<true> E{ws + WS_ACT, args.in[I_BUP], tb + 32, F.ctl + CW_UPD};
        const int cut = cv_ok ? (F.wg & 7) : 0;
        if (cut > 0) { pg8::SubOrder<pg8::MoeOrder> S1{S, 0, cut}; pg8::gemm_phase<EpiUpT<true>, pg8::SubOrder<pg8::MoeOrder>, true>(F.lds, D / 2, S1, E); }
        if (cv_ok) cvt8_item_signal(F, args, 1280 + F.wg, F.ctl + CW_UPD);
        { pg8::SubOrder<pg8::MoeOrder> S2{S, cut, 1 << 20}; pg8::gemm_phase<EpiUpT<true>, pg8::SubOrder<pg8::MoeOrder>, true>(F.lds, D / 2, S2, E); }
    }
    if (IN(9)) {
        if (!IN(8)) moe_tables(F);
        const LAS int* tb = (const LAS int*)(F.lds + LDS_TABS);
        const int utot = __builtin_amdgcn_readfirstlane(tb[96 + NE]);
        pg8::MoeDepOrder S{(const char*)(ws + WS_ACT), (const char*)(ws + WS_WDN), tb, tb + 32, tb + 160, 8, F.G, (F.vcu - utot % F.G + F.G) % F.G, (size_t)D * D, __builtin_amdgcn_readfirstlane(tb[160 + NE]), F.ctl + CW_UPD, cv_ok ? 16u : 0u};
        EpiDown E{ws + WS_YDN, args.in[I_BDN], (const float*)(ws + WS_ROWW), tb + 32};
        pg8::gemm_phase<EpiDown, pg8::MoeDepOrder, true>(F.lds, D / 2, S, E);
    } SEAM(9);
    if (IN(10)) { if (!IN(8) && !IN(9)) moe_tables(F); p10_combine(F, args); }
#undef IN
#undef SEAM
}

constexpr int N_PHASES = 12;
extern "C" void kernel_launch(void* const* d_in, const int* in_sizes, int n_in, void* d_out, int out_size, void* d_ws, size_t ws_size, hipStream_t stream) {
    static int grid = 0;
    if (grid == 0) {
        if (n_in != 21 || out_size != T * D || ws_size < WS_END) { fprintf(stderr, "kernel_launch: unexpected problem (n_in %d out %d ws %zu)\n", n_in, out_size, ws_size); grid = -1; return; }
        int dev = 0, cus = 0, per_cu = 0;
        if (hipGetDevice(&dev) != hipSuccess || hipDeviceGetAttribute(&cus, hipDeviceAttributeMultiprocessorCount, dev) != hipSuccess) { grid = -1; return; }
        if (hipFuncSetAttribute((const void*)hybrid_fwd, hipFuncAttributeMaxDynamicSharedMemorySize, LDS_BYTES) != hipSuccess) { fprintf(stderr, "kernel_launch: hipFuncSetAttribute failed\n"); grid = -1; return; }
        if (hipOccupancyMaxActiveBlocksPerMultiprocessor(&per_cu, (const void*)hybrid_fwd, 512, LDS_BYTES) != hipSuccess || per_cu < 1) fprintf(stderr, "kernel_launch: occupancy query says %d\n", per_cu);
        (void)hipGetLastError();
        grid = cus;
    }
    if (grid < 0) return;
    if (hipMemsetAsync((char*)d_ws + WS_CTL, 0, CTL_BYTES, stream) != hipSuccess) return;
    Args a{};
    for (int i = 0; i < 21; ++i) a.in[i] = (const float*)d_in[i];
    a.out = (float*)d_out; a.ws = (unsigned char*)d_ws;
#if MK_PER_PHASE
    for (int p = 0; p < N_PHASES; ++p) { a.ph_lo = p; a.ph_hi = p + 1; hipLaunchKernelGGL(hybrid_fwd, dim3(grid), dim3(512), LDS_BYTES, stream, a); }
#else
    a.ph_lo = 0; a.ph_hi = N_PHASES;
    hipLaunchKernelGGL(hybrid_fwd, dim3(grid), dim3(512), LDS_BYTES, stream, a);
#endif
}
```

```cpp
#include <hip/hip_runtime.h>
#include <cstdio>
#include <cstdint>

#ifndef MK_PER_PHASE
#define MK_PER_PHASE 0
#endif

#define LAS __attribute__((address_space(3)))
#define GAS __attribute__((address_space(1)))
typedef unsigned short bf16_t;
typedef short bf16x8 __attribute__((ext_vector_type(8)));
typedef short s16x4 __attribute__((ext_vector_type(4)));
typedef float f32x4 __attribute__((ext_vector_type(4)));
typedef float f32x2 __attribute__((ext_vector_type(2)));
typedef unsigned u32x4 __attribute__((ext_vector_type(4)));
typedef unsigned u32x2 __attribute__((ext_vector_type(2)));
typedef int i32x8 __attribute__((ext_vector_type(8)));
typedef int i32x4 __attribute__((ext_vector_type(4)));

constexpr int D = 2048, NB = 4, SEQ = 2048, T = NB * SEQ;
constexpr int DIN = 10256, ZP = 10240;
constexpr int ZQA = 0, ZKA = 512, ZVA = 1024, ZOA = 2048, ZQB = 3072, ZKB = 4096, ZVB = 5120, ZGA = 6144, ZGB = 8192;
constexpr int GATE_COL = 3072;
constexpr int NE = 32, TOPK = 4, ECAP = 8192, CROWS = 40960;
constexpr float EPS = 1e-6f;

constexpr size_t MiB = 1ull << 20;
constexpr size_t WS_CTL = 0, CTL_BYTES = 1 * MiB;
constexpr size_t WS_MODP = 1 * MiB;
constexpr size_t WS_GATES = 2 * MiB;
constexpr size_t WS_KMEAN = 3 * MiB;
constexpr size_t WS_WGF = 3 * MiB + 512 * 1024;
constexpr size_t WS_WRF = 3 * MiB + 640 * 1024;
constexpr size_t WS_MODF = 4 * MiB;
constexpr size_t WS_TOKE = 5 * MiB;
constexpr size_t WS_TOKW = 5 * MiB + 256 * 1024;
constexpr size_t WS_TOKS = 5 * MiB + 512 * 1024;
constexpr size_t WS_ROWW = 6 * MiB;
constexpr size_t WS_WIN = 8 * MiB;
constexpr size_t WS_WOUT8 = 8 * MiB;
constexpr size_t WS_WA = 48 * MiB, WS_WB = 52 * MiB, WS_WOUT = 56 * MiB;
constexpr size_t WS_HBUF = 64 * MiB;
constexpr size_t WS_YBUF8 = 64 * MiB;
constexpr float Y8_SCALE = 8.0f;
constexpr float YD_SCALE = 16.0f;
constexpr float H8_SCALE = 8.0f, O8_SCALE = 32.0f;
constexpr size_t WS_Z = 96 * MiB;
constexpr size_t WS_HM = 256 * MiB, WS_OB = 272 * MiB;
constexpr size_t WS_TMPF = 288 * MiB;
constexpr size_t WS_YBUF = 352 * MiB;
constexpr size_t WS_X1 = 384 * MiB;
constexpr size_t WS_ACT = 448 * MiB;
constexpr size_t WS_YDN = 608 * MiB;
constexpr size_t WS_CLOC = 928 * MiB;
constexpr size_t WS_CIN = 960 * MiB;
constexpr size_t WS_NLOC = 976 * MiB, WS_NIN = 977 * MiB, WS_MSC = 978 * MiB;
constexpr size_t WS_HBUF8 = 980 * MiB;
constexpr size_t WS_WIN8 = 996 * MiB;
constexpr size_t WS_WUP = 1024 * MiB;
constexpr size_t WS_WDN = 1536 * MiB;
constexpr size_t WS_TA = 2048 * MiB;
constexpr size_t WS_END = 3072 * MiB;
constexpr int CW_BAR = 4096;
constexpr int CW_CNT = 16384;
constexpr int CW_QUEUE = 32768;
constexpr int CW_MISC = 49152;
constexpr int CW_UPD = 65536;
constexpr int CW_MQ = 32768 + 64;
constexpr int CW_CUD = 36864, CW_CDD = 40960, CW_GUD = 45056;

constexpr int LDS_BYTES = 157696;
constexpr int LDS_XB = 157568;
constexpr int LDS_TABS = 147456;

__device__ __forceinline__ float bf_lo(unsigned u) { return __uint_as_float(u << 16); }
__device__ __forceinline__ float bf_hi(unsigned u) { return __uint_as_float(u & 0xffff0000u); }
__device__ __forceinline__ float bf1(bf16_t v) { return __uint_as_float(((unsigned)v) << 16); }
__device__ __forceinline__ unsigned pk2(float lo, float hi) { unsigned r; asm("v_cvt_pk_bf16_f32 %0, %1, %2" : "=v"(r) : "v"(lo), "v"(hi)); return r; }
__device__ __forceinline__ bf16_t f2bf(float f) { return (bf16_t)(pk2(f, 0.f) & 0xffffu); }
__device__ __forceinline__ float wave_sum(float v) {
#pragma unroll
    for (int o = 1; o < 64; o <<= 1) v += __shfl_xor(v, o);
    return v;
}
__device__ __forceinline__ void store16_sc1(void* p, u32x4 v) { asm volatile("global_store_dwordx4 %0, %1, off sc1\n\ts_nop 1" :: "v"(p), "v"(v) : "memory"); }
__device__ __forceinline__ void store8_sc1(void* p, u32x2 v) { asm volatile("global_store_dwordx2 %0, %1, off sc1\n\ts_nop 1" :: "v"(p), "v"(v) : "memory"); }
__device__ __forceinline__ unsigned pk4_fp8(float a, float b, float c, float d) {
    a = __builtin_amdgcn_fmed3f(a, -448.0f, 448.0f); b = __builtin_amdgcn_fmed3f(b, -448.0f, 448.0f); c = __builtin_amdgcn_fmed3f(c, -448.0f, 448.0f); d = __builtin_amdgcn_fmed3f(d, -448.0f, 448.0f);
    int r = __builtin_amdgcn_cvt_pk_fp8_f32(a, b, 0, false); r = __builtin_amdgcn_cvt_pk_fp8_f32(c, d, r, true); return (unsigned)r; }
__device__ __forceinline__ unsigned pk4_fp8_ns(float a, float b, float c, float d) { int r = __builtin_amdgcn_cvt_pk_fp8_f32(a, b, 0, false); r = __builtin_amdgcn_cvt_pk_fp8_f32(c, d, r, true); return (unsigned)r; }
constexpr float W8_SCALE = 256.0f, W8_INV = 1.0f / 256.0f;
__device__ __forceinline__ float sigmoidf_(float x) { return __builtin_amdgcn_rcpf(1.f + __expf(-x)); }
#define DPP_ADD(t, CTRL) ((t) + __builtin_bit_cast(float, __builtin_amdgcn_update_dpp(0, __builtin_bit_cast(int, (t)), (CTRL), 0xf, 0xf, false)))
__device__ __forceinline__ float sum8_(float t) { t = DPP_ADD(t, 0xB1); t = DPP_ADD(t, 0x4E); t = DPP_ADD(t, 0x141); return t; }
__device__ __forceinline__ float sum16_(float t) { t = sum8_(t); t = DPP_ADD(t, 0x140); return t; }

namespace pg8 {
constexpr int BM = 256, BK = 64, HALF = 128, HTB = HALF * BK * 2, STAGE_BYTES = 8 * HTB, NXCD = 8, WGM = 8;
__host__ __device__ __forceinline__ int lds_byte(int r, int c) { const int st = (r >> 4) * 2 + (c >> 5), rr = r & 15, cc = c & 31, ob = rr * 64 + cc * 2; return st * 1024 + (ob ^ (((ob >> 9) & 1) << 5)); }
__host__ __device__ __forceinline__ void stage_rc(int b, int& R, int& C) { const int st = b / 1024, sb = b % 1024, swz = sb ^ (((sb >> 9) & 1) << 5); R = (st >> 1) * 16 + swz / 64; C = (st & 1) * 32 + (swz % 64) / 2; }
__host__ __device__ __forceinline__ int perm32(int rho) { const int n = rho >> 4, i = rho & 15; return 8 * (i >> 2) + 4 * n + (i & 3); }

struct Unit { int pm, pn, e; };

struct DenseOrder {
    static constexpr bool HAS_DEP = false;
    const char* A; const char* Bt; int nM, nN, nwg, G, c;
    __device__ void init(const void* A_, const void* Bt_, int M, int N, int G_, int c_) { A = (const char*)A_; Bt = (const char*)Bt_; nM = M / BM; nN = N / BM; nwg = nM * nN; G = G_; c = c_; }
    __device__ bool next(int i, Unit& u) const {
        const long L = (long)i * G + c; if (L >= nwg) return false;
        int wgid = (int)L; { const int q = nwg / NXCD, r = nwg % NXCD, xcd = wgid % NXCD, off = wgid / NXCD; wgid = (xcd < r ? xcd * (q + 1) : r * (q + 1) + (xcd - r) * q) + off; }
        const int nig = WGM * nN, gid = wgid / nig, fm = gid * WGM, gsz = (nM - fm) < WGM ? (nM - fm) : WGM;
        u.pm = fm + ((wgid % nig) % gsz); u.pn = (wgid % nig) / gsz; u.e = 0; return true;
    }
    __device__ __forceinline__ const char* a_ptr(const Unit& u, size_t tstep) const { return A + (size_t)u.pm * tstep; }
    __device__ __forceinline__ const char* b_ptr(const Unit& u, size_t tstep) const { return Bt + (size_t)u.pn * tstep; }
};

constexpr unsigned DEP_NEED = 16u;
template <bool DEP>
struct MoeOrderT {
    static constexpr bool HAS_DEP = DEP;
    const char* A; const char* Bt; const LAS int* tiles; const LAS int* arow; const LAS int* ub; int nN, G, c; size_t estepB; int total; unsigned* dep; unsigned need_hi;
    __device__ bool next(int i, Unit& u) const {
        const int L = i * G + c; if (L >= total) return false;
        unsigned zz = 0u; asm volatile("" : "+v"(zz));
        const int ln = (int)__builtin_amdgcn_mbcnt_hi(~0u, __builtin_amdgcn_mbcnt_lo(~0u, zz));
        const int ubv = ub[(ln < NE ? ln : NE - 1) + 1];
        const int e = __builtin_popcountll(__ballot(ln < NE && L >= ubv));
        const int r = L - __builtin_amdgcn_readfirstlane(ub[e]), te = __builtin_amdgcn_readfirstlane(tiles[e]);
        u.e = e; u.pm = r % te; u.pn = r / te; return true;
    }
    __device__ __forceinline__ unsigned dep_issue(int i) const {
        Unit u; if (!next(i, u)) return 0xffffffffu;
        return __hip_atomic_load(dep + (u.e * 32 + u.pm) * 16, __ATOMIC_RELAXED, __HIP_MEMORY_SCOPE_AGENT);
    }
    __device__ __forceinline__ void dep_confirm(const Unit& u, unsigned v) const {
        const unsigned* ctr = dep + (u.e * 32 + u.pm) * 16;
        const unsigned need = DEP_NEED + (u.e >= 16 ? need_hi : 0u);
        while ((unsigned)__builtin_amdgcn_readfirstlane((int)v) < need) { __builtin_amdgcn_s_sleep(2); v = __hip_atomic_load(ctr, __ATOMIC_RELAXED, __HIP_MEMORY_SCOPE_AGENT); }
        asm volatile("" ::: "memory");
    }
    __device__ __forceinline__ const char* a_ptr(const Unit& u, size_t tstep) const { return A + ((size_t)arow[u.e] / 256 + (size_t)u.pm) * tstep; }
    __device__ __forceinline__ const char* b_ptr(const Unit& u, size_t tstep) const { return Bt + (size_t)u.e * estepB + (size_t)u.pn * tstep; }
};
typedef MoeOrderT<false> MoeOrder;
typedef MoeOrderT<true> MoeDepOrder;

template <class Base> struct SubOrder {
    static constexpr bool HAS_DEP = false;
    Base b; int i0, n;
    __device__ bool next(int i, Unit& u) const { if (i >= n) return false; return b.next(i0 + i, u); }
    __device__ __forceinline__ const char* a_ptr(const Unit& u, size_t tstep) const { return b.a_ptr(u, tstep); }
    __device__ __forceinline__ const char* b_ptr(const Unit& u, size_t tstep) const { return b.b_ptr(u, tstep); }
};
struct OneUnit {
    static constexpr bool HAS_DEP = false;
    const char* A; const char* Bt; Unit u;
    __device__ bool next(int i, Unit& o) const { if (i > 0) return false; o = u; return true; }
    __device__ __forceinline__ const char* a_ptr(const Unit&, size_t) const { return A; }
    __device__ __forceinline__ const char* b_ptr(const Unit&, size_t) const { return Bt; }
};

struct PairOrder {
    static constexpr bool HAS_DEP = false;
    DenseOrder d; const char* A2; const char* Bt2;
    __device__ bool next(int i, Unit& u) const { if (!d.next(i >> 1, u)) return false; u.e = i & 1; return true; }
    __device__ __forceinline__ const char* a_ptr(const Unit& u, size_t tstep) const { return (u.e ? A2 : d.A) + (size_t)u.pm * tstep; }
    __device__ __forceinline__ const char* b_ptr(const Unit& u, size_t tstep) const { return (u.e ? Bt2 : d.Bt) + (size_t)u.pn * tstep; }
};

template <class Epi, class Sched, bool FP8 = false>
__device__ __forceinline__ void gemm_phase(LAS unsigned char* lds, const int K, const Sched& S, const Epi& E) {
    int tid = threadIdx.x; asm volatile("" : "+v"(tid));
    const int wid = __builtin_amdgcn_readfirstlane(tid >> 6), lane = tid & 63, wr = wid >> 2, wc = wid & 3, fr = lane & 15, fq = lane >> 4;
    const int nt = K / BK;
    unsigned voffA, voffB;
    { int R, C; stage_rc(tid * 16, R, C); const int Rb = Epi::PERM ? ((R & ~31) + perm32(R & 31)) : R;
      voffA = (unsigned)(R * K + C) * 2u; voffB = (unsigned)(Rb * K + C) * 2u; }
    const size_t pstep = (size_t)64 * K * 2;
    const size_t kstep = (size_t)(BK * 2);
    const size_t hstep = (size_t)HALF * K * 2;
    const size_t tstep = 2 * hstep;
    const unsigned ldsw = (unsigned)wid * 1024u;
    int lanex;
    { unsigned _z = 0u; asm volatile("" : "+v"(_z)); const int _ln = (int)__builtin_amdgcn_mbcnt_hi(~0u, __builtin_amdgcn_mbcnt_lo(~0u, _z)); lanex = lds_byte(_ln & 15, (_ln >> 4) * 8); }
#define PG8_LANE_OFFS asm volatile("" : "+v"(lanex)); const int aoff = lanex + wr * 8192, boff = lanex + wc * 4096; (void)aoff; (void)boff
#define PG8_SA(b, h) (((b) * 2 + (h)) * HTB)
#define PG8_SB(b, h) ((4 + (b) * 2 + (h)) * HTB)
#define PG8_STAGE(bufoff, gbase, voff) do { asm volatile("" : "+v"(voff)); _Pragma("unroll") for (int _i = 0; _i < 2; ++_i) \
        __builtin_amdgcn_global_load_lds((const unsigned*)((const char*)(gbase) + _i * pstep + (voff)), (LAS unsigned*)(lds + (bufoff) + ldsw + _i * 8192), 16, 0, 0); } while (0)
#define PG8_LDA(dst, b, h) do { _Pragma("unroll") for (int m = 0; m < 4; ++m) { const i32x4 _l = *(const LAS i32x4*)(lds + PG8_SA(b, h) + aoff + m * 2048), _h = *(const LAS i32x4*)(lds + PG8_SA(b, h) + aoff + m * 2048 + 1024); \
        dst[m] = __builtin_shufflevector(_l, _h, 0, 1, 2, 3, 4, 5, 6, 7); } } while (0)
#define PG8_LDB(dst, b, h) do { _Pragma("unroll") for (int n = 0; n < 2; ++n) { const i32x4 _l = *(const LAS i32x4*)(lds + PG8_SB(b, h) + boff + n * 2048), _h = *(const LAS i32x4*)(lds + PG8_SB(b, h) + boff + n * 2048 + 1024); \
        dst[n] = __builtin_shufflevector(_l, _h, 0, 1, 2, 3, 4, 5, 6, 7); } } while (0)
#define PG8_LO(x) __builtin_bit_cast(bf16x8, __builtin_shufflevector((x), (x), 0, 1, 2, 3))
#define PG8_HI(x) __builtin_bit_cast(bf16x8, __builtin_shufflevector((x), (x), 4, 5, 6, 7))
#define PG8_MMA(ai, bj, At, Bt) do { __builtin_amdgcn_s_setprio(1); \
        if constexpr (FP8) { _Pragma("unroll") for (int m = 0; m < 4; ++m) _Pragma("unroll") for (int n = 0; n < 2; ++n) \
            acc[ai][bj][m][n] = __builtin_amdgcn_mfma_scale_f32_16x16x128_f8f6f4(Bt[n], At[m], acc[ai][bj][m][n], 0, 0, 0, 0x7f7f7f7f, 0, 0x7f7f7f7f); } \
        else { _Pragma("unroll") for (int m = 0; m < 4; ++m) _Pragma("unroll") for (int n = 0; n < 2; ++n) { \
            acc[ai][bj][m][n] = __builtin_amdgcn_mfma_f32_16x16x32_bf16(PG8_LO(Bt[n]), PG8_LO(At[m]), acc[ai][bj][m][n], 0, 0, 0); \
            acc[ai][bj][m][n] = __builtin_amdgcn_mfma_f32_16x16x32_bf16(PG8_HI(Bt[n]), PG8_HI(At[m]), acc[ai][bj][m][n], 0, 0, 0); } } \
        __builtin_amdgcn_s_setprio(0); } while (0)
#define PG8_WAIT_V(n) asm volatile("s_waitcnt vmcnt(" #n ")" ::: "memory")
#define PG8_WAIT_L(n) asm volatile("s_waitcnt lgkmcnt(" #n ")" ::: "memory")
#define PG8_BAR __builtin_amdgcn_s_barrier()
#define PG8_SCHED __builtin_amdgcn_sched_barrier(0)
    Unit cur, nxt, prv; int ui = 0; prv.pm = prv.pn = prv.e = 0; (void)prv;
    if (!S.next(0, cur)) return;
    unsigned depv = 0u; (void)depv;
    if constexpr (Sched::HAS_DEP) { S.dep_confirm(cur, S.dep_issue(0)); depv = S.dep_issue(1); }
    f32x4 acc[2][2][4][2];
#define PG8_ACC_INIT(U) do { f32x4 _bi[2][2]; \
        if constexpr (Epi::ACC_INIT) { unsigned _zz = 0u; asm volatile("" : "+v"(_zz)); const int _ln = (int)__builtin_amdgcn_mbcnt_hi(~0u, __builtin_amdgcn_mbcnt_lo(~0u, _zz)); E.acc_bias((U), wc, _ln >> 4, _bi); } \
        else { _bi[0][0] = (f32x4){0.f, 0.f, 0.f, 0.f}; _bi[0][1] = _bi[0][0]; _bi[1][0] = _bi[0][0]; _bi[1][1] = _bi[0][0]; } \
        _Pragma("unroll") for (int a = 0; a < 2; ++a) _Pragma("unroll") for (int b = 0; b < 2; ++b) _Pragma("unroll") for (int m = 0; m < 4; ++m) _Pragma("unroll") for (int n = 0; n < 2; ++n) acc[a][b][m][n] = _bi[b][n]; } while (0)
    PG8_ACC_INIT(cur);
    i32x8 At[4], B0[2], B1[2];
    const char* cA = S.a_ptr(cur, tstep); const char* cB = S.b_ptr(cur, tstep);
    PG8_STAGE(PG8_SB(0, 0), cB, voffB); PG8_STAGE(PG8_SB(0, 1), cB + hstep, voffB); PG8_STAGE(PG8_SA(0, 0), cA, voffA); PG8_STAGE(PG8_SA(0, 1), cA + hstep, voffA);
    if (wr == 1) PG8_BAR;
    PG8_WAIT_V(2); PG8_BAR;
    PG8_STAGE(PG8_SB(1, 0), cB + kstep, voffB); PG8_STAGE(PG8_SA(1, 0), cA + kstep, voffA); PG8_STAGE(PG8_SB(1, 1), cB + hstep + kstep, voffB);
    PG8_WAIT_V(6); PG8_BAR;
    for (;;) {
        const bool has_next = S.next(ui + 1, nxt);
        if constexpr (Sched::HAS_DEP) { if (has_next) S.dep_confirm(nxt, depv); }
        const char* nA = has_next ? S.a_ptr(nxt, tstep) : cA; const char* nB = has_next ? S.b_ptr(nxt, tstep) : cB;
#pragma unroll 1
        for (int t = 0; t < nt; t += 2) {
            const bool last = (t == nt - 2);
            const char* a1 = cA + (size_t)(t + 1) * kstep;
            const char* a2 = last ? nA : cA + (size_t)(t + 2) * kstep; const char* b2 = last ? nB : cB + (size_t)(t + 2) * kstep;
            const char* a3 = a2 + kstep; const char* b3 = b2 + kstep;
            { PG8_LANE_OFFS; PG8_LDB(B0, 0, 0); PG8_LDB(B1, 0, 1); PG8_SCHED; PG8_LDA(At, 0, 0); PG8_STAGE(PG8_SA(1, 1), a1 + hstep, voffA); }
            PG8_WAIT_V(8); PG8_WAIT_L(0); PG8_BAR; PG8_MMA(0, 0, At, B0); PG8_MMA(0, 1, At, B1); PG8_BAR; PG8_SCHED;
            { PG8_LANE_OFFS; PG8_LDA(At, 0, 1); PG8_STAGE(PG8_SB(0, 0), b2, voffB); PG8_STAGE(PG8_SB(0, 1), b2 + hstep, voffB); PG8_STAGE(PG8_SA(0, 0), a2, voffA); }
            PG8_WAIT_V(8); PG8_WAIT_L(0); PG8_BAR; PG8_MMA(1, 0, At, B0); PG8_MMA(1, 1, At, B1); PG8_BAR; PG8_SCHED;
            { PG8_LANE_OFFS; PG8_LDB(B0, 1, 0); PG8_LDB(B1, 1, 1); PG8_SCHED; PG8_LDA(At, 1, 0); PG8_STAGE(PG8_SA(0, 1), a2 + hstep, voffA); }
            PG8_WAIT_V(8); PG8_WAIT_L(0); PG8_BAR; PG8_MMA(0, 0, At, B0); PG8_MMA(0, 1, At, B1); PG8_BAR; PG8_SCHED;
            { PG8_LANE_OFFS; PG8_LDA(At, 1, 1); PG8_STAGE(PG8_SB(1, 0), b3, voffB); PG8_STAGE(PG8_SB(1, 1), b3 + hstep, voffB); PG8_STAGE(PG8_SA(1, 0), a3, voffA); }
            PG8_WAIT_V(8); PG8_WAIT_L(0); PG8_BAR; PG8_MMA(1, 0, At, B0); PG8_MMA(1, 1, At, B1); PG8_BAR; PG8_SCHED;
        }
        if (wr == 0) PG8_BAR;
        if constexpr (Sched::HAS_DEP) depv = S.dep_issue(ui + 2);
        if constexpr (Epi::SIGNALS) { if (ui > 0) { PG8_WAIT_V(8); PG8_BAR; E.signal(prv, tid == 0); } }
        { unsigned zz = 0u; asm volatile("" : "+v"(zz));
          const int ln = (int)__builtin_amdgcn_mbcnt_hi(~0u, __builtin_amdgcn_mbcnt_lo(~0u, zz));
          E(acc, cur, wr, wc, ln & 15, ln >> 4); }
        if (!has_next) break;
        if (!(Epi::CHAIN && cur.e == 0)) { PG8_ACC_INIT(nxt); }
        prv = cur; cur = nxt; cA = nA; cB = nB; ++ui;
        if (wr == 1) PG8_BAR;
    }
    PG8_WAIT_V(0);
    PG8_BAR;
    if constexpr (Epi::SIGNALS) E.signal(cur, tid == 0);
#undef PG8_SA
#undef PG8_ACC_INIT
#undef PG8_SB
#undef PG8_STAGE
#undef PG8_LDA
#undef PG8_LDB
#undef PG8_MMA
#undef PG8_LO
#undef PG8_LANE_OFFS
#undef PG8_HI
#undef PG8_WAIT_V
#undef PG8_WAIT_L
#undef PG8_BAR
#undef PG8_SCHED
}
}

using pg8::Unit;
template <bool F8>
struct EpiZT {
    static constexpr bool PERM = true;
    static constexpr bool SIGNALS = false;
    static constexpr bool CHAIN = false;
    static constexpr bool ACC_INIT = false;
    static constexpr float ASC = F8 ? W8_INV : 1.0f;
    bf16_t* O; int ldc; const float* gq; const float* gk; float* kmean; LAS unsigned char* xl;
    __device__ __forceinline__ void operator()(const f32x4 (&acc)[2][2][4][2], const Unit& u, int wr, int wc, int fr, int fq) const {
        const int row0 = u.pm * 256 + wr * 64 + fr, col0 = u.pn * 256 + wc * 32 + 8 * fq;
        if (u.pn < 12 || u.pn >= 20) {
#pragma unroll
            for (int ai = 0; ai < 2; ++ai)
#pragma unroll
                for (int m = 0; m < 4; ++m) { bf16_t* rowp = O + (size_t)(row0 + ai * 128 + m * 16) * ldc + col0;
#pragma unroll
                    for (int bj = 0; bj < 2; ++bj) { const f32x4 v0 = acc[ai][bj][m][0] * ASC, v1 = acc[ai][bj][m][1] * ASC;
                        u32x4 w; w.x = pk2(v0[0], v0[1]); w.y = pk2(v0[2], v0[3]); w.z = pk2(v1[0], v1[1]); w.w = pk2(v1[2], v1[3]);
                        *(u32x4*)(rowp + bj * 128) = w; } }
            return;
        }
        LAS float* P = (LAS float*)xl;
        LAS float* Cs = (LAS float*)(xl + 8192);
#pragma unroll
        for (int ai = 0; ai < 2; ++ai)
#pragma unroll
            for (int m = 0; m < 4; ++m)
#pragma unroll
                for (int bj = 0; bj < 2; ++bj) { const f32x4 v0 = acc[ai][bj][m][0], v1 = acc[ai][bj][m][1];
                    float ss = (v0[0] * v0[0] + v0[1] * v0[1]) + (v0[2] * v0[2] + v0[3] * v0[3]) + (v1[0] * v1[0] + v1[1] * v1[1]) + (v1[2] * v1[2] + v1[3] * v1[3]);
                    ss += __shfl_xor(ss, 16); ss += __shfl_xor(ss, 32);
                    if (fq == 0) P[((ai * 128 + wr * 64 + m * 16 + fr) * 2 + bj) * 4 + wc] = ss; asm volatile("" ::: "memory"); }
        __syncthreads();
        const bool isk = u.pn >= 16;
        const float* gv = (isk ? gk : gq) + wc * 32 + 8 * fq;
        const f32x4 g0 = *(const f32x4*)gv, g1 = *(const f32x4*)(gv + 4);
        f32x4 cs[2][2];
#pragma unroll
        for (int bj = 0; bj < 2; ++bj) { cs[bj][0] = (f32x4){0.f, 0.f, 0.f, 0.f}; cs[bj][1] = cs[bj][0]; }
#pragma unroll
        for (int ai = 0; ai < 2; ++ai)
#pragma unroll
            for (int m = 0; m < 4; ++m) { const int rl = ai * 128 + wr * 64 + m * 16 + fr; bf16_t* rowp = O + (size_t)(u.pm * 256 + rl) * ldc + col0;
#pragma unroll
                for (int bj = 0; bj < 2; ++bj) { const f32x4 pp = *(const LAS f32x4*)(P + (rl * 2 + bj) * 4);
                    const float rinv = rsqrtf(((pp[0] + pp[1]) + (pp[2] + pp[3])) * (ASC * ASC / 128.0f) + EPS) * ASC;
                    const f32x4 y0 = acc[ai][bj][m][0] * rinv * g0, y1 = acc[ai][bj][m][1] * rinv * g1;
                    cs[bj][0] += y0; cs[bj][1] += y1;
                    u32x4 w; w.x = pk2(y0[0], y0[1]); w.y = pk2(y0[2], y0[3]); w.z = pk2(y1[0], y1[1]); w.w = pk2(y1[2], y1[3]);
                    *(u32x4*)(rowp + bj * 128) = w; }
                asm volatile("" : "+v"(cs[0][0]), "+v"(cs[0][1]), "+v"(cs[1][0]), "+v"(cs[1][1]) :: "memory"); }
        if (isk) {
#pragma unroll
            for (int bj = 0; bj < 2; ++bj)
#pragma unroll
                for (int n = 0; n < 2; ++n)
#pragma unroll
                    for (int j = 0; j < 4; ++j) { float t = sum16_(cs[bj][n][j]);
                        if (fr == 0) Cs[(wr * 2 + bj) * 128 + wc * 32 + 8 * fq + 4 * n + j] = t; }
            __syncthreads();
            const int t = (wr * 4 + wc) * 64 + fq * 16 + fr;
            if (t < 256) { const int bj = t >> 7, d = t & 127, hd = (u.pn - 16) * 2 + bj;
                kmean[((((size_t)(u.pm >> 3) * 8 + hd) * 8) + (u.pm & 7)) * 128 + d] = (Cs[bj * 128 + d] + Cs[(2 + bj) * 128 + d]) * (1.0f / 256.0f); }
        }
    }
};
typedef EpiZT<false> EpiZ;
struct EpiZ8 {
    static constexpr bool PERM = true;
    static constexpr bool SIGNALS = false;
    static constexpr bool CHAIN = false;
    static constexpr bool ACC_INIT = false;
    bf16_t* O; int ldc, col_off;
    __device__ __forceinline__ void operator()(const f32x4 (&acc)[2][2][4][2], const Unit& u, int wr, int wc, int fr, int fq) const {
        const int row0 = u.pm * 256 + wr * 64 + fr, col0 = col_off + u.pn * 256 + wc * 32 + 8 * fq;
#pragma unroll
        for (int ai = 0; ai < 2; ++ai)
#pragma unroll
            for (int m = 0; m < 4; ++m) { bf16_t* rowp = O + (size_t)(row0 + ai * 128 + m * 16) * ldc + col0;
#pragma unroll
                for (int bj = 0; bj < 2; ++bj) { const f32x4 v0 = acc[ai][bj][m][0] * W8_INV, v1 = acc[ai][bj][m][1] * W8_INV;
                    u32x4 w; w.x = pk2(v0[0], v0[1]); w.y = pk2(v0[2], v0[3]); w.z = pk2(v1[0], v1[1]); w.w = pk2(v1[2], v1[3]);
                    *(u32x4*)(rowp + bj * 128) = w; } }
    }
};
struct EpiBranchA {
    static constexpr bool PERM = true;
    static constexpr bool SIGNALS = false;
    static constexpr bool CHAIN = false;
    static constexpr bool ACC_INIT = false;
    float* tmp; const bf16_t* z;
    __device__ __forceinline__ void operator()(const f32x4 (&acc)[2][2][4][2], const Unit& u, int wr, int wc, int fr, int fq) const {
        const int row0 = u.pm * 256 + wr * 64 + fr, col0 = u.pn * 256 + wc * 32 + 8 * fq;
#pragma unroll
        for (int ai = 0; ai < 2; ++ai)
#pragma unroll
            for (int m = 0; m < 4; ++m) { const size_t row = (size_t)(row0 + ai * 128 + m * 16);
#pragma unroll
                for (int bj = 0; bj < 2; ++bj) { const int col = col0 + bj * 128;
                    const u32x4 g = *(const u32x4*)(z + row * ZP + ZGA + col);
                    const f32x4 v0 = acc[ai][bj][m][0] * (W8_INV / H8_SCALE), v1 = acc[ai][bj][m][1] * (W8_INV / H8_SCALE);
                    f32x4 o0, o1;
                    o0[0] = v0[0] * sigmoidf_(bf_lo(g.x)); o0[1] = v0[1] * sigmoidf_(bf_hi(g.x)); o0[2] = v0[2] * sigmoidf_(bf_lo(g.y)); o0[3] = v0[3] * sigmoidf_(bf_hi(g.y));
                    o1[0] = v1[0] * sigmoidf_(bf_lo(g.z)); o1[1] = v1[1] * sigmoidf_(bf_hi(g.z)); o1[2] = v1[2] * sigmoidf_(bf_lo(g.w)); o1[3] = v1[3] * sigmoidf_(bf_hi(g.w));
                    float* p = tmp + row * D + col; *(f32x4*)p = o0; *(f32x4*)(p + 4) = o1; } }
    }
};
struct EpiBranchB {
    static constexpr bool PERM = true;
    static constexpr bool SIGNALS = false;
    static constexpr bool CHAIN = false;
    static constexpr bool ACC_INIT = false;
    const float* tmp; const bf16_t* z; unsigned char* y;
    __device__ __forceinline__ void operator()(const f32x4 (&acc)[2][2][4][2], const Unit& u, int wr, int wc, int fr, int fq) const {
        const int row0 = u.pm * 256 + wr * 64 + fr, col0 = u.pn * 256 + wc * 32 + 8 * fq;
#pragma unroll
        for (int ai = 0; ai < 2; ++ai)
#pragma unroll
            for (int m = 0; m < 4; ++m) { const size_t row = (size_t)(row0 + ai * 128 + m * 16);
#pragma unroll
                for (int bj = 0; bj < 2; ++bj) { const int col = col0 + bj * 128;
                    const u32x4 g = *(const u32x4*)(z + row * ZP + ZGB + col);
                    const float* p = tmp + row * D + col; const f32x4 t0 = *(const f32x4*)p, t1 = *(const f32x4*)(p + 4);
                    const f32x4 v0 = acc[ai][bj][m][0] * (W8_INV / O8_SCALE), v1 = acc[ai][bj][m][1] * (W8_INV / O8_SCALE);
                    f32x4 o0, o1;
                    o0[0] = t0[0] + v0[0] * sigmoidf_(bf_lo(g.x)); o0[1] = t0[1] + v0[1] * sigmoidf_(bf_hi(g.x)); o0[2] = t0[2] + v0[2] * sigmoidf_(bf_lo(g.y)); o0[3] = t0[3] + v0[3] * sigmoidf_(bf_hi(g.y));
                    o1[0] = t1[0] + v1[0] * sigmoidf_(bf_lo(g.z)); o1[1] = t1[1] + v1[1] * sigmoidf_(bf_hi(g.z)); o1[2] = t1[2] + v1[2] * sigmoidf_(bf_lo(g.w)); o1[3] = t1[3] + v1[3] * sigmoidf_(bf_hi(g.w));
                    o0 *= Y8_SCALE; o1 *= Y8_SCALE;
                    u32x2 w; w.x = pk4_fp8(o0[0], o0[1], o0[2], o0[3]); w.y = pk4_fp8(o1[0], o1[1], o1[2], o1[3]);
                    *(u32x2*)(y + row * D + col) = w; } }
    }
};
struct EpiBranchAB {
    static constexpr bool PERM = true;
    static constexpr bool SIGNALS = false;
    static constexpr bool CHAIN = true;
    static constexpr bool ACC_INIT = false;
    const bf16_t* z; unsigned char* y;
    __device__ __forceinline__ void operator()(f32x4 (&acc)[2][2][4][2], const Unit& u, int wr, int wc, int fr, int fq) const {
        const int row0 = u.pm * 256 + wr * 64 + fr, col0 = u.pn * 256 + wc * 32 + 8 * fq;
        if (u.e == 0) {
#pragma unroll
            for (int ai = 0; ai < 2; ++ai) {
                u32x4 ga[4][2], gb[4][2];
#pragma unroll
                for (int m = 0; m < 4; ++m)
#pragma unroll
                    for (int bj = 0; bj < 2; ++bj) { const bf16_t* zp = z + (size_t)(row0 + ai * 128 + m * 16) * ZP + col0 + bj * 128; ga[m][bj] = *(const u32x4*)(zp + ZGA); gb[m][bj] = *(const u32x4*)(zp + ZGB); }
                __builtin_amdgcn_sched_barrier(0);
#pragma unroll
                for (int m = 0; m < 4; ++m)
#pragma unroll
                    for (int bj = 0; bj < 2; ++bj) { const u32x4 a_ = ga[m][bj], b_ = gb[m][bj];
#define RHO(aw, bw, lo) ((O8_SCALE / H8_SCALE) * (1.0f + __expf(-(lo ? bf_lo(bw) : bf_hi(bw)))) * __builtin_amdgcn_rcpf(1.0f + __expf(-(lo ? bf_lo(aw) : bf_hi(aw)))))
                        f32x4 r0, r1;
                        r0[0] = RHO(a_.x, b_.x, 1); r0[1] = RHO(a_.x, b_.x, 0); r0[2] = RHO(a_.y, b_.y, 1); r0[3] = RHO(a_.y, b_.y, 0);
                        r1[0] = RHO(a_.z, b_.z, 1); r1[1] = RHO(a_.z, b_.z, 0); r1[2] = RHO(a_.w, b_.w, 1); r1[3] = RHO(a_.w, b_.w, 0);
#undef RHO
                        acc[ai][bj][m][0] *= r0; acc[ai][bj][m][1] *= r1; }
                __builtin_amdgcn_sched_barrier(0);
            }
        } else {
            u32x4 gb[2][4][2];
#pragma unroll
            for (int ai = 0; ai < 2; ++ai)
#pragma unroll
                for (int m = 0; m < 4; ++m)
#pragma unroll
                    for (int bj = 0; bj < 2; ++bj) gb[ai][m][bj] = *(const u32x4*)(z + (size_t)(row0 + ai * 128 + m * 16) * ZP + ZGB + col0 + bj * 128);
            __builtin_amdgcn_sched_barrier(0);
#pragma unroll
            for (int ai = 0; ai < 2; ++ai)
#pragma unroll
                for (int m = 0; m < 4; ++m) { const size_t row = (size_t)(row0 + ai * 128 + m * 16);
#pragma unroll
                    for (int bj = 0; bj < 2; ++bj) { const int col = col0 + bj * 128;
                        const u32x4 g = gb[ai][m][bj];
                        const f32x4 v0 = acc[ai][bj][m][0] * (W8_INV / O8_SCALE * Y8_SCALE), v1 = acc[ai][bj][m][1] * (W8_INV / O8_SCALE * Y8_SCALE);
                        u32x2 w;
                        w.x = pk4_fp8(v0[0] * sigmoidf_(bf_lo(g.x)), v0[1] * sigmoidf_(bf_hi(g.x)), v0[2] * sigmoidf_(bf_lo(g.y)), v0[3] * sigmoidf_(bf_hi(g.y)));
                        w.y = pk4_fp8(v1[0] * sigmoidf_(bf_lo(g.z)), v1[1] * sigmoidf_(bf_hi(g.z)), v1[2] * sigmoidf_(bf_lo(g.w)), v1[3] * sigmoidf_(bf_hi(g.w)));
                        *(u32x2*)(y + row * D + col) = w; } }
        }
    }
};
struct EpiOut {
    static constexpr bool PERM = false;
    static constexpr bool SIGNALS = false;
    static constexpr bool CHAIN = false;
    static constexpr bool ACC_INIT = false;
    const float* x; const float* modf; bf16_t* x1;
    __device__ __forceinline__ void operator()(const f32x4 (&acc)[2][2][4][2], const Unit& u, int wr, int wc, int fr, int fq) const {
        const int row0 = u.pm * 256 + wr * 64 + fr, col0 = u.pn * 256 + wc * 32 + 4 * fq;
        const float* gt = modf + (size_t)(u.pm >> 3) * (6 * D) + 2 * D;
        f32x4 gv[2][2];
#pragma unroll
        for (int bj = 0; bj < 2; ++bj)
#pragma unroll
            for (int n = 0; n < 2; ++n) gv[bj][n] = *(const f32x4*)(gt + col0 + bj * 128 + n * 16);
#pragma unroll
        for (int ai = 0; ai < 2; ++ai) {
            f32x4 xv[4][2][2];
#pragma unroll
            for (int m = 0; m < 4; ++m)
#pragma unroll
                for (int bj = 0; bj < 2; ++bj)
#pragma unroll
                    for (int n = 0; n < 2; ++n) xv[m][bj][n] = *(const f32x4*)(x + (size_t)(row0 + ai * 128 + m * 16) * D + col0 + bj * 128 + n * 16);
            __builtin_amdgcn_sched_barrier(0);
#pragma unroll
            for (int m = 0; m < 4; ++m) { const size_t off = (size_t)(row0 + ai * 128 + m * 16) * D + col0;
#pragma unroll
                for (int bj = 0; bj < 2; ++bj)
#pragma unroll
                    for (int n = 0; n < 2; ++n) {
                        const f32x4 v = xv[m][bj][n] + gv[bj][n] * (acc[ai][bj][m][n] * (W8_INV / Y8_SCALE));
                        u32x2 o; o.x = pk2(v[0], v[1]); o.y = pk2(v[2], v[3]);
                        *(u32x2*)(x1 + off + bj * 128 + n * 16) = o; } }
            __builtin_amdgcn_sched_barrier(0);
        }
    }
};
template <bool SC1>
struct EpiUpT {
    static constexpr bool PERM = true;
    static constexpr bool CHAIN = false;
    static constexpr bool ACC_INIT = true;
    static constexpr bool SIGNALS = SC1;
    unsigned char* act; const float* b_up; const LAS int* cbase; unsigned* upd;
    __device__ __forceinline__ void operator()(const f32x4 (&acc)[2][2][4][2], const Unit& u, int wr, int wc, int fr, int fq) const {
        const int row0 = cbase[u.e] + u.pm * 256 + wr * 64 + fr, colh = u.pn * 128 + wc * 32 + 8 * fq;
#pragma unroll
        for (int ai = 0; ai < 2; ++ai)
#pragma unroll
            for (int m = 0; m < 4; ++m) {
                const f32x4 g0 = acc[ai][0][m][0], g1 = acc[ai][0][m][1], l0 = acc[ai][1][m][0], l1 = acc[ai][1][m][1];
                constexpr float KE = 1.702f * 1.4426950408889634f * W8_INV, GC = 7.0f * W8_SCALE, OS = W8_INV * W8_INV;
                float o[8];
#pragma unroll
                for (int j = 0; j < 4; ++j) {
                    float g = fminf(g0[j], GC), l = __builtin_amdgcn_fmed3f(l0[j], -GC, GC); o[j] = (g * OS) * __builtin_amdgcn_rcpf(1.0f + __builtin_amdgcn_exp2f(g * -KE)) * (l + W8_SCALE);
                    g = fminf(g1[j], GC); l = __builtin_amdgcn_fmed3f(l1[j], -GC, GC); o[4 + j] = (g * OS) * __builtin_amdgcn_rcpf(1.0f + __builtin_amdgcn_exp2f(g * -KE)) * (l + W8_SCALE); }
                u32x2 w; w.x = pk4_fp8_ns(o[0], o[1], o[2], o[3]); w.y = pk4_fp8_ns(o[4], o[5], o[6], o[7]);
                if (SC1) store8_sc1(act + (size_t)(row0 + ai * 128 + m * 16) * D + colh, w); else *(u32x2*)(act + (size_t)(row0 + ai * 128 + m * 16) * D + colh) = w; }
    }
    __device__ __forceinline__ void acc_bias(const Unit& u, int wc, int fq, f32x4 (&bi)[2][2]) const {
        const float* bg = b_up + (size_t)u.e * (2 * D) + u.pn * 128 + wc * 32 + 8 * fq;
#pragma unroll
        for (int n = 0; n < 2; ++n) { bi[0][n] = *(const f32x4*)(bg + 4 * n) * W8_SCALE; bi[1][n] = *(const f32x4*)(bg + D + 4 * n) * W8_SCALE; }
    }
    __device__ __forceinline__ void signal(const Unit& u, bool first_lane) const { if (first_lane) __hip_atomic_fetch_add(upd + (u.e * 32 + u.pm) * 16, 1u, __ATOMIC_RELAXED, __HIP_MEMORY_SCOPE_AGENT); }
};
typedef EpiUpT<true> EpiUp;
struct EpiDown {
    static constexpr bool PERM = true;
    static constexpr bool SIGNALS = false;
    static constexpr bool CHAIN = false;
    static constexpr bool ACC_INIT = true;
    __device__ __forceinline__ void acc_bias(const Unit& u, int wc, int fq, f32x4 (&bi)[2][2]) const {
        const float* bd = b_dn + (size_t)u.e * D + u.pn * 256 + wc * 32 + 8 * fq;
#pragma unroll
        for (int bj = 0; bj < 2; ++bj)
#pragma unroll
            for (int n = 0; n < 2; ++n) bi[bj][n] = *(const f32x4*)(bd + bj * 128 + 4 * n) * W8_SCALE;
    }
    unsigned char* ydn; const float* b_dn; const float* roww; const LAS int* cbase;
    __device__ __forceinline__ void operator()(const f32x4 (&acc)[2][2][4][2], const Unit& u, int wr, int wc, int fr, int fq) const {
        const int rl = u.pm * 256 + wr * 64 + fr, row0 = cbase[u.e] + rl, col0 = u.pn * 256 + wc * 32 + 8 * fq;
        float wv[2][4];
#pragma unroll
        for (int ai = 0; ai < 2; ++ai)
#pragma unroll
            for (int m = 0; m < 4; ++m) wv[ai][m] = roww[(size_t)u.e * ECAP + rl + ai * 128 + m * 16];
        __builtin_amdgcn_sched_barrier(0);
#pragma unroll
        for (int ai = 0; ai < 2; ++ai)
#pragma unroll
            for (int m = 0; m < 4; ++m) { const float w = wv[ai][m] * YD_SCALE; unsigned char* p = ydn + (size_t)(row0 + ai * 128 + m * 16) * D + col0;
#pragma unroll
                for (int bj = 0; bj < 2; ++bj) {
                    const f32x4 v0 = acc[ai][bj][m][0] * (W8_INV * w), v1 = acc[ai][bj][m][1] * (W8_INV * w);
                    u32x2 o; o.x = pk4_fp8(v0[0], v0[1], v0[2], v0[3]); o.y = pk4_fp8(v1[0], v1[1], v1[2], v1[3]);
                    *(u32x2*)(p + bj * 128) = o; } }
    }
};

#define XB_TMO      128
#define XB_XCNT(j)  (256  + 64 * (j))
#define XB_XSUB(j)  (1280 + 64 * (j))
#define XB_XGEN(j)  (2304 + 64 * (j))
#define XB_TOP      3328
#define XB_TOPGEN   3392
#define XCD_BAR_WORDS 3456
#define XB_SPIN_CAP (1u << 18)
__device__ __forceinline__ unsigned xb_ld(unsigned* p)              { return __hip_atomic_load(p, __ATOMIC_RELAXED, __HIP_MEMORY_SCOPE_AGENT); }
__device__ __forceinline__ unsigned xb_add(unsigned* p, unsigned v) { return __hip_atomic_fetch_add(p, v, __ATOMIC_RELAXED, __HIP_MEMORY_SCOPE_AGENT); }
__device__ __forceinline__ unsigned xb_xcc_id() { return (unsigned)__builtin_amdgcn_s_getreg((3 << 11) | 20) & 0xFu; }
#define XB_SPIN(cond, bar) do { unsigned _sp = 0; while (cond) { __builtin_amdgcn_s_sleep(1); \
    if ((++_sp & 255u) == 0u) { if (xb_ld(&(bar)[XB_TMO])) break; if (_sp > XB_SPIN_CAP) { atomicAdd(&(bar)[XB_TMO], 1u); break; } } } } while (0)
struct XcdBarrier { unsigned* bar; unsigned x; volatile LAS unsigned* st; };
__device__ __forceinline__ XcdBarrier xcd_barrier_post(unsigned* bar, volatile LAS unsigned* st) {
    XcdBarrier b; b.bar = bar; b.x = xb_xcc_id(); b.st = st;
    if (threadIdx.x == 0) (void)xb_add(&bar[XB_XCNT(b.x)], 1u);
    return b;
}
__device__ __forceinline__ void xcd_barrier_complete(unsigned* bar, unsigned x, unsigned& nloc, unsigned& nx) {
    const unsigned G = gridDim.x * gridDim.y * gridDim.z;
    unsigned sum, cnt, mine, sp = 0u;
    for (;;) {
        sum = 0u; cnt = 0u; mine = 0u;
#pragma unroll
        for (unsigned j = 0; j < 16; ++j) { const unsigned c = xb_ld(&bar[XB_XCNT(j)]); sum += c; cnt += (c > 0u) ? 1u : 0u; mine = (j == x) ? c : mine; }
        if (sum == G) break;
        __builtin_amdgcn_s_sleep(1);
        if ((++sp & 255u) == 0u) { if (xb_ld(&bar[XB_TMO])) break; if (sp > XB_SPIN_CAP) { atomicAdd(&bar[XB_TMO], 1u); break; } }
    }
    nloc = mine > 0u ? mine : 1u; nx = cnt > 0u ? cnt : 1u;
}
__device__ __forceinline__ void xcd_barrier(const XcdBarrier& b) {
    asm volatile("s_waitcnt vmcnt(0)" ::: "memory");
    __syncthreads();
    if (threadIdx.x == 0) {
        unsigned* bar = b.bar;
        __builtin_amdgcn_s_waitcnt(0);
        unsigned nloc = b.st[0], nx = b.st[1];
        if (nloc == 0u) { xcd_barrier_complete(bar, b.x, nloc, nx); b.st[0] = nloc; b.st[1] = nx; }
        const unsigned old = xb_add(&bar[XB_XSUB(b.x)], 1u);
        const unsigned gen = old / nloc;
        if (old + 1u == (gen + 1u) * nloc) {
            __builtin_amdgcn_fence(__ATOMIC_RELEASE, "agent");
            asm volatile("s_waitcnt vmcnt(0)" ::: "memory");
            const unsigned og = xb_add(&bar[XB_TOP], 1u);
            const unsigned tg = og / nx;
            if (og + 1u == (tg + 1u) * nx) xb_add(&bar[XB_TOPGEN], 1u);
            else XB_SPIN(xb_ld(&bar[XB_TOPGEN]) == tg, bar);
            __builtin_amdgcn_fence(__ATOMIC_ACQUIRE, "agent");
            xb_add(&bar[XB_XGEN(b.x)], 1u);
            asm volatile("s_waitcnt vmcnt(0)" ::: "memory");
        } else {
            XB_SPIN(xb_ld(&bar[XB_XGEN(b.x)]) == gen, bar);
            __builtin_amdgcn_fence(__ATOMIC_ACQUIRE, "agent");
            asm volatile("s_waitcnt vmcnt(0)" ::: "memory");
        }
    }
    __syncthreads();
}

struct Args { const float* in[21]; float* out; unsigned char* ws; int ph_lo, ph_hi; };
enum { I_X = 0, I_C, I_WADA, I_BADA, I_GMIX, I_WIN, I_BIG, I_BFG, I_GMO, I_GQ, I_GK, I_WBA, I_WBB, I_WOUT, I_GFFN, I_WR, I_BR, I_WUP, I_BUP, I_WDN, I_BDN };

struct Frame {
    LAS unsigned char* lds; unsigned char* ws; unsigned* ctl;
    int tid, lane, wave, G, wg, vcu;
};

__device__ __forceinline__ void p0_mod_partial(Frame& F, const float* c, const float* w_ada, float* modp, int item) {
    const int cg = item % 48, ks = item / 48;
    LAS float* sS = (LAS float*)F.lds;
    LAS float* red = (LAS float*)(F.lds + 8192);
    {
        const int k = F.tid;
#pragma unroll
        for (int b = 0; b < 4; ++b) { const float v = c[b * D + ks * 512 + k]; sS[b * 512 + k] = v * sigmoidf_(v); }
    }
    __syncthreads();
    f32x4 a0 = {0.f, 0.f, 0.f, 0.f}, a1 = a0, a2 = a0, a3 = a0;
    const float* wp = w_ada + (size_t)(ks * 512 + F.wave) * (6 * D) + cg * 256 + 4 * F.lane;
#pragma unroll 8
    for (int i = 0; i < 64; ++i) {
        const f32x4 w = *(const f32x4*)(wp + (size_t)(8 * i) * (6 * D));
        const int kk = F.wave + 8 * i;
        a0 += w * sS[kk]; a1 += w * sS[512 + kk]; a2 += w * sS[1024 + kk]; a3 += w * sS[1536 + kk];
    }
    *(LAS f32x4*)(red + (F.wave * 4 + 0) * 256 + 4 * F.lane) = a0;
    *(LAS f32x4*)(red + (F.wave * 4 + 1) * 256 + 4 * F.lane) = a1;
    *(LAS f32x4*)(red + (F.wave * 4 + 2) * 256 + 4 * F.lane) = a2;
    *(LAS f32x4*)(red + (F.wave * 4 + 3) * 256 + 4 * F.lane) = a3;
    __syncthreads();
#pragma unroll
    for (int r = 0; r < 2; ++r) {
        const int o = F.tid + 512 * r, b = o >> 8, col = o & 255;
        float s = 0.f;
#pragma unroll
        for (int w = 0; w < 8; ++w) s += red[(w * 4 + b) * 256 + col];
        modp[((size_t)ks * 4 + b) * (6 * D) + cg * 256 + col] = s;
    }
    __syncthreads();
}
__device__ __forceinline__ void p0_frag_item(const float* W, int ldw, int col0, bf16_t* dst, int p) {
    const int s = p >> 6, lane = p & 63;
    const float* src = W + (size_t)(32 * s + 8 * (lane >> 4)) * ldw + col0 + (lane & 15);
    u32x4 o; o.x = pk2(src[0], src[ldw]); o.y = pk2(src[2 * (size_t)ldw], src[3 * (size_t)ldw]); o.z = pk2(src[4 * (size_t)ldw], src[5 * (size_t)ldw]); o.w = pk2(src[6 * (size_t)ldw], src[7 * (size_t)ldw]);
    *(u32x4*)(dst + (size_t)p * 8) = o;
}
constexpr int CV_RS = 528, CV_BUF = 128 * CV_RS;
struct CvtItem { const float* src; bf16_t* dst; int K, ldw; };
__device__ __forceinline__ CvtItem cvt_decode(const Args& a, unsigned char* ws, int it) {
    constexpr int N_IN = 0, N_A = 4 * 16, N_O = 8 * 16, N_UP = 8 * 32, N_DN = 8 * 16;
    CvtItem c; int r = it;
    if (r < N_IN) { const int kb = r / 48, nb = r % 48, n0 = nb * 128; c.K = D; c.ldw = DIN; c.src = a.in[I_WIN] + (size_t)(kb * 256) * DIN + n0 + (n0 >= 3072 ? 16 : 0); c.dst = (bf16_t*)(ws + WS_WIN) + (size_t)n0 * D + kb * 256; return c; } r -= N_IN;
    if (r < N_A) { const int kb = r / 16, nb = r % 16; c.K = 1024; c.ldw = D; c.src = a.in[I_WBA] + (size_t)(kb * 256) * D + nb * 128; c.dst = (bf16_t*)(ws + WS_WA) + (size_t)(nb * 128) * 1024 + kb * 256; return c; } r -= N_A;
    if (r < N_A) { const int kb = r / 16, nb = r % 16; c.K = 1024; c.ldw = D; c.src = a.in[I_WBB] + (size_t)(kb * 256) * D + nb * 128; c.dst = (bf16_t*)(ws + WS_WB) + (size_t)(nb * 128) * 1024 + kb * 256; return c; } r -= N_A;
    if (r < N_O) { const int kb = r / 16, nb = r % 16; c.K = D; c.ldw = D; c.src = a.in[I_WOUT] + (size_t)(kb * 256) * D + nb * 128; c.dst = (bf16_t*)(ws + WS_WOUT) + (size_t)(nb * 128) * D + kb * 256; return c; } r -= N_O;
    const int e = r / (N_UP + N_DN); r -= e * (N_UP + N_DN);
    if (r < N_UP) { const int kb = r / 32, nb = r % 32, t = nb >> 1; c.K = D; c.ldw = 2 * D;
        c.src = a.in[I_WUP] + (size_t)e * D * (2 * D) + (size_t)(kb * 256) * (2 * D) + ((nb & 1) ? 2048 + 128 * t : 128 * t);
        c.dst = (bf16_t*)(ws + WS_WUP) + (size_t)e * (2 * D) * D + (size_t)(nb * 128) * D + kb * 256; return c; }
    r -= N_UP; { const int kb = r / 16, nb = r % 16; c.K = D; c.ldw = D; c.src = a.in[I_WDN] + (size_t)e * D * D + (size_t)(kb * 256) * D + nb * 128; c.dst = (bf16_t*)(ws + WS_WDN) + (size_t)e * D * D + (size_t)(nb * 128) * D + kb * 256; }
    return c;
}
constexpr int CVT_DENSE_ITEMS = 2 * 4 * 16 + 8 * 16;
__device__ __forceinline__ CvtItem cvt_decode_moe(const Args& a, unsigned char* ws, int e, int which, int j, int kb) {
    CvtItem c; c.K = D;
    if (which == 0) { const int t = j >> 1; c.ldw = 2 * D;
        c.src = a.in[I_WUP] + (size_t)e * D * (2 * D) + (size_t)(kb * 256) * (2 * D) + ((j & 1) ? 2048 + 128 * t : 128 * t);
        c.dst = (bf16_t*)(ws + WS_WUP) + (size_t)e * (2 * D) * D + (size_t)(j * 128) * D + kb * 256; }
    else { c.ldw = D; c.src = a.in[I_WDN] + (size_t)e * D * D + (size_t)(kb * 256) * D + j * 128; c.dst = (bf16_t*)(ws + WS_WDN) + (size_t)e * D * D + (size_t)(j * 128) * D + kb * 256; }
    return c;
}
__device__ __forceinline__ void cvt_load(const CvtItem& c, f32x4 (&v)[16], int wave, int lane) {
    const float* p = c.src + (size_t)(32 * wave + 16 * (lane >> 5)) * c.ldw + 4 * (lane & 31);
#pragma unroll
    for (int i = 0; i < 16; ++i) v[i] = __builtin_nontemporal_load((const f32x4*)(p + (size_t)i * c.ldw));
}
__device__ __forceinline__ void cvt_to_lds(const f32x4 (&v)[16], LAS unsigned char* buf, int wave, int lane) {
    const int n4 = lane & 31, hh = lane >> 5;
#pragma unroll
    for (int g = 0; g < 2; ++g)
#pragma unroll
        for (int j = 0; j < 4; ++j) {
            u32x4 o; o.x = pk2(v[8 * g + 0][j], v[8 * g + 1][j]); o.y = pk2(v[8 * g + 2][j], v[8 * g + 3][j]); o.z = pk2(v[8 * g + 4][j], v[8 * g + 5][j]); o.w = pk2(v[8 * g + 6][j], v[8 * g + 7][j]);
            *(LAS u32x4*)(buf + (4 * n4 + j) * CV_RS + (4 * wave + 2 * hh + g) * 16) = o; }
}
template <bool SC1>
__device__ __forceinline__ void cvt_store(const CvtItem& c, const LAS unsigned char* buf, int tid) {
#pragma unroll
    for (int i = 0; i < 8; ++i) { const int id = tid + 512 * i, row = id >> 5, ch = id & 31;
        const u32x4 v = *(const LAS u32x4*)(buf + row * CV_RS + ch * 16);
        if (SC1) store16_sc1(c.dst + (size_t)row * c.K + ch * 8, v); else *(u32x4*)(c.dst + (size_t)row * c.K + ch * 8) = v; }
}
template <bool SC1, class Dec>
__device__ __forceinline__ void cvt_stream(Frame& F, const Dec& dec, int first, int n, int step) {
    int it = first;
    if (it >= n) return;
    int tid = threadIdx.x; asm volatile("" : "+v"(tid));
    const int wave = __builtin_amdgcn_readfirstlane(tid >> 6), lane = tid & 63;
    f32x4 v[16];
    CvtItem cur = dec(it);
    cvt_load(cur, v, wave, lane);
    cvt_to_lds(v, F.lds, wave, lane);
    __syncthreads();
#pragma unroll 1
    for (int i = 0;; ++i) {
        const int nx = it + step; const bool has_next = nx < n;
        CvtItem nxt = cur;
        if (has_next) { nxt = dec(nx); cvt_load(nxt, v, wave, lane); }
        cvt_store<SC1>(cur, F.lds + (i & 1) * CV_BUF, tid);
        if (has_next) cvt_to_lds(v, F.lds + ((i + 1) & 1) * CV_BUF, wave, lane);
        __syncthreads();
        if (!has_next) break;
        cur = nxt; it = nx;
    }
}
constexpr int C8_RS = 272, C8_BUF = 128 * C8_RS;
struct Cvt8Item { const float* src; unsigned char* dst; int ldw; };
__device__ __forceinline__ Cvt8Item cvt8_decode(const Args& a, unsigned char* ws, int e, int which, int j, int kb) {
    Cvt8Item c;
    if (which == 0) { const int t = j >> 1; c.ldw = 2 * D;
        c.src = a.in[I_WUP] + (size_t)e * D * (2 * D) + (size_t)(kb * 256) * (2 * D) + ((j & 1) ? 2048 + 128 * t : 128 * t);
        c.dst = ws + WS_WUP + ((size_t)e * (2 * D) + (size_t)(j * 128)) * D + kb * 256; }
    else { c.ldw = D; c.src = a.in[I_WDN] + (size_t)e * D * D + (size_t)(kb * 256) * D + j * 128; c.dst = ws + WS_WDN + ((size_t)e * D + (size_t)(j * 128)) * D + kb * 256; }
    return c;
}
__device__ __forceinline__ void cvt8_load(const Cvt8Item& c, f32x4 (&v)[16], int wave, int lane) {
    const float* p = c.src + (size_t)(32 * wave + 16 * (lane >> 5)) * c.ldw + 4 * (lane & 31);
#pragma unroll
    for (int i = 0; i < 16; ++i) v[i] = __builtin_nontemporal_load((const f32x4*)(p + (size_t)i * c.ldw));
}
__device__ __forceinline__ void cvt8_to_lds(const f32x4 (&v)[16], LAS unsigned char* buf, int wave, int lane) {
    const int n4 = lane & 31, hh = lane >> 5;
#pragma unroll
    for (int j = 0; j < 4; ++j) {
        u32x4 o;
        o.x = pk4_fp8(v[0][j] * W8_SCALE, v[1][j] * W8_SCALE, v[2][j] * W8_SCALE, v[3][j] * W8_SCALE);
        o.y = pk4_fp8(v[4][j] * W8_SCALE, v[5][j] * W8_SCALE, v[6][j] * W8_SCALE, v[7][j] * W8_SCALE);
        o.z = pk4_fp8(v[8][j] * W8_SCALE, v[9][j] * W8_SCALE, v[10][j] * W8_SCALE, v[11][j] * W8_SCALE);
        o.w = pk4_fp8(v[12][j] * W8_SCALE, v[13][j] * W8_SCALE, v[14][j] * W8_SCALE, v[15][j] * W8_SCALE);
        *(LAS u32x4*)(buf + (4 * n4 + j) * C8_RS + (2 * wave + hh) * 16) = o; }
}
__device__ __forceinline__ void cvt8_store(const Cvt8Item& c, const LAS unsigned char* buf, int tid) {
#pragma unroll
    for (int i = 0; i < 4; ++i) { const int id = tid + 512 * i, row = id >> 4, ch = id & 15;
        store16_sc1(c.dst + (size_t)row * D + ch * 16, *(const LAS u32x4*)(buf + row * C8_RS + ch * 16)); }
}
__device__ __forceinline__ void cvt8_store_keep(const Cvt8Item& c, const LAS unsigned char* buf, int tid) {
#pragma unroll
    for (int i = 0; i < 4; ++i) { const int id = tid + 512 * i, row = id >> 4, ch = id & 15;
        *(u32x4*)(c.dst + (size_t)row * D + ch * 16) = *(const LAS u32x4*)(buf + row * C8_RS + ch * 16); }
}
template <bool SC1>
__device__ __forceinline__ void cvt8_store_t(const Cvt8Item& c, const LAS unsigned char* buf, int tid) {
#pragma unroll
    for (int i = 0; i < 4; ++i) { const int id = tid + 512 * i, row = id >> 4, ch = id & 15;
        const u32x4 v = *(const LAS u32x4*)(buf + row * C8_RS + ch * 16);
        if (SC1) store16_sc1(c.dst + (size_t)row * D + ch * 16, v); else __builtin_nontemporal_store(v, (u32x4*)(c.dst + (size_t)row * D + ch * 16)); }
}
__device__ __forceinline__ Cvt8Item cvt8_decode_lin(const Args& a, unsigned char* ws, int idx) {
    const int e = idx / 384; int r = idx - e * 384; int which = 0;
    if (r >= 256) { r -= 256; which = 1; }
    return cvt8_decode(a, ws, e, which, r >> 3, r & 7);
}
__device__ __forceinline__ void cvt8_all(Frame& F, const Args& a, unsigned char* ws) {
    constexpr int N = NE * 384;
    int it = F.vcu;
    if (it >= N) return;
    int tid = threadIdx.x; asm volatile("" : "+v"(tid));
    const int wave = __builtin_amdgcn_readfirstlane(tid >> 6), lane = tid & 63;
    f32x4 v[16];
    Cvt8Item cur = cvt8_decode_lin(a, ws, it);
    cvt8_load(cur, v, wave, lane);
    cvt8_to_lds(v, F.lds, wave, lane);
    __syncthreads();
#pragma unroll 1
    for (int i = 0;; ++i) {
        const int nx = it + F.G; const bool has_next = nx < N;
        Cvt8Item nxt = cur;
        if (has_next) { nxt = cvt8_decode_lin(a, ws, nx); cvt8_load(nxt, v, wave, lane); }
        cvt8_store_t<false>(cur, F.lds + (i & 1) * C8_BUF, tid);
        if (has_next) cvt8_to_lds(v, F.lds + ((i + 1) & 1) * C8_BUF, wave, lane);
        __syncthreads();
        if (!has_next) break;
        cur = nxt; it = nx;
    }
}
__device__ __forceinline__ void cvt8_item(Frame& F, const Args& a, int idx);
template <bool SC1>
__device__ __forceinline__ void cvt8_stream(Frame& F, const Args& a, unsigned char* ws, int e, int which, int j) {
    int tid = threadIdx.x; asm volatile("" : "+v"(tid));
    const int wave = __builtin_amdgcn_readfirstlane(tid >> 6), lane = tid & 63;
    f32x4 va[16], vb[16];
    Cvt8Item c0 = cvt8_decode(a, ws, e, which, j, 0), c1 = cvt8_decode(a, ws, e, which, j, 1);
    cvt8_load(c0, va, wave, lane);
    cvt8_load(c1, vb, wave, lane);
    __builtin_amdgcn_sched_barrier(0);
    cvt8_to_lds(va, F.lds, wave, lane);
    __syncthreads();
#pragma unroll
    for (int k = 0; k < 8; k += 2) {
        Cvt8Item c2 = c0, c3 = c1;
        __builtin_amdgcn_sched_barrier(0);
        if (k + 2 < 8) { c2 = cvt8_decode(a, ws, e, which, j, k + 2); cvt8_load(c2, va, wave, lane); }
        __builtin_amdgcn_sched_barrier(0);
        cvt8_store_t<SC1>(c0, F.lds, tid);
        __builtin_amdgcn_sched_barrier(0);
        cvt8_to_lds(vb, F.lds + C8_BUF, wave, lane);
        __syncthreads();
        __builtin_amdgcn_sched_barrier(0);
        if (k + 3 < 8) { c3 = cvt8_decode(a, ws, e, which, j, k + 3); cvt8_load(c3, vb, wave, lane); }
        __builtin_amdgcn_sched_barrier(0);
        cvt8_store_t<SC1>(c1, F.lds + C8_BUF, tid);
        __builtin_amdgcn_sched_barrier(0);
        if (k + 2 < 8) cvt8_to_lds(va, F.lds, wave, lane);
        __syncthreads();
        c0 = c2; c1 = c3;
    }
}
__device__ __forceinline__ void cvt8_win_sub(Frame& F, const Args& a, int q) {
    int tid = threadIdx.x; asm volatile("" : "+v"(tid));
    const int wave = __builtin_amdgcn_readfirstlane(tid >> 6), lane = tid & 63, j = q >> 3, kb = q & 7;
    Cvt8Item c; c.ldw = DIN; c.src = a.in[I_WIN] + (size_t)(kb * 256) * DIN + j * 128 + (j >= 24 ? 16 : 0); c.dst = F.ws + WS_WIN8 + (size_t)(j * 128) * D + kb * 256;
    f32x4 v[16];
    __syncthreads();
    cvt8_load(c, v, wave, lane);
    cvt8_to_lds(v, F.lds, wave, lane);
    __syncthreads();
    cvt8_store_keep(c, F.lds, tid);
    __syncthreads();
}
__device__ __forceinline__ void cvt8_wout_sub(Frame& F, const Args& a, int q) {
    int tid = threadIdx.x; asm volatile("" : "+v"(tid));
    const int wave = __builtin_amdgcn_readfirstlane(tid >> 6), lane = tid & 63, j = q >> 3, kb = q & 7;
    Cvt8Item c; c.ldw = D; c.src = a.in[I_WOUT] + (size_t)(kb * 256) * D + j * 128; c.dst = F.ws + WS_WOUT8 + (size_t)(j * 128) * D + kb * 256;
    f32x4 v[16];
    __syncthreads();
    cvt8_load(c, v, wave, lane);
    cvt8_to_lds(v, F.lds, wave, lane);
    __syncthreads();
    cvt8_store_keep(c, F.lds, tid);
    __syncthreads();
}
__device__ __forceinline__ void cvt8_wbr_sub(Frame& F, const Args& a, int q) {
    int tid = threadIdx.x; asm volatile("" : "+v"(tid));
    const int wave = __builtin_amdgcn_readfirstlane(tid >> 6), lane = tid & 63, which = q >> 6, j = (q >> 2) & 15, kb = q & 3;
    Cvt8Item c; c.ldw = D; c.src = (which ? a.in[I_WBB] : a.in[I_WBA]) + (size_t)(kb * 256) * D + j * 128; c.dst = F.ws + (which ? WS_WB : WS_WA) + (size_t)(j * 128) * 1024 + kb * 256;
    f32x4 v[16];
    __syncthreads();
    cvt8_load(c, v, wave, lane);
    cvt8_to_lds(v, F.lds, wave, lane);
    __syncthreads();
#pragma unroll
    for (int i = 0; i < 4; ++i) { const int id = tid + 512 * i, row = id >> 4, ch = id & 15;
        *(u32x4*)(c.dst + (size_t)row * 1024 + ch * 16) = *(const LAS u32x4*)(F.lds + row * C8_RS + ch * 16); }
    __syncthreads();
}
__device__ __forceinline__ void cvt8_item(Frame& F, const Args& a, int idx) {
    if (idx < 1024) cvt8_stream<false>(F, a, F.ws, idx >> 5, 0, idx & 31);
    else cvt8_stream<false>(F, a, F.ws, (idx - 1024) >> 4, 1, (idx - 1024) & 15);
}
__device__ __forceinline__ void cvt8_item_signal(Frame& F, const Args& a, int idx, unsigned* upd) {
    const int e = (idx - 1024) >> 4;
    cvt8_stream<true>(F, a, F.ws, e, 1, (idx - 1024) & 15);
    asm volatile("s_waitcnt vmcnt(0)" ::: "memory");
    __syncthreads();
    if (F.tid < 32) __hip_atomic_fetch_add(upd + (e * 32 + F.tid) * 16, 1u, __ATOMIC_RELAXED, __HIP_MEMORY_SCOPE_AGENT);
}
struct DenseDec { const Args* a; unsigned char* ws; __device__ __forceinline__ CvtItem operator()(int it) const { return cvt_decode(*a, ws, it); } };
struct MoeDec { const Args* a; unsigned char* ws; int e, which, j; __device__ __forceinline__ CvtItem operator()(int kb) const { return cvt_decode_moe(*a, ws, e, which, j, kb); } };
__device__ __forceinline__ void p0_prologue(Frame& F, const Args& a) {
    unsigned char* ws = F.ws;
    for (int it = F.wg; it < 192; it += F.G) p0_mod_partial(F, a.in[I_C], a.in[I_WADA], (float*)(ws + WS_MODP), it);
    for (int p = (F.G - 1 - F.wg) * 512 + F.tid; p < 4096 + 8192; p += F.G * 512) {
        if (p < 4096) p0_frag_item(a.in[I_WIN], DIN, GATE_COL, (bf16_t*)(ws + WS_WGF), p);
        else { const int q = p - 4096, ct = q >> 12; p0_frag_item(a.in[I_WR], NE, 16 * ct, (bf16_t*)(ws + WS_WRF) + (size_t)ct * 4096 * 8, q & 4095); }
    }
    __syncthreads();
    if (F.G != 256) { for (int q = F.vcu; q < 640; q += F.G) cvt8_win_sub(F, a, q); }
    if (F.G != 256) { for (int q = F.G - 1 - F.vcu; q < 256; q += F.G) { if (q < 128) cvt8_wout_sub(F, a, q); else cvt8_wbr_sub(F, a, q - 128); } }
}

constexpr int HL_STRIDE = 4112;
constexpr int HL_BYTES = 32 * HL_STRIDE;
constexpr int PART_OFF = 132096;
constexpr int LOGIT_OFF = PART_OFF + 8192;
constexpr int DST_OFF = LOGIT_OFF + 4096;

__device__ __forceinline__ f32x4 mod4(const float* modp, const float* b_ada, int b, int idx) {
    f32x4 s = *(const f32x4*)(b_ada + idx);
#pragma unroll
    for (int ks = 0; ks < 4; ++ks) s += *(const f32x4*)(modp + ((size_t)ks * 4 + b) * (6 * D) + idx);
    return s;
}
template <bool FROM_PARTIALS>
__device__ __forceinline__ void norm_rows_32(Frame& F, const float* xin, const float* gvec, const float* modsrc, const float* b_ada, int chunk_sh, int rb, bf16_t* gout, unsigned char* gout8 = nullptr) {
    const int b = rb >> 6; int lane = F.lane; asm volatile("" : "+v"(lane));
    f32x4 xa[8], xb[8];
    const float* xr = xin + ((size_t)rb * 32 + 4 * F.wave) * D + 4 * lane;
#pragma unroll
    for (int j = 0; j < 8; ++j) xa[j] = *(const f32x4*)(xr + 256 * j);
#pragma unroll
    for (int j = 0; j < 8; ++j) xb[j] = *(const f32x4*)(xr + D + 256 * j);
    f32x4 xc[8], xd[8];
    if (!FROM_PARTIALS) {
#pragma unroll
        for (int j = 0; j < 8; ++j) xc[j] = *(const f32x4*)(xr + 2 * D + 256 * j);
#pragma unroll
        for (int j = 0; j < 8; ++j) xd[j] = *(const f32x4*)(xr + 3 * D + 256 * j);
    }
    f32x4 gsc[8], shv[8];
#pragma unroll
    for (int j = 0; j < 8; ++j) {
        const int col = 4 * (lane + 64 * j);
        f32x4 sh, sc;
        if (FROM_PARTIALS) { sh = mod4(modsrc, b_ada, b, chunk_sh * D + col); sc = mod4(modsrc, b_ada, b, (chunk_sh + 1) * D + col); }
        else { sh = *(const f32x4*)(modsrc + (size_t)b * (6 * D) + chunk_sh * D + col); sc = *(const f32x4*)(modsrc + (size_t)b * (6 * D) + (chunk_sh + 1) * D + col); }
        const f32x4 g = *(const f32x4*)(gvec + col);
        gsc[j] = g * (sc + 1.0f); shv[j] = sh;
        if (j & 1) __builtin_amdgcn_sched_barrier(0);
    }
#pragma unroll
    for (int i = 0; i < 4; ++i) {
        const int r = 4 * F.wave + i; const size_t row = (size_t)rb * 32 + r;
        f32x4 xv[8]; float ss = 0.f;
#pragma unroll
        for (int j = 0; j < 8; ++j) { xv[j] = FROM_PARTIALS ? ((i & 1) ? xb[j] : xa[j]) : (i == 0 ? xa[j] : i == 1 ? xb[j] : i == 2 ? xc[j] : xd[j]); ss += (xv[j][0] * xv[j][0] + xv[j][1] * xv[j][1]) + (xv[j][2] * xv[j][2] + xv[j][3] * xv[j][3]); }
        if (FROM_PARTIALS && i < 2) {
#pragma unroll
            for (int j = 0; j < 8; ++j) { const f32x4 nx = *(const f32x4*)(xr + (size_t)(i + 2) * D + 256 * j); if (i & 1) xb[j] = nx; else xa[j] = nx; }
        }
        __builtin_amdgcn_sched_barrier(0);
        const float rinv = rsqrtf(wave_sum(ss) * (1.0f / D) + EPS);
        int ls = lane; asm volatile("" : "+v"(ls));
        const size_t so = row * D + 4 * (size_t)ls;
#pragma unroll
        for (int j = 0; j < 8; ++j) {
            const f32x4 hv = xv[j] * rinv * gsc[j] + shv[j];
            u32x2 p; p.x = pk2(hv[0], hv[1]); p.y = pk2(hv[2], hv[3]);
            *(LAS u32x2*)(F.lds + r * HL_STRIDE + 8 * ls + 512 * j) = p;
            if (gout) *(u32x2*)(gout + so + 256 * j) = p;
            if (gout8) *(unsigned*)(gout8 + so + 256 * j) = pk4_fp8(hv[0], hv[1], hv[2], hv[3]);
        }
        __builtin_amdgcn_sched_barrier(0);
    }
}
__device__ __forceinline__ void norm_rows_32_b(Frame& F, const bf16_t* xin, const float* gvec, const float* modsrc, int chunk_sh, int rb) {
    const int b = rb >> 6; int lane = F.lane; asm volatile("" : "+v"(lane));
    u32x2 xr_[4][8];
    const bf16_t* xr = xin + ((size_t)rb * 32 + 4 * F.wave) * D + 4 * lane;
#pragma unroll
    for (int i = 0; i < 4; ++i)
#pragma unroll
        for (int j = 0; j < 8; ++j) xr_[i][j] = *(const u32x2*)(xr + (size_t)i * D + 256 * j);
    f32x4 gsc[8], shv[8];
#pragma unroll
    for (int j = 0; j < 8; ++j) {
        const int col = 4 * (lane + 64 * j);
        const f32x4 sh = *(const f32x4*)(modsrc + (size_t)b * (6 * D) + chunk_sh * D + col), sc = *(const f32x4*)(modsrc + (size_t)b * (6 * D) + (chunk_sh + 1) * D + col);
        const f32x4 g = *(const f32x4*)(gvec + col);
        gsc[j] = g * (sc + 1.0f); shv[j] = sh;
    }
#pragma unroll
    for (int i = 0; i < 4; ++i) {
        const int r = 4 * F.wave + i;
        f32x4 xv[8]; float ss = 0.f;
#pragma unroll
        for (int j = 0; j < 8; ++j) { const u32x2 q = xr_[i][j]; xv[j] = (f32x4){bf_lo(q.x), bf_hi(q.x), bf_lo(q.y), bf_hi(q.y)}; ss += (xv[j][0] * xv[j][0] + xv[j][1] * xv[j][1]) + (xv[j][2] * xv[j][2] + xv[j][3] * xv[j][3]); }
        const float rinv = rsqrtf(wave_sum(ss) * (1.0f / D) + EPS);
#pragma unroll
        for (int j = 0; j < 8; ++j) {
            const f32x4 hv = xv[j] * rinv * gsc[j] + shv[j];
            u32x2 p; p.x = pk2(hv[0], hv[1]); p.y = pk2(hv[2], hv[3]);
            *(LAS u32x2*)(F.lds + r * HL_STRIDE + 8 * lane + 512 * j) = p;
        }
    }
}
__device__ __forceinline__ void p1_rows(Frame& F, const Args& a) {
    unsigned char* ws = F.ws;
    const float* modp = (const float*)(ws + WS_MODP);
    { float* modf = (float*)(ws + WS_MODF);
      for (int i = F.wg * 512 + F.tid; i < NB * 6 * D; i += F.G * 512) { const int b = i / (6 * D), idx = i % (6 * D); float s = a.in[I_BADA][idx];
#pragma unroll
          for (int ks = 0; ks < 4; ++ks) s += modp[((size_t)ks * 4 + b) * (6 * D) + idx];
          modf[i] = s; } }
    if (F.wg == 0 && F.wave == 0) {
        float mq = fmaxf(fabsf(a.in[I_GQ][2 * F.lane]), fabsf(a.in[I_GQ][2 * F.lane + 1])), mk = fmaxf(fabsf(a.in[I_GK][2 * F.lane]), fabsf(a.in[I_GK][2 * F.lane + 1]));
#pragma unroll
        for (int o = 1; o < 64; o <<= 1) { mq = fmaxf(mq, __shfl_xor(mq, o)); mk = fmaxf(mk, __shfl_xor(mk, o)); }
        if (F.lane == 0) ((float*)F.ctl)[CW_MISC] = 16.3223f * 1.01f * mq * mk;
    }
    const bf16_t* wgf = (const bf16_t*)(ws + WS_WGF);
    float* gates = (float*)(ws + WS_GATES);
    LAS float* part = (LAS float*)(F.lds + PART_OFF);
    const int lane = F.lane, l15 = lane & 15, g4 = lane >> 4;
    for (int rb = F.wg; rb < T / 32; rb += F.G) {
        norm_rows_32<true>(F, a.in[I_X], a.in[I_GMIX], modp, a.in[I_BADA], 0, rb, nullptr, ws + WS_HBUF8);
        { const int rg = F.wave & 1, kq = F.wave >> 1; f32x4 acc = {0.f, 0.f, 0.f, 0.f};
          bf16x8 bvv[16];
          __builtin_amdgcn_sched_barrier(0);
          const bf16_t* wq = wgf + ((size_t)(16 * kq) * 64 + lane) * 8; asm volatile("" : "+v"(wq));
#pragma unroll
          for (int s = 0; s < 16; ++s) bvv[s] = *(const bf16x8*)(wq + (size_t)s * 512);
          __syncthreads();
#pragma unroll
          for (int s = 0; s < 16; ++s) { const int ks = 16 * kq + s;
              const bf16x8 av = *(const LAS bf16x8*)(F.lds + (16 * rg + l15) * HL_STRIDE + (32 * ks + 8 * g4) * 2);
              acc = __builtin_amdgcn_mfma_f32_16x16x32_bf16(av, bvv[s], acc, 0, 0, 0); }
#pragma unroll
          for (int r = 0; r < 4; ++r) part[(kq * 2 + rg) * 256 + (4 * g4 + r) * 16 + l15] = acc[r]; }
        __syncthreads();
        { const int rg = F.tid >> 8, rc = F.tid & 255; float s = 0.f;
#pragma unroll
          for (int kq = 0; kq < 4; ++kq) s += part[(kq * 2 + rg) * 256 + rc];
          gates[((size_t)rb * 32 + 16 * rg + (rc >> 4)) * 16 + (rc & 15)] = s; }
        __syncthreads();
    }
    if (F.G == 256) { for (int q = F.G - 1 - F.vcu; q < 640; q += F.G) cvt8_win_sub(F, a, q); }
}

__device__ __forceinline__ void p3_qknorm(Frame& F, const Args& a) {
    bf16_t* z = (bf16_t*)(F.ws + WS_Z); float* kmean = (float*)(F.ws + WS_KMEAN);
    LAS float* cs = (LAS float*)F.lds;
    const int lane = F.lane;
    for (int u = F.wg; u < 512; u += F.G) {
        const int which = u & 1, h = (u >> 1) & 7, blk = (u >> 4) & 7, b = u >> 7;
        const float* gv = which ? a.in[I_GK] : a.in[I_GQ];
        const float g0 = gv[2 * lane], g1 = gv[2 * lane + 1];
        bf16_t* base = z + ((size_t)b * SEQ + blk * 256 + 32 * F.wave) * ZP + (which ? ZKB : ZQB) + h * 128 + 2 * lane;
        unsigned v[32];
#pragma unroll
        for (int i = 0; i < 32; ++i) v[i] = *(const unsigned*)(base + (size_t)i * ZP);
        float c0 = 0.f, c1 = 0.f;
#pragma unroll
        for (int i = 0; i < 32; ++i) {
            const float f0 = bf_lo(v[i]), f1 = bf_hi(v[i]);
            const float rinv = rsqrtf(wave_sum(f0 * f0 + f1 * f1) * (1.0f / 128.0f) + EPS);
            const float y0 = f0 * rinv * g0, y1 = f1 * rinv * g1;
            *(unsigned*)(base + (size_t)i * ZP) = pk2(y0, y1);
            c0 += y0; c1 += y1;
        }
        if (which) {
            cs[F.wave * 128 + 2 * lane] = c0; cs[F.wave * 128 + 2 * lane + 1] = c1;
            __syncthreads();
            if (F.tid < 128) { float s = 0.f;
#pragma unroll
                for (int w = 0; w < 8; ++w) s += cs[w * 128 + F.tid];
                kmean[(((size_t)b * 8 + h) * 8 + blk) * 128 + F.tid] = s * (1.0f / 256.0f); }
            __syncthreads();
        }
    }
}

__device__ __forceinline__ s16x4 tr16(LAS unsigned char* p) { return __builtin_amdgcn_ds_read_tr16_b64_v4i16((LAS s16x4*)p); }
__device__ __forceinline__ bf16x8 cat8(s16x4 a, s16x4 b) { return (bf16x8){a[0], a[1], a[2], a[3], b[0], b[1], b[2], b[3]}; }
#define MFMA16(a, b, c) __builtin_amdgcn_mfma_f32_16x16x32_bf16((a), (b), (c), 0, 0, 0)

struct ChunkGates { float li, bcs, u, pmx, g, umax; };
__device__ __forceinline__ ChunkGates chunk_gates(float gi_raw, float gf_raw, float bi, float bfg, int lane) {
    ChunkGates G;
    const float ti = __expf((gi_raw + bi) * (2.0f / 15.0f)), tf = __expf((gf_raw + bfg) * (2.0f / 15.0f));
    G.li = 15.0f - 30.0f * __builtin_amdgcn_rcpf(ti + 1.0f);
    const float xf = 15.0f - 30.0f * __builtin_amdgcn_rcpf(tf + 1.0f);
    const float lf = fminf(xf, 0.f) - __logf(1.0f + __expf(-fabsf(xf)));
    float bcs = lf;
#pragma unroll
    for (int o = 1; o < 64; o <<= 1) { const float t = __shfl_up(bcs, o); if (lane >= o) bcs += t; }
    G.bcs = bcs; G.g = __shfl(bcs, 63); G.u = G.li - bcs;
    float pmx = G.u;
#pragma unroll
    for (int o = 1; o < 64; o <<= 1) { const float t = __shfl_up(pmx, o); if (lane >= o) pmx = fmaxf(pmx, t); }
    G.pmx = pmx; G.umax = __shfl(pmx, 63);
    return G;
}
constexpr int ML_QS = 0, ML_KS = 9216, ML_KW = 18432, ML_VS = 27648, ML_SB = 45056, ML_CB = 54272, ML_HO = 72704, ML_FLO = 90112, ML_RS = 144, ML_VR = 272;

struct PassAIn { u32x4 kv, v0, v1; float gi, gf; };
__device__ __forceinline__ PassAIn mlstm_passA_load(Frame& F, int u) {
    const bf16_t* z = (const bf16_t*)(F.ws + WS_Z); const float* gates = (const float*)(F.ws + WS_GATES);
    const int c = u & 31, h = (u >> 5) & 7, b = u >> 8;
    const size_t tok0 = (size_t)b * SEQ + c * 64;
    const int lr = F.tid >> 3, ls = F.tid & 7;
    const bf16_t* zr = z + (tok0 + lr) * ZP;
    PassAIn I;
    I.kv = *(const u32x4*)(zr + ZKA + h * 64 + ls * 8);
    I.v0 = *(const u32x4*)(zr + ZVA + h * 128 + ls * 8); I.v1 = *(const u32x4*)(zr + ZVA + h * 128 + 64 + ls * 8);
    I.gi = gates[(tok0 + F.lane) * 16 + h]; I.gf = gates[(tok0 + F.lane) * 16 + 8 + h];
    return I;
}
__device__ __forceinline__ void mlstm_passA(Frame& F, const Args& a, int u, const PassAIn& I) {
    LAS unsigned char* L = F.lds; LAS float* fl = (LAS float*)(L + ML_FLO);
    float* cloc = (float*)(F.ws + WS_CLOC) + (size_t)u * 8192; float* nloc = (float*)(F.ws + WS_NLOC) + (size_t)u * 64; float* msc = (float*)(F.ws + WS_MSC) + (size_t)u * 4;
    const int tid = F.tid, lane = F.lane, w = F.wave, l15 = lane & 15, g4 = lane >> 4;
    const int h = (u >> 5) & 7;
    const int lr = tid >> 3, ls = tid & 7;
    const u32x4 kv = I.kv, v0 = I.v0, v1 = I.v1;
    __syncthreads();
    if (w == 0) {
        const ChunkGates G = chunk_gates(I.gi, I.gf, a.in[I_BIG][h], a.in[I_BFG][h], lane);
        fl[256 + lane] = __expf(G.u - G.umax);
        if (lane == 0) { msc[0] = G.g + G.umax; msc[1] = G.g; }
    }
    *(LAS u32x4*)(L + ML_VS + lr * ML_VR + ls * 16) = v0; *(LAS u32x4*)(L + ML_VS + lr * ML_VR + 128 + ls * 16) = v1;
    __syncthreads();
    { const float wr_ = fl[256 + lr];
      u32x4 o; o.x = pk2(bf_lo(kv.x) * wr_, bf_hi(kv.x) * wr_); o.y = pk2(bf_lo(kv.y) * wr_, bf_hi(kv.y) * wr_); o.z = pk2(bf_lo(kv.z) * wr_, bf_hi(kv.z) * wr_); o.w = pk2(bf_lo(kv.w) * wr_, bf_hi(kv.w) * wr_);
      *(LAS u32x4*)(L + ML_KW + lr * ML_RS + ls * 16) = o; }
    __syncthreads();
    f32x4 Cacc[4];
#pragma unroll
    for (int et = 0; et < 4; ++et) Cacc[et] = (f32x4){0.f, 0.f, 0.f, 0.f};
#pragma unroll
    for (int ks = 0; ks < 2; ++ks) {
        LAS unsigned char* vp = L + ML_VS + (32 * ks + 8 * g4 + (l15 >> 2)) * ML_VR + (16 * w + 4 * (l15 & 3)) * 2;
        const bf16x8 av = cat8(tr16(vp), tr16(vp + 4 * ML_VR));
#pragma unroll
        for (int et = 0; et < 4; ++et) {
            LAS unsigned char* kp = L + ML_KW + (32 * ks + 8 * g4 + (l15 >> 2)) * ML_RS + (16 * et + 4 * (l15 & 3)) * 2;
            Cacc[et] = MFMA16(av, cat8(tr16(kp), tr16(kp + 4 * ML_RS)), Cacc[et]); } }
#pragma unroll
    for (int et = 0; et < 4; ++et)
#pragma unroll
        for (int r = 0; r < 4; ++r) cloc[(16 * w + 4 * g4 + r) * 64 + 16 * et + l15] = Cacc[et][r];
    { const int e = tid >> 3, part = tid & 7; float sacc = 0.f;
#pragma unroll
      for (int i = 0; i < 8; ++i) sacc += bf1(*(const LAS bf16_t*)(L + ML_KW + (8 * part + i) * ML_RS + e * 2));
      sacc = sum8_(sacc);
      if (part == 0) nloc[e] = sacc; }
}

__device__ __forceinline__ void mlstm_passA4(Frame& F, const Args& a) {
    constexpr int CH = 27648, VS = 0, KW = 17408, FL = 26624;
    const bf16_t* z = (const bf16_t*)(F.ws + WS_Z); const float* gates = (const float*)(F.ws + WS_GATES);
    int tid = F.tid; asm volatile("" : "+v"(tid));
    const int lane = tid & 63, w = F.wave, l15 = lane & 15, g4 = lane >> 4, lr = tid >> 3, ls = tid & 7;
    u32x4 kv[4], v0[4], v1[4]; float gi[4], gf[4];
#pragma unroll
    for (int k = 0; k < 4; ++k) {
        const int u = F.wg + 256 * k, c = u & 31, h = (u >> 5) & 7, b = u >> 8;
        const size_t tok0 = (size_t)b * SEQ + c * 64;
        const bf16_t* zr = z + (tok0 + lr) * ZP;
        kv[k] = *(const u32x4*)(zr + ZKA + h * 64 + ls * 8);
        v0[k] = *(const u32x4*)(zr + ZVA + h * 128 + ls * 8); v1[k] = *(const u32x4*)(zr + ZVA + h * 128 + 64 + ls * 8);
        gi[k] = gates[(tok0 + lane) * 16 + h]; gf[k] = gates[(tok0 + lane) * 16 + 8 + h];
    }
    __syncthreads();
#pragma unroll
    for (int k = 0; k < 4; ++k) {
        const int u = F.wg + 256 * k, h = (u >> 5) & 7;
        LAS unsigned char* L = F.lds + k * CH; LAS float* fl = (LAS float*)(L + FL);
        if (w == k) {
            const ChunkGates G = chunk_gates(gi[k], gf[k], a.in[I_BIG][h], a.in[I_BFG][h], lane);
            fl[lane] = __expf(G.u - G.umax);
            if (lane == 0) { float* msc = (float*)(F.ws + WS_MSC) + (size_t)u * 4; msc[0] = G.g + G.umax; msc[1] = G.g; }
        }
        *(LAS u32x4*)(L + VS + lr * ML_VR + ls * 16) = v0[k]; *(LAS u32x4*)(L + VS + lr * ML_VR + 128 + ls * 16) = v1[k];
    }
    __syncthreads();
#pragma unroll
    for (int k = 0; k < 4; ++k) {
        LAS unsigned char* L = F.lds + k * CH; const LAS float* fl = (const LAS float*)(L + FL);
        const float wr_ = fl[lr]; const u32x4 q = kv[k];
        u32x4 o; o.x = pk2(bf_lo(q.x) * wr_, bf_hi(q.x) * wr_); o.y = pk2(bf_lo(q.y) * wr_, bf_hi(q.y) * wr_); o.z = pk2(bf_lo(q.z) * wr_, bf_hi(q.z) * wr_); o.w = pk2(bf_lo(q.w) * wr_, bf_hi(q.w) * wr_);
        *(LAS u32x4*)(L + KW + lr * ML_RS + ls * 16) = o;
    }
    __syncthreads();
#pragma unroll
    for (int k = 0; k < 4; ++k) {
        const int u = F.wg + 256 * k;
        LAS unsigned char* L = F.lds + k * CH;
        float* cloc = (float*)(F.ws + WS_CLOC) + (size_t)u * 8192; float* nloc = (float*)(F.ws + WS_NLOC) + (size_t)u * 64;
        f32x4 Cacc[4];
#pragma unroll
        for (int et = 0; et < 4; ++et) Cacc[et] = (f32x4){0.f, 0.f, 0.f, 0.f};
#pragma unroll
        for (int ks = 0; ks < 2; ++ks) {
            LAS unsigned char* vp = L + VS + (32 * ks + 8 * g4 + (l15 >> 2)) * ML_VR + (16 * w + 4 * (l15 & 3)) * 2;
            const bf16x8 av = cat8(tr16(vp), tr16(vp + 4 * ML_VR));
#pragma unroll
            for (int et = 0; et < 4; ++et) {
                LAS unsigned char* kp = L + KW + (32 * ks + 8 * g4 + (l15 >> 2)) * ML_RS + (16 * et + 4 * (l15 & 3)) * 2;
                Cacc[et] = MFMA16(av, cat8(tr16(kp), tr16(kp + 4 * ML_RS)), Cacc[et]); } }
#pragma unroll
        for (int et = 0; et < 4; ++et)
#pragma unroll
            for (int r = 0; r < 4; ++r) cloc[(16 * w + 4 * g4 + r) * 64 + 16 * et + l15] = Cacc[et][r];
        { const int e = tid >> 3, part = tid & 7; float sacc = 0.f;
#pragma unroll
          for (int i = 0; i < 8; ++i) sacc += bf1(*(const LAS bf16_t*)(L + KW + (8 * part + i) * ML_RS + e * 2));
          sacc = sum8_(sacc);
          if (part == 0) nloc[e] = sacc; }
    }
}

__device__ __forceinline__ void mlstm_passB(Frame& F, int item) {
    const int bh = item >> 3, slice = item & 7, tid = F.tid;
    const float* cloc = (const float*)(F.ws + WS_CLOC) + (size_t)bh * 32 * 8192 + slice * 1024 + 2 * tid;
    bf16_t* cin = (bf16_t*)(F.ws + WS_CIN) + (size_t)bh * 32 * 8192 + slice * 1024 + 2 * tid;
    const float* nloc = (const float*)(F.ws + WS_NLOC) + (size_t)bh * 32 * 64 + 2 * tid;
    float* nin = (float*)(F.ws + WS_NIN) + (size_t)bh * 32 * 64 + 2 * tid;
    float* msc = (float*)(F.ws + WS_MSC) + (size_t)bh * 32 * 4;
    const bool do_n = (slice == 0) && (tid < 32);
    f32x2 cl[32], nl[32], mg[32];
#pragma unroll
    for (int c = 0; c < 32; ++c) { cl[c] = *(const f32x2*)(cloc + (size_t)c * 8192); nl[c] = do_n ? *(const f32x2*)(nloc + c * 64) : (f32x2){0.f, 0.f}; mg[c] = *(const f32x2*)(msc + c * 4); }
    __builtin_amdgcn_sched_barrier(0);
    float m = 0.f; f32x2 C = {0.f, 0.f}, N = {0.f, 0.f};
#pragma unroll
    for (int c = 0; c < 32; ++c) {
        *(unsigned*)(cin + (size_t)c * 8192) = pk2(C[0], C[1]);
        if (do_n) *(f32x2*)(nin + c * 64) = N;
        if (slice == 0 && tid == 0) msc[c * 4 + 2] = m;
        const float mloc = mg[c][0], g = mg[c][1];
        const float m_new = fmaxf(g + m, mloc), sp = __expf(g + m - m_new), sl = __expf(mloc - m_new);
        C = C * sp + cl[c] * sl; N = N * sp + nl[c] * sl; m = m_new;
    }
}

__device__ __forceinline__ void mlstm_passC(Frame& F, const Args& a, int u) {
    constexpr int QS = ML_QS, KS = ML_KS, VS = ML_VS, SB = ML_SB, CB = ML_CB, HO = ML_HO, RS = ML_RS, VR = ML_VR;
    LAS unsigned char* L = F.lds; LAS float* fl = (LAS float*)(L + ML_FLO);
    const bf16_t* z = (const bf16_t*)(F.ws + WS_Z); const float* gates = (const float*)(F.ws + WS_GATES);
    unsigned char* hm = F.ws + WS_HM;
    int tid = F.tid; asm volatile("" : "+v"(tid));
    const int lane = tid & 63, w = F.wave, l15 = lane & 15, g4 = lane >> 4;
    const int c = u & 31, h = (u >> 5) & 7, b = u >> 8;
    const float* gmo = a.in[I_GMO] + h * 128;
    const size_t tok0 = (size_t)b * SEQ + c * 64;
    const int lr = tid >> 3, ls = tid & 7, jt = w & 3, hf = w >> 2;
    const bf16_t* zr = z + (tok0 + lr) * ZP;
    const u32x4 qv = *(const u32x4*)(zr + ZQA + h * 64 + ls * 8), kv = *(const u32x4*)(zr + ZKA + h * 64 + ls * 8);
    const u32x4 v0 = *(const u32x4*)(zr + ZVA + h * 128 + ls * 8), v1 = *(const u32x4*)(zr + ZVA + h * 128 + 64 + ls * 8);
    const u32x4 oc0 = *(const u32x4*)(zr + ZOA + h * 128 + ls * 16), oc1 = *(const u32x4*)(zr + ZOA + h * 128 + ls * 16 + 8);
    const bf16_t* cin = (const bf16_t*)(F.ws + WS_CIN) + (size_t)u * 8192;
    const u32x4 c0 = *(const u32x4*)(cin + tid * 8), c1 = *(const u32x4*)(cin + 4096 + tid * 8);
    const float* msc = (const float*)(F.ws + WS_MSC) + (size_t)u * 4;
    const float mstate = msc[2], gi_raw = gates[(tok0 + lane) * 16 + h], gf_raw = gates[(tok0 + lane) * 16 + 8 + h], big = a.in[I_BIG][h], bfg = a.in[I_BFG][h];
    const float nin_l = ((const float*)(F.ws + WS_NIN))[(size_t)u * 64 + lane];
    float gmo_r[4];
#pragma unroll
    for (int d4 = 0; d4 < 4; ++d4) gmo_r[d4] = gmo[16 * (4 * hf + d4) + l15];
    __syncthreads();
    if (w == 0) {
        const ChunkGates G = chunk_gates(gi_raw, gf_raw, big, bfg, lane);
        const float M = fmaxf(mstate, G.pmx);
        fl[lane] = -M; fl[64 + lane] = G.u; fl[128 + lane] = __expf(mstate - M); fl[192 + lane] = __expf(-(G.bcs + M));
    }
    if (w == 1) fl[640 + lane] = nin_l;
    *(LAS u32x4*)(L + QS + lr * RS + ls * 16) = qv; *(LAS u32x4*)(L + KS + lr * RS + ls * 16) = kv;
    *(LAS u32x4*)(L + VS + lr * VR + ls * 16) = v0; *(LAS u32x4*)(L + VS + lr * VR + 128 + ls * 16) = v1;
    *(LAS u32x4*)(L + CB + lr * RS + ls * 16) = c0; *(LAS u32x4*)(L + CB + (64 + lr) * RS + ls * 16) = c1;
    __syncthreads();
    { const LAS float* nv = fl + 640 + ls * 8;
      float s = bf_lo(qv.x) * nv[0] + bf_hi(qv.x) * nv[1] + bf_lo(qv.y) * nv[2] + bf_hi(qv.y) * nv[3] + bf_lo(qv.z) * nv[4] + bf_hi(qv.z) * nv[5] + bf_lo(qv.w) * nv[6] + bf_hi(qv.w) * nv[7];
      s = sum8_(s);
      if (ls == 0) fl[320 + lr] = s * 0.125f; }
    { bf16x8 aq[2];
#pragma unroll
      for (int ks = 0; ks < 2; ++ks) aq[ks] = *(const LAS bf16x8*)(L + QS + (16 * jt + l15) * RS + (32 * ks + 8 * g4) * 2);
      float rsum[4] = {0.f, 0.f, 0.f, 0.f};
#pragma unroll
      for (int st2 = 0; st2 < 2; ++st2) { const int st = 2 * hf + st2; f32x4 s = {0.f, 0.f, 0.f, 0.f};
          if (st <= jt) {
#pragma unroll
              for (int ks = 0; ks < 2; ++ks) { const bf16x8 bk = *(const LAS bf16x8*)(L + KS + (16 * st + l15) * RS + (32 * ks + 8 * g4) * 2); s = MFMA16(aq[ks], bk, s); } }
          const int scol = 16 * st + l15; const float cf = fl[64 + scol];
#pragma unroll
          for (int r = 0; r < 4; ++r) { const int j = 16 * jt + 4 * g4 + r;
              const float val = (scol <= j) ? s[r] * 0.125f * __expf(fl[j] + cf) : 0.f; rsum[r] += val;
              *(LAS bf16_t*)(L + SB + j * RS + scol * 2) = f2bf(val); } }
#pragma unroll
      for (int r = 0; r < 4; ++r) { float t = sum16_(rsum[r]);
          if (l15 == 0) fl[384 + hf * 64 + 16 * jt + 4 * g4 + r] = t; } }
    __syncthreads();
    float hv[4][4];
    { bf16x8 as_[2], aq[2];
#pragma unroll
      for (int ks = 0; ks < 2; ++ks) { as_[ks] = *(const LAS bf16x8*)(L + SB + (16 * jt + l15) * RS + (32 * ks + 8 * g4) * 2); aq[ks] = *(const LAS bf16x8*)(L + QS + (16 * jt + l15) * RS + (32 * ks + 8 * g4) * 2); }
      float si[4], dn[4], en[4], ss[4] = {0.f, 0.f, 0.f, 0.f};
#pragma unroll
      for (int r = 0; r < 4; ++r) { const int j = 16 * jt + 4 * g4 + r; si[r] = fl[128 + j]; dn[r] = fl[384 + j] + fl[448 + j] + si[r] * fl[320 + j]; en[r] = fl[192 + j]; si[r] *= 0.125f; }
#pragma unroll
      for (int d4 = 0; d4 < 4; ++d4) { const int dt = 4 * hf + d4; f32x4 nacc = {0.f, 0.f, 0.f, 0.f}, iacc = nacc;
#pragma unroll
          for (int ks = 0; ks < 2; ++ks) {
              LAS unsigned char* vp = L + VS + (32 * ks + 8 * g4 + (l15 >> 2)) * VR + (16 * dt + 4 * (l15 & 3)) * 2;
              nacc = MFMA16(as_[ks], cat8(tr16(vp), tr16(vp + 4 * VR)), nacc);
              const bf16x8 bc = *(const LAS bf16x8*)(L + CB + (16 * dt + l15) * RS + (32 * ks + 8 * g4) * 2);
              iacc = MFMA16(aq[ks], bc, iacc); }
#pragma unroll
          for (int r = 0; r < 4; ++r) { const float num = nacc[r] + si[r] * iacc[r]; const float hvv = num * __builtin_amdgcn_rcpf(fmaxf(fabsf(dn[r]), en[r])); hv[d4][r] = hvv; ss[r] += hvv * hvv; } }
#pragma unroll
      for (int r = 0; r < 4; ++r) { float t = sum16_(ss[r]);
          if (l15 == 0) fl[512 + hf * 64 + 16 * jt + 4 * g4 + r] = t; } }
    __syncthreads();
    { float rinv[4];
#pragma unroll
      for (int r = 0; r < 4; ++r) { const int j = 16 * jt + 4 * g4 + r; rinv[r] = rsqrtf((fl[512 + j] + fl[576 + j]) * (1.0f / 128.0f) + EPS); }
#pragma unroll
      for (int d4 = 0; d4 < 4; ++d4) { const int d = 16 * (4 * hf + d4) + l15; const float gg = gmo_r[d4];
#pragma unroll
          for (int r = 0; r < 4; ++r) *(LAS bf16_t*)(L + HO + (16 * jt + 4 * g4 + r) * VR + d * 2) = f2bf(hv[d4][r] * rinv[r] * gg); } }
    __syncthreads();
    { const u32x4 h0 = *(const LAS u32x4*)(L + HO + lr * VR + ls * 32), h1 = *(const LAS u32x4*)(L + HO + lr * VR + ls * 32 + 16);
#define HG(hw, ow, lo) ((lo ? bf_lo(hw) : bf_hi(hw)) * sigmoidf_(lo ? bf_lo(ow) : bf_hi(ow)) * H8_SCALE)
      u32x4 r;
      r.x = pk4_fp8(HG(h0.x, oc0.x, 1), HG(h0.x, oc0.x, 0), HG(h0.y, oc0.y, 1), HG(h0.y, oc0.y, 0));
      r.y = pk4_fp8(HG(h0.z, oc0.z, 1), HG(h0.z, oc0.z, 0), HG(h0.w, oc0.w, 1), HG(h0.w, oc0.w, 0));
      r.z = pk4_fp8(HG(h1.x, oc1.x, 1), HG(h1.x, oc1.x, 0), HG(h1.y, oc1.y, 1), HG(h1.y, oc1.y, 0));
      r.w = pk4_fp8(HG(h1.z, oc1.z, 1), HG(h1.z, oc1.z, 0), HG(h1.w, oc1.w, 1), HG(h1.w, oc1.w, 0));
#undef HG
      *(u32x4*)(hm + (tok0 + lr) * 1024 + h * 128 + ls * 16) = r; }
}

__device__ __forceinline__ void mlstm_passC2(Frame& F, const Args& a, int ua, int ub) {
    constexpr int QS = 0, KS = 9216, VS = 18432, SB = 35840, CB = 45056, HO = 0, FLO = 63488, CH = 66560, RS = ML_RS, VR = ML_VR;
    const bf16_t* z = (const bf16_t*)(F.ws + WS_Z); const float* gates = (const float*)(F.ws + WS_GATES);
    unsigned char* hm = F.ws + WS_HM;
    int tid = F.tid; asm volatile("" : "+v"(tid));
    const int lane = tid & 63, w = F.wave, l15 = lane & 15, g4 = lane >> 4;
    const int lr = tid >> 3, ls = tid & 7, jt = w & 3, hf = w >> 2;
    u32x4 qv[2], kv[2], v0[2], v1[2], oc0[2], oc1[2], c0[2], c1[2];
    float mstate[2], gi_raw[2], gf_raw[2], big[2], bfg[2], nin_l[2], gmo_r[2][4];
    size_t tok0[2]; int hh[2];
#pragma unroll
    for (int k = 0; k < 2; ++k) {
        const int u = k ? ub : ua, c = u & 31, h = (u >> 5) & 7, b = u >> 8;
        hh[k] = h; tok0[k] = (size_t)b * SEQ + c * 64;
        const bf16_t* zr = z + (tok0[k] + lr) * ZP;
        qv[k] = *(const u32x4*)(zr + ZQA + h * 64 + ls * 8); kv[k] = *(const u32x4*)(zr + ZKA + h * 64 + ls * 8);
        v0[k] = *(const u32x4*)(zr + ZVA + h * 128 + ls * 8); v1[k] = *(const u32x4*)(zr + ZVA + h * 128 + 64 + ls * 8);
        oc0[k] = *(const u32x4*)(zr + ZOA + h * 128 + ls * 16); oc1[k] = *(const u32x4*)(zr + ZOA + h * 128 + ls * 16 + 8);
        const bf16_t* cin = (const bf16_t*)(F.ws + WS_CIN) + (size_t)u * 8192;
        c0[k] = *(const u32x4*)(cin + tid * 8); c1[k] = *(const u32x4*)(cin + 4096 + tid * 8);
        const float* msc = (const float*)(F.ws + WS_MSC) + (size_t)u * 4;
        mstate[k] = msc[2]; gi_raw[k] = gates[(tok0[k] + lane) * 16 + h]; gf_raw[k] = gates[(tok0[k] + lane) * 16 + 8 + h]; big[k] = a.in[I_BIG][h]; bfg[k] = a.in[I_BFG][h];
        nin_l[k] = ((const float*)(F.ws + WS_NIN))[(size_t)u * 64 + lane];
        const float* gmo = a.in[I_GMO] + h * 128;
#pragma unroll
        for (int d4 = 0; d4 < 4; ++d4) gmo_r[k][d4] = gmo[16 * (4 * hf + d4) + l15];
    }
    __syncthreads();
#pragma unroll
    for (int k = 0; k < 2; ++k) {
        LAS unsigned char* L = F.lds + k * CH; LAS float* fl = (LAS float*)(L + FLO);
        if (w == k) {
            const ChunkGates G = chunk_gates(gi_raw[k], gf_raw[k], big[k], bfg[k], lane);
            const float M = fmaxf(mstate[k], G.pmx);
            fl[lane] = -M; fl[64 + lane] = G.u; fl[128 + lane] = __expf(mstate[k] - M); fl[192 + lane] = __expf(-(G.bcs + M));
        }
        if (w == 2 + k) fl[640 + lane] = nin_l[k];
        *(LAS u32x4*)(L + QS + lr * RS + ls * 16) = qv[k]; *(LAS u32x4*)(L + KS + lr * RS + ls * 16) = kv[k];
        *(LAS u32x4*)(L + VS + lr * VR + ls * 16) = v0[k]; *(LAS u32x4*)(L + VS + lr * VR + 128 + ls * 16) = v1[k];
        *(LAS u32x4*)(L + CB + lr * RS + ls * 16) = c0[k]; *(LAS u32x4*)(L + CB + (64 + lr) * RS + ls * 16) = c1[k];
    }
    __syncthreads();
#pragma unroll
    for (int k = 0; k < 2; ++k) {
        LAS unsigned char* L = F.lds + k * CH; LAS float* fl = (LAS float*)(L + FLO);
        { const LAS float* nv = fl + 640 + ls * 8; const u32x4 q = qv[k];
          float s = bf_lo(q.x) * nv[0] + bf_hi(q.x) * nv[1] + bf_lo(q.y) * nv[2] + bf_hi(q.y) * nv[3] + bf_lo(q.z) * nv[4] + bf_hi(q.z) * nv[5] + bf_lo(q.w) * nv[6] + bf_hi(q.w) * nv[7];
          s = sum8_(s);
          if (ls == 0) fl[320 + lr] = s * 0.125f; }
        { bf16x8 aq[2];
#pragma unroll
          for (int ks = 0; ks < 2; ++ks) aq[ks] = *(const LAS bf16x8*)(L + QS + (16 * jt + l15) * RS + (32 * ks + 8 * g4) * 2);
          float rsum[4] = {0.f, 0.f, 0.f, 0.f};
#pragma unroll
          for (int st2 = 0; st2 < 2; ++st2) { const int st = 2 * hf + st2; f32x4 s = {0.f, 0.f, 0.f, 0.f};
              if (st <= jt) {
#pragma unroll
                  for (int ks = 0; ks < 2; ++ks) { const bf16x8 bk = *(const LAS bf16x8*)(L + KS + (16 * st + l15) * RS + (32 * ks + 8 * g4) * 2); s = MFMA16(aq[ks], bk, s); } }
              const int scol = 16 * st + l15; const float cf = fl[64 + scol];
#pragma unroll
              for (int r = 0; r < 4; ++r) { const int j = 16 * jt + 4 * g4 + r;
                  const float val = (scol <= j) ? s[r] * 0.125f * __expf(fl[j] + cf) : 0.f; rsum[r] += val;
                  *(LAS bf16_t*)(L + SB + j * RS + scol * 2) = f2bf(val); } }
#pragma unroll
          for (int r = 0; r < 4; ++r) { float t = sum16_(rsum[r]);
              if (l15 == 0) fl[384 + hf * 64 + 16 * jt + 4 * g4 + r] = t; } }
    }
    __syncthreads();
    float hv[2][4][4];
#pragma unroll
    for (int k = 0; k < 2; ++k) {
        LAS unsigned char* L = F.lds + k * CH; LAS float* fl = (LAS float*)(L + FLO);
        bf16x8 as_[2], aq[2];
#pragma unroll
        for (int ks = 0; ks < 2; ++ks) { as_[ks] = *(const LAS bf16x8*)(L + SB + (16 * jt + l15) * RS + (32 * ks + 8 * g4) * 2); aq[ks] = *(const LAS bf16x8*)(L + QS + (16 * jt + l15) * RS + (32 * ks + 8 * g4) * 2); }
        float si[4], dn[4], en[4], ss[4] = {0.f, 0.f, 0.f, 0.f};
#pragma unroll
        for (int r = 0; r < 4; ++r) { const int j = 16 * jt + 4 * g4 + r; si[r] = fl[128 + j]; dn[r] = fl[384 + j] + fl[448 + j] + si[r] * fl[320 + j]; en[r] = fl[192 + j]; si[r] *= 0.125f; }
#pragma unroll
        for (int d4 = 0; d4 < 4; ++d4) { const int dt = 4 * hf + d4; f32x4 nacc = {0.f, 0.f, 0.f, 0.f}, iacc = nacc;
#pragma unroll
            for (int ks = 0; ks < 2; ++ks) {
                LAS unsigned char* vp = L + VS + (32 * ks + 8 * g4 + (l15 >> 2)) * VR + (16 * dt + 4 * (l15 & 3)) * 2;
                nacc = MFMA16(as_[ks], cat8(tr16(vp), tr16(vp + 4 * VR)), nacc);
                const bf16x8 bc = *(const LAS bf16x8*)(L + CB + (16 * dt + l15) * RS + (32 * ks + 8 * g4) * 2);
                iacc = MFMA16(aq[ks], bc, iacc); }
#pragma unroll
            for (int r = 0; r < 4; ++r) { const float num = nacc[r] + si[r] * iacc[r]; const float hvv = num * __builtin_amdgcn_rcpf(fmaxf(fabsf(dn[r]), en[r])); hv[k][d4][r] = hvv; ss[r] += hvv * hvv; } }
#pragma unroll
        for (int r = 0; r < 4; ++r) { float t = sum16_(ss[r]);
            if (l15 == 0) fl[512 + hf * 64 + 16 * jt + 4 * g4 + r] = t; }
    }
    __syncthreads();
#pragma unroll
    for (int k = 0; k < 2; ++k) {
        LAS unsigned char* L = F.lds + k * CH; LAS float* fl = (LAS float*)(L + FLO);
        float rinv[4];
#pragma unroll
        for (int r = 0; r < 4; ++r) { const int j = 16 * jt + 4 * g4 + r; rinv[r] = rsqrtf((fl[512 + j] + fl[576 + j]) * (1.0f / 128.0f) + EPS); }
#pragma unroll
        for (int d4 = 0; d4 < 4; ++d4) { const int d = 16 * (4 * hf + d4) + l15; const float gg = gmo_r[k][d4];
#pragma unroll
            for (int r = 0; r < 4; ++r) *(LAS bf16_t*)(L + HO + (16 * jt + 4 * g4 + r) * VR + d * 2) = f2bf(hv[k][d4][r] * rinv[r] * gg); }
    }
    __syncthreads();
#pragma unroll
    for (int k = 0; k < 2; ++k) {
        LAS unsigned char* L = F.lds + k * CH;
        const u32x4 h0 = *(const LAS u32x4*)(L + HO + lr * VR + ls * 32), h1 = *(const LAS u32x4*)(L + HO + lr * VR + ls * 32 + 16);
        const u32x4 o0 = oc0[k], o1 = oc1[k];
#define HG(hw, ow, lo) ((lo ? bf_lo(hw) : bf_hi(hw)) * sigmoidf_(lo ? bf_lo(ow) : bf_hi(ow)) * H8_SCALE)
        u32x4 r;
        r.x = pk4_fp8(HG(h0.x, o0.x, 1), HG(h0.x, o0.x, 0), HG(h0.y, o0.y, 1), HG(h0.y, o0.y, 0));
        r.y = pk4_fp8(HG(h0.z, o0.z, 1), HG(h0.z, o0.z, 0), HG(h0.w, o0.w, 1), HG(h0.w, o0.w, 0));
        r.z = pk4_fp8(HG(h1.x, o1.x, 1), HG(h1.x, o1.x, 0), HG(h1.y, o1.y, 1), HG(h1.y, o1.y, 0));
        r.w = pk4_fp8(HG(h1.z, o1.z, 1), HG(h1.z, o1.z, 0), HG(h1.w, o1.w, 1), HG(h1.w, o1.w, 0));
#undef HG
        *(u32x4*)(hm + (tok0[k] + lr) * 1024 + hh[k] * 128 + ls * 16) = r;
    }
}

template <bool FIXED>
__device__ __forceinline__ void moba_unit(Frame& F, const Args& a, int b, int h, int qb, const float B2) {
    constexpr int KT = 0, VT = 34816, KM = 88064, TS = 17408, VR = 272;
    LAS unsigned char* L = F.lds;
    const bf16_t* z = (const bf16_t*)(F.ws + WS_Z);
    const float* kmean = (const float*)(F.ws + WS_KMEAN) + ((size_t)b * 8 + h) * 8 * 128;
    unsigned char* ob = F.ws + WS_OB;
    int tid = F.tid; asm volatile("" : "+v"(tid));
    const int lane = tid & 63, w = F.wave, l15 = lane & 15, g4 = lane >> 4;
    const int q0 = qb * 256, blk = qb, ntile = 4 * qb + 4;
    const size_t tokb = (size_t)b * SEQ;
    __syncthreads();
    if (tid < 256) *(LAS f32x4*)(L + KM + tid * 16) = *(const f32x4*)(kmean + tid * 4);
    bf16x8 qf[2][4];
#pragma unroll
    for (int g = 0; g < 2; ++g) { const bf16_t* qr = z + (tokb + q0 + 32 * w + 16 * g + l15) * ZP + ZQB + h * 128 + 8 * g4;
#pragma unroll
        for (int ks = 0; ks < 4; ++ks) qf[g][ks] = *(const bf16x8*)(qr + 32 * ks); }
    const int key0 = tid >> 4, seg = tid & 15;
    const bf16_t* kbase = z + (tokb + key0) * ZP + ZKB + h * 128 + seg * 8;
    const bf16_t* vbase = z + (tokb + key0) * ZP + ZVB + h * 128 + seg * 8;
    u32x4 kA0 = *(const u32x4*)kbase, kA1 = *(const u32x4*)(kbase + (size_t)32 * ZP), vA0 = *(const u32x4*)vbase, vA1 = *(const u32x4*)(vbase + (size_t)32 * ZP);
    u32x4 kB0 = *(const u32x4*)(kbase + (size_t)64 * ZP), kB1 = *(const u32x4*)(kbase + (size_t)96 * ZP), vB0 = *(const u32x4*)(vbase + (size_t)64 * ZP), vB1 = *(const u32x4*)(vbase + (size_t)96 * ZP);
    __syncthreads();
    unsigned mymask[2];
#pragma unroll
    for (int g = 0; g < 2; ++g) {
        if (blk <= 3) mymask[g] = (1u << blk) - 1u;
        else {
            float gate[7];
#pragma unroll
            for (int n = 0; n < 7; ++n) { float s = 0.f;
                if (n < blk) {
#pragma unroll
                    for (int ks = 0; ks < 4; ++ks) { const LAS float* km = (const LAS float*)(L + KM) + n * 128 + 32 * ks + 8 * g4;
#pragma unroll
                        for (int j = 0; j < 8; ++j) s += bf1((bf16_t)qf[g][ks][j]) * km[j]; }
                    s += __shfl_xor(s, 16); s += __shfl_xor(s, 32); }
                gate[n] = (n < blk) ? s : -3.0e38f; }
            unsigned mm = 0u;
#pragma unroll
            for (int t = 0; t < 3; ++t) { float best = -3.0e38f; int bi = 0;
#pragma unroll
                for (int n = 0; n < 7; ++n) { const bool take = (n < blk) && !((mm >> n) & 1u) && (gate[n] > best); best = take ? gate[n] : best; bi = take ? n : bi; }
                mm |= 1u << bi; }
            mymask[g] = mm;
        }
    }
    f32x4 O[2][8];
#pragma unroll
    for (int g = 0; g < 2; ++g)
#pragma unroll
        for (int dt = 0; dt < 8; ++dt) O[g][dt] = (f32x4){0.f, 0.f, 0.f, 0.f};
    float mrun[2] = {-1.0e30f, -1.0e30f}, lsum[2] = {0.f, 0.f};
    const float SC = 0.08838834764831845f * 1.4426950408889634f;
#pragma unroll 1
    for (int kt2 = 0; kt2 < ntile; kt2 += 2) {
#pragma unroll
      for (int buf = 0; buf < 2; ++buf) {
        const int kt = kt2 + buf;
        { LAS unsigned char* kd = L + KT + buf * TS + key0 * VR + seg * 16; LAS unsigned char* vd = L + VT + buf * TS + key0 * VR + seg * 16;
          const int t2 = (kt + 2 < ntile) ? kt + 2 : ntile - 1;
          const size_t adv = (size_t)t2 * 64 * ZP;
          if (buf == 0) { *(LAS u32x4*)kd = kA0; *(LAS u32x4*)(kd + 32 * VR) = kA1; *(LAS u32x4*)vd = vA0; *(LAS u32x4*)(vd + 32 * VR) = vA1;
              kA0 = *(const u32x4*)(kbase + adv); kA1 = *(const u32x4*)(kbase + adv + (size_t)32 * ZP); vA0 = *(const u32x4*)(vbase + adv); vA1 = *(const u32x4*)(vbase + adv + (size_t)32 * ZP); }
          else { *(LAS u32x4*)kd = kB0; *(LAS u32x4*)(kd + 32 * VR) = kB1; *(LAS u32x4*)vd = vB0; *(LAS u32x4*)(vd + 32 * VR) = vB1;
              kB0 = *(const u32x4*)(kbase + adv); kB1 = *(const u32x4*)(kbase + adv + (size_t)32 * ZP); vB0 = *(const u32x4*)(vbase + adv); vB1 = *(const u32x4*)(vbase + adv + (size_t)32 * ZP); } }
        __syncthreads();
        const int kb = kt >> 2; const bool past = kb < blk;
        const int kmin = 64 * kt;
        int cls[2];
#pragma unroll
        for (int g = 0; g < 2; ++g) { const int qmin = q0 + 32 * w + 16 * g; cls[g] = past ? 1 : ((kmin + 63 <= qmin) ? 1 : ((kmin > qmin + 15) ? 0 : 2)); }
        if ((cls[0] | cls[1]) != 0) {
            f32x4 st[2][4];
#pragma unroll
            for (int nt = 0; nt < 4; ++nt) { st[0][nt] = (f32x4){0.f, 0.f, 0.f, 0.f}; st[1][nt] = st[0][nt];
                bf16x8 bk[4];
#pragma unroll
                for (int ks = 0; ks < 4; ++ks) bk[ks] = *(const LAS bf16x8*)(L + KT + buf * TS + (16 * nt + l15) * VR + (32 * ks + 8 * g4) * 2);
                __builtin_amdgcn_sched_barrier(0);
#pragma unroll
                for (int ks = 0; ks < 4; ++ks) { st[0][nt] = MFMA16(bk[ks], qf[0][ks], st[0][nt]); st[1][nt] = MFMA16(bk[ks], qf[1][ks], st[1][nt]); }
                __builtin_amdgcn_sched_barrier(0); }
            bf16x8 pf[2][2];
#pragma unroll
            for (int g = 0; g < 2; ++g) {
                float pv[4][4]; float mnew = 0.f, alpha = 1.0f;
                if (FIXED) {
                    if (cls[g] == 1) {
                        const bool sel = past ? (((mymask[g] >> kb) & 1u) != 0u) : true;
                        const float nb = sel ? -B2 : -1.0e30f;
#pragma unroll
                        for (int nt = 0; nt < 4; ++nt)
#pragma unroll
                            for (int r = 0; r < 4; ++r) pv[nt][r] = __builtin_amdgcn_exp2f(fmaf(st[g][nt][r], SC, nb));
                    } else if (cls[g] == 2) {
                        const int qpos = q0 + 32 * w + 16 * g + l15;
#pragma unroll
                        for (int nt = 0; nt < 4; ++nt)
#pragma unroll
                            for (int r = 0; r < 4; ++r) { const bool ok = (kmin + 16 * nt + 4 * g4 + r) <= qpos; pv[nt][r] = __builtin_amdgcn_exp2f(ok ? fmaf(st[g][nt][r], SC, -B2) : -1.0e30f); }
                    } else {
#pragma unroll
                        for (int nt = 0; nt < 4; ++nt)
#pragma unroll
                            for (int r = 0; r < 4; ++r) pv[nt][r] = 0.f;
                    }
                } else if (cls[g] == 1) {
                    const bool sel = past ? (((mymask[g] >> kb) & 1u) != 0u) : true;
                    float mx = fmaxf(fmaxf(fmaxf(st[g][0][0], st[g][0][1]), fmaxf(st[g][0][2], st[g][0][3])), fmaxf(fmaxf(st[g][1][0], st[g][1][1]), fmaxf(st[g][1][2], st[g][1][3])));
                    mx = fmaxf(mx, fmaxf(fmaxf(fmaxf(st[g][2][0], st[g][2][1]), fmaxf(st[g][2][2], st[g][2][3])), fmaxf(fmaxf(st[g][3][0], st[g][3][1]), fmaxf(st[g][3][2], st[g][3][3]))));
                    mx = sel ? mx * SC : -1.0e30f;
                    mx = fmaxf(mx, __shfl_xor(mx, 16)); mx = fmaxf(mx, __shfl_xor(mx, 32));
                    mnew = fmaxf(mrun[g], mx); alpha = __builtin_amdgcn_exp2f(mrun[g] - mnew);
                    const float nb = sel ? -mnew : -1.0e30f;
#pragma unroll
                    for (int nt = 0; nt < 4; ++nt)
#pragma unroll
                        for (int r = 0; r < 4; ++r) pv[nt][r] = __builtin_amdgcn_exp2f(fmaf(st[g][nt][r], SC, nb));
                } else if (cls[g] == 2) {
                    const int qpos = q0 + 32 * w + 16 * g + l15; float sv[4][4]; float mx = -1.0e30f;
#pragma unroll
                    for (int nt = 0; nt < 4; ++nt)
#pragma unroll
                        for (int r = 0; r < 4; ++r) { const bool ok = (kmin + 16 * nt + 4 * g4 + r) <= qpos; sv[nt][r] = ok ? st[g][nt][r] * SC : -1.0e30f; mx = fmaxf(mx, sv[nt][r]); }
                    mx = fmaxf(mx, __shfl_xor(mx, 16)); mx = fmaxf(mx, __shfl_xor(mx, 32));
                    mnew = fmaxf(mrun[g], mx); alpha = __builtin_amdgcn_exp2f(mrun[g] - mnew);
#pragma unroll
                    for (int nt = 0; nt < 4; ++nt)
#pragma unroll
                        for (int r = 0; r < 4; ++r) pv[nt][r] = (sv[nt][r] > -1.0e29f) ? __builtin_amdgcn_exp2f(sv[nt][r] - mnew) : 0.f;
                } else {
                    mnew = mrun[g]; alpha = 1.0f;
#pragma unroll
                    for (int nt = 0; nt < 4; ++nt)
#pragma unroll
                        for (int r = 0; r < 4; ++r) pv[nt][r] = 0.f;
                }
                float ps = 0.f;
#pragma unroll
                for (int nt = 0; nt < 4; ++nt) ps += (pv[nt][0] + pv[nt][1]) + (pv[nt][2] + pv[nt][3]);
                if (FIXED) lsum[g] += ps;
                else { mrun[g] = mnew; lsum[g] = lsum[g] * alpha + ps;
#pragma unroll
                    for (int dt = 0; dt < 8; ++dt) O[g][dt] *= alpha; }
#pragma unroll
                for (int k2 = 0; k2 < 2; ++k2) {
                    u32x4 pw4; pw4.x = pk2(pv[2 * k2][0], pv[2 * k2][1]); pw4.y = pk2(pv[2 * k2][2], pv[2 * k2][3]); pw4.z = pk2(pv[2 * k2 + 1][0], pv[2 * k2 + 1][1]); pw4.w = pk2(pv[2 * k2 + 1][2], pv[2 * k2 + 1][3]);
                    pf[g][k2] = __builtin_bit_cast(bf16x8, pw4); }
            }
            bf16x8 vf[2][4];
#define MOBA_VREAD(bq, slot) do { _Pragma("unroll") for (int d = 0; d < 4; ++d) { const int k2_ = (bq) >> 1, dt_ = 4 * ((bq) & 1) + d; \
                LAS unsigned char* vp = L + VT + buf * TS + (32 * k2_ + 4 * g4 + (l15 >> 2)) * VR + (16 * dt_ + 4 * (l15 & 3)) * 2; vf[slot][d] = cat8(tr16(vp), tr16(vp + 16 * VR)); } } while (0)
            MOBA_VREAD(0, 0);
#pragma unroll
            for (int bq = 0; bq < 4; ++bq) {
                if (bq + 1 < 4) MOBA_VREAD(bq + 1, (bq + 1) & 1);
                __builtin_amdgcn_sched_barrier(0);
#pragma unroll
                for (int d = 0; d < 4; ++d) { const int k2 = bq >> 1, dt = 4 * (bq & 1) + d;
                    O[0][dt] = MFMA16(vf[bq & 1][d], pf[0][k2], O[0][dt]); O[1][dt] = MFMA16(vf[bq & 1][d], pf[1][k2], O[1][dt]); }
                __builtin_amdgcn_sched_barrier(0);
            }
#undef MOBA_VREAD
        }
      }
    }
#pragma unroll
    for (int g = 0; g < 2; ++g) { float t = lsum[g]; t += __shfl_xor(t, 16); t += __shfl_xor(t, 32);
      const float inv = O8_SCALE / t; unsigned char* op = ob + (tokb + q0 + 32 * w + 16 * g + l15) * 1024 + h * 128 + 4 * g4;
#pragma unroll
      for (int dt = 0; dt < 8; ++dt) *(unsigned*)(op + 16 * dt) = pk4_fp8(O[g][dt][0] * inv, O[g][dt][1] * inv, O[g][dt][2] * inv, O[g][dt][3] * inv); }
}

__device__ __forceinline__ void p4_mixers(Frame& F, const Args& a, bool with_cvt) {
    LAS int* qslot = (LAS int*)(F.lds + 140032);
    const int total = with_cvt ? 768 + 256 + 256 : 768;
    const float B2 = __builtin_bit_cast(float, __builtin_amdgcn_readfirstlane((int)__hip_atomic_load(F.ctl + CW_MISC, __ATOMIC_RELAXED, __HIP_MEMORY_SCOPE_AGENT)));
    const bool fixed_ok = B2 <= 40.0f;
    for (;;) {
        __syncthreads();
        if (F.tid == 0) *qslot = (int)__hip_atomic_fetch_add(F.ctl + CW_QUEUE, 1u, __ATOMIC_RELAXED, __HIP_MEMORY_SCOPE_AGENT);
        __syncthreads();
        const int idx = *qslot;
        __syncthreads();
        if (idx >= total) break;
        int it = idx;
        if (with_cvt) { const int g = idx / 5, r = idx - 5 * g; if (r == 3) { cvt8_item(F, a, 512 + g); continue; } if (r == 4) { if (g < 128) cvt8_wout_sub(F, a, g); else cvt8_wbr_sub(F, a, g - 128); continue; } it = 3 * g + r; }
        if (it < 256) { if (fixed_ok) moba_unit<true>(F, a, (it & 31) >> 3, it & 7, 7 - (it >> 5), B2); else moba_unit<false>(F, a, (it & 31) >> 3, it & 7, 7 - (it >> 5), B2); }
        else mlstm_passC2(F, a, it - 256, it - 256 + 512);
    }
}

__device__ __forceinline__ void p7_router(Frame& F, const Args& a) {
    unsigned char* ws = F.ws;
    const float* modf = (const float*)(ws + WS_MODF);
    const bf16_t* wrf = (const bf16_t*)(ws + WS_WRF);
    int* toke = (int*)(ws + WS_TOKE); float* tokw = (float*)(ws + WS_TOKW); int* toks = (int*)(ws + WS_TOKS); float* roww = (float*)(ws + WS_ROWW);
    unsigned char* tA = ws + WS_TA;
    LAS float* part = (LAS float*)(F.lds + PART_OFF);
    LAS float* logit = (LAS float*)(F.lds + LOGIT_OFF);
    LAS int* dstl = (LAS int*)(F.lds + DST_OFF);
    LAS int* lcnt = (LAS int*)(F.lds + DST_OFF + 512);
    const int lane = F.lane, l15 = lane & 15, g4 = lane >> 4;
    for (int rb = F.wg; rb < T / 32; rb += F.G) {
        norm_rows_32_b(F, (const bf16_t*)(ws + WS_X1), a.in[I_GFFN], modf, 3, rb);
        { const int rg = F.wave & 1, ct = (F.wave >> 1) & 1, kh = F.wave >> 2; f32x4 acc = {0.f, 0.f, 0.f, 0.f};
          bf16x8 bvv[32];
          __builtin_amdgcn_sched_barrier(0);
          const bf16_t* wq = wrf + ((size_t)ct * 4096 + (size_t)(32 * kh) * 64 + lane) * 8; asm volatile("" : "+v"(wq));
#pragma unroll
          for (int s = 0; s < 32; ++s) bvv[s] = *(const bf16x8*)(wq + (size_t)s * 512);
          __syncthreads();
#pragma unroll
          for (int s = 0; s < 32; ++s) { const int ks = 32 * kh + s;
              const bf16x8 av = *(const LAS bf16x8*)(F.lds + (16 * rg + l15) * HL_STRIDE + (32 * ks + 8 * g4) * 2);
              acc = __builtin_amdgcn_mfma_f32_16x16x32_bf16(av, bvv[s], acc, 0, 0, 0); }
#pragma unroll
          for (int r = 0; r < 4; ++r) part[((kh * 2 + rg) * 2 + ct) * 256 + (4 * g4 + r) * 16 + l15] = acc[r]; }
        __syncthreads();
#pragma unroll
        for (int q = 0; q < 2; ++q) { const int o = F.tid + 512 * q, row = o >> 5, e = o & 31, rg = row >> 4, ct = e >> 4;
            logit[o] = part[((0 * 2 + rg) * 2 + ct) * 256 + (row & 15) * 16 + (e & 15)] + part[((1 * 2 + rg) * 2 + ct) * 256 + (row & 15) * 16 + (e & 15)] + a.in[I_BR][e]; }
        __syncthreads();
        if (F.tid < 32) {
            const int row = F.tid; const size_t tok = (size_t)rb * 32 + row;
            lcnt[row] = 0;
            float v[NE];
#pragma unroll
            for (int e = 0; e < NE; ++e) v[e] = logit[row * NE + e];
            float tv[4]; int ti[4]; unsigned used = 0u;
#pragma unroll
            for (int k = 0; k < 4; ++k) { float best = -3.0e38f; int bi = 0;
#pragma unroll
                for (int e = 0; e < NE; ++e) { const bool take = !((used >> e) & 1u) && (v[e] > best); best = take ? v[e] : best; bi = take ? e : bi; }
                used |= 1u << bi; tv[k] = best; ti[k] = bi; }
            float ex[4], sum = 0.f;
#pragma unroll
            for (int k = 0; k < 4; ++k) { ex[k] = __expf(tv[k] - tv[0]); sum += ex[k]; }
            const float inv = 1.0f / sum;
            int lr[4];
#pragma unroll
            for (int k = 0; k < 4; ++k) lr[k] = __hip_atomic_fetch_add(lcnt + ti[k], 1, __ATOMIC_RELAXED, __HIP_MEMORY_SCOPE_WORKGROUP);
            __builtin_amdgcn_wave_barrier();
            { const int mine = lcnt[row];
              int base = 0; if (mine > 0) base = (int)__hip_atomic_fetch_add(F.ctl + CW_CNT + 64 * row, (unsigned)mine, __ATOMIC_RELAXED, __HIP_MEMORY_SCOPE_AGENT);
              lcnt[32 + row] = base; }
            __builtin_amdgcn_wave_barrier();
#pragma unroll
            for (int k = 0; k < 4; ++k) {
                const int slot = lcnt[32 + ti[k]] + lr[k];
                const float wk = ex[k] * inv;
                toke[tok * 4 + k] = ti[k]; tokw[tok * 4 + k] = wk; toks[tok * 4 + k] = slot;
                roww[(size_t)ti[k] * ECAP + slot] = wk;
                dstl[row * 4 + k] = ti[k] * ECAP + slot;
            }
        }
        __syncthreads();
#pragma unroll 1
        for (int i = 0; i < 4; ++i) { const int r = 4 * F.wave + i;
            u32x4 q8[2];
#pragma unroll
            for (int cidx = 0; cidx < 2; ++cidx) { const int ch = lane + 64 * cidx;
                const u32x4 lo = *(const LAS u32x4*)(F.lds + r * HL_STRIDE + ch * 32), hi = *(const LAS u32x4*)(F.lds + r * HL_STRIDE + ch * 32 + 16);
                q8[cidx].x = pk4_fp8(bf_lo(lo.x), bf_hi(lo.x), bf_lo(lo.y), bf_hi(lo.y)); q8[cidx].y = pk4_fp8(bf_lo(lo.z), bf_hi(lo.z), bf_lo(lo.w), bf_hi(lo.w));
                q8[cidx].z = pk4_fp8(bf_lo(hi.x), bf_hi(hi.x), bf_lo(hi.y), bf_hi(hi.y)); q8[cidx].w = pk4_fp8(bf_lo(hi.z), bf_hi(hi.z), bf_lo(hi.w), bf_hi(hi.w)); }
#pragma unroll
            for (int k = 0; k < 4; ++k) { unsigned char* dp = tA + (size_t)dstl[r * 4 + k] * D;
#pragma unroll
                for (int cidx = 0; cidx < 2; ++cidx) *(u32x4*)(dp + (lane + 64 * cidx) * 16) = q8[cidx]; } }
        __syncthreads();
    }
}

__device__ __forceinline__ void moe_tables(Frame& F) {
    LAS int* tb = (LAS int*)(F.lds + LDS_TABS);
    __syncthreads();
    if (F.wave == 0) {
        const int e = F.lane & 31;
        const int cnt = (int)__hip_atomic_load(F.ctl + CW_CNT + 64 * e, __ATOMIC_RELAXED, __HIP_MEMORY_SCOPE_AGENT);
        const int tl = (cnt + 255) >> 8;
        int inc = tl;
#pragma unroll
        for (int o = 1; o < 32; o <<= 1) { const int t = __shfl_up(inc, o); if (e >= o) inc += t; }
        const int exc = inc - tl;
        if (F.lane < 32) {
            tb[e] = tl; tb[32 + e] = exc * 256; tb[64 + e] = e * ECAP; tb[96 + e] = exc * 16; tb[160 + e] = exc * 8;
            if (e == NE - 1) { tb[96 + NE] = inc * 16; tb[160 + NE] = inc * 8; }
        }
    }
    __syncthreads();
}

__device__ __forceinline__ void p10_combine(Frame& F, const Args& a) {
    unsigned char* ws = F.ws;
    const bf16_t* x1 = (const bf16_t*)(ws + WS_X1); const unsigned char* ydn = ws + WS_YDN; const float* modf = (const float*)(ws + WS_MODF);
    const int* toke = (const int*)(ws + WS_TOKE); const int* toks = (const int*)(ws + WS_TOKS);
    const LAS int* tb = (const LAS int*)(F.lds + LDS_TABS);
    int tz = threadIdx.x; asm volatile("" : "+v"(tz));
    const int gw = F.vcu * 8 + F.wave, NGW = F.G * 8, lane = tz & 63;
    for (int tok = gw; tok < T; tok += NGW) {
        const float* gt = modf + (size_t)(tok >> 11) * (6 * D) + 5 * D;
        const unsigned char* yr[4];
#pragma unroll
        for (int k = 0; k < 4; ++k) yr[k] = ydn + (size_t)(tb[32 + toke[tok * 4 + k]] + toks[tok * 4 + k]) * D;
        u32x2 y[4][4]; u32x4 xq[4]; f32x4 g0[4], g1[4];
#pragma unroll
        for (int j = 0; j < 4; ++j) { const int col = 8 * (lane + 64 * j);
#pragma unroll
            for (int k = 0; k < 4; ++k) y[j][k] = __builtin_nontemporal_load((const u32x2*)(yr[k] + col));
            xq[j] = __builtin_nontemporal_load((const u32x4*)(x1 + (size_t)tok * D + col));
            g0[j] = *(const f32x4*)(gt + col); g1[j] = *(const f32x4*)(gt + col + 4); }
        __builtin_amdgcn_sched_barrier(0);
#pragma unroll
        for (int j = 0; j < 4; ++j) { const int col = 8 * (lane + 64 * j);
            f32x4 s0 = {0.f, 0.f, 0.f, 0.f}, s1 = s0;
#pragma unroll
            for (int k = 0; k < 4; ++k) {
                const f32x2 p0 = __builtin_amdgcn_cvt_pk_f32_fp8((int)y[j][k].x, false), p1 = __builtin_amdgcn_cvt_pk_f32_fp8((int)y[j][k].x, true);
                const f32x2 p2 = __builtin_amdgcn_cvt_pk_f32_fp8((int)y[j][k].y, false), p3 = __builtin_amdgcn_cvt_pk_f32_fp8((int)y[j][k].y, true);
                s0[0] += p0[0]; s0[1] += p0[1]; s0[2] += p1[0]; s0[3] += p1[1]; s1[0] += p2[0]; s1[1] += p2[1]; s1[2] += p3[0]; s1[3] += p3[1]; }
            const size_t o = (size_t)tok * D + col;
            const f32x4 xa = {bf_lo(xq[j].x), bf_hi(xq[j].x), bf_lo(xq[j].y), bf_hi(xq[j].y)}, xb = {bf_lo(xq[j].z), bf_hi(xq[j].z), bf_lo(xq[j].w), bf_hi(xq[j].w)};
            __builtin_nontemporal_store(xa + g0[j] * (s0 * (1.0f / YD_SCALE)), (f32x4*)(a.out + o));
            __builtin_nontemporal_store(xb + g1[j] * (s1 * (1.0f / YD_SCALE)), (f32x4*)(a.out + o + 4)); }
    }
}

__global__ void __launch_bounds__(512, 2) hybrid_fwd(Args args) {
    extern __shared__ __attribute__((aligned(16))) unsigned char lds_raw[];
    Frame F;
    F.lds = (LAS unsigned char*)lds_raw; F.ws = args.ws; F.ctl = (unsigned*)(args.ws + WS_CTL);
    F.tid = threadIdx.x; F.lane = F.tid & 63; F.wave = __builtin_amdgcn_readfirstlane(F.tid >> 6);
    F.G = gridDim.x; F.wg = blockIdx.x; F.vcu = (F.G % 8 == 0) ? (F.wg % 8) * (F.G / 8) + F.wg / 8 : F.wg;
    if (F.tid < 4) ((LAS unsigned*)(F.lds + LDS_XB))[F.tid] = 0u;
    __syncthreads();
    XcdBarrier bar; bar.bar = F.ctl + CW_BAR; bar.x = 0; bar.st = nullptr;
#if !MK_PER_PHASE
    bar = xcd_barrier_post(F.ctl + CW_BAR, (volatile LAS unsigned*)(F.lds + LDS_XB));
#endif
    const int lo = args.ph_lo, hi = args.ph_hi;
#define IN(k) (lo <= (k) && (k) < hi)
#define SEAM(k) do { if (IN(k) && IN((k) + 1)) xcd_barrier(bar); } while (0)
    unsigned char* ws = args.ws;

    if (IN(0)) { p0_prologue(F, args); } SEAM(0);
    if (IN(1)) { p1_rows(F, args); } SEAM(1);
    const bool cv_ok = (F.G == 256);
    if (IN(2)) {
        pg8::DenseOrder S0; S0.init(ws + WS_HBUF8, ws + WS_WIN8, T, ZP, F.G, F.wg);
        EpiZT<true> E{(bf16_t*)(ws + WS_Z), ZP, args.in[I_GQ], args.in[I_GK], (float*)(ws + WS_KMEAN), F.lds + 131072};
        unsigned gaps = 0u;
        if (cv_ok) { int c = F.wg % 15, g0 = 0; while (c >= 5 - g0) { c -= 5 - g0; ++g0; } gaps = (1u << g0) | (1u << (g0 + 1 + c)); }
        int cvn = F.wg * 2;
        if (!cv_ok) { for (int idx = F.wg; idx < 1536; idx += F.G) cvt8_item(F, args, idx); }
        int lo = 0;
#pragma unroll 1
        for (int seg = 0; seg < 3; ++seg) {
            if ((gaps >> lo) & 1u) { cvt8_item(F, args, cvn++); gaps &= ~(1u << lo); }
            int hi = lo + 1; while (hi < 5 && !((gaps >> hi) & 1u)) ++hi;
            if (lo < 5) { pg8::SubOrder<pg8::DenseOrder> S{S0, lo, hi - lo}; pg8::gemm_phase<EpiZT<true>, pg8::SubOrder<pg8::DenseOrder>, true>(F.lds, D / 2, S, E); }
            lo = hi;
        }
        if (gaps & 32u) cvt8_item(F, args, cvn++);
    } SEAM(2);
    if (IN(3) && F.G == 256) { mlstm_passA4(F, args); }
    else if (IN(3)) {
        PassAIn cur = mlstm_passA_load(F, F.wg < 1024 ? F.wg : 0);
        for (int u = F.wg; u < 1024; u += F.G) { const int un = u + F.G; const PassAIn nxt = mlstm_passA_load(F, un < 1024 ? un : u); mlstm_passA(F, args, u, cur); cur = nxt; }
    } SEAM(3);
    if (IN(11)) { for (int it = F.wg; it < 256; it += F.G) mlstm_passB(F, it); }
    if (IN(3) && IN(4)) xcd_barrier(bar);
    if (IN(4)) { p4_mixers(F, args, F.G == 256); } SEAM(4);
    if (IN(5)) {
        if (cv_ok && (F.wg & 1) == 0) cvt8_item(F, args, 768 + F.wg);
        { pg8::PairOrder S; S.d.init(ws + WS_HM, ws + WS_WA, T, D, F.G, F.wg); S.A2 = (const char*)(ws + WS_OB); S.Bt2 = (const char*)(ws + WS_WB);
          EpiBranchAB E{(const bf16_t*)(ws + WS_Z), ws + WS_YBUF8};
          pg8::gemm_phase<EpiBranchAB, pg8::PairOrder, true>(F.lds, 512, S, E); }
        if (cv_ok && (F.wg & 1) == 1) cvt8_item(F, args, 768 + F.wg);
    } SEAM(5);
    if (IN(6)) {
        if (cv_ok && (F.wg & 1) == 0) cvt8_item(F, args, 1024 + F.wg);
        pg8::DenseOrder S; S.init(ws + WS_YBUF8, ws + WS_WOUT8, T, D, F.G, F.wg);
        EpiOut E{args.in[I_X], (const float*)(ws + WS_MODF), (bf16_t*)(ws + WS_X1)};
        pg8::gemm_phase<EpiOut, pg8::DenseOrder, true>(F.lds, D / 2, S, E);
        if (cv_ok && (F.wg & 1) == 1) cvt8_item(F, args, 1024 + F.wg);
    } SEAM(6);
    if (IN(7)) { p7_router(F, args); } SEAM(7);
    if (IN(8)) {
        moe_tables(F);
        const LAS int* tb = (const LAS int*)(F.lds + LDS_TABS);
        pg8::MoeOrder S{(const char*)(ws + WS_TA), (const char*)(ws + WS_WUP), tb, tb + 64, tb + 96, 16, F.G, F.vcu, (size_t)(2 * D) * D, __builtin_amdgcn_readfirstlane(tb[96 + NE]), nullptr, 0u};
        EpiUpT<true> E{ws + WS_ACT, args.in[I_BUP], tb + 32, F.ctl + CW_UPD};
        const int cut = cv_ok ? (F.wg & 7) : 0;
        if (cut > 0) { pg8::SubOrder<pg8::MoeOrder> S1{S, 0, cut}; pg8::gemm_phase<EpiUpT<true>, pg8::SubOrder<pg8::MoeOrder>, true>(F.lds, D / 2, S1, E); }
        if (cv_ok) cvt8_item_signal(F, args, 1280 + F.wg, F.ctl + CW_UPD);
        { pg8::SubOrder<pg8::MoeOrder> S2{S, cut, 1 << 20}; pg8::gemm_phase<EpiUpT<true>, pg8::SubOrder<pg8::MoeOrder>, true>(F.lds, D / 2, S2, E); }
    }
    if (IN(9)) {
        if (!IN(8)) moe_tables(F);
        const LAS int* tb = (const LAS int*)(F.lds + LDS_TABS);
        const int utot = __builtin_amdgcn_readfirstlane(tb[96 + NE]);
        pg8::MoeDepOrder S{(const char*)(ws + WS_ACT), (const char*)(ws + WS_WDN), tb, tb + 32, tb + 160, 8, F.G, (F.vcu - utot % F.G + F.G) % F.G, (size_t)D * D, __builtin_amdgcn_readfirstlane(tb[160 + NE]), F.ctl + CW_UPD, cv_ok ? 16u : 0u};
        EpiDown E{ws + WS_YDN, args.in[I_BDN], (const float*)(ws + WS_ROWW), tb + 32};
        pg8::gemm_phase<EpiDown, pg8::MoeDepOrder, true>(F.lds, D / 2, S, E);
    } SEAM(9);
    if (IN(10)) { if (!IN(8) && !IN(9)) moe_tables(F); p10_combine(F, args); }
#undef IN
#undef SEAM
}

constexpr int N_PHASES = 12;
extern "C" void kernel_launch(void* const* d_in, const int* in_sizes, int n_in, void* d_out, int out_size, void* d_ws, size_t ws_size, hipStream_t stream) {
    static int grid = 0;
    if (grid == 0) {
        if (n_in != 21 || out_size != T * D || ws_size < WS_END) { fprintf(stderr, "kernel_launch: unexpected problem (n_in %d out %d ws %zu)\n", n_in, out_size, ws_size); grid = -1; return; }
        int dev = 0, cus = 0, per_cu = 0;
        if (hipGetDevice(&dev) != hipSuccess || hipDeviceGetAttribute(&cus, hipDeviceAttributeMultiprocessorCount, dev) != hipSuccess) { grid = -1; return; }
        if (hipFuncSetAttribute((const void*)hybrid_fwd, hipFuncAttributeMaxDynamicSharedMemorySize, LDS_BYTES) != hipSuccess) { fprintf(stderr, "kernel_launch: hipFuncSetAttribute failed\n"); grid = -1; return; }
        if (hipOccupancyMaxActiveBlocksPerMultiprocessor(&per_cu, (const void*)hybrid_fwd, 512, LDS_BYTES) != hipSuccess || per_cu < 1) fprintf(stderr, "kernel_launch: occupancy query says %d\n", per_cu);
        (void)hipGetLastError();
        grid = cus;
    }
    if (grid < 0) return;
    if (hipMemsetAsync((char*)d_ws + WS_CTL, 0, CTL_BYTES, stream) != hipSuccess) return;
    Args a{};
    for (int i = 0; i < 21; ++i) a.in[i] = (const float*)d_in[i];
    a.out = (float*)d_out; a.ws = (unsigned char*)d_ws;
#if MK_PER_PHASE
    for (int p = 0; p < N_PHASES; ++p) { a.ph_lo = p; a.ph_hi = p + 1; hipLaunchKernelGGL(hybrid_fwd, dim3(grid), dim3(512), LDS_BYTES, stream, a); }
#else
    a.ph_lo = 0; a.ph_hi = N_PHASES;
    hipLaunchKernelGGL(hybrid_fwd, dim3(grid), dim3(512), LDS_BYTES, stream, a);
#endif
}
```

```cpp
#include <hip/hip_runtime.h>
#include <cstdio>
#include <cstdint>

#ifndef MK_PER_PHASE
#define MK_PER_PHASE 0
#endif

#define LAS __attribute__((address_space(3)))
#define GAS __attribute__((address_space(1)))
typedef unsigned short bf16_t;
typedef short bf16x8 __attribute__((ext_vector_type(8)));
typedef short s16x4 __attribute__((ext_vector_type(4)));
typedef float f32x4 __attribute__((ext_vector_type(4)));
typedef float f32x2 __attribute__((ext_vector_type(2)));
typedef unsigned u32x4 __attribute__((ext_vector_type(4)));
typedef unsigned u32x2 __attribute__((ext_vector_type(2)));
typedef int i32x8 __attribute__((ext_vector_type(8)));
typedef int i32x4 __attribute__((ext_vector_type(4)));

constexpr int D = 2048, NB = 4, SEQ = 2048, T = NB * SEQ;
constexpr int DIN = 10256, ZP = 10240;
constexpr int ZQA = 0, ZKA = 512, ZVA = 1024, ZOA = 2048, ZQB = 3072, ZKB = 4096, ZVB = 5120, ZGA = 6144, ZGB = 8192;
constexpr int GATE_COL = 3072;
constexpr int NE = 32, TOPK = 4, ECAP = 8192, CROWS = 40960;
constexpr float EPS = 1e-6f;

constexpr size_t MiB = 1ull << 20;
constexpr size_t WS_CTL = 0, CTL_BYTES = 1 * MiB;
constexpr size_t WS_MODP = 1 * MiB;
constexpr size_t WS_GATES = 2 * MiB;
constexpr size_t WS_KMEAN = 3 * MiB;
constexpr size_t WS_WGF = 3 * MiB + 512 * 1024;
constexpr size_t WS_WRF = 3 * MiB + 640 * 1024;
constexpr size_t WS_MODF = 4 * MiB;
constexpr size_t WS_TOKE = 5 * MiB;
constexpr size_t WS_TOKW = 5 * MiB + 256 * 1024;
constexpr size_t WS_TOKS = 5 * MiB + 512 * 1024;
constexpr size_t WS_ROWW = 6 * MiB;
constexpr size_t WS_WIN = 8 * MiB;
constexpr size_t WS_WOUT8 = 8 * MiB;
constexpr size_t WS_WA = 48 * MiB, WS_WB = 52 * MiB, WS_WOUT = 56 * MiB;
constexpr size_t WS_HBUF = 64 * MiB;
constexpr size_t WS_YBUF8 = 64 * MiB;
constexpr float Y8_SCALE = 8.0f;
constexpr float YD_SCALE = 16.0f;
constexpr float H8_SCALE = 8.0f, O8_SCALE = 32.0f;
constexpr size_t WS_Z = 96 * MiB;
constexpr size_t WS_HM = 256 * MiB, WS_OB = 272 * MiB;
constexpr size_t WS_TMPF = 288 * MiB;
constexpr size_t WS_YBUF = 352 * MiB;
constexpr size_t WS_X1 = 384 * MiB;
constexpr size_t WS_ACT = 448 * MiB;
constexpr size_t WS_YDN = 608 * MiB;
constexpr size_t WS_CLOC = 928 * MiB;
constexpr size_t WS_CIN = 960 * MiB;
constexpr size_t WS_NLOC = 976 * MiB, WS_NIN = 977 * MiB, WS_MSC = 978 * MiB;
constexpr size_t WS_HBUF8 = 980 * MiB;
constexpr size_t WS_WIN8 = 996 * MiB;
constexpr size_t WS_WUP = 1024 * MiB;
constexpr size_t WS_WDN = 1536 * MiB;
constexpr size_t WS_TA = 2048 * MiB;
constexpr size_t WS_END = 3072 * MiB;
constexpr int CW_BAR = 4096;
constexpr int CW_CNT = 16384;
constexpr int CW_QUEUE = 32768;
constexpr int CW_MISC = 49152;
constexpr int CW_UPD = 65536;
constexpr int CW_MQ = 32768 + 64;
constexpr int CW_CUD = 36864, CW_CDD = 40960, CW_GUD = 45056;

constexpr int LDS_BYTES = 157696;
constexpr int LDS_XB = 157568;
constexpr int LDS_TABS = 147456;

__device__ __forceinline__ float bf_lo(unsigned u) { return __uint_as_float(u << 16); }
__device__ __forceinline__ float bf_hi(unsigned u) { return __uint_as_float(u & 0xffff0000u); }
__device__ __forceinline__ float bf1(bf16_t v) { return __uint_as_float(((unsigned)v) << 16); }
__device__ __forceinline__ unsigned pk2(float lo, float hi) { unsigned r; asm("v_cvt_pk_bf16_f32 %0, %1, %2" : "=v"(r) : "v"(lo), "v"(hi)); return r; }
__device__ __forceinline__ bf16_t f2bf(float f) { return (bf16_t)(pk2(f, 0.f) & 0xffffu); }
__device__ __forceinline__ float wave_sum(float v) {
#pragma unroll
    for (int o = 1; o < 64; o <<= 1) v += __shfl_xor(v, o);
    return v;
}
__device__ __forceinline__ void store16_sc1(void* p, u32x4 v) { asm volatile("global_store_dwordx4 %0, %1, off sc1\n\ts_nop 1" :: "v"(p), "v"(v) : "memory"); }
__device__ __forceinline__ void store8_sc1(void* p, u32x2 v) { asm volatile("global_store_dwordx2 %0, %1, off sc1\n\ts_nop 1" :: "v"(p), "v"(v) : "memory"); }
__device__ __forceinline__ unsigned pk4_fp8(float a, float b, float c, float d) {
    a = __builtin_amdgcn_fmed3f(a, -448.0f, 448.0f); b = __builtin_amdgcn_fmed3f(b, -448.0f, 448.0f); c = __builtin_amdgcn_fmed3f(c, -448.0f, 448.0f); d = __builtin_amdgcn_fmed3f(d, -448.0f, 448.0f);
    int r = __builtin_amdgcn_cvt_pk_fp8_f32(a, b, 0, false); r = __builtin_amdgcn_cvt_pk_fp8_f32(c, d, r, true); return (unsigned)r; }
__device__ __forceinline__ unsigned pk4_fp8_ns(float a, float b, float c, float d) { int r = __builtin_amdgcn_cvt_pk_fp8_f32(a, b, 0, false); r = __builtin_amdgcn_cvt_pk_fp8_f32(c, d, r, true); return (unsigned)r; }
constexpr float W8_SCALE = 256.0f, W8_INV = 1.0f / 256.0f;
__device__ __forceinline__ float sigmoidf_(float x) { return __builtin_amdgcn_rcpf(1.f + __expf(-x)); }
#define DPP_ADD(t, CTRL) ((t) + __builtin_bit_cast(float, __builtin_amdgcn_update_dpp(0, __builtin_bit_cast(int, (t)), (CTRL), 0xf, 0xf, false)))
__device__ __forceinline__ float sum8_(float t) { t = DPP_ADD(t, 0xB1); t = DPP_ADD(t, 0x4E); t = DPP_ADD(t, 0x141); return t; }
__device__ __forceinline__ float sum16_(float t) { t = sum8_(t); t = DPP_ADD(t, 0x140); return t; }

namespace pg8 {
constexpr int BM = 256, BK = 64, HALF = 128, HTB = HALF * BK * 2, STAGE_BYTES = 8 * HTB, NXCD = 8, WGM = 8;
__host__ __device__ __forceinline__ int lds_byte(int r, int c) { const int st = (r >> 4) * 2 + (c >> 5), rr = r & 15, cc = c & 31, ob = rr * 64 + cc * 2; return st * 1024 + (ob ^ (((ob >> 9) & 1) << 5)); }
__host__ __device__ __forceinline__ void stage_rc(int b, int& R, int& C) { const int st = b / 1024, sb = b % 1024, swz = sb ^ (((sb >> 9) & 1) << 5); R = (st >> 1) * 16 + swz / 64; C = (st & 1) * 32 + (swz % 64) / 2; }
__host__ __device__ __forceinline__ int perm32(int rho) { const int n = rho >> 4, i = rho & 15; return 8 * (i >> 2) + 4 * n + (i & 3); }

struct Unit { int pm, pn, e; };

struct DenseOrder {
    static constexpr bool HAS_DEP = false;
    const char* A; const char* Bt; int nM, nN, nwg, G, c;
    __device__ void init(const void* A_, const void* Bt_, int M, int N, int G_, int c_) { A = (const char*)A_; Bt = (const char*)Bt_; nM = M / BM; nN = N / BM; nwg = nM * nN; G = G_; c = c_; }
    __device__ bool next(int i, Unit& u) const {
        const long L = (long)i * G + c; if (L >= nwg) return false;
        int wgid = (int)L; { const int q = nwg / NXCD, r = nwg % NXCD, xcd = wgid % NXCD, off = wgid / NXCD; wgid = (xcd < r ? xcd * (q + 1) : r * (q + 1) + (xcd - r) * q) + off; }
        const int nig = WGM * nN, gid = wgid / nig, fm = gid * WGM, gsz = (nM - fm) < WGM ? (nM - fm) : WGM;
        u.pm = fm + ((wgid % nig) % gsz); u.pn = (wgid % nig) / gsz; u.e = 0; return true;
    }
    __device__ __forceinline__ const char* a_ptr(const Unit& u, size_t tstep) const { return A + (size_t)u.pm * tstep; }
    __device__ __forceinline__ const char* b_ptr(const Unit& u, size_t tstep) const { return Bt + (size_t)u.pn * tstep; }
};

constexpr unsigned DEP_NEED = 16u;
template <bool DEP>
struct MoeOrderT {
    static constexpr bool HAS_DEP = DEP;
    const char* A; const char* Bt; const LAS int* tiles; const LAS int* arow; const LAS int* ub; int nN, G, c; size_t estepB; int total; unsigned* dep; unsigned need_hi;
    __device__ bool next(int i, Unit& u) const {
        const int L = i * G + c; if (L >= total) return false;
        unsigned zz = 0u; asm volatile("" : "+v"(zz));
        const int ln = (int)__builtin_amdgcn_mbcnt_hi(~0u, __builtin_amdgcn_mbcnt_lo(~0u, zz));
        const int ubv = ub[(ln < NE ? ln : NE - 1) + 1];
        const int e = __builtin_popcountll(__ballot(ln < NE && L >= ubv));
        const int r = L - __builtin_amdgcn_readfirstlane(ub[e]), te = __builtin_amdgcn_readfirstlane(tiles[e]);
        u.e = e; u.pm = r % te; u.pn = r / te; return true;
    }
    __device__ __forceinline__ unsigned dep_issue(int i) const {
        Unit u; if (!next(i, u)) return 0xffffffffu;
        return __hip_atomic_load(dep + (u.e * 32 + u.pm) * 16, __ATOMIC_RELAXED, __HIP_MEMORY_SCOPE_AGENT);
    }
    __device__ __forceinline__ void dep_confirm(const Unit& u, unsigned v) const {
        const unsigned* ctr = dep + (u.e * 32 + u.pm) * 16;
        const unsigned need = DEP_NEED + (u.e >= 16 ? need_hi : 0u);
        while ((unsigned)__builtin_amdgcn_readfirstlane((int)v) < need) { __builtin_amdgcn_s_sleep(2); v = __hip_atomic_load(ctr, __ATOMIC_RELAXED, __HIP_MEMORY_SCOPE_AGENT); }
        asm volatile("" ::: "memory");
    }
    __device__ __forceinline__ const char* a_ptr(const Unit& u, size_t tstep) const { return A + ((size_t)arow[u.e] / 256 + (size_t)u.pm) * tstep; }
    __device__ __forceinline__ const char* b_ptr(const Unit& u, size_t tstep) const { return Bt + (size_t)u.e * estepB + (size_t)u.pn * tstep; }
};
typedef MoeOrderT<false> MoeOrder;
typedef MoeOrderT<true> MoeDepOrder;

template <class Base> struct SubOrder {
    static constexpr bool HAS_DEP = false;
    Base b; int i0, n;
    __device__ bool next(int i, Unit& u) const { if (i >= n) return false; return b.next(i0 + i, u); }
    __device__ __forceinline__ const char* a_ptr(const Unit& u, size_t tstep) const { return b.a_ptr(u, tstep); }
    __device__ __forceinline__ const char* b_ptr(const Unit& u, size_t tstep) const { return b.b_ptr(u, tstep); }
};
struct OneUnit {
    static constexpr bool HAS_DEP = false;
    const char* A; const char* Bt; Unit u;
    __device__ bool next(int i, Unit& o) const { if (i > 0) return false; o = u; return true; }
    __device__ __forceinline__ const char* a_ptr(const Unit&, size_t) const { return A; }
    __device__ __forceinline__ const char* b_ptr(const Unit&, size_t) const { return Bt; }
};

struct PairOrder {
    static constexpr bool HAS_DEP = false;
    DenseOrder d; const char* A2; const char* Bt2;
    __device__ bool next(int i, Unit& u) const { if (!d.next(i >> 1, u)) return false; u.e = i & 1; return true; }
    __device__ __forceinline__ const char* a_ptr(const Unit& u, size_t tstep) const { return (u.e ? A2 : d.A) + (size_t)u.pm * tstep; }
    __device__ __forceinline__ const char* b_ptr(const Unit& u, size_t tstep) const { return (u.e ? Bt2 : d.Bt) + (size_t)u.pn * tstep; }
};

template <class Epi, class Sched, bool FP8 = false>
__device__ __forceinline__ void gemm_phase(LAS unsigned char* lds, const int K, const Sched& S, const Epi& E) {
    int tid = threadIdx.x; asm volatile("" : "+v"(tid));
    const int wid = __builtin_amdgcn_readfirstlane(tid >> 6), lane = tid & 63, wr = wid >> 2, wc = wid & 3, fr = lane & 15, fq = lane >> 4;
    const int nt = K / BK;
    unsigned voffA, voffB;
    { int R, C; stage_rc(tid * 16, R, C); const int Rb = Epi::PERM ? ((R & ~31) + perm32(R & 31)) : R;
      voffA = (unsigned)(R * K + C) * 2u; voffB = (unsigned)(Rb * K + C) * 2u; }
    const size_t pstep = (size_t)64 * K * 2;
    const size_t kstep = (size_t)(BK * 2);
    const size_t hstep = (size_t)HALF * K * 2;
    const size_t tstep = 2 * hstep;
    const unsigned ldsw = (unsigned)wid * 1024u;
    int lanex;
    { unsigned _z = 0u; asm volatile("" : "+v"(_z)); const int _ln = (int)__builtin_amdgcn_mbcnt_hi(~0u, __builtin_amdgcn_mbcnt_lo(~0u, _z)); lanex = lds_byte(_ln & 15, (_ln >> 4) * 8); }
#define PG8_LANE_OFFS asm volatile("" : "+v"(lanex)); const int aoff = lanex + wr * 8192, boff = lanex + wc * 4096; (void)aoff; (void)boff
#define PG8_SA(b, h) (((b) * 2 + (h)) * HTB)
#define PG8_SB(b, h) ((4 + (b) * 2 + (h)) * HTB)
#define PG8_STAGE(bufoff, gbase, voff) do { asm volatile("" : "+v"(voff)); _Pragma("unroll") for (int _i = 0; _i < 2; ++_i) \
        __builtin_amdgcn_global_load_lds((const unsigned*)((const char*)(gbase) + _i * pstep + (voff)), (LAS unsigned*)(lds + (bufoff) + ldsw + _i * 8192), 16, 0, 0); } while (0)
#define PG8_LDA(dst, b, h) do { _Pragma("unroll") for (int m = 0; m < 4; ++m) { const i32x4 _l = *(const LAS i32x4*)(lds + PG8_SA(b, h) + aoff + m * 2048), _h = *(const LAS i32x4*)(lds + PG8_SA(b, h) + aoff + m * 2048 + 1024); \
        dst[m] = __builtin_shufflevector(_l, _h, 0, 1, 2, 3, 4, 5, 6, 7); } } while (0)
#define PG8_LDB(dst, b, h) do { _Pragma("unroll") for (int n = 0; n < 2; ++n) { const i32x4 _l = *(const LAS i32x4*)(lds + PG8_SB(b, h) + boff + n * 2048), _h = *(const LAS i32x4*)(lds + PG8_SB(b, h) + boff + n * 2048 + 1024); \
        dst[n] = __builtin_shufflevector(_l, _h, 0, 1, 2, 3, 4, 5, 6, 7); } } while (0)
#define PG8_LO(x) __builtin_bit_cast(bf16x8, __builtin_shufflevector((x), (x), 0, 1, 2, 3))
#define PG8_HI(x) __builtin_bit_cast(bf16x8, __builtin_shufflevector((x), (x), 4, 5, 6, 7))
#define PG8_MMA(ai, bj, At, Bt) do { __builtin_amdgcn_s_setprio(1); \
        if constexpr (FP8) { _Pragma("unroll") for (int m = 0; m < 4; ++m) _Pragma("unroll") for (int n = 0; n < 2; ++n) \
            acc[ai][bj][m][n] = __builtin_amdgcn_mfma_scale_f32_16x16x128_f8f6f4(Bt[n], At[m], acc[ai][bj][m][n], 0, 0, 0, 0x7f7f7f7f, 0, 0x7f7f7f7f); } \
        else { _Pragma("unroll") for (int m = 0; m < 4; ++m) _Pragma("unroll") for (int n = 0; n < 2; ++n) { \
            acc[ai][bj][m][n] = __builtin_amdgcn_mfma_f32_16x16x32_bf16(PG8_LO(Bt[n]), PG8_LO(At[m]), acc[ai][bj][m][n], 0, 0, 0); \
            acc[ai][bj][m][n] = __builtin_amdgcn_mfma_f32_16x16x32_bf16(PG8_HI(Bt[n]), PG8_HI(At[m]), acc[ai][bj][m][n], 0, 0, 0); } } \
        __builtin_amdgcn_s_setprio(0); } while (0)
#define PG8_WAIT_V(n) asm volatile("s_waitcnt vmcnt(" #n ")" ::: "memory")
#define PG8_WAIT_L(n) asm volatile("s_waitcnt lgkmcnt(" #n ")" ::: "memory")
#define PG8_BAR __builtin_amdgcn_s_barrier()
#define PG8_SCHED __builtin_amdgcn_sched_barrier(0)
    Unit cur, nxt, prv; int ui = 0; prv.pm = prv.pn = prv.e = 0; (void)prv;
    if (!S.next(0, cur)) return;
    unsigned depv = 0u; (void)depv;
    if constexpr (Sched::HAS_DEP) { S.dep_confirm(cur, S.dep_issue(0)); depv = S.dep_issue(1); }
    f32x4 acc[2][2][4][2];
#define PG8_ACC_INIT(U) do { f32x4 _bi[2][2]; \
        if constexpr (Epi::ACC_INIT) { unsigned _zz = 0u; asm volatile("" : "+v"(_zz)); const int _ln = (int)__builtin_amdgcn_mbcnt_hi(~0u, __builtin_amdgcn_mbcnt_lo(~0u, _zz)); E.acc_bias((U), wc, _ln >> 4, _bi); } \
        else { _bi[0][0] = (f32x4){0.f, 0.f, 0.f, 0.f}; _bi[0][1] = _bi[0][0]; _bi[1][0] = _bi[0][0]; _bi[1][1] = _bi[0][0]; } \
        _Pragma("unroll") for (int a = 0; a < 2; ++a) _Pragma("unroll") for (int b = 0; b < 2; ++b) _Pragma("unroll") for (int m = 0; m < 4; ++m) _Pragma("unroll") for (int n = 0; n < 2; ++n) acc[a][b][m][n] = _bi[b][n]; } while (0)
    PG8_ACC_INIT(cur);
    i32x8 At[4], B0[2], B1[2];
    const char* cA = S.a_ptr(cur, tstep); const char* cB = S.b_ptr(cur, tstep);
    PG8_STAGE(PG8_SB(0, 0), cB, voffB); PG8_STAGE(PG8_SB(0, 1), cB + hstep, voffB); PG8_STAGE(PG8_SA(0, 0), cA, voffA); PG8_STAGE(PG8_SA(0, 1), cA + hstep, voffA);
    if (wr == 1) PG8_BAR;
    PG8_WAIT_V(2); PG8_BAR;
    PG8_STAGE(PG8_SB(1, 0), cB + kstep, voffB); PG8_STAGE(PG8_SA(1, 0), cA + kstep, voffA); PG8_STAGE(PG8_SB(1, 1), cB + hstep + kstep, voffB);
    PG8_WAIT_V(6); PG8_BAR;
    for (;;) {
        const bool has_next = S.next(ui + 1, nxt);
        if constexpr (Sched::HAS_DEP) { if (has_next) S.dep_confirm(nxt, depv); }
        const char* nA = has_next ? S.a_ptr(nxt, tstep) : cA; const char* nB = has_next ? S.b_ptr(nxt, tstep) : cB;
#pragma unroll 1
        for (int t = 0; t < nt; t += 2) {
            const bool last = (t == nt - 2);
            const char* a1 = cA + (size_t)(t + 1) * kstep;
            const char* a2 = last ? nA : cA + (size_t)(t + 2) * kstep; const char* b2 = last ? nB : cB + (size_t)(t + 2) * kstep;
            const char* a3 = a2 + kstep; const char* b3 = b2 + kstep;
            { PG8_LANE_OFFS; PG8_LDB(B0, 0, 0); PG8_LDB(B1, 0, 1); PG8_SCHED; PG8_LDA(At, 0, 0); PG8_STAGE(PG8_SA(1, 1), a1 + hstep, voffA); }
            PG8_WAIT_V(8); PG8_WAIT_L(0); PG8_BAR; PG8_MMA(0, 0, At, B0); PG8_MMA(0, 1, At, B1); PG8_BAR; PG8_SCHED;
            { PG8_LANE_OFFS; PG8_LDA(At, 0, 1); PG8_STAGE(PG8_SB(0, 0), b2, voffB); PG8_STAGE(PG8_SB(0, 1), b2 + hstep, voffB); PG8_STAGE(PG8_SA(0, 0), a2, voffA); }
            PG8_WAIT_V(8); PG8_WAIT_L(0); PG8_BAR; PG8_MMA(1, 0, At, B0); PG8_MMA(1, 1, At, B1); PG8_BAR; PG8_SCHED;
            { PG8_LANE_OFFS; PG8_LDB(B0, 1, 0); PG8_LDB(B1, 1, 1); PG8_SCHED; PG8_LDA(At, 1, 0); PG8_STAGE(PG8_SA(0, 1), a2 + hstep, voffA); }
            PG8_WAIT_V(8); PG8_WAIT_L(0); PG8_BAR; PG8_MMA(0, 0, At, B0); PG8_MMA(0, 1, At, B1); PG8_BAR; PG8_SCHED;
            { PG8_LANE_OFFS; PG8_LDA(At, 1, 1); PG8_STAGE(PG8_SB(1, 0), b3, voffB); PG8_STAGE(PG8_SB(1, 1), b3 + hstep, voffB); PG8_STAGE(PG8_SA(1, 0), a3, voffA); }
            PG8_WAIT_V(8); PG8_WAIT_L(0); PG8_BAR; PG8_MMA(1, 0, At, B0); PG8_MMA(1, 1, At, B1); PG8_BAR; PG8_SCHED;
        }
        if (wr == 0) PG8_BAR;
        if constexpr (Sched::HAS_DEP) depv = S.dep_issue(ui + 2);
        if constexpr (Epi::SIGNALS) { if (ui > 0) { PG8_WAIT_V(8); PG8_BAR; E.signal(prv, tid == 0); } }
        { unsigned zz = 0u; asm volatile("" : "+v"(zz));
          const int ln = (int)__builtin_amdgcn_mbcnt_hi(~0u, __builtin_amdgcn_mbcnt_lo(~0u, zz));
          E(acc, cur, wr, wc, ln & 15, ln >> 4); }
        if (!has_next) break;
        if (!(Epi::CHAIN && cur.e == 0)) { PG8_ACC_INIT(nxt); }
        prv = cur; cur = nxt; cA = nA; cB = nB; ++ui;
        if (wr == 1) PG8_BAR;
    }
    PG8_WAIT_V(0);
    PG8_BAR;
    if constexpr (Epi::SIGNALS) E.signal(cur, tid == 0);
#undef PG8_SA
#undef PG8_ACC_INIT
#undef PG8_SB
#undef PG8_STAGE
#undef PG8_LDA
#undef PG8_LDB
#undef PG8_MMA
#undef PG8_LO
#undef PG8_LANE_OFFS
#undef PG8_HI
#undef PG8_WAIT_V
#undef PG8_WAIT_L
#undef PG8_BAR
#undef PG8_SCHED
}
}

using pg8::Unit;
template <bool F8>
struct EpiZT {
    static constexpr bool PERM = true;
    static constexpr bool SIGNALS = false;
    static constexpr bool CHAIN = false;
    static constexpr bool ACC_INIT = false;
    static constexpr float ASC = F8 ? W8_INV : 1.0f;
    bf16_t* O; int ldc; const float* gq; const float* gk; float* kmean; LAS unsigned char* xl;
    __device__ __forceinline__ void operator()(const f32x4 (&acc)[2][2][4][2], const Unit& u, int wr, int wc, int fr, int fq) const {
        const int row0 = u.pm * 256 + wr * 64 + fr, col0 = u.pn * 256 + wc * 32 + 8 * fq;
        if (u.pn < 12 || u.pn >= 20) {
#pragma unroll
            for (int ai = 0; ai < 2; ++ai)
#pragma unroll
                for (int m = 0; m < 4; ++m) { bf16_t* rowp = O + (size_t)(row0 + ai * 128 + m * 16) * ldc + col0;
#pragma unroll
                    for (int bj = 0; bj < 2; ++bj) { const f32x4 v0 = acc[ai][bj][m][0] * ASC, v1 = acc[ai][bj][m][1] * ASC;
                        u32x4 w; w.x = pk2(v0[0], v0[1]); w.y = pk2(v0[2], v0[3]); w.z = pk2(v1[0], v1[1]); w.w = pk2(v1[2], v1[3]);
                        *(u32x4*)(rowp + bj * 128) = w; } }
            return;
        }
        LAS float* P = (LAS float*)xl;
        LAS float* Cs = (LAS float*)(xl + 8192);
#pragma unroll
        for (int ai = 0; ai < 2; ++ai)
#pragma unroll
            for (int m = 0; m < 4; ++m)
#pragma unroll
                for (int bj = 0; bj < 2; ++bj) { const f32x4 v0 = acc[ai][bj][m][0], v1 = acc[ai][bj][m][1];
                    float ss = (v0[0] * v0[0] + v0[1] * v0[1]) + (v0[2] * v0[2] + v0[3] * v0[3]) + (v1[0] * v1[0] + v1[1] * v1[1]) + (v1[2] * v1[2] + v1[3] * v1[3]);
                    ss += __shfl_xor(ss, 16); ss += __shfl_xor(ss, 32);
                    if (fq == 0) P[((ai * 128 + wr * 64 + m * 16 + fr) * 2 + bj) * 4 + wc] = ss; asm volatile("" ::: "memory"); }
        __syncthreads();
        const bool isk = u.pn >= 16;
        const float* gv = (isk ? gk : gq) + wc * 32 + 8 * fq;
        const f32x4 g0 = *(const f32x4*)gv, g1 = *(const f32x4*)(gv + 4);
        f32x4 cs[2][2];
#pragma unroll
        for (int bj = 0; bj < 2; ++bj) { cs[bj][0] = (f32x4){0.f, 0.f, 0.f, 0.f}; cs[bj][1] = cs[bj][0]; }
#pragma unroll
        for (int ai = 0; ai < 2; ++ai)
#pragma unroll
            for (int m = 0; m < 4; ++m) { const int rl = ai * 128 + wr * 64 + m * 16 + fr; bf16_t* rowp = O + (size_t)(u.pm * 256 + rl) * ldc + col0;
#pragma unroll
                for (int bj = 0; bj < 2; ++bj) { const f32x4 pp = *(const LAS f32x4*)(P + (rl * 2 + bj) * 4);
                    const float rinv = rsqrtf(((pp[0] + pp[1]) + (pp[2] + pp[3])) * (ASC * ASC / 128.0f) + EPS) * ASC;
                    const f32x4 y0 = acc[ai][bj][m][0] * rinv * g0, y1 = acc[ai][bj][m][1] * rinv * g1;
                    cs[bj][0] += y0; cs[bj][1] += y1;
                    u32x4 w; w.x = pk2(y0[0], y0[1]); w.y = pk2(y0[2], y0[3]); w.z = pk2(y1[0], y1[1]); w.w = pk2(y1[2], y1[3]);
                    *(u32x4*)(rowp + bj * 128) = w; }
                asm volatile("" : "+v"(cs[0][0]), "+v"(cs[0][1]), "+v"(cs[1][0]), "+v"(cs[1][1]) :: "memory"); }
        if (isk) {
#pragma unroll
            for (int bj = 0; bj < 2; ++bj)
#pragma unroll
                for (int n = 0; n < 2; ++n)
#pragma unroll
                    for (int j = 0; j < 4; ++j) { float t = sum16_(cs[bj][n][j]);
                        if (fr == 0) Cs[(wr * 2 + bj) * 128 + wc * 32 + 8 * fq + 4 * n + j] = t; }
            __syncthreads();
            const int t = (wr * 4 + wc) * 64 + fq * 16 + fr;
            if (t < 256) { const int bj = t >> 7, d = t & 127, hd = (u.pn - 16) * 2 + bj;
                kmean[((((size_t)(u.pm >> 3) * 8 + hd) * 8) + (u.pm & 7)) * 128 + d] = (Cs[bj * 128 + d] + Cs[(2 + bj) * 128 + d]) * (1.0f / 256.0f); }
        }
    }
};
typedef EpiZT<false> EpiZ;
struct EpiZ8 {
    static constexpr bool PERM = true;
    static constexpr bool SIGNALS = false;
    static constexpr bool CHAIN = false;
    static constexpr bool ACC_INIT = false;
    bf16_t* O; int ldc, col_off;
    __device__ __forceinline__ void operator()(const f32x4 (&acc)[2][2][4][2], const Unit& u, int wr, int wc, int fr, int fq) const {
        const int row0 = u.pm * 256 + wr * 64 + fr, col0 = col_off + u.pn * 256 + wc * 32 + 8 * fq;
#pragma unroll
        for (int ai = 0; ai < 2; ++ai)
#pragma unroll
            for (int m = 0; m < 4; ++m) { bf16_t* rowp = O + (size_t)(row0 + ai * 128 + m * 16) * ldc + col0;
#pragma unroll
                for (int bj = 0; bj < 2; ++bj) { const f32x4 v0 = acc[ai][bj][m][0] * W8_INV, v1 = acc[ai][bj][m][1] * W8_INV;
                    u32x4 w; w.x = pk2(v0[0], v0[1]); w.y = pk2(v0[2], v0[3]); w.z = pk2(v1[0], v1[1]); w.w = pk2(v1[2], v1[3]);
                    *(u32x4*)(rowp + bj * 128) = w; } }
    }
};
struct EpiBranchA {
    static constexpr bool PERM = true;
    static constexpr bool SIGNALS = false;
    static constexpr bool CHAIN = false;
    static constexpr bool ACC_INIT = false;
    float* tmp; const bf16_t* z;
    __device__ __forceinline__ void operator()(const f32x4 (&acc)[2][2][4][2], const Unit& u, int wr, int wc, int fr, int fq) const {
        const int row0 = u.pm * 256 + wr * 64 + fr, col0 = u.pn * 256 + wc * 32 + 8 * fq;
#pragma unroll
        for (int ai = 0; ai < 2; ++ai)
#pragma unroll
            for (int m = 0; m < 4; ++m) { const size_t row = (size_t)(row0 + ai * 128 + m * 16);
#pragma unroll
                for (int bj = 0; bj < 2; ++bj) { const int col = col0 + bj * 128;
                    const u32x4 g = *(const u32x4*)(z + row * ZP + ZGA + col);
                    const f32x4 v0 = acc[ai][bj][m][0] * (W8_INV / H8_SCALE), v1 = acc[ai][bj][m][1] * (W8_INV / H8_SCALE);
                    f32x4 o0, o1;
                    o0[0] = v0[0] * sigmoidf_(bf_lo(g.x)); o0[1] = v0[1] * sigmoidf_(bf_hi(g.x)); o0[2] = v0[2] * sigmoidf_(bf_lo(g.y)); o0[3] = v0[3] * sigmoidf_(bf_hi(g.y));
                    o1[0] = v1[0] * sigmoidf_(bf_lo(g.z)); o1[1] = v1[1] * sigmoidf_(bf_hi(g.z)); o1[2] = v1[2] * sigmoidf_(bf_lo(g.w)); o1[3] = v1[3] * sigmoidf_(bf_hi(g.w));
                    float* p = tmp + row * D + col; *(f32x4*)p = o0; *(f32x4*)(p + 4) = o1; } }
    }
};
struct EpiBranchB {
    static constexpr bool PERM = true;
    static constexpr bool SIGNALS = false;
    static constexpr bool CHAIN = false;
    static constexpr bool ACC_INIT = false;
    const float* tmp; const bf16_t* z; unsigned char* y;
    __device__ __forceinline__ void operator()(const f32x4 (&acc)[2][2][4][2], const Unit& u, int wr, int wc, int fr, int fq) const {
        const int row0 = u.pm * 256 + wr * 64 + fr, col0 = u.pn * 256 + wc * 32 + 8 * fq;
#pragma unroll
        for (int ai = 0; ai < 2; ++ai)
#pragma unroll
            for (int m = 0; m < 4; ++m) { const size_t row = (size_t)(row0 + ai * 128 + m * 16);
#pragma unroll
                for (int bj = 0; bj < 2; ++bj) { const int col = col0 + bj * 128;
                    const u32x4 g = *(const u32x4*)(z + row * ZP + ZGB + col);
                    const float* p = tmp + row * D + col; const f32x4 t0 = *(const f32x4*)p, t1 = *(const f32x4*)(p + 4);
                    const f32x4 v0 = acc[ai][bj][m][0] * (W8_INV / O8_SCALE), v1 = acc[ai][bj][m][1] * (W8_INV / O8_SCALE);
                    f32x4 o0, o1;
                    o0[0] = t0[0] + v0[0] * sigmoidf_(bf_lo(g.x)); o0[1] = t0[1] + v0[1] * sigmoidf_(bf_hi(g.x)); o0[2] = t0[2] + v0[2] * sigmoidf_(bf_lo(g.y)); o0[3] = t0[3] + v0[3] * sigmoidf_(bf_hi(g.y));
                    o1[0] = t1[0] + v1[0] * sigmoidf_(bf_lo(g.z)); o1[1] = t1[1] + v1[1] * sigmoidf_(bf_hi(g.z)); o1[2] = t1[2] + v1[2] * sigmoidf_(bf_lo(g.w)); o1[3] = t1[3] + v1[3] * sigmoidf_(bf_hi(g.w));
                    o0 *= Y8_SCALE; o1 *= Y8_SCALE;
                    u32x2 w; w.x = pk4_fp8(o0[0], o0[1], o0[2], o0[3]); w.y = pk4_fp8(o1[0], o1[1], o1[2], o1[3]);
                    *(u32x2*)(y + row * D + col) = w; } }
    }
};
struct EpiBranchAB {
    static constexpr bool PERM = true;
    static constexpr bool SIGNALS = false;
    static constexpr bool CHAIN = true;
    static constexpr bool ACC_INIT = false;
    const bf16_t* z; unsigned char* y;
    __device__ __forceinline__ void operator()(f32x4 (&acc)[2][2][4][2], const Unit& u, int wr, int wc, int fr, int fq) const {
        const int row0 = u.pm * 256 + wr * 64 + fr, col0 = u.pn * 256 + wc * 32 + 8 * fq;
        if (u.e == 0) {
#pragma unroll
            for (int ai = 0; ai < 2; ++ai) {
                u32x4 ga[4][2], gb[4][2];
#pragma unroll
                for (int m = 0; m < 4; ++m)
#pragma unroll
                    for (int bj = 0; bj < 2; ++bj) { const bf16_t* zp = z + (size_t)(row0 + ai * 128 + m * 16) * ZP + col0 + bj * 128; ga[m][bj] = *(const u32x4*)(zp + ZGA); gb[m][bj] = *(const u32x4*)(zp + ZGB); }
                __builtin_amdgcn_sched_barrier(0);
#pragma unroll
                for (int m = 0; m < 4; ++m)
#pragma unroll
                    for (int bj = 0; bj < 2; ++bj) { const u32x4 a_ = ga[m][bj], b_ = gb[m][bj];
#define RHO(aw, bw, lo) ((O8_SCALE / H8_SCALE) * (1.0f + __expf(-(lo ? bf_lo(bw) : bf_hi(bw)))) * __builtin_amdgcn_rcpf(1.0f + __expf(-(lo ? bf_lo(aw) : bf_hi(aw)))))
                        f32x4 r0, r1;
                        r0[0] = RHO(a_.x, b_.x, 1); r0[1] = RHO(a_.x, b_.x, 0); r0[2] = RHO(a_.y, b_.y, 1); r0[3] = RHO(a_.y, b_.y, 0);
                        r1[0] = RHO(a_.z, b_.z, 1); r1[1] = RHO(a_.z, b_.z, 0); r1[2] = RHO(a_.w, b_.w, 1); r1[3] = RHO(a_.w, b_.w, 0);
#undef RHO
                        acc[ai][bj][m][0] *= r0; acc[ai][bj][m][1] *= r1; }
                __builtin_amdgcn_sched_barrier(0);
            }
        } else {
            u32x4 gb[2][4][2];
#pragma unroll
            for (int ai = 0; ai < 2; ++ai)
#pragma unroll
                for (int m = 0; m < 4; ++m)
#pragma unroll
                    for (int bj = 0; bj < 2; ++bj) gb[ai][m][bj] = *(const u32x4*)(z + (size_t)(row0 + ai * 128 + m * 16) * ZP + ZGB + col0 + bj * 128);
            __builtin_amdgcn_sched_barrier(0);
#pragma unroll
            for (int ai = 0; ai < 2; ++ai)
#pragma unroll
                for (int m = 0; m < 4; ++m) { const size_t row = (size_t)(row0 + ai * 128 + m * 16);
#pragma unroll
                    for (int bj = 0; bj < 2; ++bj) { const int col = col0 + bj * 128;
                        const u32x4 g = gb[ai][m][bj];
                        const f32x4 v0 = acc[ai][bj][m][0] * (W8_INV / O8_SCALE * Y8_SCALE), v1 = acc[ai][bj][m][1] * (W8_INV / O8_SCALE * Y8_SCALE);
                        u32x2 w;
                        w.x = pk4_fp8(v0[0] * sigmoidf_(bf_lo(g.x)), v0[1] * sigmoidf_(bf_hi(g.x)), v0[2] * sigmoidf_(bf_lo(g.y)), v0[3] * sigmoidf_(bf_hi(g.y)));
                        w.y = pk4_fp8(v1[0] * sigmoidf_(bf_lo(g.z)), v1[1] * sigmoidf_(bf_hi(g.z)), v1[2] * sigmoidf_(bf_lo(g.w)), v1[3] * sigmoidf_(bf_hi(g.w)));
                        *(u32x2*)(y + row * D + col) = w; } }
        }
    }
};
struct EpiOut {
    static constexpr bool PERM = false;
    static constexpr bool SIGNALS = false;
    static constexpr bool CHAIN = false;
    static constexpr bool ACC_INIT = false;
    const float* x; const float* modf; bf16_t* x1;
    __device__ __forceinline__ void operator()(const f32x4 (&acc)[2][2][4][2], const Unit& u, int wr, int wc, int fr, int fq) const {
        const int row0 = u.pm * 256 + wr * 64 + fr, col0 = u.pn * 256 + wc * 32 + 4 * fq;
        const float* gt = modf + (size_t)(u.pm >> 3) * (6 * D) + 2 * D;
        f32x4 gv[2][2];
#pragma unroll
        for (int bj = 0; bj < 2; ++bj)
#pragma unroll
            for (int n = 0; n < 2; ++n) gv[bj][n] = *(const f32x4*)(gt + col0 + bj * 128 + n * 16);
#pragma unroll
        for (int ai = 0; ai < 2; ++ai) {
            f32x4 xv[4][2][2];
#pragma unroll
            for (int m = 0; m < 4; ++m)
#pragma unroll
                for (int bj = 0; bj < 2; ++bj)
#pragma unroll
                    for (int n = 0; n < 2; ++n) xv[m][bj][n] = *(const f32x4*)(x + (size_t)(row0 + ai * 128 + m * 16) * D + col0 + bj * 128 + n * 16);
            __builtin_amdgcn_sched_barrier(0);
#pragma unroll
            for (int m = 0; m < 4; ++m) { const size_t off = (size_t)(row0 + ai * 128 + m * 16) * D + col0;
#pragma unroll
                for (int bj = 0; bj < 2; ++bj)
#pragma unroll
                    for (int n = 0; n < 2; ++n) {
                        const f32x4 v = xv[m][bj][n] + gv[bj][n] * (acc[ai][bj][m][n] * (W8_INV / Y8_SCALE));
                        u32x2 o; o.x = pk2(v[0], v[1]); o.y = pk2(v[2], v[3]);
                        *(u32x2*)(x1 + off + bj * 128 + n * 16) = o; } }
            __builtin_amdgcn_sched_barrier(0);
        }
    }
};
template <bool SC1>
struct EpiUpT {
    static constexpr bool PERM = true;
    static constexpr bool CHAIN = false;
    static constexpr bool ACC_INIT = true;
    static constexpr bool SIGNALS = SC1;
    unsigned char* act; const float* b_up; const LAS int* cbase; unsigned* upd;
    __device__ __forceinline__ void operator()(const f32x4 (&acc)[2][2][4][2], const Unit& u, int wr, int wc, int fr, int fq) const {
        const int row0 = cbase[u.e] + u.pm * 256 + wr * 64 + fr, colh = u.pn * 128 + wc * 32 + 8 * fq;
#pragma unroll
        for (int ai = 0; ai < 2; ++ai)
#pragma unroll
            for (int m = 0; m < 4; ++m) {
                const f32x4 g0 = acc[ai][0][m][0], g1 = acc[ai][0][m][1], l0 = acc[ai][1][m][0], l1 = acc[ai][1][m][1];
                constexpr float KE = 1.702f * 1.4426950408889634f * W8_INV, GC = 7.0f * W8_SCALE, OS = W8_INV * W8_INV;
                float o[8];
#pragma unroll
                for (int j = 0; j < 4; ++j) {
                    float g = fminf(g0[j], GC), l = __builtin_amdgcn_fmed3f(l0[j], -GC, GC); o[j] = (g * OS) * __builtin_amdgcn_rcpf(1.0f + __builtin_amdgcn_exp2f(g * -KE)) * (l + W8_SCALE);
                    g = fminf(g1[j], GC); l = __builtin_amdgcn_fmed3f(l1[j], -GC, GC); o[4 + j] = (g * OS) * __builtin_amdgcn_rcpf(1.0f + __builtin_amdgcn_exp2f(g * -KE)) * (l + W8_SCALE); }
                u32x2 w; w.x = pk4_fp8_ns(o[0], o[1], o[2], o[3]); w.y = pk4_fp8_ns(o[4], o[5], o[6], o[7]);
                if (SC1) store8_sc1(act + (size_t)(row0 + ai * 128 + m * 16) * D + colh, w); else *(u32x2*)(act + (size_t)(row0 + ai * 128 + m * 16) * D + colh) = w; }
    }
    __device__ __forceinline__ void acc_bias(const Unit& u, int wc, int fq, f32x4 (&bi)[2][2]) const {
        const float* bg = b_up + (size_t)u.e * (2 * D) + u.pn * 128 + wc * 32 + 8 * fq;
#pragma unroll
        for (int n = 0; n < 2; ++n) { bi[0][n] = *(const f32x4*)(bg + 4 * n) * W8_SCALE; bi[1][n] = *(const f32x4*)(bg + D + 4 * n) * W8_SCALE; }
    }
    __device__ __forceinline__ void signal(const Unit& u, bool first_lane) const { if (first_lane) __hip_atomic_fetch_add(upd + (u.e * 32 + u.pm) * 16, 1u, __ATOMIC_RELAXED, __HIP_MEMORY_SCOPE_AGENT); }
};
typedef EpiUpT<true> EpiUp;
struct EpiDown {
    static constexpr bool PERM = true;
    static constexpr bool SIGNALS = false;
    static constexpr bool CHAIN = false;
    static constexpr bool ACC_INIT = true;
    __device__ __forceinline__ void acc_bias(const Unit& u, int wc, int fq, f32x4 (&bi)[2][2]) const {
        const float* bd = b_dn + (size_t)u.e * D + u.pn * 256 + wc * 32 + 8 * fq;
#pragma unroll
        for (int bj = 0; bj < 2; ++bj)
#pragma unroll
            for (int n = 0; n < 2; ++n) bi[bj][n] = *(const f32x4*)(bd + bj * 128 + 4 * n) * W8_SCALE;
    }
    unsigned char* ydn; const float* b_dn; const float* roww; const LAS int* cbase;
    __device__ __forceinline__ void operator()(const f32x4 (&acc)[2][2][4][2], const Unit& u, int wr, int wc, int fr, int fq) const {
        const int rl = u.pm * 256 + wr * 64 + fr, row0 = cbase[u.e] + rl, col0 = u.pn * 256 + wc * 32 + 8 * fq;
        float wv[2][4];
#pragma unroll
        for (int ai = 0; ai < 2; ++ai)
#pragma unroll
            for (int m = 0; m < 4; ++m) wv[ai][m] = roww[(size_t)u.e * ECAP + rl + ai * 128 + m * 16];
        __builtin_amdgcn_sched_barrier(0);
#pragma unroll
        for (int ai = 0; ai < 2; ++ai)
#pragma unroll
            for (int m = 0; m < 4; ++m) { const float w = wv[ai][m] * YD_SCALE; unsigned char* p = ydn + (size_t)(row0 + ai * 128 + m * 16) * D + col0;
#pragma unroll
                for (int bj = 0; bj < 2; ++bj) {
                    const f32x4 v0 = acc[ai][bj][m][0] * (W8_INV * w), v1 = acc[ai][bj][m][1] * (W8_INV * w);
                    u32x2 o; o.x = pk4_fp8(v0[0], v0[1], v0[2], v0[3]); o.y = pk4_fp8(v1[0], v1[1], v1[2], v1[3]);
                    *(u32x2*)(p + bj * 128) = o; } }
    }
};

#define XB_TMO      128
#define XB_XCNT(j)  (256  + 64 * (j))
#define XB_XSUB(j)  (1280 + 64 * (j))
#define XB_XGEN(j)  (2304 + 64 * (j))
#define XB_TOP      3328
#define XB_TOPGEN   3392
#define XCD_BAR_WORDS 3456
#define XB_SPIN_CAP (1u << 18)
__device__ __forceinline__ unsigned xb_ld(unsigned* p)              { return __hip_atomic_load(p, __ATOMIC_RELAXED, __HIP_MEMORY_SCOPE_AGENT); }
__device__ __forceinline__ unsigned xb_add(unsigned* p, unsigned v) { return __hip_atomic_fetch_add(p, v, __ATOMIC_RELAXED, __HIP_MEMORY_SCOPE_AGENT); }
__device__ __forceinline__ unsigned xb_xcc_id() { return (unsigned)__builtin_amdgcn_s_getreg((3 << 11) | 20) & 0xFu; }
#define XB_SPIN(cond, bar) do { unsigned _sp = 0; while (cond) { __builtin_amdgcn_s_sleep(1); \
    if ((++_sp & 255u) == 0u) { if (xb_ld(&(bar)[XB_TMO])) break; if (_sp > XB_SPIN_CAP) { atomicAdd(&(bar)[XB_TMO], 1u); break; } } } } while (0)
struct XcdBarrier { unsigned* bar; unsigned x; volatile LAS unsigned* st; };
__device__ __forceinline__ XcdBarrier xcd_barrier_post(unsigned* bar, volatile LAS unsigned* st) {
    XcdBarrier b; b.bar = bar; b.x = xb_xcc_id(); b.st = st;
    if (threadIdx.x == 0) (void)xb_add(&bar[XB_XCNT(b.x)], 1u);
    return b;
}
__device__ __forceinline__ void xcd_barrier_complete(unsigned* bar, unsigned x, unsigned& nloc, unsigned& nx) {
    const unsigned G = gridDim.x * gridDim.y * gridDim.z;
    unsigned sum, cnt, mine, sp = 0u;
    for (;;) {
        sum = 0u; cnt = 0u; mine = 0u;
#pragma unroll
        for (unsigned j = 0; j < 16; ++j) { const unsigned c = xb_ld(&bar[XB_XCNT(j)]); sum += c; cnt += (c > 0u) ? 1u : 0u; mine = (j == x) ? c : mine; }
        if (sum == G) break;
        __builtin_amdgcn_s_sleep(1);
        if ((++sp & 255u) == 0u) { if (xb_ld(&bar[XB_TMO])) break; if (sp > XB_SPIN_CAP) { atomicAdd(&bar[XB_TMO], 1u); break; } }
    }
    nloc = mine > 0u ? mine : 1u; nx = cnt > 0u ? cnt : 1u;
}
__device__ __forceinline__ void xcd_barrier(const XcdBarrier& b) {
    asm volatile("s_waitcnt vmcnt(0)" ::: "memory");
    __syncthreads();
    if (threadIdx.x == 0) {
        unsigned* bar = b.bar;
        __builtin_amdgcn_s_waitcnt(0);
        unsigned nloc = b.st[0], nx = b.st[1];
        if (nloc == 0u) { xcd_barrier_complete(bar, b.x, nloc, nx); b.st[0] = nloc; b.st[1] = nx; }
        const unsigned old = xb_add(&bar[XB_XSUB(b.x)], 1u);
        const unsigned gen = old / nloc;
        if (old + 1u == (gen + 1u) * nloc) {
            __builtin_amdgcn_fence(__ATOMIC_RELEASE, "agent");
            asm volatile("s_waitcnt vmcnt(0)" ::: "memory");
            const unsigned og = xb_add(&bar[XB_TOP], 1u);
            const unsigned tg = og / nx;
            if (og + 1u == (tg + 1u) * nx) xb_add(&bar[XB_TOPGEN], 1u);
            else XB_SPIN(xb_ld(&bar[XB_TOPGEN]) == tg, bar);
            __builtin_amdgcn_fence(__ATOMIC_ACQUIRE, "agent");
            xb_add(&bar[XB_XGEN(b.x)], 1u);
            asm volatile("s_waitcnt vmcnt(0)" ::: "memory");
        } else {
            XB_SPIN(xb_ld(&bar[XB_XGEN(b.x)]) == gen, bar);
            __builtin_amdgcn_fence(__ATOMIC_ACQUIRE, "agent");
            asm volatile("s_waitcnt vmcnt(0)" ::: "memory");
        }
    }
    __syncthreads();
}

struct Args { const float* in[21]; float* out; unsigned char* ws; int ph_lo, ph_hi; };
enum { I_X = 0, I_C, I_WADA, I_BADA, I_GMIX, I_WIN, I_BIG, I_BFG, I_GMO, I_GQ, I_GK, I_WBA, I_WBB, I_WOUT, I_GFFN, I_WR, I_BR, I_WUP, I_BUP, I_WDN, I_BDN };

struct Frame {
    LAS unsigned char* lds; unsigned char* ws; unsigned* ctl;
    int tid, lane, wave, G, wg, vcu;
};

__device__ __forceinline__ void p0_mod_partial(Frame& F, const float* c, const float* w_ada, float* modp, int item) {
    const int cg = item % 48, ks = item / 48;
    LAS float* sS = (LAS float*)F.lds;
    LAS float* red = (LAS float*)(F.lds + 8192);
    {
        const int k = F.tid;
#pragma unroll
        for (int b = 0; b < 4; ++b) { const float v = c[b * D + ks * 512 + k]; sS[b * 512 + k] = v * sigmoidf_(v); }
    }
    __syncthreads();
    f32x4 a0 = {0.f, 0.f, 0.f, 0.f}, a1 = a0, a2 = a0, a3 = a0;
    const float* wp = w_ada + (size_t)(ks * 512 + F.wave) * (6 * D) + cg * 256 + 4 * F.lane;
#pragma unroll 8
    for (int i = 0; i < 64; ++i) {
        const f32x4 w = *(const f32x4*)(wp + (size_t)(8 * i) * (6 * D));
        const int kk = F.wave + 8 * i;
        a0 += w * sS[kk]; a1 += w * sS[512 + kk]; a2 += w * sS[1024 + kk]; a3 += w * sS[1536 + kk];
    }
    *(LAS f32x4*)(red + (F.wave * 4 + 0) * 256 + 4 * F.lane) = a0;
    *(LAS f32x4*)(red + (F.wave * 4 + 1) * 256 + 4 * F.lane) = a1;
    *(LAS f32x4*)(red + (F.wave * 4 + 2) * 256 + 4 * F.lane) = a2;
    *(LAS f32x4*)(red + (F.wave * 4 + 3) * 256 + 4 * F.lane) = a3;
    __syncthreads();
#pragma unroll
    for (int r = 0; r < 2; ++r) {
        const int o = F.tid + 512 * r, b = o >> 8, col = o & 255;
        float s = 0.f;
#pragma unroll
        for (int w = 0; w < 8; ++w) s += red[(w * 4 + b) * 256 + col];
        modp[((size_t)ks * 4 + b) * (6 * D) + cg * 256 + col] = s;
    }
    __syncthreads();
}
__device__ __forceinline__ void p0_frag_item(const float* W, int ldw, int col0, bf16_t* dst, int p) {
    const int s = p >> 6, lane = p & 63;
    const float* src = W + (size_t)(32 * s + 8 * (lane >> 4)) * ldw + col0 + (lane & 15);
    u32x4 o; o.x = pk2(src[0], src[ldw]); o.y = pk2(src[2 * (size_t)ldw], src[3 * (size_t)ldw]); o.z = pk2(src[4 * (size_t)ldw], src[5 * (size_t)ldw]); o.w = pk2(src[6 * (size_t)ldw], src[7 * (size_t)ldw]);
    *(u32x4*)(dst + (size_t)p * 8) = o;
}
constexpr int CV_RS = 528, CV_BUF = 128 * CV_RS;
struct CvtItem { const float* src; bf16_t* dst; int K, ldw; };
__device__ __forceinline__ CvtItem cvt_decode(const Args& a, unsigned char* ws, int it) {
    constexpr int N_IN = 0, N_A = 4 * 16, N_O = 8 * 16, N_UP = 8 * 32, N_DN = 8 * 16;
    CvtItem c; int r = it;
    if (r < N_IN) { const int kb = r / 48, nb = r % 48, n0 = nb * 128; c.K = D; c.ldw = DIN; c.src = a.in[I_WIN] + (size_t)(kb * 256) * DIN + n0 + (n0 >= 3072 ? 16 : 0); c.dst = (bf16_t*)(ws + WS_WIN) + (size_t)n0 * D + kb * 256; return c; } r -= N_IN;
    if (r < N_A) { const int kb = r / 16, nb = r % 16; c.K = 1024; c.ldw = D; c.src = a.in[I_WBA] + (size_t)(kb * 256) * D + nb * 128; c.dst = (bf16_t*)(ws + WS_WA) + (size_t)(nb * 128) * 1024 + kb * 256; return c; } r -= N_A;
    if (r < N_A) { const int kb = r / 16, nb = r % 16; c.K = 1024; c.ldw = D; c.src = a.in[I_WBB] + (size_t)(kb * 256) * D + nb * 128; c.dst = (bf16_t*)(ws + WS_WB) + (size_t)(nb * 128) * 1024 + kb * 256; return c; } r -= N_A;
    if (r < N_O) { const int kb = r / 16, nb = r % 16; c.K = D; c.ldw = D; c.src = a.in[I_WOUT] + (size_t)(kb * 256) * D + nb * 128; c.dst = (bf16_t*)(ws + WS_WOUT) + (size_t)(nb * 128) * D + kb * 256; return c; } r -= N_O;
    const int e = r / (N_UP + N_DN); r -= e * (N_UP + N_DN);
    if (r < N_UP) { const int kb = r / 32, nb = r % 32, t = nb >> 1; c.K = D; c.ldw = 2 * D;
        c.src = a.in[I_WUP] + (size_t)e * D * (2 * D) + (size_t)(kb * 256) * (2 * D) + ((nb & 1) ? 2048 + 128 * t : 128 * t);
        c.dst = (bf16_t*)(ws + WS_WUP) + (size_t)e * (2 * D) * D + (size_t)(nb * 128) * D + kb * 256; return c; }
    r -= N_UP; { const int kb = r / 16, nb = r % 16; c.K = D; c.ldw = D; c.src = a.in[I_WDN] + (size_t)e * D * D + (size_t)(kb * 256) * D + nb * 128; c.dst = (bf16_t*)(ws + WS_WDN) + (size_t)e * D * D + (size_t)(nb * 128) * D + kb * 256; }
    return c;
}
constexpr int CVT_DENSE_ITEMS = 2 * 4 * 16 + 8 * 16;
__device__ __forceinline__ CvtItem cvt_decode_moe(const Args& a, unsigned char* ws, int e, int which, int j, int kb) {
    CvtItem c; c.K = D;
    if (which == 0) { const int t = j >> 1; c.ldw = 2 * D;
        c.src = a.in[I_WUP] + (size_t)e * D * (2 * D) + (size_t)(kb * 256) * (2 * D) + ((j & 1) ? 2048 + 128 * t : 128 * t);
        c.dst = (bf16_t*)(ws + WS_WUP) + (size_t)e * (2 * D) * D + (size_t)(j * 128) * D + kb * 256; }
    else { c.ldw = D; c.src = a.in[I_WDN] + (size_t)e * D * D + (size_t)(kb * 256) * D + j * 128; c.dst = (bf16_t*)(ws + WS_WDN) + (size_t)e * D * D + (size_t)(j * 128) * D + kb * 256; }
    return c;
}
__device__ __forceinline__ void cvt_load(const CvtItem& c, f32x4 (&v)[16], int wave, int lane) {
    const float* p = c.src + (size_t)(32 * wave + 16 * (lane >> 5)) * c.ldw + 4 * (lane & 31);
#pragma unroll
    for (int i = 0; i < 16; ++i) v[i] = __builtin_nontemporal_load((const f32x4*)(p + (size_t)i * c.ldw));
}
__device__ __forceinline__ void cvt_to_lds(const f32x4 (&v)[16], LAS unsigned char* buf, int wave, int lane) {
    const int n4 = lane & 31, hh = lane >> 5;
#pragma unroll
    for (int g = 0; g < 2; ++g)
#pragma unroll
        for (int j = 0; j < 4; ++j) {
            u32x4 o; o.x = pk2(v[8 * g + 0][j], v[8 * g + 1][j]); o.y = pk2(v[8 * g + 2][j], v[8 * g + 3][j]); o.z = pk2(v[8 * g + 4][j], v[8 * g + 5][j]); o.w = pk2(v[8 * g + 6][j], v[8 * g + 7][j]);
            *(LAS u32x4*)(buf + (4 * n4 + j) * CV_RS + (4 * wave + 2 * hh + g) * 16) = o; }
}
template <bool SC1>
__device__ __forceinline__ void cvt_store(const CvtItem& c, const LAS unsigned char* buf, int tid) {
#pragma unroll
    for (int i = 0; i < 8; ++i) { const int id = tid + 512 * i, row = id >> 5, ch = id & 31;
        const u32x4 v = *(const LAS u32x4*)(buf + row * CV_RS + ch * 16);
        if (SC1) store16_sc1(c.dst + (size_t)row * c.K + ch * 8, v); else *(u32x4*)(c.dst + (size_t)row * c.K + ch * 8) = v; }
}
template <bool SC1, class Dec>
__device__ __forceinline__ void cvt_stream(Frame& F, const Dec& dec, int first, int n, int step) {
    int it = first;
    if (it >= n) return;
    int tid = threadIdx.x; asm volatile("" : "+v"(tid));
    const int wave = __builtin_amdgcn_readfirstlane(tid >> 6), lane = tid & 63;
    f32x4 v[16];
    CvtItem cur = dec(it);
    cvt_load(cur, v, wave, lane);
    cvt_to_lds(v, F.lds, wave, lane);
    __syncthreads();
#pragma unroll 1
    for (int i = 0;; ++i) {
        const int nx = it + step; const bool has_next = nx < n;
        CvtItem nxt = cur;
        if (has_next) { nxt = dec(nx); cvt_load(nxt, v, wave, lane); }
        cvt_store<SC1>(cur, F.lds + (i & 1) * CV_BUF, tid);
        if (has_next) cvt_to_lds(v, F.lds + ((i + 1) & 1) * CV_BUF, wave, lane);
        __syncthreads();
        if (!has_next) break;
        cur = nxt; it = nx;
    }
}
constexpr int C8_RS = 272, C8_BUF = 128 * C8_RS;
struct Cvt8Item { const float* src; unsigned char* dst; int ldw; };
__device__ __forceinline__ Cvt8Item cvt8_decode(const Args& a, unsigned char* ws, int e, int which, int j, int kb) {
    Cvt8Item c;
    if (which == 0) { const int t = j >> 1; c.ldw = 2 * D;
        c.src = a.in[I_WUP] + (size_t)e * D * (2 * D) + (size_t)(kb * 256) * (2 * D) + ((j & 1) ? 2048 + 128 * t : 128 * t);
        c.dst = ws + WS_WUP + ((size_t)e * (2 * D) + (size_t)(j * 128)) * D + kb * 256; }
    else { c.ldw = D; c.src = a.in[I_WDN] + (size_t)e * D * D + (size_t)(kb * 256) * D + j * 128; c.dst = ws + WS_WDN + ((size_t)e * D + (size_t)(j * 128)) * D + kb * 256; }
    return c;
}
__device__ __forceinline__ void cvt8_load(const Cvt8Item& c, f32x4 (&v)[16], int wave, int lane) {
    const float* p = c.src + (size_t)(32 * wave + 16 * (lane >> 5)) * c.ldw + 4 * (lane & 31);
#pragma unroll
    for (int i = 0; i < 16; ++i) v[i] = __builtin_nontemporal_load((const f32x4*)(p + (size_t)i * c.ldw));
}
__device__ __forceinline__ void cvt8_to_lds(const f32x4 (&v)[16], LAS unsigned char* buf, int wave, int lane) {
    const int n4 = lane & 31, hh = lane >> 5;
#pragma unroll
    for (int j = 0; j < 4; ++j) {
        u32x4 o;
        o.x = pk4_fp8(v[0][j] * W8_SCALE, v[1][j] * W8_SCALE, v[2][j] * W8_SCALE, v[3][j] * W8_SCALE);
        o.y = pk4_fp8(v[4][j] * W8_SCALE, v[5][j] * W8_SCALE, v[6][j] * W8_SCALE, v[7][j] * W8_SCALE);
        o.z = pk4_fp8(v[8][j] * W8_SCALE, v[9][j] * W8_SCALE, v[10][j] * W8_SCALE, v[11][j] * W8_SCALE);
        o.w = pk4_fp8(v[12][j] * W8_SCALE, v[13][j] * W8_SCALE, v[14][j] * W8_SCALE, v[15][j] * W8_SCALE);
        *(LAS u32x4*)(buf + (4 * n4 + j) * C8_RS + (2 * wave + hh) * 16) = o; }
}
__device__ __forceinline__ void cvt8_store(const Cvt8Item& c, const LAS unsigned char* buf, int tid) {
#pragma unroll
    for (int i = 0; i < 4; ++i) { const int id = tid + 512 * i, row = id >> 4, ch = id & 15;
        store16_sc1(c.dst + (size_t)row * D + ch * 16, *(const LAS u32x4*)(buf + row * C8_RS + ch * 16)); }
}
__device__ __forceinline__ void cvt8_store_keep(const Cvt8Item& c, const LAS unsigned char* buf, int tid) {
#pragma unroll
    for (int i = 0; i < 4; ++i) { const int id = tid + 512 * i, row = id >> 4, ch = id & 15;
        *(u32x4*)(c.dst + (size_t)row * D + ch * 16) = *(const LAS u32x4*)(buf + row * C8_RS + ch * 16); }
}
template <bool SC1>
__device__ __forceinline__ void cvt8_store_t(const Cvt8Item& c, const LAS unsigned char* buf, int tid) {
#pragma unroll
    for (int i = 0; i < 4; ++i) { const int id = tid + 512 * i, row = id >> 4, ch = id & 15;
        const u32x4 v = *(const LAS u32x4*)(buf + row * C8_RS + ch * 16);
        if (SC1) store16_sc1(c.dst + (size_t)row * D + ch * 16, v); else __builtin_nontemporal_store(v, (u32x4*)(c.dst + (size_t)row * D + ch * 16)); }
}
__device__ __forceinline__ Cvt8Item cvt8_decode_lin(const Args& a, unsigned char* ws, int idx) {
    const int e = idx / 384; int r = idx - e * 384; int which = 0;
    if (r >= 256) { r -= 256; which = 1; }
    return cvt8_decode(a, ws, e, which, r >> 3, r & 7);
}
__device__ __forceinline__ void cvt8_all(Frame& F, const Args& a, unsigned char* ws) {
    constexpr int N = NE * 384;
    int it = F.vcu;
    if (it >= N) return;
    int tid = threadIdx.x; asm volatile("" : "+v"(tid));
    const int wave = __builtin_amdgcn_readfirstlane(tid >> 6), lane = tid & 63;
    f32x4 v[16];
    Cvt8Item cur = cvt8_decode_lin(a, ws, it);
    cvt8_load(cur, v, wave, lane);
    cvt8_to_lds(v, F.lds, wave, lane);
    __syncthreads();
#pragma unroll 1
    for (int i = 0;; ++i) {
        const int nx = it + F.G; const bool has_next = nx < N;
        Cvt8Item nxt = cur;
        if (has_next) { nxt = cvt8_decode_lin(a, ws, nx); cvt8_load(nxt, v, wave, lane); }
        cvt8_store_t<false>(cur, F.lds + (i & 1) * C8_BUF, tid);
        if (has_next) cvt8_to_lds(v, F.lds + ((i + 1) & 1) * C8_BUF, wave, lane);
        __syncthreads();
        if (!has_next) break;
        cur = nxt; it = nx;
    }
}
__device__ __forceinline__ void cvt8_item(Frame& F, const Args& a, int idx);
template <bool SC1>
__device__ __forceinline__ void cvt8_stream(Frame& F, const Args& a, unsigned char* ws, int e, int which, int j) {
    int tid = threadIdx.x; asm volatile("" : "+v"(tid));
    const int wave = __builtin_amdgcn_readfirstlane(tid >> 6), lane = tid & 63;
    f32x4 va[16], vb[16];
    Cvt8Item c0 = cvt8_decode(a, ws, e, which, j, 0), c1 = cvt8_decode(a, ws, e, which, j, 1);
    cvt8_load(c0, va, wave, lane);
    cvt8_load(c1, vb, wave, lane);
    __builtin_amdgcn_sched_barrier(0);
    cvt8_to_lds(va, F.lds, wave, lane);
    __syncthreads();
#pragma unroll
    for (int k = 0; k < 8; k += 2) {
        Cvt8Item c2 = c0, c3 = c1;
        __builtin_amdgcn_sched_barrier(0);
        if (k + 2 < 8) { c2 = cvt8_decode(a, ws, e, which, j, k + 2); cvt8_load(c2, va, wave, lane); }
        __builtin_amdgcn_sched_barrier(0);
        cvt8_store_t<SC1>(c0, F.lds, tid);
        __builtin_amdgcn_sched_barrier(0);
        cvt8_to_lds(vb, F.lds + C8_BUF, wave, lane);
        __syncthreads();
        __builtin_amdgcn_sched_barrier(0);
        if (k + 3 < 8) { c3 = cvt8_decode(a, ws, e, which, j, k + 3); cvt8_load(c3, vb, wave, lane); }
        __builtin_amdgcn_sched_barrier(0);
        cvt8_store_t<SC1>(c1, F.lds + C8_BUF, tid);
        __builtin_amdgcn_sched_barrier(0);
        if (k + 2 < 8) cvt8_to_lds(va, F.lds, wave, lane);
        __syncthreads();
        c0 = c2; c1 = c3;
    }
}
__device__ __forceinline__ void cvt8_win_sub(Frame& F, const Args& a, int q) {
    int tid = threadIdx.x; asm volatile("" : "+v"(tid));
    const int wave = __builtin_amdgcn_readfirstlane(tid >> 6), lane = tid & 63, j = q >> 3, kb = q & 7;
    Cvt8Item c; c.ldw = DIN; c.src = a.in[I_WIN] + (size_t)(kb * 256) * DIN + j * 128 + (j >= 24 ? 16 : 0); c.dst = F.ws + WS_WIN8 + (size_t)(j * 128) * D + kb * 256;
    f32x4 v[16];
    __syncthreads();
    cvt8_load(c, v, wave, lane);
    cvt8_to_lds(v, F.lds, wave, lane);
    __syncthreads();
    cvt8_store_keep(c, F.lds, tid);
    __syncthreads();
}
__device__ __forceinline__ void cvt8_wout_sub(Frame& F, const Args& a, int q) {
    int tid = threadIdx.x; asm volatile("" : "+v"(tid));
    const int wave = __builtin_amdgcn_readfirstlane(tid >> 6), lane = tid & 63, j = q >> 3, kb = q & 7;
    Cvt8Item c; c.ldw = D; c.src = a.in[I_WOUT] + (size_t)(kb * 256) * D + j * 128; c.dst = F.ws + WS_WOUT8 + (size_t)(j * 128) * D + kb * 256;
    f32x4 v[16];
    __syncthreads();
    cvt8_load(c, v, wave, lane);
    cvt8_to_lds(v, F.lds, wave, lane);
    __syncthreads();
    cvt8_store_keep(c, F.lds, tid);
    __syncthreads();
}
__device__ __forceinline__ void cvt8_wbr_sub(Frame& F, const Args& a, int q) {
    int tid = threadIdx.x; asm volatile("" : "+v"(tid));
    const int wave = __builtin_amdgcn_readfirstlane(tid >> 6), lane = tid & 63, which = q >> 6, j = (q >> 2) & 15, kb = q & 3;
    Cvt8Item c; c.ldw = D; c.src = (which ? a.in[I_WBB] : a.in[I_WBA]) + (size_t)(kb * 256) * D + j * 128; c.dst = F.ws + (which ? WS_WB : WS_WA) + (size_t)(j * 128) * 1024 + kb * 256;
    f32x4 v[16];
    __syncthreads();
    cvt8_load(c, v, wave, lane);
    cvt8_to_lds(v, F.lds, wave, lane);
    __syncthreads();
#pragma unroll
    for (int i = 0; i < 4; ++i) { const int id = tid + 512 * i, row = id >> 4, ch = id & 15;
        *(u32x4*)(c.dst + (size_t)row * 1024 + ch * 16) = *(const LAS u32x4*)(F.lds + row * C8_RS + ch * 16); }
    __syncthreads();
}
__device__ __forceinline__ void cvt8_item(Frame& F, const Args& a, int idx) {
    if (idx < 1024) cvt8_stream<false>(F, a, F.ws, idx >> 5, 0, idx & 31);
    else cvt8_stream<false>(F, a, F.ws, (idx - 1024) >> 4, 1, (idx - 1024) & 15);
}
__device__ __forceinline__ void cvt8_item_signal(Frame& F, const Args& a, int idx, unsigned* upd) {
    const int e = (idx - 1024) >> 4;
    cvt8_stream<true>(F, a, F.ws, e, 1, (idx - 1024) & 15);
    asm volatile("s_waitcnt vmcnt(0)" ::: "memory");
    __syncthreads();
    if (F.tid < 32) __hip_atomic_fetch_add(upd + (e * 32 + F.tid) * 16, 1u, __ATOMIC_RELAXED, __HIP_MEMORY_SCOPE_AGENT);
}
struct DenseDec { const Args* a; unsigned char* ws; __device__ __forceinline__ CvtItem operator()(int it) const { return cvt_decode(*a, ws, it); } };
struct MoeDec { const Args* a; unsigned char* ws; int e, which, j; __device__ __forceinline__ CvtItem operator()(int kb) const { return cvt_decode_moe(*a, ws, e, which, j, kb); } };
__device__ __forceinline__ void p0_prologue(Frame& F, const Args& a) {
    unsigned char* ws = F.ws;
    for (int it = F.wg; it < 192; it += F.G) p0_mod_partial(F, a.in[I_C], a.in[I_WADA], (float*)(ws + WS_MODP), it);
    for (int p = (F.G - 1 - F.wg) * 512 + F.tid; p < 4096 + 8192; p += F.G * 512) {
        if (p < 4096) p0_frag_item(a.in[I_WIN], DIN, GATE_COL, (bf16_t*)(ws + WS_WGF), p);
        else { const int q = p - 4096, ct = q >> 12; p0_frag_item(a.in[I_WR], NE, 16 * ct, (bf16_t*)(ws + WS_WRF) + (size_t)ct * 4096 * 8, q & 4095); }
    }
    __syncthreads();
    if (F.G != 256) { for (int q = F.vcu; q < 640; q += F.G) cvt8_win_sub(F, a, q); }
    if (F.G != 256) { for (int q = F.G - 1 - F.vcu; q < 256; q += F.G) { if (q < 128) cvt8_wout_sub(F, a, q); else cvt8_wbr_sub(F, a, q - 128); } }
}

constexpr int HL_STRIDE = 4112;
constexpr int HL_BYTES = 32 * HL_STRIDE;
constexpr int PART_OFF = 132096;
constexpr int LOGIT_OFF = PART_OFF + 8192;
constexpr int DST_OFF = LOGIT_OFF + 4096;

__device__ __forceinline__ f32x4 mod4(const float* modp, const float* b_ada, int b, int idx) {
    f32x4 s = *(const f32x4*)(b_ada + idx);
#pragma unroll
    for (int ks = 0; ks < 4; ++ks) s += *(const f32x4*)(modp + ((size_t)ks * 4 + b) * (6 * D) + idx);
    return s;
}
template <bool FROM_PARTIALS>
__device__ __forceinline__ void norm_rows_32(Frame& F, const float* xin, const float* gvec, const float* modsrc, const float* b_ada, int chunk_sh, int rb, bf16_t* gout, unsigned char* gout8 = nullptr) {
    const int b = rb >> 6; int lane = F.lane; asm volatile("" : "+v"(lane));
    f32x4 xa[8], xb[8];
    const float* xr = xin + ((size_t)rb * 32 + 4 * F.wave) * D + 4 * lane;
#pragma unroll
    for (int j = 0; j < 8; ++j) xa[j] = *(const f32x4*)(xr + 256 * j);
#pragma unroll
    for (int j = 0; j < 8; ++j) xb[j] = *(const f32x4*)(xr + D + 256 * j);
    f32x4 xc[8], xd[8];
    if (!FROM_PARTIALS) {
#pragma unroll
        for (int j = 0; j < 8; ++j) xc[j] = *(const f32x4*)(xr + 2 * D + 256 * j);
#pragma unroll
        for (int j = 0; j < 8; ++j) xd[j] = *(const f32x4*)(xr + 3 * D + 256 * j);
    }
    f32x4 gsc[8], shv[8];
#pragma unroll
    for (int j = 0; j < 8; ++j) {
        const int col = 4 * (lane + 64 * j);
        f32x4 sh, sc;
        if (FROM_PARTIALS) { sh = mod4(modsrc, b_ada, b, chunk_sh * D + col); sc = mod4(modsrc, b_ada, b, (chunk_sh + 1) * D + col); }
        else { sh = *(const f32x4*)(modsrc + (size_t)b * (6 * D) + chunk_sh * D + col); sc = *(const f32x4*)(modsrc + (size_t)b * (6 * D) + (chunk_sh + 1) * D + col); }
        const f32x4 g = *(const f32x4*)(gvec + col);
        gsc[j] = g * (sc + 1.0f); shv[j] = sh;
        if (j & 1) __builtin_amdgcn_sched_barrier(0);
    }
#pragma unroll
    for (int i = 0; i < 4; ++i) {
        const int r = 4 * F.wave + i; const size_t row = (size_t)rb * 32 + r;
        f32x4 xv[8]; float ss = 0.f;
#pragma unroll
        for (int j = 0; j < 8; ++j) { xv[j] = FROM_PARTIALS ? ((i & 1) ? xb[j] : xa[j]) : (i == 0 ? xa[j] : i == 1 ? xb[j] : i == 2 ? xc[j] : xd[j]); ss += (xv[j][0] * xv[j][0] + xv[j][1] * xv[j][1]) + (xv[j][2] * xv[j][2] + xv[j][3] * xv[j][3]); }
        if (FROM_PARTIALS && i < 2) {
#pragma unroll
            for (int j = 0; j < 8; ++j) { const f32x4 nx = *(const f32x4*)(xr + (size_t)(i + 2) * D + 256 * j); if (i & 1) xb[j] = nx; else xa[j] = nx; }
        }
        __builtin_amdgcn_sched_barrier(0);
        const float rinv = rsqrtf(wave_sum(ss) * (1.0f / D) + EPS);
        int ls = lane; asm volatile("" : "+v"(ls));
        const size_t so = row * D + 4 * (size_t)ls;
#pragma unroll
        for (int j = 0; j < 8; ++j) {
            const f32x4 hv = xv[j] * rinv * gsc[j] + shv[j];
            u32x2 p; p.x = pk2(hv[0], hv[1]); p.y = pk2(hv[2], hv[3]);
            *(LAS u32x2*)(F.lds + r * HL_STRIDE + 8 * ls + 512 * j) = p;
            if (gout) *(u32x2*)(gout + so + 256 * j) = p;
            if (gout8) *(unsigned*)(gout8 + so + 256 * j) = pk4_fp8(hv[0], hv[1], hv[2], hv[3]);
        }
        __builtin_amdgcn_sched_barrier(0);
    }
}
__device__ __forceinline__ void norm_rows_32_b(Frame& F, const bf16_t* xin, const float* gvec, const float* modsrc, int chunk_sh, int rb) {
    const int b = rb >> 6; int lane = F.lane; asm volatile("" : "+v"(lane));
    u32x2 xr_[4][8];
    const bf16_t* xr = xin + ((size_t)rb * 32 + 4 * F.wave) * D + 4 * lane;
#pragma unroll
    for (int i = 0; i < 4; ++i)
#pragma unroll
        for (int j = 0; j < 8; ++j) xr_[i][j] = *(const u32x2*)(xr + (size_t)i * D + 256 * j);
    f32x4 gsc[8], shv[8];
#pragma unroll
    for (int j = 0; j < 8; ++j) {
        const int col = 4 * (lane + 64 * j);
        const f32x4 sh = *(const f32x4*)(modsrc + (size_t)b * (6 * D) + chunk_sh * D + col), sc = *(const f32x4*)(modsrc + (size_t)b * (6 * D) + (chunk_sh + 1) * D + col);
        const f32x4 g = *(const f32x4*)(gvec + col);
        gsc[j] = g * (sc + 1.0f); shv[j] = sh;
    }
#pragma unroll
    for (int i = 0; i < 4; ++i) {
        const int r = 4 * F.wave + i;
        f32x4 xv[8]; float ss = 0.f;
#pragma unroll
        for (int j = 0; j < 8; ++j) { const u32x2 q = xr_[i][j]; xv[j] = (f32x4){bf_lo(q.x), bf_hi(q.x), bf_lo(q.y), bf_hi(q.y)}; ss += (xv[j][0] * xv[j][0] + xv[j][1] * xv[j][1]) + (xv[j][2] * xv[j][2] + xv[j][3] * xv[j][3]); }
        const float rinv = rsqrtf(wave_sum(ss) * (1.0f / D) + EPS);
#pragma unroll
        for (int j = 0; j < 8; ++j) {
            const f32x4 hv = xv[j] * rinv * gsc[j] + shv[j];
            u32x2 p; p.x = pk2(hv[0], hv[1]); p.y = pk2(hv[2], hv[3]);
            *(LAS u32x2*)(F.lds + r * HL_STRIDE + 8 * lane + 512 * j) = p;
        }
    }
}
__device__ __forceinline__ void p1_rows(Frame& F, const Args& a) {
    unsigned char* ws = F.ws;
    const float* modp = (const float*)(ws + WS_MODP);
    { float* modf = (float*)(ws + WS_MODF);
      for (int i = F.wg * 512 + F.tid; i < NB * 6 * D; i += F.G * 512) { const int b = i / (6 * D), idx = i % (6 * D); float s = a.in[I_BADA][idx];
#pragma unroll
          for (int ks = 0; ks < 4; ++ks) s += modp[((size_t)ks * 4 + b) * (6 * D) + idx];
          modf[i] = s; } }
    if (F.wg == 0 && F.wave == 0) {
        float mq = fmaxf(fabsf(a.in[I_GQ][2 * F.lane]), fabsf(a.in[I_GQ][2 * F.lane + 1])), mk = fmaxf(fabsf(a.in[I_GK][2 * F.lane]), fabsf(a.in[I_GK][2 * F.lane + 1]));
#pragma unroll
        for (int o = 1; o < 64; o <<= 1) { mq = fmaxf(mq, __shfl_xor(mq, o)); mk = fmaxf(mk, __shfl_xor(mk, o)); }
        if (F.lane == 0) ((float*)F.ctl)[CW_MISC] = 16.3223f * 1.01f * mq * mk;
    }
    const bf16_t* wgf = (const bf16_t*)(ws + WS_WGF);
    float* gates = (float*)(ws + WS_GATES);
    LAS float* part = (LAS float*)(F.lds + PART_OFF);
    const int lane = F.lane, l15 = lane & 15, g4 = lane >> 4;
    for (int rb = F.wg; rb < T / 32; rb += F.G) {
        norm_rows_32<true>(F, a.in[I_X], a.in[I_GMIX], modp, a.in[I_BADA], 0, rb, nullptr, ws + WS_HBUF8);
        { const int rg = F.wave & 1, kq = F.wave >> 1; f32x4 acc = {0.f, 0.f, 0.f, 0.f};
          bf16x8 bvv[16];
          __builtin_amdgcn_sched_barrier(0);
          const bf16_t* wq = wgf + ((size_t)(16 * kq) * 64 + lane) * 8; asm volatile("" : "+v"(wq));
#pragma unroll
          for (int s = 0; s < 16; ++s) bvv[s] = *(const bf16x8*)(wq + (size_t)s * 512);
          __syncthreads();
#pragma unroll
          for (int s = 0; s < 16; ++s) { const int ks = 16 * kq + s;
              const bf16x8 av = *(const LAS bf16x8*)(F.lds + (16 * rg + l15) * HL_STRIDE + (32 * ks + 8 * g4) * 2);
              acc = __builtin_amdgcn_mfma_f32_16x16x32_bf16(av, bvv[s], acc, 0, 0, 0); }
#pragma unroll
          for (int r = 0; r < 4; ++r) part[(kq * 2 + rg) * 256 + (4 * g4 + r) * 16 + l15] = acc[r]; }
        __syncthreads();
        { const int rg = F.tid >> 8, rc = F.tid & 255; float s = 0.f;
#pragma unroll
          for (int kq = 0; kq < 4; ++kq) s += part[(kq * 2 + rg) * 256 + rc];
          gates[((size_t)rb * 32 + 16 * rg + (rc >> 4)) * 16 + (rc & 15)] = s; }
        __syncthreads();
    }
    if (F.G == 256) { for (int q = F.G - 1 - F.vcu; q < 640; q += F.G) cvt8_win_sub(F, a, q); }
}

__device__ __forceinline__ void p3_qknorm(Frame& F, const Args& a) {
    bf16_t* z = (bf16_t*)(F.ws + WS_Z); float* kmean = (float*)(F.ws + WS_KMEAN);
    LAS float* cs = (LAS float*)F.lds;
    const int lane = F.lane;
    for (int u = F.wg; u < 512; u += F.G) {
        const int which = u & 1, h = (u >> 1) & 7, blk = (u >> 4) & 7, b = u >> 7;
        const float* gv = which ? a.in[I_GK] : a.in[I_GQ];
        const float g0 = gv[2 * lane], g1 = gv[2 * lane + 1];
        bf16_t* base = z + ((size_t)b * SEQ + blk * 256 + 32 * F.wave) * ZP + (which ? ZKB : ZQB) + h * 128 + 2 * lane;
        unsigned v[32];
#pragma unroll
        for (int i = 0; i < 32; ++i) v[i] = *(const unsigned*)(base + (size_t)i * ZP);
        float c0 = 0.f, c1 = 0.f;
#pragma unroll
        for (int i = 0; i < 32; ++i) {
            const float f0 = bf_lo(v[i]), f1 = bf_hi(v[i]);
            const float rinv = rsqrtf(wave_sum(f0 * f0 + f1 * f1) * (1.0f / 128.0f) + EPS);
            const float y0 = f0 * rinv * g0, y1 = f1 * rinv * g1;
            *(unsigned*)(base + (size_t)i * ZP) = pk2(y0, y1);
            c0 += y0; c1 += y1;
        }
        if (which) {
            cs[F.wave * 128 + 2 * lane] = c0; cs[F.wave * 128 + 2 * lane + 1] = c1;
            __syncthreads();
            if (F.tid < 128) { float s = 0.f;
#pragma unroll
                for (int w = 0; w < 8; ++w) s += cs[w * 128 + F.tid];
                kmean[(((size_t)b * 8 + h) * 8 + blk) * 128 + F.tid] = s * (1.0f / 256.0f); }
            __syncthreads();
        }
    }
}

__device__ __forceinline__ s16x4 tr16(LAS unsigned char* p) { return __builtin_amdgcn_ds_read_tr16_b64_v4i16((LAS s16x4*)p); }
__device__ __forceinline__ bf16x8 cat8(s16x4 a, s16x4 b) { return (bf16x8){a[0], a[1], a[2], a[3], b[0], b[1], b[2], b[3]}; }
#define MFMA16(a, b, c) __builtin_amdgcn_mfma_f32_16x16x32_bf16((a), (b), (c), 0, 0, 0)

struct ChunkGates { float li, bcs, u, pmx, g, umax; };
__device__ __forceinline__ ChunkGates chunk_gates(float gi_raw, float gf_raw, float bi, float bfg, int lane) {
    ChunkGates G;
    const float ti = __expf((gi_raw + bi) * (2.0f / 15.0f)), tf = __expf((gf_raw + bfg) * (2.0f / 15.0f));
    G.li = 15.0f - 30.0f * __builtin_amdgcn_rcpf(ti + 1.0f);
    const float xf = 15.0f - 30.0f * __builtin_amdgcn_rcpf(tf + 1.0f);
    const float lf = fminf(xf, 0.f) - __logf(1.0f + __expf(-fabsf(xf)));
    float bcs = lf;
#pragma unroll
    for (int o = 1; o < 64; o <<= 1) { const float t = __shfl_up(bcs, o); if (lane >= o) bcs += t; }
    G.bcs = bcs; G.g = __shfl(bcs, 63); G.u = G.li - bcs;
    float pmx = G.u;
#pragma unroll
    for (int o = 1; o < 64; o <<= 1) { const float t = __shfl_up(pmx, o); if (lane >= o) pmx = fmaxf(pmx, t); }
    G.pmx = pmx; G.umax = __shfl(pmx, 63);
    return G;
}
constexpr int ML_QS = 0, ML_KS = 9216, ML_KW = 18432, ML_VS = 27648, ML_SB = 45056, ML_CB = 54272, ML_HO = 72704, ML_FLO = 90112, ML_RS = 144, ML_VR = 272;

struct PassAIn { u32x4 kv, v0, v1; float gi, gf; };
__device__ __forceinline__ PassAIn mlstm_passA_load(Frame& F, int u) {
    const bf16_t* z = (const bf16_t*)(F.ws + WS_Z); const float* gates = (const float*)(F.ws + WS_GATES);
    const int c = u & 31, h = (u >> 5) & 7, b = u >> 8;
    const size_t tok0 = (size_t)b * SEQ + c * 64;
    const int lr = F.tid >> 3, ls = F.tid & 7;
    const bf16_t* zr = z + (tok0 + lr) * ZP;
    PassAIn I;
    I.kv = *(const u32x4*)(zr + ZKA + h * 64 + ls * 8);
    I.v0 = *(const u32x4*)(zr + ZVA + h * 128 + ls * 8); I.v1 = *(const u32x4*)(zr + ZVA + h * 128 + 64 + ls * 8);
    I.gi = gates[(tok0 + F.lane) * 16 + h]; I.gf = gates[(tok0 + F.lane) * 16 + 8 + h];
    return I;
}
__device__ __forceinline__ void mlstm_passA(Frame& F, const Args& a, int u, const PassAIn& I) {
    LAS unsigned char* L = F.lds; LAS float* fl = (LAS float*)(L + ML_FLO);
    float* cloc = (float*)(F.ws + WS_CLOC) + (size_t)u * 8192; float* nloc = (float*)(F.ws + WS_NLOC) + (size_t)u * 64; float* msc = (float*)(F.ws + WS_MSC) + (size_t)u * 4;
    const int tid = F.tid, lane = F.lane, w = F.wave, l15 = lane & 15, g4 = lane >> 4;
    const int h = (u >> 5) & 7;
    const int lr = tid >> 3, ls = tid & 7;
    const u32x4 kv = I.kv, v0 = I.v0, v1 = I.v1;
    __syncthreads();
    if (w == 0) {
        const ChunkGates G = chunk_gates(I.gi, I.gf, a.in[I_BIG][h], a.in[I_BFG][h], lane);
        fl[256 + lane] = __expf(G.u - G.umax);
        if (lane == 0) { msc[0] = G.g + G.umax; msc[1] = G.g; }
    }
    *(LAS u32x4*)(L + ML_VS + lr * ML_VR + ls * 16) = v0; *(LAS u32x4*)(L + ML_VS + lr * ML_VR + 128 + ls * 16) = v1;
    __syncthreads();
    { const float wr_ = fl[256 + lr];
      u32x4 o; o.x = pk2(bf_lo(kv.x) * wr_, bf_hi(kv.x) * wr_); o.y = pk2(bf_lo(kv.y) * wr_, bf_hi(kv.y) * wr_); o.z = pk2(bf_lo(kv.z) * wr_, bf_hi(kv.z) * wr_); o.w = pk2(bf_lo(kv.w) * wr_, bf_hi(kv.w) * wr_);
      *(LAS u32x4*)(L + ML_KW + lr * ML_RS + ls * 16) = o; }
    __syncthreads();
    f32x4 Cacc[4];
#pragma unroll
    for (int et = 0; et < 4; ++et) Cacc[et] = (f32x4){0.f, 0.f, 0.f, 0.f};
#pragma unroll
    for (int ks = 0; ks < 2; ++ks) {
        LAS unsigned char* vp = L + ML_VS + (32 * ks + 8 * g4 + (l15 >> 2)) * ML_VR + (16 * w + 4 * (l15 & 3)) * 2;
        const bf16x8 av = cat8(tr16(vp), tr16(vp + 4 * ML_VR));
#pragma unroll
        for (int et = 0; et < 4; ++et) {
            LAS unsigned char* kp = L + ML_KW + (32 * ks + 8 * g4 + (l15 >> 2)) * ML_RS + (16 * et + 4 * (l15 & 3)) * 2;
            Cacc[et] = MFMA16(av, cat8(tr16(kp), tr16(kp + 4 * ML_RS)), Cacc[et]); } }
#pragma unroll
    for (int et = 0; et < 4; ++et)
#pragma unroll
        for (int r = 0; r < 4; ++r) cloc[(16 * w + 4 * g4 + r) * 64 + 16 * et + l15] = Cacc[et][r];
    { const int e = tid >> 3, part = tid & 7; float sacc = 0.f;
#pragma unroll
      for (int i = 0; i < 8; ++i) sacc += bf1(*(const LAS bf16_t*)(L + ML_KW + (8 * part + i) * ML_RS + e * 2));
      sacc = sum8_(sacc);
      if (part == 0) nloc[e] = sacc; }
}

__device__ __forceinline__ void mlstm_passA4(Frame& F, const Args& a) {
    constexpr int CH = 27648, VS = 0, KW = 17408, FL = 26624;
    const bf16_t* z = (const bf16_t*)(F.ws + WS_Z); const float* gates = (const float*)(F.ws + WS_GATES);
    int tid = F.tid; asm volatile("" : "+v"(tid));
    const int lane = tid & 63, w = F.wave, l15 = lane & 15, g4 = lane >> 4, lr = tid >> 3, ls = tid & 7;
    u32x4 kv[4], v0[4], v1[4]; float gi[4], gf[4];
#pragma unroll
    for (int k = 0; k < 4; ++k) {
        const int u = F.wg + 256 * k, c = u & 31, h = (u >> 5) & 7, b = u >> 8;
        const size_t tok0 = (size_t)b * SEQ + c * 64;
        const bf16_t* zr = z + (tok0 + lr) * ZP;
        kv[k] = *(const u32x4*)(zr + ZKA + h * 64 + ls * 8);
        v0[k] = *(const u32x4*)(zr + ZVA + h * 128 + ls * 8); v1[k] = *(const u32x4*)(zr + ZVA + h * 128 + 64 + ls * 8);
        gi[k] = gates[(tok0 + lane) * 16 + h]; gf[k] = gates[(tok0 + lane) * 16 + 8 + h];
    }
    __syncthreads();
#pragma unroll
    for (int k = 0; k < 4; ++k) {
        const int u = F.wg + 256 * k, h = (u >> 5) & 7;
        LAS unsigned char* L = F.lds + k * CH; LAS float* fl = (LAS float*)(L + FL);
        if (w == k) {
            const ChunkGates G = chunk_gates(gi[k], gf[k], a.in[I_BIG][h], a.in[I_BFG][h], lane);
            fl[lane] = __expf(G.u - G.umax);
            if (lane == 0) { float* msc = (float*)(F.ws + WS_MSC) + (size_t)u * 4; msc[0] = G.g + G.umax; msc[1] = G.g; }
        }
        *(LAS u32x4*)(L + VS + lr * ML_VR + ls * 16) = v0[k]; *(LAS u32x4*)(L + VS + lr * ML_VR + 128 + ls * 16) = v1[k];
    }
    __syncthreads();
#pragma unroll
    for (int k = 0; k < 4; ++k) {
        LAS unsigned char* L = F.lds + k * CH; const LAS float* fl = (const LAS float*)(L + FL);
        const float wr_ = fl[lr]; const u32x4 q = kv[k];
        u32x4 o; o.x = pk2(bf_lo(q.x) * wr_, bf_hi(q.x) * wr_); o.y = pk2(bf_lo(q.y) * wr_, bf_hi(q.y) * wr_); o.z = pk2(bf_lo(q.z) * wr_, bf_hi(q.z) * wr_); o.w = pk2(bf_lo(q.w) * wr_, bf_hi(q.w) * wr_);
        *(LAS u32x4*)(L + KW + lr * ML_RS + ls * 16) = o;
    }
    __syncthreads();
#pragma unroll
    for (int k = 0; k < 4; ++k) {
        const int u = F.wg + 256 * k;
        LAS unsigned char* L = F.lds + k * CH;
        float* cloc = (float*)(F.ws + WS_CLOC) + (size_t)u * 8192; float* nloc = (float*)(F.ws + WS_NLOC) + (size_t)u * 64;
        f32x4 Cacc[4];
#pragma unroll
        for (int et = 0; et < 4; ++et) Cacc[et] = (f32x4){0.f, 0.f, 0.f, 0.f};
#pragma unroll
        for (int ks = 0; ks < 2; ++ks) {
            LAS unsigned char* vp = L + VS + (32 * ks + 8 * g4 + (l15 >> 2)) * ML_VR + (16 * w + 4 * (l15 & 3)) * 2;
            const bf16x8 av = cat8(tr16(vp), tr16(vp + 4 * ML_VR));
#pragma unroll
            for (int et = 0; et < 4; ++et) {
                LAS unsigned char* kp = L + KW + (32 * ks + 8 * g4 + (l15 >> 2)) * ML_RS + (16 * et + 4 * (l15 & 3)) * 2;
                Cacc[et] = MFMA16(av, cat8(tr16(kp), tr16(kp + 4 * ML_RS)), Cacc[et]); } }
#pragma unroll
        for (int et = 0; et < 4; ++et)
#pragma unroll
            for (int r = 0; r < 4; ++r) cloc[(16 * w + 4 * g4 + r) * 64 + 16 * et + l15] = Cacc[et][r];
        { const int e = tid >> 3, part = tid & 7; float sacc = 0.f;
#pragma unroll
          for (int i = 0; i < 8; ++i) sacc += bf1(*(const LAS bf16_t*)(L + KW + (8 * part + i) * ML_RS + e * 2));
          sacc = sum8_(sacc);
          if (part == 0) nloc[e] = sacc; }
    }
}

__device__ __forceinline__ void mlstm_passB(Frame& F, int item) {
    const int bh = item >> 3, slice = item & 7, tid = F.tid;
    const float* cloc = (const float*)(F.ws + WS_CLOC) + (size_t)bh * 32 * 8192 + slice * 1024 + 2 * tid;
    bf16_t* cin = (bf16_t*)(F.ws + WS_CIN) + (size_t)bh * 32 * 8192 + slice * 1024 + 2 * tid;
    const float* nloc = (const float*)(F.ws + WS_NLOC) + (size_t)bh * 32 * 64 + 2 * tid;
    float* nin = (float*)(F.ws + WS_NIN) + (size_t)bh * 32 * 64 + 2 * tid;
    float* msc = (float*)(F.ws + WS_MSC) + (size_t)bh * 32 * 4;
    const bool do_n = (slice == 0) && (tid < 32);
    f32x2 cl[32], nl[32], mg[32];
#pragma unroll
    for (int c = 0; c < 32; ++c) { cl[c] = *(const f32x2*)(cloc + (size_t)c * 8192); nl[c] = do_n ? *(const f32x2*)(nloc + c * 64) : (f32x2){0.f, 0.f}; mg[c] = *(const f32x2*)(msc + c * 4); }
    __builtin_amdgcn_sched_barrier(0);
    float m = 0.f; f32x2 C = {0.f, 0.f}, N = {0.f, 0.f};
#pragma unroll
    for (int c = 0; c < 32; ++c) {
        *(unsigned*)(cin + (size_t)c * 8192) = pk2(C[0], C[1]);
        if (do_n) *(f32x2*)(nin + c * 64) = N;
        if (slice == 0 && tid == 0) msc[c * 4 + 2] = m;
        const float mloc = mg[c][0], g = mg[c][1];
        const float m_new = fmaxf(g + m, mloc), sp = __expf(g + m - m_new), sl = __expf(mloc - m_new);
        C = C * sp + cl[c] * sl; N = N * sp + nl[c] * sl; m = m_new;
    }
}

__device__ __forceinline__ void mlstm_passC(Frame& F, const Args& a, int u) {
    constexpr int QS = ML_QS, KS = ML_KS, VS = ML_VS, SB = ML_SB, CB = ML_CB, HO = ML_HO, RS = ML_RS, VR = ML_VR;
    LAS unsigned char* L = F.lds; LAS float* fl = (LAS float*)(L + ML_FLO);
    const bf16_t* z = (const bf16_t*)(F.ws + WS_Z); const float* gates = (const float*)(F.ws + WS_GATES);
    unsigned char* hm = F.ws + WS_HM;
    int tid = F.tid; asm volatile("" : "+v"(tid));
    const int lane = tid & 63, w = F.wave, l15 = lane & 15, g4 = lane >> 4;
    const int c = u & 31, h = (u >> 5) & 7, b = u >> 8;
    const float* gmo = a.in[I_GMO] + h * 128;
    const size_t tok0 = (size_t)b * SEQ + c * 64;
    const int lr = tid >> 3, ls = tid & 7, jt = w & 3, hf = w >> 2;
    const bf16_t* zr = z + (tok0 + lr) * ZP;
    const u32x4 qv = *(const u32x4*)(zr + ZQA + h * 64 + ls * 8), kv = *(const u32x4*)(zr + ZKA + h * 64 + ls * 8);
    const u32x4 v0 = *(const u32x4*)(zr + ZVA + h * 128 + ls * 8), v1 = *(const u32x4*)(zr + ZVA + h * 128 + 64 + ls * 8);
    const u32x4 oc0 = *(const u32x4*)(zr + ZOA + h * 128 + ls * 16), oc1 = *(const u32x4*)(zr + ZOA + h * 128 + ls * 16 + 8);
    const bf16_t* cin = (const bf16_t*)(F.ws + WS_CIN) + (size_t)u * 8192;
    const u32x4 c0 = *(const u32x4*)(cin + tid * 8), c1 = *(const u32x4*)(cin + 4096 + tid * 8);
    const float* msc = (const float*)(F.ws + WS_MSC) + (size_t)u * 4;
    const float mstate = msc[2], gi_raw = gates[(tok0 + lane) * 16 + h], gf_raw = gates[(tok0 + lane) * 16 + 8 + h], big = a.in[I_BIG][h], bfg = a.in[I_BFG][h];
    const float nin_l = ((const float*)(F.ws + WS_NIN))[(size_t)u * 64 + lane];
    float gmo_r[4];
#pragma unroll
    for (int d4 = 0; d4 < 4; ++d4) gmo_r[d4] = gmo[16 * (4 * hf + d4) + l15];
    __syncthreads();
    if (w == 0) {
        const ChunkGates G = chunk_gates(gi_raw, gf_raw, big, bfg, lane);
        const float M = fmaxf(mstate, G.pmx);
        fl[lane] = -M; fl[64 + lane] = G.u; fl[128 + lane] = __expf(mstate - M); fl[192 + lane] = __expf(-(G.bcs + M));
    }
    if (w == 1) fl[640 + lane] = nin_l;
    *(LAS u32x4*)(L + QS + lr * RS + ls * 16) = qv; *(LAS u32x4*)(L + KS + lr * RS + ls * 16) = kv;
    *(LAS u32x4*)(L + VS + lr * VR + ls * 16) = v0; *(LAS u32x4*)(L + VS + lr * VR + 128 + ls * 16) = v1;
    *(LAS u32x4*)(L + CB + lr * RS + ls * 16) = c0; *(LAS u32x4*)(L + CB + (64 + lr) * RS + ls * 16) = c1;
    __syncthreads();
    { const LAS float* nv = fl + 640 + ls * 8;
      float s = bf_lo(qv.x) * nv[0] + bf_hi(qv.x) * nv[1] + bf_lo(qv.y) * nv[2] + bf_hi(qv.y) * nv[3] + bf_lo(qv.z) * nv[4] + bf_hi(qv.z) * nv[5] + bf_lo(qv.w) * nv[6] + bf_hi(qv.w) * nv[7];
      s = sum8_(s);
      if (ls == 0) fl[320 + lr] = s * 0.125f; }
    { bf16x8 aq[2];
#pragma unroll
      for (int ks = 0; ks < 2; ++ks) aq[ks] = *(const LAS bf16x8*)(L + QS + (16 * jt + l15) * RS + (32 * ks + 8 * g4) * 2);
      float rsum[4] = {0.f, 0.f, 0.f, 0.f};
#pragma unroll
      for (int st2 = 0; st2 < 2; ++st2) { const int st = 2 * hf + st2; f32x4 s = {0.f, 0.f, 0.f, 0.f};
          if (st <= jt) {
#pragma unroll
              for (int ks = 0; ks < 2; ++ks) { const bf16x8 bk = *(const LAS bf16x8*)(L + KS + (16 * st + l15) * RS + (32 * ks + 8 * g4) * 2); s = MFMA16(aq[ks], bk, s); } }
          const int scol = 16 * st + l15; const float cf = fl[64 + scol];
#pragma unroll
          for (int r = 0; r < 4; ++r) { const int j = 16 * jt + 4 * g4 + r;
              const float val = (scol <= j) ? s[r] * 0.125f * __expf(fl[j] + cf) : 0.f; rsum[r] += val;
              *(LAS bf16_t*)(L + SB + j * RS + scol * 2) = f2bf(val); } }
#pragma unroll
      for (int r = 0; r < 4; ++r) { float t = sum16_(rsum[r]);
          if (l15 == 0) fl[384 + hf * 64 + 16 * jt + 4 * g4 + r] = t; } }
    __syncthreads();
    float hv[4][4];
    { bf16x8 as_[2], aq[2];
#pragma unroll
      for (int ks = 0; ks < 2; ++ks) { as_[ks] = *(const LAS bf16x8*)(L + SB + (16 * jt + l15) * RS + (32 * ks + 8 * g4) * 2); aq[ks] = *(const LAS bf16x8*)(L + QS + (16 * jt + l15) * RS + (32 * ks + 8 * g4) * 2); }
      float si[4], dn[4], en[4], ss[4] = {0.f, 0.f, 0.f, 0.f};
#pragma unroll
      for (int r = 0; r < 4; ++r) { const int j = 16 * jt + 4 * g4 + r; si[r] = fl[128 + j]; dn[r] = fl[384 + j] + fl[448 + j] + si[r] * fl[320 + j]; en[r] = fl[192 + j]; si[r] *= 0.125f; }
#pragma unroll
      for (int d4 = 0; d4 < 4; ++d4) { const int dt = 4 * hf + d4; f32x4 nacc = {0.f, 0.f, 0.f, 0.f}, iacc = nacc;
#pragma unroll
          for (int ks = 0; ks < 2; ++ks) {
              LAS unsigned char* vp = L + VS + (32 * ks + 8 * g4 + (l15 >> 2)) * VR + (16 * dt + 4 * (l15 & 3)) * 2;
              nacc = MFMA16(as_[ks], cat8(tr16(vp), tr16(vp + 4 * VR)), nacc);
              const bf16x8 bc = *(const LAS bf16x8*)(L + CB + (16 * dt + l15) * RS + (32 * ks + 8 * g4) * 2);
              iacc = MFMA16(aq[ks], bc, iacc); }
#pragma unroll
          for (int r = 0; r < 4; ++r) { const float num = nacc[r] + si[r] * iacc[r]; const float hvv = num * __builtin_amdgcn_rcpf(fmaxf(fabsf(dn[r]), en[r])); hv[d4][r] = hvv; ss[r] += hvv * hvv; } }
#pragma unroll
      for (int r = 0; r < 4; ++r) { float t = sum16_(ss[r]);
          if (l15 == 0) fl[512 + hf * 64 + 16 * jt + 4 * g4 + r] = t; } }
    __syncthreads();
    { float rinv[4];
#pragma unroll
      for (int r = 0; r < 4; ++r) { const int j = 16 * jt + 4 * g4 + r; rinv[r] = rsqrtf((fl[512 + j] + fl[576 + j]) * (1.0f / 128.0f) + EPS); }
#pragma unroll
      for (int d4 = 0; d4 < 4; ++d4) { const int d = 16 * (4 * hf + d4) + l15; const float gg = gmo_r[d4];
#pragma unroll
          for (int r = 0; r < 4; ++r) *(LAS bf16_t*)(L + HO + (16 * jt + 4 * g4 + r) * VR + d * 2) = f2bf(hv[d4][r] * rinv[r] * gg); } }
    __syncthreads();
    { const u32x4 h0 = *(const LAS u32x4*)(L + HO + lr * VR + ls * 32), h1 = *(const LAS u32x4*)(L + HO + lr * VR + ls * 32 + 16);
#define HG(hw, ow, lo) ((lo ? bf_lo(hw) : bf_hi(hw)) * sigmoidf_(lo ? bf_lo(ow) : bf_hi(ow)) * H8_SCALE)
      u32x4 r;
      r.x = pk4_fp8(HG(h0.x, oc0.x, 1), HG(h0.x, oc0.x, 0), HG(h0.y, oc0.y, 1), HG(h0.y, oc0.y, 0));
      r.y = pk4_fp8(HG(h0.z, oc0.z, 1), HG(h0.z, oc0.z, 0), HG(h0.w, oc0.w, 1), HG(h0.w, oc0.w, 0));
      r.z = pk4_fp8(HG(h1.x, oc1.x, 1), HG(h1.x, oc1.x, 0), HG(h1.y, oc1.y, 1), HG(h1.y, oc1.y, 0));
      r.w = pk4_fp8(HG(h1.z, oc1.z, 1), HG(h1.z, oc1.z, 0), HG(h1.w, oc1.w, 1), HG(h1.w, oc1.w, 0));
#undef HG
      *(u32x4*)(hm + (tok0 + lr) * 1024 + h * 128 + ls * 16) = r; }
}

__device__ __forceinline__ void mlstm_passC2(Frame& F, const Args& a, int ua, int ub) {
    constexpr int QS = 0, KS = 9216, VS = 18432, SB = 35840, CB = 45056, HO = 0, FLO = 63488, CH = 66560, RS = ML_RS, VR = ML_VR;
    const bf16_t* z = (const bf16_t*)(F.ws + WS_Z); const float* gates = (const float*)(F.ws + WS_GATES);
    unsigned char* hm = F.ws + WS_HM;
    int tid = F.tid; asm volatile("" : "+v"(tid));
    const int lane = tid & 63, w = F.wave, l15 = lane & 15, g4 = lane >> 4;
    const int lr = tid >> 3, ls = tid & 7, jt = w & 3, hf = w >> 2;
    u32x4 qv[2], kv[2], v0[2], v1[2], oc0[2], oc1[2], c0[2], c1[2];
    float mstate[2], gi_raw[2], gf_raw[2], big[2], bfg[2], nin_l[2], gmo_r[2][4];
    size_t tok0[2]; int hh[2];
#pragma unroll
    for (int k = 0; k < 2; ++k) {
        const int u = k ? ub : ua, c = u & 31, h = (u >> 5) & 7, b = u >> 8;
        hh[k] = h; tok0[k] = (size_t)b * SEQ + c * 64;
        const bf16_t* zr = z + (tok0[k] + lr) * ZP;
        qv[k] = *(const u32x4*)(zr + ZQA + h * 64 + ls * 8); kv[k] = *(const u32x4*)(zr + ZKA + h * 64 + ls * 8);
        v0[k] = *(const u32x4*)(zr + ZVA + h * 128 + ls * 8); v1[k] = *(const u32x4*)(zr + ZVA + h * 128 + 64 + ls * 8);
        oc0[k] = *(const u32x4*)(zr + ZOA + h * 128 + ls * 16); oc1[k] = *(const u32x4*)(zr + ZOA + h * 128 + ls * 16 + 8);
        const bf16_t* cin = (const bf16_t*)(F.ws + WS_CIN) + (size_t)u * 8192;
        c0[k] = *(const u32x4*)(cin + tid * 8); c1[k] = *(const u32x4*)(cin + 4096 + tid * 8);
        const float* msc = (const float*)(F.ws + WS_MSC) + (size_t)u * 4;
        mstate[k] = msc[2]; gi_raw[k] = gates[(tok0[k] + lane) * 16 + h]; gf_raw[k] = gates[(tok0[k] + lane) * 16 + 8 + h]; big[k] = a.in[I_BIG][h]; bfg[k] = a.in[I_BFG][h];
        nin_l[k] = ((const float*)(F.ws + WS_NIN))[(size_t)u * 64 + lane];
        const float* gmo = a.in[I_GMO] + h * 128;
#pragma unroll
        for (int d4 = 0; d4 < 4; ++d4) gmo_r[k][d4] = gmo[16 * (4 * hf + d4) + l15];
    }
    __syncthreads();
#pragma unroll
    for (int k = 0; k < 2; ++k) {
        LAS unsigned char* L = F.lds + k * CH; LAS float* fl = (LAS float*)(L + FLO);
        if (w == k) {
            const ChunkGates G = chunk_gates(gi_raw[k], gf_raw[k], big[k], bfg[k], lane);
            const float M = fmaxf(mstate[k], G.pmx);
            fl[lane] = -M; fl[64 + lane] = G.u; fl[128 + lane] = __expf(mstate[k] - M); fl[192 + lane] = __expf(-(G.bcs + M));
        }
        if (w == 2 + k) fl[640 + lane] = nin_l[k];
        *(LAS u32x4*)(L + QS + lr * RS + ls * 16) = qv[k]; *(LAS u32x4*)(L + KS + lr * RS + ls * 16) = kv[k];
        *(LAS u32x4*)(L + VS + lr * VR + ls * 16) = v0[k]; *(LAS u32x4*)(L + VS + lr * VR + 128 + ls * 16) = v1[k];
        *(LAS u32x4*)(L + CB + lr * RS + ls * 16) = c0[k]; *(LAS u32x4*)(L + CB + (64 + lr) * RS + ls * 16) = c1[k];
    }
    __syncthreads();
#pragma unroll
    for (int k = 0; k < 2; ++k) {
        LAS unsigned char* L = F.lds + k * CH; LAS float* fl = (LAS float*)(L + FLO);
        { const LAS float* nv = fl + 640 + ls * 8; const u32x4 q = qv[k];
          float s = bf_lo(q.x) * nv[0] + bf_hi(q.x) * nv[1] + bf_lo(q.y) * nv[2] + bf_hi(q.y) * nv[3] + bf_lo(q.z) * nv[4] + bf_hi(q.z) * nv[5] + bf_lo(q.w) * nv[6] + bf_hi(q.w) * nv[7];
          s = sum8_(s);
          if (ls == 0) fl[320 + lr] = s * 0.125f; }
        { bf16x8 aq[2];
#pragma unroll
          for (int ks = 0; ks < 2; ++ks) aq[ks] = *(const LAS bf16x8*)(L + QS + (16 * jt + l15) * RS + (32 * ks + 8 * g4) * 2);
          float rsum[4] = {0.f, 0.f, 0.f, 0.f};
#pragma unroll
          for (int st2 = 0; st2 < 2; ++st2) { const int st = 2 * hf + st2; f32x4 s = {0.f, 0.f, 0.f, 0.f};
              if (st <= jt) {
#pragma unroll
                  for (int ks = 0; ks < 2; ++ks) { const bf16x8 bk = *(const LAS bf16x8*)(L + KS + (16 * st + l15) * RS + (32 * ks + 8 * g4) * 2); s = MFMA16(aq[ks], bk, s); } }
              const int scol = 16 * st + l15; const float cf = fl[64 + scol];
#pragma unroll
              for (int r = 0; r < 4; ++r) { const int j = 16 * jt + 4 * g4 + r;
                  const float val = (scol <= j) ? s[r] * 0.125f * __expf(fl[j] + cf) : 0.f; rsum[r] += val;
                  *(LAS bf16_t*)(L + SB + j * RS + scol * 2) = f2bf(val); } }
#pragma unroll
          for (int r = 0; r < 4; ++r) { float t = sum16_(rsum[r]);
              if (l15 == 0) fl[384 + hf * 64 + 16 * jt + 4 * g4 + r] = t; } }
    }
    __syncthreads();
    float hv[2][4][4];
#pragma unroll
    for (int k = 0; k < 2; ++k) {
        LAS unsigned char* L = F.lds + k * CH; LAS float* fl = (LAS float*)(L + FLO);
        bf16x8 as_[2], aq[2];
#pragma unroll
        for (int ks = 0; ks < 2; ++ks) { as_[ks] = *(const LAS bf16x8*)(L + SB + (16 * jt + l15) * RS + (32 * ks + 8 * g4) * 2); aq[ks] = *(const LAS bf16x8*)(L + QS + (16 * jt + l15) * RS + (32 * ks + 8 * g4) * 2); }
        float si[4], dn[4], en[4], ss[4] = {0.f, 0.f, 0.f, 0.f};
#pragma unroll
        for (int r = 0; r < 4; ++r) { const int j = 16 * jt + 4 * g4 + r; si[r] = fl[128 + j]; dn[r] = fl[384 + j] + fl[448 + j] + si[r] * fl[320 + j]; en[r] = fl[192 + j]; si[r] *= 0.125f; }
#pragma unroll
        for (int d4 = 0; d4 < 4; ++d4) { const int dt = 4 * hf + d4; f32x4 nacc = {0.f, 0.f, 0.f, 0.f}, iacc = nacc;
#pragma unroll
            for (int ks = 0; ks < 2; ++ks) {
                LAS unsigned char* vp = L + VS + (32 * ks + 8 * g4 + (l15 >> 2)) * VR + (16 * dt + 4 * (l15 & 3)) * 2;
                nacc = MFMA16(as_[ks], cat8(tr16(vp), tr16(vp + 4 * VR)), nacc);
                const bf16x8 bc = *(const LAS bf16x8*)(L + CB + (16 * dt + l15) * RS + (32 * ks + 8 * g4) * 2);
                iacc = MFMA16(aq[ks], bc, iacc); }
#pragma unroll
            for (int r = 0; r < 4; ++r) { const float num = nacc[r] + si[r] * iacc[r]; const float hvv = num * __builtin_amdgcn_rcpf(fmaxf(fabsf(dn[r]), en[r])); hv[k][d4][r] = hvv; ss[r] += hvv * hvv; } }
#pragma unroll
        for (int r = 0; r < 4; ++r) { float t = sum16_(ss[r]);
            if (l15 == 0) fl[512 + hf * 64 + 16 * jt + 4 * g4 + r] = t; }
    }
    __syncthreads();
#pragma unroll
    for (int k = 0; k < 2; ++k) {
        LAS unsigned char* L = F.lds + k * CH; LAS float* fl = (LAS float*)(L + FLO);
        float rinv[4];
#pragma unroll
        for (int r = 0; r < 4; ++r) { const int j = 16 * jt + 4 * g4 + r; rinv[r] = rsqrtf((fl[512 + j] + fl[576 + j]) * (1.0f / 128.0f) + EPS); }
#pragma unroll
        for (int d4 = 0; d4 < 4; ++d4) { const int d = 16 * (4 * hf + d4) + l15; const float gg = gmo_r[k][d4];
#pragma unroll
            for (int r = 0; r < 4; ++r) *(LAS bf16_t*)(L + HO + (16 * jt + 4 * g4 + r) * VR + d * 2) = f2bf(hv[k][d4][r] * rinv[r] * gg); }
    }
    __syncthreads();
#pragma unroll
    for (int k = 0; k < 2; ++k) {
        LAS unsigned char* L = F.lds + k * CH;
        const u32x4 h0 = *(const LAS u32x4*)(L + HO + lr * VR + ls * 32), h1 = *(const LAS u32x4*)(L + HO + lr * VR + ls * 32 + 16);
        const u32x4 o0 = oc0[k], o1 = oc1[k];
#define HG(hw, ow, lo) ((lo ? bf_lo(hw) : bf_hi(hw)) * sigmoidf_(lo ? bf_lo(ow) : bf_hi(ow)) * H8_SCALE)
        u32x4 r;
        r.x = pk4_fp8(HG(h0.x, o0.x, 1), HG(h0.x, o0.x, 0), HG(h0.y, o0.y, 1), HG(h0.y, o0.y, 0));
        r.y = pk4_fp8(HG(h0.z, o0.z, 1), HG(h0.z, o0.z, 0), HG(h0.w, o0.w, 1), HG(h0.w, o0.w, 0));
        r.z = pk4_fp8(HG(h1.x, o1.x, 1), HG(h1.x, o1.x, 0), HG(h1.y, o1.y, 1), HG(h1.y, o1.y, 0));
        r.w = pk4_fp8(HG(h1.z, o1.z, 1), HG(h1.z, o1.z, 0), HG(h1.w, o1.w, 1), HG(h1.w, o1.w, 0));
#undef HG
        *(u32x4*)(hm + (tok0[k] + lr) * 1024 + hh[k] * 128 + ls * 16) = r;
    }
}

template <bool FIXED>
__device__ __forceinline__ void moba_unit(Frame& F, const Args& a, int b, int h, int qb, const float B2) {
    constexpr int KT = 0, VT = 34816, KM = 88064, TS = 17408, VR = 272;
    LAS unsigned char* L = F.lds;
    const bf16_t* z = (const bf16_t*)(F.ws + WS_Z);
    const float* kmean = (const float*)(F.ws + WS_KMEAN) + ((size_t)b * 8 + h) * 8 * 128;
    unsigned char* ob = F.ws + WS_OB;
    int tid = F.tid; asm volatile("" : "+v"(tid));
    const int lane = tid & 63, w = F.wave, l15 = lane & 15, g4 = lane >> 4;
    const int q0 = qb * 256, blk = qb, ntile = 4 * qb + 4;
    const size_t tokb = (size_t)b * SEQ;
    __syncthreads();
    if (tid < 256) *(LAS f32x4*)(L + KM + tid * 16) = *(const f32x4*)(kmean + tid * 4);
    bf16x8 qf[2][4];
#pragma unroll
    for (int g = 0; g < 2; ++g) { const bf16_t* qr = z + (tokb + q0 + 32 * w + 16 * g + l15) * ZP + ZQB + h * 128 + 8 * g4;
#pragma unroll
        for (int ks = 0; ks < 4; ++ks) qf[g][ks] = *(const bf16x8*)(qr + 32 * ks); }
    const int key0 = tid >> 4, seg = tid & 15;
    const bf16_t* kbase = z + (tokb + key0) * ZP + ZKB + h * 128 + seg * 8;
    const bf16_t* vbase = z + (tokb + key0) * ZP + ZVB + h * 128 + seg * 8;
    u32x4 kA0 = *(const u32x4*)kbase, kA1 = *(const u32x4*)(kbase + (size_t)32 * ZP), vA0 = *(const u32x4*)vbase, vA1 = *(const u32x4*)(vbase + (size_t)32 * ZP);
    u32x4 kB0 = *(const u32x4*)(kbase + (size_t)64 * ZP), kB1 = *(const u32x4*)(kbase + (size_t)96 * ZP), vB0 = *(const u32x4*)(vbase + (size_t)64 * ZP), vB1 = *(const u32x4*)(vbase + (size_t)96 * ZP);
    __syncthreads();
    unsigned mymask[2];
#pragma unroll
    for (int g = 0; g < 2; ++g) {
        if (blk <= 3) mymask[g] = (1u << blk) - 1u;
        else {
            float gate[7];
#pragma unroll
            for (int n = 0; n < 7; ++n) { float s = 0.f;
                if (n < blk) {
#pragma unroll
                    for (int ks = 0; ks < 4; ++ks) { const LAS float* km = (const LAS float*)(L + KM) + n * 128 + 32 * ks + 8 * g4;
#pragma unroll
                        for (int j = 0; j < 8; ++j) s += bf1((bf16_t)qf[g][ks][j]) * km[j]; }
                    s += __shfl_xor(s, 16); s += __shfl_xor(s, 32); }
                gate[n] = (n < blk) ? s : -3.0e38f; }
            unsigned mm = 0u;
#pragma unroll
            for (int t = 0; t < 3; ++t) { float best = -3.0e38f; int bi = 0;
#pragma unroll
                for (int n = 0; n < 7; ++n) { const bool take = (n < blk) && !((mm >> n) & 1u) && (gate[n] > best); best = take ? gate[n] : best; bi = take ? n : bi; }
                mm |= 1u << bi; }
            mymask[g] = mm;
        }
    }
    f32x4 O[2][8];
#pragma unroll
    for (int g = 0; g < 2; ++g)
#pragma unroll
        for (int dt = 0; dt < 8; ++dt) O[g][dt] = (f32x4){0.f, 0.f, 0.f, 0.f};
    float mrun[2] = {-1.0e30f, -1.0e30f}, lsum[2] = {0.f, 0.f};
    const float SC = 0.08838834764831845f * 1.4426950408889634f;
#pragma unroll 1
    for (int kt2 = 0; kt2 < ntile; kt2 += 2) {
#pragma unroll
      for (int buf = 0; buf < 2; ++buf) {
        const int kt = kt2 + buf;
        { LAS unsigned char* kd = L + KT + buf * TS + key0 * VR + seg * 16; LAS unsigned char* vd = L + VT + buf * TS + key0 * VR + seg * 16;
          const int t2 = (kt + 2 < ntile) ? kt + 2 : ntile - 1;
          const size_t adv = (size_t)t2 * 64 * ZP;
          if (buf == 0) { *(LAS u32x4*)kd = kA0; *(LAS u32x4*)(kd + 32 * VR) = kA1; *(LAS u32x4*)vd = vA0; *(LAS u32x4*)(vd + 32 * VR) = vA1;
              kA0 = *(const u32x4*)(kbase + adv); kA1 = *(const u32x4*)(kbase + adv + (size_t)32 * ZP); vA0 = *(const u32x4*)(vbase + adv); vA1 = *(const u32x4*)(vbase + adv + (size_t)32 * ZP); }
          else { *(LAS u32x4*)kd = kB0; *(LAS u32x4*)(kd + 32 * VR) = kB1; *(LAS u32x4*)vd = vB0; *(LAS u32x4*)(vd + 32 * VR) = vB1;
              kB0 = *(const u32x4*)(kbase + adv); kB1 = *(const u32x4*)(kbase + adv + (size_t)32 * ZP); vB0 = *(const u32x4*)(vbase + adv); vB1 = *(const u32x4*)(vbase + adv + (size_t)32 * ZP); } }
        __syncthreads();
        const int kb = kt >> 2; const bool past = kb < blk;
        const int kmin = 64 * kt;
        int cls[2];
#pragma unroll
        for (int g = 0; g < 2; ++g) { const int qmin = q0 + 32 * w + 16 * g; cls[g] = past ? 1 : ((kmin + 63 <= qmin) ? 1 : ((kmin > qmin + 15) ? 0 : 2)); }
        if ((cls[0] | cls[1]) != 0) {
            f32x4 st[2][4];
#pragma unroll
            for (int nt = 0; nt < 4; ++nt) { st[0][nt] = (f32x4){0.f, 0.f, 0.f, 0.f}; st[1][nt] = st[0][nt];
                bf16x8 bk[4];
#pragma unroll
                for (int ks = 0; ks < 4; ++ks) bk[ks] = *(const LAS bf16x8*)(L + KT + buf * TS + (16 * nt + l15) * VR + (32 * ks + 8 * g4) * 2);
                __builtin_amdgcn_sched_barrier(0);
#pragma unroll
                for (int ks = 0; ks < 4; ++ks) { st[0][nt] = MFMA16(bk[ks], qf[0][ks], st[0][nt]); st[1][nt] = MFMA16(bk[ks], qf[1][ks], st[1][nt]); }
                __builtin_amdgcn_sched_barrier(0); }
            bf16x8 pf[2][2];
#pragma unroll
            for (int g = 0; g < 2; ++g) {
                float pv[4][4]; float mnew = 0.f, alpha = 1.0f;
                if (FIXED) {
                    if (cls[g] == 1) {
                        const bool sel = past ? (((mymask[g] >> kb) & 1u) != 0u) : true;
                        const float nb = sel ? -B2 : -1.0e30f;
#pragma unroll
                        for (int nt = 0; nt < 4; ++nt)
#pragma unroll
                            for (int r = 0; r < 4; ++r) pv[nt][r] = __builtin_amdgcn_exp2f(fmaf(st[g][nt][r], SC, nb));
                    } else if (cls[g] == 2) {
                        const int qpos = q0 + 32 * w + 16 * g + l15;
#pragma unroll
                        for (int nt = 0; nt < 4; ++nt)
#pragma unroll
                            for (int r = 0; r < 4; ++r) { const bool ok = (kmin + 16 * nt + 4 * g4 + r) <= qpos; pv[nt][r] = __builtin_amdgcn_exp2f(ok ? fmaf(st[g][nt][r], SC, -B2) : -1.0e30f); }
                    } else {
#pragma unroll
                        for (int nt = 0; nt < 4; ++nt)
#pragma unroll
                            for (int r = 0; r < 4; ++r) pv[nt][r] = 0.f;
                    }
                } else if (cls[g] == 1) {
                    const bool sel = past ? (((mymask[g] >> kb) & 1u) != 0u) : true;
                    float mx = fmaxf(fmaxf(fmaxf(st[g][0][0], st[g][0][1]), fmaxf(st[g][0][2], st[g][0][3])), fmaxf(fmaxf(st[g][1][0], st[g][1][1]), fmaxf(st[g][1][2], st[g][1][3])));
                    mx = fmaxf(mx, fmaxf(fmaxf(fmaxf(st[g][2][0], st[g][2][1]), fmaxf(st[g][2][2], st[g][2][3])), fmaxf(fmaxf(st[g][3][0], st[g][3][1]), fmaxf(st[g][3][2], st[g][3][3]))));
                    mx = sel ? mx * SC : -1.0e30f;
                    mx = fmaxf(mx, __shfl_xor(mx, 16)); mx = fmaxf(mx, __shfl_xor(mx, 32));
                    mnew = fmaxf(mrun[g], mx); alpha = __builtin_amdgcn_exp2f(mrun[g] - mnew);
                    const float nb = sel ? -mnew : -1.0e30f;
#pragma unroll
                    for (int nt = 0; nt < 4; ++nt)
#pragma unroll
                        for (int r = 0; r < 4; ++r) pv[nt][r] = __builtin_amdgcn_exp2f(fmaf(st[g][nt][r], SC, nb));
                } else if (cls[g] == 2) {
                    const int qpos = q0 + 32 * w + 16 * g + l15; float sv[4][4]; float mx = -1.0e30f;
#pragma unroll
                    for (int nt = 0; nt < 4; ++nt)
#pragma unroll
                        for (int r = 0; r < 4; ++r) { const bool ok = (kmin + 16 * nt + 4 * g4 + r) <= qpos; sv[nt][r] = ok ? st[g][nt][r] * SC : -1.0e30f; mx = fmaxf(mx, sv[nt][r]); }
                    mx = fmaxf(mx, __shfl_xor(mx, 16)); mx = fmaxf(mx, __shfl_xor(mx, 32));
                    mnew = fmaxf(mrun[g], mx); alpha = __builtin_amdgcn_exp2f(mrun[g] - mnew);
#pragma unroll
                    for (int nt = 0; nt < 4; ++nt)
#pragma unroll
                        for (int r = 0; r < 4; ++r) pv[nt][r] = (sv[nt][r] > -1.0e29f) ? __builtin_amdgcn_exp2f(sv[nt][r] - mnew) : 0.f;
                } else {
                    mnew = mrun[g]; alpha = 1.0f;
#pragma unroll
                    for (int nt = 0; nt < 4; ++nt)
#pragma unroll
                        for (int r = 0; r < 4; ++r) pv[nt][r] = 0.f;
                }
                float ps = 0.f;
#pragma unroll
                for (int nt = 0; nt < 4; ++nt) ps += (pv[nt][0] + pv[nt][1]) + (pv[nt][2] + pv[nt][3]);
                if (FIXED) lsum[g] += ps;
                else { mrun[g] = mnew; lsum[g] = lsum[g] * alpha + ps;
#pragma unroll
                    for (int dt = 0; dt < 8; ++dt) O[g][dt] *= alpha; }
#pragma unroll
                for (int k2 = 0; k2 < 2; ++k2) {
                    u32x4 pw4; pw4.x = pk2(pv[2 * k2][0], pv[2 * k2][1]); pw4.y = pk2(pv[2 * k2][2], pv[2 * k2][3]); pw4.z = pk2(pv[2 * k2 + 1][0], pv[2 * k2 + 1][1]); pw4.w = pk2(pv[2 * k2 + 1][2], pv[2 * k2 + 1][3]);
                    pf[g][k2] = __builtin_bit_cast(bf16x8, pw4); }
            }
            bf16x8 vf[2][4];
#define MOBA_VREAD(bq, slot) do { _Pragma("unroll") for (int d = 0; d < 4; ++d) { const int k2_ = (bq) >> 1, dt_ = 4 * ((bq) & 1) + d; \
                LAS unsigned char* vp = L + VT + buf * TS + (32 * k2_ + 4 * g4 + (l15 >> 2)) * VR + (16 * dt_ + 4 * (l15 & 3)) * 2; vf[slot][d] = cat8(tr16(vp), tr16(vp + 16 * VR)); } } while (0)
            MOBA_VREAD(0, 0);
#pragma unroll
            for (int bq = 0; bq < 4; ++bq) {
                if (bq + 1 < 4) MOBA_VREAD(bq + 1, (bq + 1) & 1);
                __builtin_amdgcn_sched_barrier(0);
#pragma unroll
                for (int d = 0; d < 4; ++d) { const int k2 = bq >> 1, dt = 4 * (bq & 1) + d;
                    O[0][dt] = MFMA16(vf[bq & 1][d], pf[0][k2], O[0][dt]); O[1][dt] = MFMA16(vf[bq & 1][d], pf[1][k2], O[1][dt]); }
                __builtin_amdgcn_sched_barrier(0);
            }
#undef MOBA_VREAD
        }
      }
    }
#pragma unroll
    for (int g = 0; g < 2; ++g) { float t = lsum[g]; t += __shfl_xor(t, 16); t += __shfl_xor(t, 32);
      const float inv = O8_SCALE / t; unsigned char* op = ob + (tokb + q0 + 32 * w + 16 * g + l15) * 1024 + h * 128 + 4 * g4;
#pragma unroll
      for (int dt = 0; dt < 8; ++dt) *(unsigned*)(op + 16 * dt) = pk4_fp8(O[g][dt][0] * inv, O[g][dt][1] * inv, O[g][dt][2] * inv, O[g][dt][3] * inv); }
}

__device__ __forceinline__ void p4_mixers(Frame& F, const Args& a, bool with_cvt) {
    LAS int* qslot = (LAS int*)(F.lds + 140032);
    const int total = with_cvt ? 768 + 256 + 256 : 768;
    const float B2 = __builtin_bit_cast(float, __builtin_amdgcn_readfirstlane((int)__hip_atomic_load(F.ctl + CW_MISC, __ATOMIC_RELAXED, __HIP_MEMORY_SCOPE_AGENT)));
    const bool fixed_ok = B2 <= 40.0f;
    for (;;) {
        __syncthreads();
        if (F.tid == 0) *qslot = (int)__hip_atomic_fetch_add(F.ctl + CW_QUEUE, 1u, __ATOMIC_RELAXED, __HIP_MEMORY_SCOPE_AGENT);
        __syncthreads();
        const int idx = *qslot;
        __syncthreads();
        if (idx >= total) break;
        int it = idx;
        if (with_cvt) { const int g = idx / 5, r = idx - 5 * g; if (r == 3) { cvt8_item(F, a, 512 + g); continue; } if (r == 4) { if (g < 128) cvt8_wout_sub(F, a, g); else cvt8_wbr_sub(F, a, g - 128); continue; } it = 3 * g + r; }
        if (it < 256) { if (fixed_ok) moba_unit<true>(F, a, (it & 31) >> 3, it & 7, 7 - (it >> 5), B2); else moba_unit<false>(F, a, (it & 31) >> 3, it & 7, 7 - (it >> 5), B2); }
        else mlstm_passC2(F, a, it - 256, it - 256 + 512);
    }
}

__device__ __forceinline__ void p7_router(Frame& F, const Args& a) {
    unsigned char* ws = F.ws;
    const float* modf = (const float*)(ws + WS_MODF);
    const bf16_t* wrf = (const bf16_t*)(ws + WS_WRF);
    int* toke = (int*)(ws + WS_TOKE); float* tokw = (float*)(ws + WS_TOKW); int* toks = (int*)(ws + WS_TOKS); float* roww = (float*)(ws + WS_ROWW);
    unsigned char* tA = ws + WS_TA;
    LAS float* part = (LAS float*)(F.lds + PART_OFF);
    LAS float* logit = (LAS float*)(F.lds + LOGIT_OFF);
    LAS int* dstl = (LAS int*)(F.lds + DST_OFF);
    LAS int* lcnt = (LAS int*)(F.lds + DST_OFF + 512);
    const int lane = F.lane, l15 = lane & 15, g4 = lane >> 4;
    for (int rb = F.wg; rb < T / 32; rb += F.G) {
        norm_rows_32_b(F, (const bf16_t*)(ws + WS_X1), a.in[I_GFFN], modf, 3, rb);
        { const int rg = F.wave & 1, ct = (F.wave >> 1) & 1, kh = F.wave >> 2; f32x4 acc = {0.f, 0.f, 0.f, 0.f};
          bf16x8 bvv[32];
          __builtin_amdgcn_sched_barrier(0);
          const bf16_t* wq = wrf + ((size_t)ct * 4096 + (size_t)(32 * kh) * 64 + lane) * 8; asm volatile("" : "+v"(wq));
#pragma unroll
          for (int s = 0; s < 32; ++s) bvv[s] = *(const bf16x8*)(wq + (size_t)s * 512);
          __syncthreads();
#pragma unroll
          for (int s = 0; s < 32; ++s) { const int ks = 32 * kh + s;
              const bf16x8 av = *(const LAS bf16x8*)(F.lds + (16 * rg + l15) * HL_STRIDE + (32 * ks + 8 * g4) * 2);
              acc = __builtin_amdgcn_mfma_f32_16x16x32_bf16(av, bvv[s], acc, 0, 0, 0); }
#pragma unroll
          for (int r = 0; r < 4; ++r) part[((kh * 2 + rg) * 2 + ct) * 256 + (4 * g4 + r) * 16 + l15] = acc[r]; }
        __syncthreads();
#pragma unroll
        for (int q = 0; q < 2; ++q) { const int o = F.tid + 512 * q, row = o >> 5, e = o & 31, rg = row >> 4, ct = e >> 4;
            logit[o] = part[((0 * 2 + rg) * 2 + ct) * 256 + (row & 15) * 16 + (e & 15)] + part[((1 * 2 + rg) * 2 + ct) * 256 + (row & 15) * 16 + (e & 15)] + a.in[I_BR][e]; }
        __syncthreads();
        if (F.tid < 32) {
            const int row = F.tid; const size_t tok = (size_t)rb * 32 + row;
            lcnt[row] = 0;
            float v[NE];
#pragma unroll
            for (int e = 0; e < NE; ++e) v[e] = logit[row * NE + e];
            float tv[4]; int ti[4]; unsigned used = 0u;
#pragma unroll
            for (int k = 0; k < 4; ++k) { float best = -3.0e38f; int bi = 0;
#pragma unroll
                for (int e = 0; e < NE; ++e) { const bool take = !((used >> e) & 1u) && (v[e] > best); best = take ? v[e] : best; bi = take ? e : bi; }
                used |= 1u << bi; tv[k] = best; ti[k] = bi; }
            float ex[4], sum = 0.f;
#pragma unroll
            for (int k = 0; k < 4; ++k) { ex[k] = __expf(tv[k] - tv[0]); sum += ex[k]; }
            const float inv = 1.0f / sum;
            int lr[4];
#pragma unroll
            for (int k = 0; k < 4; ++k) lr[k] = __hip_atomic_fetch_add(lcnt + ti[k], 1, __ATOMIC_RELAXED, __HIP_MEMORY_SCOPE_WORKGROUP);
            __builtin_amdgcn_wave_barrier();
            { const int mine = lcnt[row];
              int base = 0; if (mine > 0) base = (int)__hip_atomic_fetch_add(F.ctl + CW_CNT + 64 * row, (unsigned)mine, __ATOMIC_RELAXED, __HIP_MEMORY_SCOPE_AGENT);
              lcnt[32 + row] = base; }
            __builtin_amdgcn_wave_barrier();
#pragma unroll
            for (int k = 0; k < 4; ++k) {
                const int slot = lcnt[32 + ti[k]] + lr[k];
                const float wk = ex[k] * inv;
                toke[tok * 4 + k] = ti[k]; tokw[tok * 4 + k] = wk; toks[tok * 4 + k] = slot;
                roww[(size_t)ti[k] * ECAP + slot] = wk;
                dstl[row * 4 + k] = ti[k] * ECAP + slot;
            }
        }
        __syncthreads();
#pragma unroll 1
        for (int i = 0; i < 4; ++i) { const int r = 4 * F.wave + i;
            u32x4 q8[2];
#pragma unroll
            for (int cidx = 0; cidx < 2; ++cidx) { const int ch = lane + 64 * cidx;
                const u32x4 lo = *(const LAS u32x4*)(F.lds + r * HL_STRIDE + ch * 32), hi = *(const LAS u32x4*)(F.lds + r * HL_STRIDE + ch * 32 + 16);
                q8[cidx].x = pk4_fp8(bf_lo(lo.x), bf_hi(lo.x), bf_lo(lo.y), bf_hi(lo.y)); q8[cidx].y = pk4_fp8(bf_lo(lo.z), bf_hi(lo.z), bf_lo(lo.w), bf_hi(lo.w));
                q8[cidx].z = pk4_fp8(bf_lo(hi.x), bf_hi(hi.x), bf_lo(hi.y), bf_hi(hi.y)); q8[cidx].w = pk4_fp8(bf_lo(hi.z), bf_hi(hi.z), bf_lo(hi.w), bf_hi(hi.w)); }
#pragma unroll
            for (int k = 0; k < 4; ++k) { unsigned char* dp = tA + (size_t)dstl[r * 4 + k] * D;
#pragma unroll
                for (int cidx = 0; cidx < 2; ++cidx) *(u32x4*)(dp + (lane + 64 * cidx) * 16) = q8[cidx]; } }
        __syncthreads();
    }
}

__device__ __forceinline__ void moe_tables(Frame& F) {
    LAS int* tb = (LAS int*)(F.lds + LDS_TABS);
    __syncthreads();
    if (F.wave == 0) {
        const int e = F.lane & 31;
        const int cnt = (int)__hip_atomic_load(F.ctl + CW_CNT + 64 * e, __ATOMIC_RELAXED, __HIP_MEMORY_SCOPE_AGENT);
        const int tl = (cnt + 255) >> 8;
        int inc = tl;
#pragma unroll
        for (int o = 1; o < 32; o <<= 1) { const int t = __shfl_up(inc, o); if (e >= o) inc += t; }
        const int exc = inc - tl;
        if (F.lane < 32) {
            tb[e] = tl; tb[32 + e] = exc * 256; tb[64 + e] = e * ECAP; tb[96 + e] = exc * 16; tb[160 + e] = exc * 8;
            if (e == NE - 1) { tb[96 + NE] = inc * 16; tb[160 + NE] = inc * 8; }
        }
    }
    __syncthreads();
}

__device__ __forceinline__ void p10_combine(Frame& F, const Args& a) {
    unsigned char* ws = F.ws;
    const bf16_t* x1 = (const bf16_t*)(ws + WS_X1); const unsigned char* ydn = ws + WS_YDN; const float* modf = (const float*)(ws + WS_MODF);
    const int* toke = (const int*)(ws + WS_TOKE); const int* toks = (const int*)(ws + WS_TOKS);
    const LAS int* tb = (const LAS int*)(F.lds + LDS_TABS);
    int tz = threadIdx.x; asm volatile("" : "+v"(tz));
    const int gw = F.vcu * 8 + F.wave, NGW = F.G * 8, lane = tz & 63;
    for (int tok = gw; tok < T; tok += NGW) {
        const float* gt = modf + (size_t)(tok >> 11) * (6 * D) + 5 * D;
        const unsigned char* yr[4];
#pragma unroll
        for (int k = 0; k < 4; ++k) yr[k] = ydn + (size_t)(tb[32 + toke[tok * 4 + k]] + toks[tok * 4 + k]) * D;
        u32x2 y[4][4]; u32x4 xq[4]; f32x4 g0[4], g1[4];
#pragma unroll
        for (int j = 0; j < 4; ++j) { const int col = 8 * (lane + 64 * j);
#pragma unroll
            for (int k = 0; k < 4; ++k) y[j][k] = __builtin_nontemporal_load((const u32x2*)(yr[k] + col));
            xq[j] = __builtin_nontemporal_load((const u32x4*)(x1 + (size_t)tok * D + col));
            g0[j] = *(const f32x4*)(gt + col); g1[j] = *(const f32x4*)(gt + col + 4); }
        __builtin_amdgcn_sched_barrier(0);
#pragma unroll
        for (int j = 0; j < 4; ++j) { const int col = 8 * (lane + 64 * j);
            f32x4 s0 = {0.f, 0.f, 0.f, 0.f}, s1 = s0;
#pragma unroll
            for (int k = 0; k < 4; ++k) {
                const f32x2 p0 = __builtin_amdgcn_cvt_pk_f32_fp8((int)y[j][k].x, false), p1 = __builtin_amdgcn_cvt_pk_f32_fp8((int)y[j][k].x, true);
                const f32x2 p2 = __builtin_amdgcn_cvt_pk_f32_fp8((int)y[j][k].y, false), p3 = __builtin_amdgcn_cvt_pk_f32_fp8((int)y[j][k].y, true);
                s0[0] += p0[0]; s0[1] += p0[1]; s0[2] += p1[0]; s0[3] += p1[1]; s1[0] += p2[0]; s1[1] += p2[1]; s1[2] += p3[0]; s1[3] += p3[1]; }
            const size_t o = (size_t)tok * D + col;
            const f32x4 xa = {bf_lo(xq[j].x), bf_hi(xq[j].x), bf_lo(xq[j].y), bf_hi(xq[j].y)}, xb = {bf_lo(xq[j].z), bf_hi(xq[j].z), bf_lo(xq[j].w), bf_hi(xq[j].w)};
            __builtin_nontemporal_store(xa + g0[j] * (s0 * (1.0f / YD_SCALE)), (f32x4*)(a.out + o));
            __builtin_nontemporal_store(xb + g1[j] * (s1 * (1.0f / YD_SCALE)), (f32x4*)(a.out + o + 4)); }
    }
}

__global__ void __launch_bounds__(512, 2) hybrid_fwd(Args args) {
    extern __shared__ __attribute__((aligned(16))) unsigned char lds_raw[];
    Frame F;
    F.lds = (LAS unsigned char*)lds_raw; F.ws = args.ws; F.ctl = (unsigned*)(args.ws + WS_CTL);
    F.tid = threadIdx.x; F.lane = F.tid & 63; F.wave = __builtin_amdgcn_readfirstlane(F.tid >> 6);
    F.G = gridDim.x; F.wg = blockIdx.x; F.vcu = (F.G % 8 == 0) ? (F.wg % 8) * (F.G / 8) + F.wg / 8 : F.wg;
    if (F.tid < 4) ((LAS unsigned*)(F.lds + LDS_XB))[F.tid] = 0u;
    __syncthreads();
    XcdBarrier bar; bar.bar = F.ctl + CW_BAR; bar.x = 0; bar.st = nullptr;
#if !MK_PER_PHASE
    bar = xcd_barrier_post(F.ctl + CW_BAR, (volatile LAS unsigned*)(F.lds + LDS_XB));
#endif
    const int lo = args.ph_lo, hi = args.ph_hi;
#define IN(k) (lo <= (k) && (k) < hi)
#define SEAM(k) do { if (IN(k) && IN((k) + 1)) xcd_barrier(bar); } while (0)
    unsigned char* ws = args.ws;

    if (IN(0)) { p0_prologue(F, args); } SEAM(0);
    if (IN(1)) { p1_rows(F, args); } SEAM(1);
    const bool cv_ok = (F.G == 256);
    if (IN(2)) {
        pg8::DenseOrder S0; S0.init(ws + WS_HBUF8, ws + WS_WIN8, T, ZP, F.G, F.wg);
        EpiZT<true> E{(bf16_t*)(ws + WS_Z), ZP, args.in[I_GQ], args.in[I_GK], (float*)(ws + WS_KMEAN), F.lds + 131072};
        unsigned gaps = 0u;
        if (cv_ok) { int c = F.wg % 15, g0 = 0; while (c >= 5 - g0) { c -= 5 - g0; ++g0; } gaps = (1u << g0) | (1u << (g0 + 1 + c)); }
        int cvn = F.wg * 2;
        if (!cv_ok) { for (int idx = F.wg; idx < 1536; idx += F.G) cvt8_item(F, args, idx); }
        int lo = 0;
#pragma unroll 1
        for (int seg = 0; seg < 3; ++seg) {
            if ((gaps >> lo) & 1u) { cvt8_item(F, args, cvn++); gaps &= ~(1u << lo); }
            int hi = lo + 1; while (hi < 5 && !((gaps >> hi) & 1u)) ++hi;
            if (lo < 5) { pg8::SubOrder<pg8::DenseOrder> S{S0, lo, hi - lo}; pg8::gemm_phase<EpiZT<true>, pg8::SubOrder<pg8::DenseOrder>, true>(F.lds, D / 2, S, E); }
            lo = hi;
        }
        if (gaps & 32u) cvt8_item(F, args, cvn++);
    } SEAM(2);
    if (IN(3) && F.G == 256) { mlstm_passA4(F, args); }
    else if (IN(3)) {
        PassAIn cur = mlstm_passA_load(F, F.wg < 1024 ? F.wg : 0);
        for (int u = F.wg; u < 1024; u += F.G) { const int un = u + F.G; const PassAIn nxt = mlstm_passA_load(F, un < 1024 ? un : u); mlstm_passA(F, args, u, cur); cur = nxt; }
    } SEAM(3);
    if (IN(11)) { for (int it = F.wg; it < 256; it += F.G) mlstm_passB(F, it); }
    if (IN(3) && IN(4)) xcd_barrier(bar);
    if (IN(4)) { p4_mixers(F, args, F.G == 256); } SEAM(4);
    if (IN(5)) {
        if (cv_ok && (F.wg & 1) == 0) cvt8_item(F, args, 768 + F.wg);
        { pg8::PairOrder S; S.d.init(ws + WS_HM, ws + WS_WA, T, D, F.G, F.wg); S.A2 = (const char*)(ws + WS_OB); S.Bt2 = (const char*)(ws + WS_WB);
          EpiBranchAB E{(const bf16_t*)(ws + WS_Z), ws + WS_YBUF8};
          pg8::gemm_phase<EpiBranchAB, pg8::PairOrder, true>(F.lds, 512, S, E); }
        if (cv_ok && (F.wg & 1) == 1) cvt8_item(F, args, 768 + F.wg);
    } SEAM(5);
    if (IN(6)) {
        if (cv_ok && (F.wg & 1) == 0) cvt8_item(F, args, 1024 + F.wg);
        pg8::DenseOrder S; S.init(ws + WS_YBUF8, ws + WS_WOUT8, T, D, F.G, F.wg);
        EpiOut E{args.in[I_X], (const float*)(ws + WS_MODF), (bf16_t*)(ws + WS_X1)};
        pg8::gemm_phase<EpiOut, pg8::DenseOrder, true>(F.lds, D / 2, S, E);
        if (cv_ok && (F.wg & 1) == 1) cvt8_item(F, args, 1024 + F.wg);
    } SEAM(6);
    if (IN(7)) { p7_router(F, args); } SEAM(7);
    if (IN(8)) {
        moe_tables(F);
        const LAS int* tb = (const LAS int*)(F.lds + LDS_TABS);
        pg8::MoeOrder S{(const char*)(ws + WS_TA), (const char*)(ws + WS_WUP), tb, tb + 64, tb + 96, 16, F.G, F.vcu, (size_t)(2 * D) * D, __builtin_amdgcn_readfirstlane(tb[96 + NE]), nullptr, 0u};
        EpiUpT<true> E{ws + WS_ACT, args.in[I_BUP], tb + 32, F.ctl + CW_UPD};
        const int cut = cv_ok ? (F.wg % 10) : 0;
        if (cut > 0) { pg8::SubOrder<pg8::MoeOrder> S1{S, 0, cut}; pg8::gemm_phase<EpiUpT<true>, pg8::SubOrder<pg8::MoeOrder>, true>(F.lds, D / 2, S1, E); }
        if (cv_ok) cvt8_item_signal(F, args, 1280 + F.wg, F.ctl + CW_UPD);
        { pg8::SubOrder<pg8::MoeOrder> S2{S, cut, 1 << 20}; pg8::gemm_phase<EpiUpT<true>, pg8::SubOrder<pg8::MoeOrder>, true>(F.lds, D / 2, S2, E); }
    }
    if (IN(9)) {
        if (!IN(8)) moe_tables(F);
        const LAS int* tb = (const LAS int*)(F.lds + LDS_TABS);
        const int utot = __builtin_amdgcn_readfirstlane(tb[96 + NE]);
        pg8::MoeDepOrder S{(const char*)(ws + WS_ACT), (const char*)(ws + WS_WDN), tb, tb + 32, tb + 160, 8, F.G, (F.vcu - utot % F.G + F.G) % F.G, (size_t)D * D, __builtin_amdgcn_readfirstlane(tb[160 + NE]), F.ctl + CW_UPD, cv_ok ? 16u : 0u};
        EpiDown E{ws + WS_YDN, args.in[I_BDN], (const float*)(ws + WS_ROWW), tb + 32};
        pg8::gemm_phase<EpiDown, pg8::MoeDepOrder, true>(F.lds, D / 2, S, E);
    } SEAM(9);
    if (IN(10)) { if (!IN(8) && !IN(9)) moe_tables(F); p10_combine(F, args); }
#undef IN
#undef SEAM
}

constexpr int N_PHASES = 12;
extern "C" void kernel_launch(void* const* d_in, const int* in_sizes, int n_in, void* d_out, int out_size, void* d_ws, size_t ws_size, hipStream_t stream) {
    static int grid = 0;
    if (grid == 0) {
        if (n_in != 21 || out_size != T * D || ws_size < WS_END) { fprintf(stderr, "kernel_launch: unexpected problem (n_in %d out %d ws %zu)\n", n_in, out_size, ws_size); grid = -1; return; }
        int dev = 0, cus = 0, per_cu = 0;
        if (hipGetDevice(&dev) != hipSuccess || hipDeviceGetAttribute(&cus, hipDeviceAttributeMultiprocessorCount, dev) != hipSuccess) { grid = -1; return; }
        if (hipFuncSetAttribute((const void*)hybrid_fwd, hipFuncAttributeMaxDynamicSharedMemorySize, LDS_BYTES) != hipSuccess) { fprintf(stderr, "kernel_launch: hipFuncSetAttribute failed\n"); grid = -1; return; }
        if (hipOccupancyMaxActiveBlocksPerMultiprocessor(&per_cu, (const void*)hybrid_fwd, 512, LDS_BYTES) != hipSuccess || per_cu < 1) fprintf(stderr, "kernel_launch: occupancy query says %d\n", per_cu);
        (void)hipGetLastError();
        grid = cus;
    }
    if (grid < 0) return;
    if (hipMemsetAsync((char*)d_ws + WS_CTL, 0, CTL_BYTES, stream) != hipSuccess) return;
    Args a{};
    for (int i = 0; i < 21; ++i) a.in[i] = (const float*)d_in[i];
    a.out = (float*)d_out; a.ws = (unsigned char*)d_ws;
#if MK_PER_PHASE
    for (int p = 0; p < N_PHASES; ++p) { a.ph_lo = p; a.ph_hi = p + 1; hipLaunchKernelGGL(hybrid_fwd, dim3(grid), dim3(512), LDS_BYTES, stream, a); }
#else
    a.ph_lo = 0; a.ph_hi = N_PHASES;
    hipLaunchKernelGGL(hybrid_fwd, dim3(grid), dim3(512), LDS_BYTES, stream, a);
#endif
}
```

```cpp
#include <hip/hip_runtime.h>
#include <cstdio>
#include <cstdint>

#ifndef MK_PER_PHASE
#define MK_PER_PHASE 0
#endif

#define LAS __attribute__((address_space(3)))
#define GAS __attribute__((address_space(1)))
typedef unsigned short bf16_t;
typedef short bf16x8 __attribute__((ext_vector_type(8)));
typedef short s16x4 __attribute__((ext_vector_type(4)));
typedef float f32x4 __attribute__((ext_vector_type(4)));
typedef float f32x2 __attribute__((ext_vector_type(2)));
typedef unsigned u32x4 __attribute__((ext_vector_type(4)));
typedef unsigned u32x2 __attribute__((ext_vector_type(2)));
typedef int i32x8 __attribute__((ext_vector_type(8)));
typedef int i32x4 __attribute__((ext_vector_type(4)));

constexpr int D = 2048, NB = 4, SEQ = 2048, T = NB * SEQ;
constexpr int DIN = 10256, ZP = 10240;
constexpr int ZQA = 0, ZKA = 512, ZVA = 1024, ZOA = 2048, ZQB = 3072, ZKB = 4096, ZVB = 5120, ZGA = 6144, ZGB = 8192;
constexpr int GATE_COL = 3072;
constexpr int NE = 32, TOPK = 4, ECAP = 8192, CROWS = 40960;
constexpr float EPS = 1e-6f;

constexpr size_t MiB = 1ull << 20;
constexpr size_t WS_CTL = 0, CTL_BYTES = 1 * MiB;
constexpr size_t WS_MODP = 1 * MiB;
constexpr size_t WS_GATES = 2 * MiB;
constexpr size_t WS_KMEAN = 3 * MiB;
constexpr size_t WS_WGF = 3 * MiB + 512 * 1024;
constexpr size_t WS_WRF = 3 * MiB + 640 * 1024;
constexpr size_t WS_MODF = 4 * MiB;
constexpr size_t WS_TOKE = 5 * MiB;
constexpr size_t WS_TOKW = 5 * MiB + 256 * 1024;
constexpr size_t WS_TOKS = 5 * MiB + 512 * 1024;
constexpr size_t WS_ROWW = 6 * MiB;
constexpr size_t WS_WIN = 8 * MiB;
constexpr size_t WS_WOUT8 = 8 * MiB;
constexpr size_t WS_WA = 48 * MiB, WS_WB = 52 * MiB, WS_WOUT = 56 * MiB;
constexpr size_t WS_HBUF = 64 * MiB;
constexpr size_t WS_YBUF8 = 64 * MiB;
constexpr float Y8_SCALE = 8.0f;
constexpr float YD_SCALE = 16.0f;
constexpr float H8_SCALE = 8.0f, O8_SCALE = 32.0f;
constexpr size_t WS_Z = 96 * MiB;
constexpr size_t WS_HM = 256 * MiB, WS_OB = 272 * MiB;
constexpr size_t WS_TMPF = 288 * MiB;
constexpr size_t WS_YBUF = 352 * MiB;
constexpr size_t WS_X1 = 384 * MiB;
constexpr size_t WS_ACT = 448 * MiB;
constexpr size_t WS_YDN = 608 * MiB;
constexpr size_t WS_CLOC = 928 * MiB;
constexpr size_t WS_CIN = 960 * MiB;
constexpr size_t WS_NLOC = 976 * MiB, WS_NIN = 977 * MiB, WS_MSC = 978 * MiB;
constexpr size_t WS_HBUF8 = 980 * MiB;
constexpr size_t WS_WIN8 = 996 * MiB;
constexpr size_t WS_WUP = 1024 * MiB;
constexpr size_t WS_WDN = 1536 * MiB;
constexpr size_t WS_TA = 2048 * MiB;
constexpr size_t WS_END = 3072 * MiB;
constexpr int CW_BAR = 4096;
constexpr int CW_CNT = 16384;
constexpr int CW_QUEUE = 32768;
constexpr int CW_MISC = 49152;
constexpr int CW_UPD = 65536;
constexpr int CW_MQ = 32768 + 64;
constexpr int CW_CUD = 36864, CW_CDD = 40960, CW_GUD = 45056;

constexpr int LDS_BYTES = 157696;
constexpr int LDS_XB = 157568;
constexpr int LDS_TABS = 147456;

__device__ __forceinline__ float bf_lo(unsigned u) { return __uint_as_float(u << 16); }
__device__ __forceinline__ float bf_hi(unsigned u) { return __uint_as_float(u & 0xffff0000u); }
__device__ __forceinline__ float bf1(bf16_t v) { return __uint_as_float(((unsigned)v) << 16); }
__device__ __forceinline__ unsigned pk2(float lo, float hi) { unsigned r; asm("v_cvt_pk_bf16_f32 %0, %1, %2" : "=v"(r) : "v"(lo), "v"(hi)); return r; }
__device__ __forceinline__ bf16_t f2bf(float f) { return (bf16_t)(pk2(f, 0.f) & 0xffffu); }
__device__ __forceinline__ float wave_sum(float v) {
#pragma unroll
    for (int o = 1; o < 64; o <<= 1) v += __shfl_xor(v, o);
    return v;
}
__device__ __forceinline__ void store16_sc1(void* p, u32x4 v) { asm volatile("global_store_dwordx4 %0, %1, off sc1\n\ts_nop 1" :: "v"(p), "v"(v) : "memory"); }
__device__ __forceinline__ void store8_sc1(void* p, u32x2 v) { asm volatile("global_store_dwordx2 %0, %1, off sc1\n\ts_nop 1" :: "v"(p), "v"(v) : "memory"); }
__device__ __forceinline__ unsigned pk4_fp8(float a, float b, float c, float d) {
    a = __builtin_amdgcn_fmed3f(a, -448.0f, 448.0f); b = __builtin_amdgcn_fmed3f(b, -448.0f, 448.0f); c = __builtin_amdgcn_fmed3f(c, -448.0f, 448.0f); d = __builtin_amdgcn_fmed3f(d, -448.0f, 448.0f);
    int r = __builtin_amdgcn_cvt_pk_fp8_f32(a, b, 0, false); r = __builtin_amdgcn_cvt_pk_fp8_f32(c, d, r, true); return (unsigned)r; }
__device__ __forceinline__ unsigned pk4_fp8_ns(float a, float b, float c, float d) { int r = __builtin_amdgcn_cvt_pk_fp8_f32(a, b, 0, false); r = __builtin_amdgcn_cvt_pk_fp8_f32(c, d, r, true); return (unsigned)r; }
constexpr float W8_SCALE = 256.0f, W8_INV = 1.0f / 256.0f;
__device__ __forceinline__ float sigmoidf_(float x) { return __builtin_amdgcn_rcpf(1.f + __expf(-x)); }
#define DPP_ADD(t, CTRL) ((t) + __builtin_bit_cast(float, __builtin_amdgcn_update_dpp(0, __builtin_bit_cast(int, (t)), (CTRL), 0xf, 0xf, false)))
__device__ __forceinline__ float sum8_(float t) { t = DPP_ADD(t, 0xB1); t = DPP_ADD(t, 0x4E); t = DPP_ADD(t, 0x141); return t; }
__device__ __forceinline__ float sum16_(float t) { t = sum8_(t); t = DPP_ADD(t, 0x140); return t; }

namespace pg8 {
constexpr int BM = 256, BK = 64, HALF = 128, HTB = HALF * BK * 2, STAGE_BYTES = 8 * HTB, NXCD = 8, WGM = 8;
__host__ __device__ __forceinline__ int lds_byte(int r, int c) { const int st = (r >> 4) * 2 + (c >> 5), rr = r & 15, cc = c & 31, ob = rr * 64 + cc * 2; return st * 1024 + (ob ^ (((ob >> 9) & 1) << 5)); }
__host__ __device__ __forceinline__ void stage_rc(int b, int& R, int& C) { const int st = b / 1024, sb = b % 1024, swz = sb ^ (((sb >> 9) & 1) << 5); R = (st >> 1) * 16 + swz / 64; C = (st & 1) * 32 + (swz % 64) / 2; }
__host__ __device__ __forceinline__ int perm32(int rho) { const int n = rho >> 4, i = rho & 15; return 8 * (i >> 2) + 4 * n + (i & 3); }

struct Unit { int pm, pn, e; };

struct DenseOrder {
    static constexpr bool HAS_DEP = false;
    const char* A; const char* Bt; int nM, nN, nwg, G, c;
    __device__ void init(const void* A_, const void* Bt_, int M, int N, int G_, int c_) { A = (const char*)A_; Bt = (const char*)Bt_; nM = M / BM; nN = N / BM; nwg = nM * nN; G = G_; c = c_; }
    __device__ bool next(int i, Unit& u) const {
        const long L = (long)i * G + c; if (L >= nwg) return false;
        int wgid = (int)L; { const int q = nwg / NXCD, r = nwg % NXCD, xcd = wgid % NXCD, off = wgid / NXCD; wgid = (xcd < r ? xcd * (q + 1) : r * (q + 1) + (xcd - r) * q) + off; }
        const int nig = WGM * nN, gid = wgid / nig, fm = gid * WGM, gsz = (nM - fm) < WGM ? (nM - fm) : WGM;
        u.pm = fm + ((wgid % nig) % gsz); u.pn = (wgid % nig) / gsz; u.e = 0; return true;
    }
    __device__ __forceinline__ const char* a_ptr(const Unit& u, size_t tstep) const { return A + (size_t)u.pm * tstep; }
    __device__ __forceinline__ const char* b_ptr(const Unit& u, size_t tstep) const { return Bt + (size_t)u.pn * tstep; }
};

constexpr unsigned DEP_NEED = 16u;
template <bool DEP>
struct MoeOrderT {
    static constexpr bool HAS_DEP = DEP;
    const char* A; const char* Bt; const LAS int* tiles; const LAS int* arow; const LAS int* ub; int nN, G, c; size_t estepB; int total; unsigned* dep; unsigned need_hi;
    __device__ bool next(int i, Unit& u) const {
        const int L = i * G + c; if (L >= total) return false;
        unsigned zz = 0u; asm volatile("" : "+v"(zz));
        const int ln = (int)__builtin_amdgcn_mbcnt_hi(~0u, __builtin_amdgcn_mbcnt_lo(~0u, zz));
        const int ubv = ub[(ln < NE ? ln : NE - 1) + 1];
        const int e = __builtin_popcountll(__ballot(ln < NE && L >= ubv));
        const int r = L - __builtin_amdgcn_readfirstlane(ub[e]), te = __builtin_amdgcn_readfirstlane(tiles[e]);
        u.e = e; u.pm = r % te; u.pn = r / te; return true;
    }
    __device__ __forceinline__ unsigned dep_issue(int i) const {
        Unit u; if (!next(i, u)) return 0xffffffffu;
        return __hip_atomic_load(dep + (u.e * 32 + u.pm) * 16, __ATOMIC_RELAXED, __HIP_MEMORY_SCOPE_AGENT);
    }
    __device__ __forceinline__ void dep_confirm(const Unit& u, unsigned v) const {
        const unsigned* ctr = dep + (u.e * 32 + u.pm) * 16;
        const unsigned need = DEP_NEED + (u.e >= 16 ? need_hi : 0u);
        while ((unsigned)__builtin_amdgcn_readfirstlane((int)v) < need) { __builtin_amdgcn_s_sleep(2); v = __hip_atomic_load(ctr, __ATOMIC_RELAXED, __HIP_MEMORY_SCOPE_AGENT); }
        asm volatile("" ::: "memory");
    }
    __device__ __forceinline__ const char* a_ptr(const Unit& u, size_t tstep) const { return A + ((size_t)arow[u.e] / 256 + (size_t)u.pm) * tstep; }
    __device__ __forceinline__ const char* b_ptr(const Unit& u, size_t tstep) const { return Bt + (size_t)u.e * estepB + (size_t)u.pn * tstep; }
};
typedef MoeOrderT<false> MoeOrder;
typedef MoeOrderT<true> MoeDepOrder;

template <class Base> struct SubOrder {
    static constexpr bool HAS_DEP = false;
    Base b; int i0, n;
    __device__ bool next(int i, Unit& u) const { if (i >= n) return false; return b.next(i0 + i, u); }
    __device__ __forceinline__ const char* a_ptr(const Unit& u, size_t tstep) const { return b.a_ptr(u, tstep); }
    __device__ __forceinline__ const char* b_ptr(const Unit& u, size_t tstep) const { return b.b_ptr(u, tstep); }
};
struct OneUnit {
    static constexpr bool HAS_DEP = false;
    const char* A; const char* Bt; Unit u;
    __device__ bool next(int i, Unit& o) const { if (i > 0) return false; o = u; return true; }
    __device__ __forceinline__ const char* a_ptr(const Unit&, size_t) const { return A; }
    __device__ __forceinline__ const char* b_ptr(const Unit&, size_t) const { return Bt; }
};

struct PairOrder {
    static constexpr bool HAS_DEP = false;
    DenseOrder d; const char* A2; const char* Bt2;
    __device__ bool next(int i, Unit& u) const { if (!d.next(i >> 1, u)) return false; u.e = i & 1; return true; }
    __device__ __forceinline__ const char* a_ptr(const Unit& u, size_t tstep) const { return (u.e ? A2 : d.A) + (size_t)u.pm * tstep; }
    __device__ __forceinline__ const char* b_ptr(const Unit& u, size_t tstep) const { return (u.e ? Bt2 : d.Bt) + (size_t)u.pn * tstep; }
};

template <class Epi, class Sched, bool FP8 = false>
__device__ __forceinline__ void gemm_phase(LAS unsigned char* lds, const int K, const Sched& S, const Epi& E) {
    int tid = threadIdx.x; asm volatile("" : "+v"(tid));
    const int wid = __builtin_amdgcn_readfirstlane(tid >> 6), lane = tid & 63, wr = wid >> 2, wc = wid & 3, fr = lane & 15, fq = lane >> 4;
    const int nt = K / BK;
    unsigned voffA, voffB;
    { int R, C; stage_rc(tid * 16, R, C); const int Rb = Epi::PERM ? ((R & ~31) + perm32(R & 31)) : R;
      voffA = (unsigned)(R * K + C) * 2u; voffB = (unsigned)(Rb * K + C) * 2u; }
    const size_t pstep = (size_t)64 * K * 2;
    const size_t kstep = (size_t)(BK * 2);
    const size_t hstep = (size_t)HALF * K * 2;
    const size_t tstep = 2 * hstep;
    const unsigned ldsw = (unsigned)wid * 1024u;
    int lanex;
    { unsigned _z = 0u; asm volatile("" : "+v"(_z)); const int _ln = (int)__builtin_amdgcn_mbcnt_hi(~0u, __builtin_amdgcn_mbcnt_lo(~0u, _z)); lanex = lds_byte(_ln & 15, (_ln >> 4) * 8); }
#define PG8_LANE_OFFS asm volatile("" : "+v"(lanex)); const int aoff = lanex + wr * 8192, boff = lanex + wc * 4096; (void)aoff; (void)boff
#define PG8_SA(b, h) (((b) * 2 + (h)) * HTB)
#define PG8_SB(b, h) ((4 + (b) * 2 + (h)) * HTB)
#define PG8_STAGE(bufoff, gbase, voff) do { asm volatile("" : "+v"(voff)); _Pragma("unroll") for (int _i = 0; _i < 2; ++_i) \
        __builtin_amdgcn_global_load_lds((const unsigned*)((const char*)(gbase) + _i * pstep + (voff)), (LAS unsigned*)(lds + (bufoff) + ldsw + _i * 8192), 16, 0, 0); } while (0)
#define PG8_LDA(dst, b, h) do { _Pragma("unroll") for (int m = 0; m < 4; ++m) { const i32x4 _l = *(const LAS i32x4*)(lds + PG8_SA(b, h) + aoff + m * 2048), _h = *(const LAS i32x4*)(lds + PG8_SA(b, h) + aoff + m * 2048 + 1024); \
        dst[m] = __builtin_shufflevector(_l, _h, 0, 1, 2, 3, 4, 5, 6, 7); } } while (0)
#define PG8_LDB(dst, b, h) do { _Pragma("unroll") for (int n = 0; n < 2; ++n) { const i32x4 _l = *(const LAS i32x4*)(lds + PG8_SB(b, h) + boff + n * 2048), _h = *(const LAS i32x4*)(lds + PG8_SB(b, h) + boff + n * 2048 + 1024); \
        dst[n] = __builtin_shufflevector(_l, _h, 0, 1, 2, 3, 4, 5, 6, 7); } } while (0)
#define PG8_LO(x) __builtin_bit_cast(bf16x8, __builtin_shufflevector((x), (x), 0, 1, 2, 3))
#define PG8_HI(x) __builtin_bit_cast(bf16x8, __builtin_shufflevector((x), (x), 4, 5, 6, 7))
#define PG8_MMA(ai, bj, At, Bt) do { __builtin_amdgcn_s_setprio(1); \
        if constexpr (FP8) { _Pragma("unroll") for (int m = 0; m < 4; ++m) _Pragma("unroll") for (int n = 0; n < 2; ++n) \
            acc[ai][bj][m][n] = __builtin_amdgcn_mfma_scale_f32_16x16x128_f8f6f4(Bt[n], At[m], acc[ai][bj][m][n], 0, 0, 0, 0x7f7f7f7f, 0, 0x7f7f7f7f); } \
        else { _Pragma("unroll") for (int m = 0; m < 4; ++m) _Pragma("unroll") for (int n = 0; n < 2; ++n) { \
            acc[ai][bj][m][n] = __builtin_amdgcn_mfma_f32_16x16x32_bf16(PG8_LO(Bt[n]), PG8_LO(At[m]), acc[ai][bj][m][n], 0, 0, 0); \
            acc[ai][bj][m][n] = __builtin_amdgcn_mfma_f32_16x16x32_bf16(PG8_HI(Bt[n]), PG8_HI(At[m]), acc[ai][bj][m][n], 0, 0, 0); } } \
        __builtin_amdgcn_s_setprio(0); } while (0)
#define PG8_WAIT_V(n) asm volatile("s_waitcnt vmcnt(" #n ")" ::: "memory")
#define PG8_WAIT_L(n) asm volatile("s_waitcnt lgkmcnt(" #n ")" ::: "memory")
#define PG8_BAR __builtin_amdgcn_s_barrier()
#define PG8_SCHED __builtin_amdgcn_sched_barrier(0)
    Unit cur, nxt, prv; int ui = 0; prv.pm = prv.pn = prv.e = 0; (void)prv;
    if (!S.next(0, cur)) return;
    unsigned depv = 0u; (void)depv;
    if constexpr (Sched::HAS_DEP) { S.dep_confirm(cur, S.dep_issue(0)); depv = S.dep_issue(1); }
    f32x4 acc[2][2][4][2];
#define PG8_ACC_INIT(U) do { f32x4 _bi[2][2]; \
        if constexpr (Epi::ACC_INIT) { unsigned _zz = 0u; asm volatile("" : "+v"(_zz)); const int _ln = (int)__builtin_amdgcn_mbcnt_hi(~0u, __builtin_amdgcn_mbcnt_lo(~0u, _zz)); E.acc_bias((U), wc, _ln >> 4, _bi); } \
        else { _bi[0][0] = (f32x4){0.f, 0.f, 0.f, 0.f}; _bi[0][1] = _bi[0][0]; _bi[1][0] = _bi[0][0]; _bi[1][1] = _bi[0][0]; } \
        _Pragma("unroll") for (int a = 0; a < 2; ++a) _Pragma("unroll") for (int b = 0; b < 2; ++b) _Pragma("unroll") for (int m = 0; m < 4; ++m) _Pragma("unroll") for (int n = 0; n < 2; ++n) acc[a][b][m][n] = _bi[b][n]; } while (0)
    PG8_ACC_INIT(cur);
    i32x8 At[4], B0[2], B1[2];
    const char* cA = S.a_ptr(cur, tstep); const char* cB = S.b_ptr(cur, tstep);
    PG8_STAGE(PG8_SB(0, 0), cB, voffB); PG8_STAGE(PG8_SB(0, 1), cB + hstep, voffB); PG8_STAGE(PG8_SA(0, 0), cA, voffA); PG8_STAGE(PG8_SA(0, 1), cA + hstep, voffA);
    if (wr == 1) PG8_BAR;
    PG8_WAIT_V(2); PG8_BAR;
    PG8_STAGE(PG8_SB(1, 0), cB + kstep, voffB); PG8_STAGE(PG8_SA(1, 0), cA + kstep, voffA); PG8_STAGE(PG8_SB(1, 1), cB + hstep + kstep, voffB);
    PG8_WAIT_V(6); PG8_BAR;
    for (;;) {
        const bool has_next = S.next(ui + 1, nxt);
        if constexpr (Sched::HAS_DEP) { if (has_next) S.dep_confirm(nxt, depv); }
        const char* nA = has_next ? S.a_ptr(nxt, tstep) : cA; const char* nB = has_next ? S.b_ptr(nxt, tstep) : cB;
#pragma unroll 1
        for (int t = 0; t < nt; t += 2) {
            const bool last = (t == nt - 2);
            const char* a1 = cA + (size_t)(t + 1) * kstep;
            const char* a2 = last ? nA : cA + (size_t)(t + 2) * kstep; const char* b2 = last ? nB : cB + (size_t)(t + 2) * kstep;
            const char* a3 = a2 + kstep; const char* b3 = b2 + kstep;
            { PG8_LANE_OFFS; PG8_LDB(B0, 0, 0); PG8_LDB(B1, 0, 1); PG8_SCHED; PG8_LDA(At, 0, 0); PG8_STAGE(PG8_SA(1, 1), a1 + hstep, voffA); }
            PG8_WAIT_V(8); PG8_WAIT_L(0); PG8_BAR; PG8_MMA(0, 0, At, B0); PG8_MMA(0, 1, At, B1); PG8_BAR; PG8_SCHED;
            { PG8_LANE_OFFS; PG8_LDA(At, 0, 1); PG8_STAGE(PG8_SB(0, 0), b2, voffB); PG8_STAGE(PG8_SB(0, 1), b2 + hstep, voffB); PG8_STAGE(PG8_SA(0, 0), a2, voffA); }
            PG8_WAIT_V(8); PG8_WAIT_L(0); PG8_BAR; PG8_MMA(1, 0, At, B0); PG8_MMA(1, 1, At, B1); PG8_BAR; PG8_SCHED;
            { PG8_LANE_OFFS; PG8_LDB(B0, 1, 0); PG8_LDB(B1, 1, 1); PG8_SCHED; PG8_LDA(At, 1, 0); PG8_STAGE(PG8_SA(0, 1), a2 + hstep, voffA); }
            PG8_WAIT_V(8); PG8_WAIT_L(0); PG8_BAR; PG8_MMA(0, 0, At, B0); PG8_MMA(0, 1, At, B1); PG8_BAR; PG8_SCHED;
            { PG8_LANE_OFFS; PG8_LDA(At, 1, 1); PG8_STAGE(PG8_SB(1, 0), b3, voffB); PG8_STAGE(PG8_SB(1, 1), b3 + hstep, voffB); PG8_STAGE(PG8_SA(1, 0), a3, voffA); }
            PG8_WAIT_V(8); PG8_WAIT_L(0); PG8_BAR; PG8_MMA(1, 0, At, B0); PG8_MMA(1, 1, At, B1); PG8_BAR; PG8_SCHED;
        }
        if (wr == 0) PG8_BAR;
        if constexpr (Sched::HAS_DEP) depv = S.dep_issue(ui + 2);
        if constexpr (Epi::SIGNALS) { if (ui > 0) { PG8_WAIT_V(8); PG8_BAR; E.signal(prv, tid == 0); } }
        { unsigned zz = 0u; asm volatile("" : "+v"(zz));
          const int ln = (int)__builtin_amdgcn_mbcnt_hi(~0u, __builtin_amdgcn_mbcnt_lo(~0u, zz));
          E(acc, cur, wr, wc, ln & 15, ln >> 4); }
        if (!has_next) break;
        if (!(Epi::CHAIN && cur.e == 0)) { PG8_ACC_INIT(nxt); }
        prv = cur; cur = nxt; cA = nA; cB = nB; ++ui;
        if (wr == 1) PG8_BAR;
    }
    PG8_WAIT_V(0);
    PG8_BAR;
    if constexpr (Epi::SIGNALS) E.signal(cur, tid == 0);
#undef PG8_SA
#undef PG8_ACC_INIT
#undef PG8_SB
#undef PG8_STAGE
#undef PG8_LDA
#undef PG8_LDB
#undef PG8_MMA
#undef PG8_LO
#undef PG8_LANE_OFFS
#undef PG8_HI
#undef PG8_WAIT_V
#undef PG8_WAIT_L
#undef PG8_BAR
#undef PG8_SCHED
}
}

using pg8::Unit;
template <bool F8>
struct EpiZT {
    static constexpr bool PERM = true;
    static constexpr bool SIGNALS = false;
    static constexpr bool CHAIN = false;
    static constexpr bool ACC_INIT = false;
    static constexpr float ASC = F8 ? W8_INV : 1.0f;
    bf16_t* O; int ldc; const float* gq; const float* gk; float* kmean; LAS unsigned char* xl;
    __device__ __forceinline__ void operator()(const f32x4 (&acc)[2][2][4][2], const Unit& u, int wr, int wc, int fr, int fq) const {
        const int row0 = u.pm * 256 + wr * 64 + fr, col0 = u.pn * 256 + wc * 32 + 8 * fq;
        if (u.pn < 12 || u.pn >= 20) {
#pragma unroll
            for (int ai = 0; ai < 2; ++ai)
#pragma unroll
                for (int m = 0; m < 4; ++m) { bf16_t* rowp = O + (size_t)(row0 + ai * 128 + m * 16) * ldc + col0;
#pragma unroll
                    for (int bj = 0; bj < 2; ++bj) { const f32x4 v0 = acc[ai][bj][m][0] * ASC, v1 = acc[ai][bj][m][1] * ASC;
                        u32x4 w; w.x = pk2(v0[0], v0[1]); w.y = pk2(v0[2], v0[3]); w.z = pk2(v1[0], v1[1]); w.w = pk2(v1[2], v1[3]);
                        *(u32x4*)(rowp + bj * 128) = w; } }
            return;
        }
        LAS float* P = (LAS float*)xl;
        LAS float* Cs = (LAS float*)(xl + 8192);
#pragma unroll
        for (int ai = 0; ai < 2; ++ai)
#pragma unroll
            for (int m = 0; m < 4; ++m)
#pragma unroll
                for (int bj = 0; bj < 2; ++bj) { const f32x4 v0 = acc[ai][bj][m][0], v1 = acc[ai][bj][m][1];
                    float ss = (v0[0] * v0[0] + v0[1] * v0[1]) + (v0[2] * v0[2] + v0[3] * v0[3]) + (v1[0] * v1[0] + v1[1] * v1[1]) + (v1[2] * v1[2] + v1[3] * v1[3]);
                    ss += __shfl_xor(ss, 16); ss += __shfl_xor(ss, 32);
                    if (fq == 0) P[((ai * 128 + wr * 64 + m * 16 + fr) * 2 + bj) * 4 + wc] = ss; asm volatile("" ::: "memory"); }
        __syncthreads();
        const bool isk = u.pn >= 16;
        const float* gv = (isk ? gk : gq) + wc * 32 + 8 * fq;
        const f32x4 g0 = *(const f32x4*)gv, g1 = *(const f32x4*)(gv + 4);
        f32x4 cs[2][2];
#pragma unroll
        for (int bj = 0; bj < 2; ++bj) { cs[bj][0] = (f32x4){0.f, 0.f, 0.f, 0.f}; cs[bj][1] = cs[bj][0]; }
#pragma unroll
        for (int ai = 0; ai < 2; ++ai)
#pragma unroll
            for (int m = 0; m < 4; ++m) { const int rl = ai * 128 + wr * 64 + m * 16 + fr; bf16_t* rowp = O + (size_t)(u.pm * 256 + rl) * ldc + col0;
#pragma unroll
                for (int bj = 0; bj < 2; ++bj) { const f32x4 pp = *(const LAS f32x4*)(P + (rl * 2 + bj) * 4);
                    const float rinv = rsqrtf(((pp[0] + pp[1]) + (pp[2] + pp[3])) * (ASC * ASC / 128.0f) + EPS) * ASC;
                    const f32x4 y0 = acc[ai][bj][m][0] * rinv * g0, y1 = acc[ai][bj][m][1] * rinv * g1;
                    cs[bj][0] += y0; cs[bj][1] += y1;
                    u32x4 w; w.x = pk2(y0[0], y0[1]); w.y = pk2(y0[2], y0[3]); w.z = pk2(y1[0], y1[1]); w.w = pk2(y1[2], y1[3]);
                    *(u32x4*)(rowp + bj * 128) = w; }
                asm volatile("" : "+v"(cs[0][0]), "+v"(cs[0][1]), "+v"(cs[1][0]), "+v"(cs[1][1]) :: "memory"); }
        if (isk) {
#pragma unroll
            for (int bj = 0; bj < 2; ++bj)
#pragma unroll
                for (int n = 0; n < 2; ++n)
#pragma unroll
                    for (int j = 0; j < 4; ++j) { float t = sum16_(cs[bj][n][j]);
                        if (fr == 0) Cs[(wr * 2 + bj) * 128 + wc * 32 + 8 * fq + 4 * n + j] = t; }
            __syncthreads();
            const int t = (wr * 4 + wc) * 64 + fq * 16 + fr;
            if (t < 256) { const int bj = t >> 7, d = t & 127, hd = (u.pn - 16) * 2 + bj;
                kmean[((((size_t)(u.pm >> 3) * 8 + hd) * 8) + (u.pm & 7)) * 128 + d] = (Cs[bj * 128 + d] + Cs[(2 + bj) * 128 + d]) * (1.0f / 256.0f); }
        }
    }
};
typedef EpiZT<false> EpiZ;
struct EpiZ8 {
    static constexpr bool PERM = true;
    static constexpr bool SIGNALS = false;
    static constexpr bool CHAIN = false;
    static constexpr bool ACC_INIT = false;
    bf16_t* O; int ldc, col_off;
    __device__ __forceinline__ void operator()(const f32x4 (&acc)[2][2][4][2], const Unit& u, int wr, int wc, int fr, int fq) const {
        const int row0 = u.pm * 256 + wr * 64 + fr, col0 = col_off + u.pn * 256 + wc * 32 + 8 * fq;
#pragma unroll
        for (int ai = 0; ai < 2; ++ai)
#pragma unroll
            for (int m = 0; m < 4; ++m) { bf16_t* rowp = O + (size_t)(row0 + ai * 128 + m * 16) * ldc + col0;
#pragma unroll
                for (int bj = 0; bj < 2; ++bj) { const f32x4 v0 = acc[ai][bj][m][0] * W8_INV, v1 = acc[ai][bj][m][1] * W8_INV;
                    u32x4 w; w.x = pk2(v0[0], v0[1]); w.y = pk2(v0[2], v0[3]); w.z = pk2(v1[0], v1[1]); w.w = pk2(v1[2], v1[3]);
                    *(u32x4*)(rowp + bj * 128) = w; } }
    }
};
struct EpiBranchA {
    static constexpr bool PERM = true;
    static constexpr bool SIGNALS = false;
    static constexpr bool CHAIN = false;
    static constexpr bool ACC_INIT = false;
    float* tmp; const bf16_t* z;
    __device__ __forceinline__ void operator()(const f32x4 (&acc)[2][2][4][2], const Unit& u, int wr, int wc, int fr, int fq) const {
        const int row0 = u.pm * 256 + wr * 64 + fr, col0 = u.pn * 256 + wc * 32 + 8 * fq;
#pragma unroll
        for (int ai = 0; ai < 2; ++ai)
#pragma unroll
            for (int m = 0; m < 4; ++m) { const size_t row = (size_t)(row0 + ai * 128 + m * 16);
#pragma unroll
                for (int bj = 0; bj < 2; ++bj) { const int col = col0 + bj * 128;
                    const u32x4 g = *(const u32x4*)(z + row * ZP + ZGA + col);
                    const f32x4 v0 = acc[ai][bj][m][0] * (W8_INV / H8_SCALE), v1 = acc[ai][bj][m][1] * (W8_INV / H8_SCALE);
                    f32x4 o0, o1;
                    o0[0] = v0[0] * sigmoidf_(bf_lo(g.x)); o0[1] = v0[1] * sigmoidf_(bf_hi(g.x)); o0[2] = v0[2] * sigmoidf_(bf_lo(g.y)); o0[3] = v0[3] * sigmoidf_(bf_hi(g.y));
                    o1[0] = v1[0] * sigmoidf_(bf_lo(g.z)); o1[1] = v1[1] * sigmoidf_(bf_hi(g.z)); o1[2] = v1[2] * sigmoidf_(bf_lo(g.w)); o1[3] = v1[3] * sigmoidf_(bf_hi(g.w));
                    float* p = tmp + row * D + col; *(f32x4*)p = o0; *(f32x4*)(p + 4) = o1; } }
    }
};
struct EpiBranchB {
    static constexpr bool PERM = true;
    static constexpr bool SIGNALS = false;
    static constexpr bool CHAIN = false;
    static constexpr bool ACC_INIT = false;
    const float* tmp; const bf16_t* z; unsigned char* y;
    __device__ __forceinline__ void operator()(const f32x4 (&acc)[2][2][4][2], const Unit& u, int wr, int wc, int fr, int fq) const {
        const int row0 = u.pm * 256 + wr * 64 + fr, col0 = u.pn * 256 + wc * 32 + 8 * fq;
#pragma unroll
        for (int ai = 0; ai < 2; ++ai)
#pragma unroll
            for (int m = 0; m < 4; ++m) { const size_t row = (size_t)(row0 + ai * 128 + m * 16);
#pragma unroll
                for (int bj = 0; bj < 2; ++bj) { const int col = col0 + bj * 128;
                    const u32x4 g = *(const u32x4*)(z + row * ZP + ZGB + col);
                    const float* p = tmp + row * D + col; const f32x4 t0 = *(const f32x4*)p, t1 = *(const f32x4*)(p + 4);
                    const f32x4 v0 = acc[ai][bj][m][0] * (W8_INV / O8_SCALE), v1 = acc[ai][bj][m][1] * (W8_INV / O8_SCALE);
                    f32x4 o0, o1;
                    o0[0] = t0[0] + v0[0] * sigmoidf_(bf_lo(g.x)); o0[1] = t0[1] + v0[1] * sigmoidf_(bf_hi(g.x)); o0[2] = t0[2] + v0[2] * sigmoidf_(bf_lo(g.y)); o0[3] = t0[3] + v0[3] * sigmoidf_(bf_hi(g.y));
                    o1[0] = t1[0] + v1[0] * sigmoidf_(bf_lo(g.z)); o1[1] = t1[1] + v1[1] * sigmoidf_(bf_hi(g.z)); o1[2] = t1[2] + v1[2] * sigmoidf_(bf_lo(g.w)); o1[3] = t1[3] + v1[3] * sigmoidf_(bf_hi(g.w));
                    o0 *= Y8_SCALE; o1 *= Y8_SCALE;
                    u32x2 w; w.x = pk4_fp8(o0[0], o0[1], o0[2], o0[3]); w.y = pk4_fp8(o1[0], o1[1], o1[2], o1[3]);
                    *(u32x2*)(y + row * D + col) = w; } }
    }
};
struct EpiBranchAB {
    static constexpr bool PERM = true;
    static constexpr bool SIGNALS = false;
    static constexpr bool CHAIN = true;
    static constexpr bool ACC_INIT = false;
    const bf16_t* z; unsigned char* y;
    __device__ __forceinline__ void operator()(f32x4 (&acc)[2][2][4][2], const Unit& u, int wr, int wc, int fr, int fq) const {
        const int row0 = u.pm * 256 + wr * 64 + fr, col0 = u.pn * 256 + wc * 32 + 8 * fq;
        if (u.e == 0) {
#pragma unroll
            for (int ai = 0; ai < 2; ++ai) {
                u32x4 ga[4][2], gb[4][2];
#pragma unroll
                for (int m = 0; m < 4; ++m)
#pragma unroll
                    for (int bj = 0; bj < 2; ++bj) { const bf16_t* zp = z + (size_t)(row0 + ai * 128 + m * 16) * ZP + col0 + bj * 128; ga[m][bj] = *(const u32x4*)(zp + ZGA); gb[m][bj] = *(const u32x4*)(zp + ZGB); }
                __builtin_amdgcn_sched_barrier(0);
#pragma unroll
                for (int m = 0; m < 4; ++m)
#pragma unroll
                    for (int bj = 0; bj < 2; ++bj) { const u32x4 a_ = ga[m][bj], b_ = gb[m][bj];
#define RHO(aw, bw, lo) ((O8_SCALE / H8_SCALE) * (1.0f + __expf(-(lo ? bf_lo(bw) : bf_hi(bw)))) * __builtin_amdgcn_rcpf(1.0f + __expf(-(lo ? bf_lo(aw) : bf_hi(aw)))))
                        f32x4 r0, r1;
                        r0[0] = RHO(a_.x, b_.x, 1); r0[1] = RHO(a_.x, b_.x, 0); r0[2] = RHO(a_.y, b_.y, 1); r0[3] = RHO(a_.y, b_.y, 0);
                        r1[0] = RHO(a_.z, b_.z, 1); r1[1] = RHO(a_.z, b_.z, 0); r1[2] = RHO(a_.w, b_.w, 1); r1[3] = RHO(a_.w, b_.w, 0);
#undef RHO
                        acc[ai][bj][m][0] *= r0; acc[ai][bj][m][1] *= r1; }
                __builtin_amdgcn_sched_barrier(0);
            }
        } else {
            u32x4 gb[2][4][2];
#pragma unroll
            for (int ai = 0; ai < 2; ++ai)
#pragma unroll
                for (int m = 0; m < 4; ++m)
#pragma unroll
                    for (int bj = 0; bj < 2; ++bj) gb[ai][m][bj] = *(const u32x4*)(z + (size_t)(row0 + ai * 128 + m * 16) * ZP + ZGB + col0 + bj * 128);
            __builtin_amdgcn_sched_barrier(0);
#pragma unroll
            for (int ai = 0; ai < 2; ++ai)
#pragma unroll
                for (int m = 0; m < 4; ++m) { const size_t row = (size_t)(row0 + ai * 128 + m * 16);
#pragma unroll
                    for (int bj = 0; bj < 2; ++bj) { const int col = col0 + bj * 128;
                        const u32x4 g = gb[ai][m][bj];
                        const f32x4 v0 = acc[ai][bj][m][0] * (W8_INV / O8_SCALE * Y8_SCALE), v1 = acc[ai][bj][m][1] * (W8_INV / O8_SCALE * Y8_SCALE);
                        u32x2 w;
                        w.x = pk4_fp8(v0[0] * sigmoidf_(bf_lo(g.x)), v0[1] * sigmoidf_(bf_hi(g.x)), v0[2] * sigmoidf_(bf_lo(g.y)), v0[3] * sigmoidf_(bf_hi(g.y)));
                        w.y = pk4_fp8(v1[0] * sigmoidf_(bf_lo(g.z)), v1[1] * sigmoidf_(bf_hi(g.z)), v1[2] * sigmoidf_(bf_lo(g.w)), v1[3] * sigmoidf_(bf_hi(g.w)));
                        *(u32x2*)(y + row * D + col) = w; } }
        }
    }
};
struct EpiOut {
    static constexpr bool PERM = false;
    static constexpr bool SIGNALS = false;
    static constexpr bool CHAIN = false;
    static constexpr bool ACC_INIT = false;
    const float* x; const float* modf; bf16_t* x1;
    __device__ __forceinline__ void operator()(const f32x4 (&acc)[2][2][4][2], const Unit& u, int wr, int wc, int fr, int fq) const {
        const int row0 = u.pm * 256 + wr * 64 + fr, col0 = u.pn * 256 + wc * 32 + 4 * fq;
        const float* gt = modf + (size_t)(u.pm >> 3) * (6 * D) + 2 * D;
        f32x4 gv[2][2];
#pragma unroll
        for (int bj = 0; bj < 2; ++bj)
#pragma unroll
            for (int n = 0; n < 2; ++n) gv[bj][n] = *(const f32x4*)(gt + col0 + bj * 128 + n * 16);
#pragma unroll
        for (int ai = 0; ai < 2; ++ai) {
            f32x4 xv[4][2][2];
#pragma unroll
            for (int m = 0; m < 4; ++m)
#pragma unroll
                for (int bj = 0; bj < 2; ++bj)
#pragma unroll
                    for (int n = 0; n < 2; ++n) xv[m][bj][n] = *(const f32x4*)(x + (size_t)(row0 + ai * 128 + m * 16) * D + col0 + bj * 128 + n * 16);
            __builtin_amdgcn_sched_barrier(0);
#pragma unroll
            for (int m = 0; m < 4; ++m) { const size_t off = (size_t)(row0 + ai * 128 + m * 16) * D + col0;
#pragma unroll
                for (int bj = 0; bj < 2; ++bj)
#pragma unroll
                    for (int n = 0; n < 2; ++n) {
                        const f32x4 v = xv[m][bj][n] + gv[bj][n] * (acc[ai][bj][m][n] * (W8_INV / Y8_SCALE));
                        u32x2 o; o.x = pk2(v[0], v[1]); o.y = pk2(v[2], v[3]);
                        *(u32x2*)(x1 + off + bj * 128 + n * 16) = o; } }
            __builtin_amdgcn_sched_barrier(0);
        }
    }
};
template <bool SC1>
struct EpiUpT {
    static constexpr bool PERM = true;
    static constexpr bool CHAIN = false;
    static constexpr bool ACC_INIT = true;
    static constexpr bool SIGNALS = SC1;
    unsigned char* act; const float* b_up; const LAS int* cbase; unsigned* upd;
    __device__ __forceinline__ void operator()(const f32x4 (&acc)[2][2][4][2], const Unit& u, int wr, int wc, int fr, int fq) const {
        const int row0 = cbase[u.e] + u.pm * 256 + wr * 64 + fr, colh = u.pn * 128 + wc * 32 + 8 * fq;
#pragma unroll
        for (int ai = 0; ai < 2; ++ai)
#pragma unroll
            for (int m = 0; m < 4; ++m) {
                const f32x4 g0 = acc[ai][0][m][0], g1 = acc[ai][0][m][1], l0 = acc[ai][1][m][0], l1 = acc[ai][1][m][1];
                constexpr float KE = 1.702f * 1.4426950408889634f * W8_INV, GC = 7.0f * W8_SCALE, OS = W8_INV * W8_INV;
                float o[8];
#pragma unroll
                for (int j = 0; j < 4; ++j) {
                    float g = fminf(g0[j], GC), l = __builtin_amdgcn_fmed3f(l0[j], -GC, GC); o[j] = (g * OS) * __builtin_amdgcn_rcpf(1.0f + __builtin_amdgcn_exp2f(g * -KE)) * (l + W8_SCALE);
                    g = fminf(g1[j], GC); l = __builtin_amdgcn_fmed3f(l1[j], -GC, GC); o[4 + j] = (g * OS) * __builtin_amdgcn_rcpf(1.0f + __builtin_amdgcn_exp2f(g * -KE)) * (l + W8_SCALE); }
                u32x2 w; w.x = pk4_fp8_ns(o[0], o[1], o[2], o[3]); w.y = pk4_fp8_ns(o[4], o[5], o[6], o[7]);
                if (SC1) store8_sc1(act + (size_t)(row0 + ai * 128 + m * 16) * D + colh, w); else *(u32x2*)(act + (size_t)(row0 + ai * 128 + m * 16) * D + colh) = w; }
    }
    __device__ __forceinline__ void acc_bias(const Unit& u, int wc, int fq, f32x4 (&bi)[2][2]) const {
        const float* bg = b_up + (size_t)u.e * (2 * D) + u.pn * 128 + wc * 32 + 8 * fq;
#pragma unroll
        for (int n = 0; n < 2; ++n) { bi[0][n] = *(const f32x4*)(bg + 4 * n) * W8_SCALE; bi[1][n] = *(const f32x4*)(bg + D + 4 * n) * W8_SCALE; }
    }
    __device__ __forceinline__ void signal(const Unit& u, bool first_lane) const { if (first_lane) __hip_atomic_fetch_add(upd + (u.e * 32 + u.pm) * 16, 1u, __ATOMIC_RELAXED, __HIP_MEMORY_SCOPE_AGENT); }
};
typedef EpiUpT<true> EpiUp;
struct EpiDown {
    static constexpr bool PERM = true;
    static constexpr bool SIGNALS = false;
    static constexpr bool CHAIN = false;
    static constexpr bool ACC_INIT = true;
    __device__ __forceinline__ void acc_bias(const Unit& u, int wc, int fq, f32x4 (&bi)[2][2]) const {
        const float* bd = b_dn + (size_t)u.e * D + u.pn * 256 + wc * 32 + 8 * fq;
#pragma unroll
        for (int bj = 0; bj < 2; ++bj)
#pragma unroll
            for (int n = 0; n < 2; ++n) bi[bj][n] = *(const f32x4*)(bd + bj * 128 + 4 * n) * W8_SCALE;
    }
    unsigned char* ydn; const float* b_dn; const float* roww; const LAS int* cbase;
    __device__ __forceinline__ void operator()(const f32x4 (&acc)[2][2][4][2], const Unit& u, int wr, int wc, int fr, int fq) const {
        const int rl = u.pm * 256 + wr * 64 + fr, row0 = cbase[u.e] + rl, col0 = u.pn * 256 + wc * 32 + 8 * fq;
        float wv[2][4];
#pragma unroll
        for (int ai = 0; ai < 2; ++ai)
#pragma unroll
            for (int m = 0; m < 4; ++m) wv[ai][m] = roww[(size_t)u.e * ECAP + rl + ai * 128 + m * 16];
        __builtin_amdgcn_sched_barrier(0);
#pragma unroll
        for (int ai = 0; ai < 2; ++ai)
#pragma unroll
            for (int m = 0; m < 4; ++m) { const float w = wv[ai][m] * YD_SCALE; unsigned char* p = ydn + (size_t)(row0 + ai * 128 + m * 16) * D + col0;
#pragma unroll
                for (int bj = 0; bj < 2; ++bj) {
                    const f32x4 v0 = acc[ai][bj][m][0] * (W8_INV * w), v1 = acc[ai][bj][m][1] * (W8_INV * w);
                    u32x2 o; o.x = pk4_fp8(v0[0], v0[1], v0[2], v0[3]); o.y = pk4_fp8(v1[0], v1[1], v1[2], v1[3]);
                    *(u32x2*)(p + bj * 128) = o; } }
    }
};

#define XB_TMO      128
#define XB_XCNT(j)  (256  + 64 * (j))
#define XB_XSUB(j)  (1280 + 64 * (j))
#define XB_XGEN(j)  (2304 + 64 * (j))
#define XB_TOP      3328
#define XB_TOPGEN   3392
#define XCD_BAR_WORDS 3456
#define XB_SPIN_CAP (1u << 18)
__device__ __forceinline__ unsigned xb_ld(unsigned* p)              { return __hip_atomic_load(p, __ATOMIC_RELAXED, __HIP_MEMORY_SCOPE_AGENT); }
__device__ __forceinline__ unsigned xb_add(unsigned* p, unsigned v) { return __hip_atomic_fetch_add(p, v, __ATOMIC_RELAXED, __HIP_MEMORY_SCOPE_AGENT); }
__device__ __forceinline__ unsigned xb_xcc_id() { return (unsigned)__builtin_amdgcn_s_getreg((3 << 11) | 20) & 0xFu; }
#define XB_SPIN(cond, bar) do { unsigned _sp = 0; while (cond) { __builtin_amdgcn_s_sleep(1); \
    if ((++_sp & 255u) == 0u) { if (xb_ld(&(bar)[XB_TMO])) break; if (_sp > XB_SPIN_CAP) { atomicAdd(&(bar)[XB_TMO], 1u); break; } } } } while (0)
struct XcdBarrier { unsigned* bar; unsigned x; volatile LAS unsigned* st; };
__device__ __forceinline__ XcdBarrier xcd_barrier_post(unsigned* bar, volatile LAS unsigned* st) {
    XcdBarrier b; b.bar = bar; b.x = xb_xcc_id(); b.st = st;
    if (threadIdx.x == 0) (void)xb_add(&bar[XB_XCNT(b.x)], 1u);
    return b;
}
__device__ __forceinline__ void xcd_barrier_complete(unsigned* bar, unsigned x, unsigned& nloc, unsigned& nx) {
    const unsigned G = gridDim.x * gridDim.y * gridDim.z;
    unsigned sum, cnt, mine, sp = 0u;
    for (;;) {
        sum = 0u; cnt = 0u; mine = 0u;
#pragma unroll
        for (unsigned j = 0; j < 16; ++j) { const unsigned c = xb_ld(&bar[XB_XCNT(j)]); sum += c; cnt += (c > 0u) ? 1u : 0u; mine = (j == x) ? c : mine; }
        if (sum == G) break;
        __builtin_amdgcn_s_sleep(1);
        if ((++sp & 255u) == 0u) { if (xb_ld(&bar[XB_TMO])) break; if (sp > XB_SPIN_CAP) { atomicAdd(&bar[XB_TMO], 1u); break; } }
    }
    nloc = mine > 0u ? mine : 1u; nx = cnt > 0u ? cnt : 1u;
}
__device__ __forceinline__ void xcd_barrier(const XcdBarrier& b) {
    asm volatile("s_waitcnt vmcnt(0)" ::: "memory");
    __syncthreads();
    if (threadIdx.x == 0) {
        unsigned* bar = b.bar;
        __builtin_amdgcn_s_waitcnt(0);
        unsigned nloc = b.st[0], nx = b.st[1];
        if (nloc == 0u) { xcd_barrier_complete(bar, b.x, nloc, nx); b.st[0] = nloc; b.st[1] = nx; }
        const unsigned old = xb_add(&bar[XB_XSUB(b.x)], 1u);
        const unsigned gen = old / nloc;
        if (old + 1u == (gen + 1u) * nloc) {
            __builtin_amdgcn_fence(__ATOMIC_RELEASE, "agent");
            asm volatile("s_waitcnt vmcnt(0)" ::: "memory");
            const unsigned og = xb_add(&bar[XB_TOP], 1u);
            const unsigned tg = og / nx;
            if (og + 1u == (tg + 1u) * nx) xb_add(&bar[XB_TOPGEN], 1u);
            else XB_SPIN(xb_ld(&bar[XB_TOPGEN]) == tg, bar);
            __builtin_amdgcn_fence(__ATOMIC_ACQUIRE, "agent");
            xb_add(&bar[XB_XGEN(b.x)], 1u);
            asm volatile("s_waitcnt vmcnt(0)" ::: "memory");
        } else {
            XB_SPIN(xb_ld(&bar[XB_XGEN(b.x)]) == gen, bar);
            __builtin_amdgcn_fence(__ATOMIC_ACQUIRE, "agent");
            asm volatile("s_waitcnt vmcnt(0)" ::: "memory");
        }
    }
    __syncthreads();
}

struct Args { const float* in[21]; float* out; unsigned char* ws; int ph_lo, ph_hi; };
enum { I_X = 0, I_C, I_WADA, I_BADA, I_GMIX, I_WIN, I_BIG, I_BFG, I_GMO, I_GQ, I_GK, I_WBA, I_WBB, I_WOUT, I_GFFN, I_WR, I_BR, I_WUP, I_BUP, I_WDN, I_BDN };

struct Frame {
    LAS unsigned char* lds; unsigned char* ws; unsigned* ctl;
    int tid, lane, wave, G, wg, vcu;
};

__device__ __forceinline__ void p0_mod_partial(Frame& F, const float* c, const float* w_ada, float* modp, int item) {
    const int cg = item % 48, ks = item / 48;
    LAS float* sS = (LAS float*)F.lds;
    LAS float* red = (LAS float*)(F.lds + 8192);
    {
        const int k = F.tid;
#pragma unroll
        for (int b = 0; b < 4; ++b) { const float v = c[b * D + ks * 512 + k]; sS[b * 512 + k] = v * sigmoidf_(v); }
    }
    __syncthreads();
    f32x4 a0 = {0.f, 0.f, 0.f, 0.f}, a1 = a0, a2 = a0, a3 = a0;
    const float* wp = w_ada + (size_t)(ks * 512 + F.wave) * (6 * D) + cg * 256 + 4 * F.lane;
#pragma unroll 8
    for (int i = 0; i < 64; ++i) {
        const f32x4 w = *(const f32x4*)(wp + (size_t)(8 * i) * (6 * D));
        const int kk = F.wave + 8 * i;
        a0 += w * sS[kk]; a1 += w * sS[512 + kk]; a2 += w * sS[1024 + kk]; a3 += w * sS[1536 + kk];
    }
    *(LAS f32x4*)(red + (F.wave * 4 + 0) * 256 + 4 * F.lane) = a0;
    *(LAS f32x4*)(red + (F.wave * 4 + 1) * 256 + 4 * F.lane) = a1;
    *(LAS f32x4*)(red + (F.wave * 4 + 2) * 256 + 4 * F.lane) = a2;
    *(LAS f32x4*)(red + (F.wave * 4 + 3) * 256 + 4 * F.lane) = a3;
    __syncthreads();
#pragma unroll
    for (int r = 0; r < 2; ++r) {
        const int o = F.tid + 512 * r, b = o >> 8, col = o & 255;
        float s = 0.f;
#pragma unroll
        for (int w = 0; w < 8; ++w) s += red[(w * 4 + b) * 256 + col];
        modp[((size_t)ks * 4 + b) * (6 * D) + cg * 256 + col] = s;
    }
    __syncthreads();
}
__device__ __forceinline__ void p0_frag_item(const float* W, int ldw, int col0, bf16_t* dst, int p) {
    const int s = p >> 6, lane = p & 63;
    const float* src = W + (size_t)(32 * s + 8 * (lane >> 4)) * ldw + col0 + (lane & 15);
    u32x4 o; o.x = pk2(src[0], src[ldw]); o.y = pk2(src[2 * (size_t)ldw], src[3 * (size_t)ldw]); o.z = pk2(src[4 * (size_t)ldw], src[5 * (size_t)ldw]); o.w = pk2(src[6 * (size_t)ldw], src[7 * (size_t)ldw]);
    *(u32x4*)(dst + (size_t)p * 8) = o;
}
constexpr int CV_RS = 528, CV_BUF = 128 * CV_RS;
struct CvtItem { const float* src; bf16_t* dst; int K, ldw; };
__device__ __forceinline__ CvtItem cvt_decode(const Args& a, unsigned char* ws, int it) {
    constexpr int N_IN = 0, N_A = 4 * 16, N_O = 8 * 16, N_UP = 8 * 32, N_DN = 8 * 16;
    CvtItem c; int r = it;
    if (r < N_IN) { const int kb = r / 48, nb = r % 48, n0 = nb * 128; c.K = D; c.ldw = DIN; c.src = a.in[I_WIN] + (size_t)(kb * 256) * DIN + n0 + (n0 >= 3072 ? 16 : 0); c.dst = (bf16_t*)(ws + WS_WIN) + (size_t)n0 * D + kb * 256; return c; } r -= N_IN;
    if (r < N_A) { const int kb = r / 16, nb = r % 16; c.K = 1024; c.ldw = D; c.src = a.in[I_WBA] + (size_t)(kb * 256) * D + nb * 128; c.dst = (bf16_t*)(ws + WS_WA) + (size_t)(nb * 128) * 1024 + kb * 256; return c; } r -= N_A;
    if (r < N_A) { const int kb = r / 16, nb = r % 16; c.K = 1024; c.ldw = D; c.src = a.in[I_WBB] + (size_t)(kb * 256) * D + nb * 128; c.dst = (bf16_t*)(ws + WS_WB) + (size_t)(nb * 128) * 1024 + kb * 256; return c; } r -= N_A;
    if (r < N_O) { const int kb = r / 16, nb = r % 16; c.K = D; c.ldw = D; c.src = a.in[I_WOUT] + (size_t)(kb * 256) * D + nb * 128; c.dst = (bf16_t*)(ws + WS_WOUT) + (size_t)(nb * 128) * D + kb * 256; return c; } r -= N_O;
    const int e = r / (N_UP + N_DN); r -= e * (N_UP + N_DN);
    if (r < N_UP) { const int kb = r / 32, nb = r % 32, t = nb >> 1; c.K = D; c.ldw = 2 * D;
        c.src = a.in[I_WUP] + (size_t)e * D * (2 * D) + (size_t)(kb * 256) * (2 * D) + ((nb & 1) ? 2048 + 128 * t : 128 * t);
        c.dst = (bf16_t*)(ws + WS_WUP) + (size_t)e * (2 * D) * D + (size_t)(nb * 128) * D + kb * 256; return c; }
    r -= N_UP; { const int kb = r / 16, nb = r % 16; c.K = D; c.ldw = D; c.src = a.in[I_WDN] + (size_t)e * D * D + (size_t)(kb * 256) * D + nb * 128; c.dst = (bf16_t*)(ws + WS_WDN) + (size_t)e * D * D + (size_t)(nb * 128) * D + kb * 256; }
    return c;
}
constexpr int CVT_DENSE_ITEMS = 2 * 4 * 16 + 8 * 16;
__device__ __forceinline__ CvtItem cvt_decode_moe(const Args& a, unsigned char* ws, int e, int which, int j, int kb) {
    CvtItem c; c.K = D;
    if (which == 0) { const int t = j >> 1; c.ldw = 2 * D;
        c.src = a.in[I_WUP] + (size_t)e * D * (2 * D) + (size_t)(kb * 256) * (2 * D) + ((j & 1) ? 2048 + 128 * t : 128 * t);
        c.dst = (bf16_t*)(ws + WS_WUP) + (size_t)e * (2 * D) * D + (size_t)(j * 128) * D + kb * 256; }
    else { c.ldw = D; c.src = a.in[I_WDN] + (size_t)e * D * D + (size_t)(kb * 256) * D + j * 128; c.dst = (bf16_t*)(ws + WS_WDN) + (size_t)e * D * D + (size_t)(j * 128) * D + kb * 256; }
    return c;
}
__device__ __forceinline__ void cvt_load(const CvtItem& c, f32x4 (&v)[16], int wave, int lane) {
    const float* p = c.src + (size_t)(32 * wave + 16 * (lane >> 5)) * c.ldw + 4 * (lane & 31);
#pragma unroll
    for (int i = 0; i < 16; ++i) v[i] = __builtin_nontemporal_load((const f32x4*)(p + (size_t)i * c.ldw));
}
__device__ __forceinline__ void cvt_to_lds(const f32x4 (&v)[16], LAS unsigned char* buf, int wave, int lane) {
    const int n4 = lane & 31, hh = lane >> 5;
#pragma unroll
    for (int g = 0; g < 2; ++g)
#pragma unroll
        for (int j = 0; j < 4; ++j) {
            u32x4 o; o.x = pk2(v[8 * g + 0][j], v[8 * g + 1][j]); o.y = pk2(v[8 * g + 2][j], v[8 * g + 3][j]); o.z = pk2(v[8 * g + 4][j], v[8 * g + 5][j]); o.w = pk2(v[8 * g + 6][j], v[8 * g + 7][j]);
            *(LAS u32x4*)(buf + (4 * n4 + j) * CV_RS + (4 * wave + 2 * hh + g) * 16) = o; }
}
template <bool SC1>
__device__ __forceinline__ void cvt_store(const CvtItem& c, const LAS unsigned char* buf, int tid) {
#pragma unroll
    for (int i = 0; i < 8; ++i) { const int id = tid + 512 * i, row = id >> 5, ch = id & 31;
        const u32x4 v = *(const LAS u32x4*)(buf + row * CV_RS + ch * 16);
        if (SC1) store16_sc1(c.dst + (size_t)row * c.K + ch * 8, v); else *(u32x4*)(c.dst + (size_t)row * c.K + ch * 8) = v; }
}
template <bool SC1, class Dec>
__device__ __forceinline__ void cvt_stream(Frame& F, const Dec& dec, int first, int n, int step) {
    int it = first;
    if (it >= n) return;
    int tid = threadIdx.x; asm volatile("" : "+v"(tid));
    const int wave = __builtin_amdgcn_readfirstlane(tid >> 6), lane = tid & 63;
    f32x4 v[16];
    CvtItem cur = dec(it);
    cvt_load(cur, v, wave, lane);
    cvt_to_lds(v, F.lds, wave, lane);
    __syncthreads();
#pragma unroll 1
    for (int i = 0;; ++i) {
        const int nx = it + step; const bool has_next = nx < n;
        CvtItem nxt = cur;
        if (has_next) { nxt = dec(nx); cvt_load(nxt, v, wave, lane); }
        cvt_store<SC1>(cur, F.lds + (i & 1) * CV_BUF, tid);
        if (has_next) cvt_to_lds(v, F.lds + ((i + 1) & 1) * CV_BUF, wave, lane);
        __syncthreads();
        if (!has_next) break;
        cur = nxt; it = nx;
    }
}
constexpr int C8_RS = 272, C8_BUF = 128 * C8_RS;
struct Cvt8Item { const float* src; unsigned char* dst; int ldw; };
__device__ __forceinline__ Cvt8Item cvt8_decode(const Args& a, unsigned char* ws, int e, int which, int j, int kb) {
    Cvt8Item c;
    if (which == 0) { const int t = j >> 1; c.ldw = 2 * D;
        c.src = a.in[I_WUP] + (size_t)e * D * (2 * D) + (size_t)(kb * 256) * (2 * D) + ((j & 1) ? 2048 + 128 * t : 128 * t);
        c.dst = ws + WS_WUP + ((size_t)e * (2 * D) + (size_t)(j * 128)) * D + kb * 256; }
    else { c.ldw = D; c.src = a.in[I_WDN] + (size_t)e * D * D + (size_t)(kb * 256) * D + j * 128; c.dst = ws + WS_WDN + ((size_t)e * D + (size_t)(j * 128)) * D + kb * 256; }
    return c;
}
__device__ __forceinline__ void cvt8_load(const Cvt8Item& c, f32x4 (&v)[16], int wave, int lane) {
    const float* p = c.src + (size_t)(32 * wave + 16 * (lane >> 5)) * c.ldw + 4 * (lane & 31);
#pragma unroll
    for (int i = 0; i < 16; ++i) v[i] = __builtin_nontemporal_load((const f32x4*)(p + (size_t)i * c.ldw));
}
__device__ __forceinline__ void cvt8_to_lds(const f32x4 (&v)[16], LAS unsigned char* buf, int wave, int lane) {
    const int n4 = lane & 31, hh = lane >> 5;
#pragma unroll
    for (int j = 0; j < 4; ++j) {
        u32x4 o;
        o.x = pk4_fp8(v[0][j] * W8_SCALE, v[1][j] * W8_SCALE, v[2][j] * W8_SCALE, v[3][j] * W8_SCALE);
        o.y = pk4_fp8(v[4][j] * W8_SCALE, v[5][j] * W8_SCALE, v[6][j] * W8_SCALE, v[7][j] * W8_SCALE);
        o.z = pk4_fp8(v[8][j] * W8_SCALE, v[9][j] * W8_SCALE, v[10][j] * W8_SCALE, v[11][j] * W8_SCALE);
        o.w = pk4_fp8(v[12][j] * W8_SCALE, v[13][j] * W8_SCALE, v[14][j] * W8_SCALE, v[15][j] * W8_SCALE);
        *(LAS u32x4*)(buf + (4 * n4 + j) * C8_RS + (2 * wave + hh) * 16) = o; }
}
__device__ __forceinline__ void cvt8_store(const Cvt8Item& c, const LAS unsigned char* buf, int tid) {
#pragma unroll
    for (int i = 0; i < 4; ++i) { const int id = tid + 512 * i, row = id >> 4, ch = id & 15;
        store16_sc1(c.dst + (size_t)row * D + ch * 16, *(const LAS u32x4*)(buf + row * C8_RS + ch * 16)); }
}
__device__ __forceinline__ void cvt8_store_keep(const Cvt8Item& c, const LAS unsigned char* buf, int tid) {
#pragma unroll
    for (int i = 0; i < 4; ++i) { const int id = tid + 512 * i, row = id >> 4, ch = id & 15;
        *(u32x4*)(c.dst + (size_t)row * D + ch * 16) = *(const LAS u32x4*)(buf + row * C8_RS + ch * 16); }
}
template <bool SC1>
__device__ __forceinline__ void cvt8_store_t(const Cvt8Item& c, const LAS unsigned char* buf, int tid) {
#pragma unroll
    for (int i = 0; i < 4; ++i) { const int id = tid + 512 * i, row = id >> 4, ch = id & 15;
        const u32x4 v = *(const LAS u32x4*)(buf + row * C8_RS + ch * 16);
        if (SC1) store16_sc1(c.dst + (size_t)row * D + ch * 16, v); else __builtin_nontemporal_store(v, (u32x4*)(c.dst + (size_t)row * D + ch * 16)); }
}
__device__ __forceinline__ Cvt8Item cvt8_decode_lin(const Args& a, unsigned char* ws, int idx) {
    const int e = idx / 384; int r = idx - e * 384; int which = 0;
    if (r >= 256) { r -= 256; which = 1; }
    return cvt8_decode(a, ws, e, which, r >> 3, r & 7);
}
__device__ __forceinline__ void cvt8_all(Frame& F, const Args& a, unsigned char* ws) {
    constexpr int N = NE * 384;
    int it = F.vcu;
    if (it >= N) return;
    int tid = threadIdx.x; asm volatile("" : "+v"(tid));
    const int wave = __builtin_amdgcn_readfirstlane(tid >> 6), lane = tid & 63;
    f32x4 v[16];
    Cvt8Item cur = cvt8_decode_lin(a, ws, it);
    cvt8_load(cur, v, wave, lane);
    cvt8_to_lds(v, F.lds, wave, lane);
    __syncthreads();
#pragma unroll 1
    for (int i = 0;; ++i) {
        const int nx = it + F.G; const bool has_next = nx < N;
        Cvt8Item nxt = cur;
        if (has_next) { nxt = cvt8_decode_lin(a, ws, nx); cvt8_load(nxt, v, wave, lane); }
        cvt8_store_t<false>(cur, F.lds + (i & 1) * C8_BUF, tid);
        if (has_next) cvt8_to_lds(v, F.lds + ((i + 1) & 1) * C8_BUF, wave, lane);
        __syncthreads();
        if (!has_next) break;
        cur = nxt; it = nx;
    }
}
__device__ __forceinline__ void cvt8_item(Frame& F, const Args& a, int idx);
template <bool SC1>
__device__ __forceinline__ void cvt8_stream(Frame& F, const Args& a, unsigned char* ws, int e, int which, int j) {
    int tid = threadIdx.x; asm volatile("" : "+v"(tid));
    const int wave = __builtin_amdgcn_readfirstlane(tid >> 6), lane = tid & 63;
    f32x4 va[16], vb[16];
    Cvt8Item c0 = cvt8_decode(a, ws, e, which, j, 0), c1 = cvt8_decode(a, ws, e, which, j, 1);
    cvt8_load(c0, va, wave, lane);
    cvt8_load(c1, vb, wave, lane);
    __builtin_amdgcn_sched_barrier(0);
    cvt8_to_lds(va, F.lds, wave, lane);
    __syncthreads();
#pragma unroll
    for (int k = 0; k < 8; k += 2) {
        Cvt8Item c2 = c0, c3 = c1;
        __builtin_amdgcn_sched_barrier(0);
        if (k + 2 < 8) { c2 = cvt8_decode(a, ws, e, which, j, k + 2); cvt8_load(c2, va, wave, lane); }
        __builtin_amdgcn_sched_barrier(0);
        cvt8_store_t<SC1>(c0, F.lds, tid);
        __builtin_amdgcn_sched_barrier(0);
        cvt8_to_lds(vb, F.lds + C8_BUF, wave, lane);
        __syncthreads();
        __builtin_amdgcn_sched_barrier(0);
        if (k + 3 < 8) { c3 = cvt8_decode(a, ws, e, which, j, k + 3); cvt8_load(c3, vb, wave, lane); }
        __builtin_amdgcn_sched_barrier(0);
        cvt8_store_t<SC1>(c1, F.lds + C8_BUF, tid);
        __builtin_amdgcn_sched_barrier(0);
        if (k + 2 < 8) cvt8_to_lds(va, F.lds, wave, lane);
        __syncthreads();
        c0 = c2; c1 = c3;
    }
}
__device__ __forceinline__ void cvt8_win_sub(Frame& F, const Args& a, int q) {
    int tid = threadIdx.x; asm volatile("" : "+v"(tid));
    const int wave = __builtin_amdgcn_readfirstlane(tid >> 6), lane = tid & 63, j = q >> 3, kb = q & 7;
    Cvt8Item c; c.ldw = DIN; c.src = a.in[I_WIN] + (size_t)(kb * 256) * DIN + j * 128 + (j >= 24 ? 16 : 0); c.dst = F.ws + WS_WIN8 + (size_t)(j * 128) * D + kb * 256;
    f32x4 v[16];
    __syncthreads();
    cvt8_load(c, v, wave, lane);
    cvt8_to_lds(v, F.lds, wave, lane);
    __syncthreads();
    cvt8_store_keep(c, F.lds, tid);
    __syncthreads();
}
__device__ __forceinline__ void cvt8_wout_sub(Frame& F, const Args& a, int q) {
    int tid = threadIdx.x; asm volatile("" : "+v"(tid));
    const int wave = __builtin_amdgcn_readfirstlane(tid >> 6), lane = tid & 63, j = q >> 3, kb = q & 7;
    Cvt8Item c; c.ldw = D; c.src = a.in[I_WOUT] + (size_t)(kb * 256) * D + j * 128; c.dst = F.ws + WS_WOUT8 + (size_t)(j * 128) * D + kb * 256;
    f32x4 v[16];
    __syncthreads();
    cvt8_load(c, v, wave, lane);
    cvt8_to_lds(v, F.lds, wave, lane);
    __syncthreads();
    cvt8_store_keep(c, F.lds, tid);
    __syncthreads();
}
__device__ __forceinline__ void cvt8_wbr_sub(Frame& F, const Args& a, int q) {
    int tid = threadIdx.x; asm volatile("" : "+v"(tid));
    const int wave = __builtin_amdgcn_readfirstlane(tid >> 6), lane = tid & 63, which = q >> 6, j = (q >> 2) & 15, kb = q & 3;
    Cvt8Item c; c.ldw = D; c.src = (which ? a.in[I_WBB] : a.in[I_WBA]) + (size_t)(kb * 256) * D + j * 128; c.dst = F.ws + (which ? WS_WB : WS_WA) + (size_t)(j * 128) * 1024 + kb * 256;
    f32x4 v[16];
    __syncthreads();
    cvt8_load(c, v, wave, lane);
    cvt8_to_lds(v, F.lds, wave, lane);
    __syncthreads();
#pragma unroll
    for (int i = 0; i < 4; ++i) { const int id = tid + 512 * i, row = id >> 4, ch = id & 15;
        *(u32x4*)(c.dst + (size_t)row * 1024 + ch * 16) = *(const LAS u32x4*)(F.lds + row * C8_RS + ch * 16); }
    __syncthreads();
}
__device__ __forceinline__ void cvt8_item(Frame& F, const Args& a, int idx) {
    if (idx < 1024) cvt8_stream<false>(F, a, F.ws, idx >> 5, 0, idx & 31);
    else cvt8_stream<false>(F, a, F.ws, (idx - 1024) >> 4, 1, (idx - 1024) & 15);
}
__device__ __forceinline__ void cvt8_item_signal(Frame& F, const Args& a, int idx, unsigned* upd) {
    const int e = (idx - 1024) >> 4;
    cvt8_stream<true>(F, a, F.ws, e, 1, (idx - 1024) & 15);
    asm volatile("s_waitcnt vmcnt(0)" ::: "memory");
    __syncthreads();
    if (F.tid < 32) __hip_atomic_fetch_add(upd + (e * 32 + F.tid) * 16, 1u, __ATOMIC_RELAXED, __HIP_MEMORY_SCOPE_AGENT);
}
struct DenseDec { const Args* a; unsigned char* ws; __device__ __forceinline__ CvtItem operator()(int it) const { return cvt_decode(*a, ws, it); } };
struct MoeDec { const Args* a; unsigned char* ws; int e, which, j; __device__ __forceinline__ CvtItem operator()(int kb) const { return cvt_decode_moe(*a, ws, e, which, j, kb); } };
__device__ __forceinline__ void p0_prologue(Frame& F, const Args& a) {
    unsigned char* ws = F.ws;
    for (int it = F.wg; it < 192; it += F.G) p0_mod_partial(F, a.in[I_C], a.in[I_WADA], (float*)(ws + WS_MODP), it);
    for (int p = (F.G - 1 - F.wg) * 512 + F.tid; p < 4096 + 8192; p += F.G * 512) {
        if (p < 4096) p0_frag_item(a.in[I_WIN], DIN, GATE_COL, (bf16_t*)(ws + WS_WGF), p);
        else { const int q = p - 4096, ct = q >> 12; p0_frag_item(a.in[I_WR], NE, 16 * ct, (bf16_t*)(ws + WS_WRF) + (size_t)ct * 4096 * 8, q & 4095); }
    }
    __syncthreads();
    if (F.G != 256) { for (int q = F.vcu; q < 640; q += F.G) cvt8_win_sub(F, a, q); }
    if (F.G != 256) { for (int q = F.G - 1 - F.vcu; q < 256; q += F.G) { if (q < 128) cvt8_wout_sub(F, a, q); else cvt8_wbr_sub(F, a, q - 128); } }
}

constexpr int HL_STRIDE = 4112;
constexpr int HL_BYTES = 32 * HL_STRIDE;
constexpr int PART_OFF = 132096;
constexpr int LOGIT_OFF = PART_OFF + 8192;
constexpr int DST_OFF = LOGIT_OFF + 4096;

__device__ __forceinline__ f32x4 mod4(const float* modp, const float* b_ada, int b, int idx) {
    f32x4 s = *(const f32x4*)(b_ada + idx);
#pragma unroll
    for (int ks = 0; ks < 4; ++ks) s += *(const f32x4*)(modp + ((size_t)ks * 4 + b) * (6 * D) + idx);
    return s;
}
template <bool FROM_PARTIALS>
__device__ __forceinline__ void norm_rows_32(Frame& F, const float* xin, const float* gvec, const float* modsrc, const float* b_ada, int chunk_sh, int rb, bf16_t* gout, unsigned char* gout8 = nullptr) {
    const int b = rb >> 6; int lane = F.lane; asm volatile("" : "+v"(lane));
    f32x4 xa[8], xb[8];
    const float* xr = xin + ((size_t)rb * 32 + 4 * F.wave) * D + 4 * lane;
#pragma unroll
    for (int j = 0; j < 8; ++j) xa[j] = *(const f32x4*)(xr + 256 * j);
#pragma unroll
    for (int j = 0; j < 8; ++j) xb[j] = *(const f32x4*)(xr + D + 256 * j);
    f32x4 xc[8], xd[8];
    if (!FROM_PARTIALS) {
#pragma unroll
        for (int j = 0; j < 8; ++j) xc[j] = *(const f32x4*)(xr + 2 * D + 256 * j);
#pragma unroll
        for (int j = 0; j < 8; ++j) xd[j] = *(const f32x4*)(xr + 3 * D + 256 * j);
    }
    f32x4 gsc[8], shv[8];
#pragma unroll
    for (int j = 0; j < 8; ++j) {
        const int col = 4 * (lane + 64 * j);
        f32x4 sh, sc;
        if (FROM_PARTIALS) { sh = mod4(modsrc, b_ada, b, chunk_sh * D + col); sc = mod4(modsrc, b_ada, b, (chunk_sh + 1) * D + col); }
        else { sh = *(const f32x4*)(modsrc + (size_t)b * (6 * D) + chunk_sh * D + col); sc = *(const f32x4*)(modsrc + (size_t)b * (6 * D) + (chunk_sh + 1) * D + col); }
        const f32x4 g = *(const f32x4*)(gvec + col);
        gsc[j] = g * (sc + 1.0f); shv[j] = sh;
        if (j & 1) __builtin_amdgcn_sched_barrier(0);
    }
#pragma unroll
    for (int i = 0; i < 4; ++i) {
        const int r = 4 * F.wave + i; const size_t row = (size_t)rb * 32 + r;
        f32x4 xv[8]; float ss = 0.f;
#pragma unroll
        for (int j = 0; j < 8; ++j) { xv[j] = FROM_PARTIALS ? ((i & 1) ? xb[j] : xa[j]) : (i == 0 ? xa[j] : i == 1 ? xb[j] : i == 2 ? xc[j] : xd[j]); ss += (xv[j][0] * xv[j][0] + xv[j][1] * xv[j][1]) + (xv[j][2] * xv[j][2] + xv[j][3] * xv[j][3]); }
        if (FROM_PARTIALS && i < 2) {
#pragma unroll
            for (int j = 0; j < 8; ++j) { const f32x4 nx = *(const f32x4*)(xr + (size_t)(i + 2) * D + 256 * j); if (i & 1) xb[j] = nx; else xa[j] = nx; }
        }
        __builtin_amdgcn_sched_barrier(0);
        const float rinv = rsqrtf(wave_sum(ss) * (1.0f / D) + EPS);
        int ls = lane; asm volatile("" : "+v"(ls));
        const size_t so = row * D + 4 * (size_t)ls;
#pragma unroll
        for (int j = 0; j < 8; ++j) {
            const f32x4 hv = xv[j] * rinv * gsc[j] + shv[j];
            u32x2 p; p.x = pk2(hv[0], hv[1]); p.y = pk2(hv[2], hv[3]);
            *(LAS u32x2*)(F.lds + r * HL_STRIDE + 8 * ls + 512 * j) = p;
            if (gout) *(u32x2*)(gout + so + 256 * j) = p;
            if (gout8) *(unsigned*)(gout8 + so + 256 * j) = pk4_fp8(hv[0], hv[1], hv[2], hv[3]);
        }
        __builtin_amdgcn_sched_barrier(0);
    }
}
__device__ __forceinline__ void norm_rows_32_b(Frame& F, const bf16_t* xin, const float* gvec, const float* modsrc, int chunk_sh, int rb) {
    const int b = rb >> 6; int lane = F.lane; asm volatile("" : "+v"(lane));
    u32x2 xr_[4][8];
    const bf16_t* xr = xin + ((size_t)rb * 32 + 4 * F.wave) * D + 4 * lane;
#pragma unroll
    for (int i = 0; i < 4; ++i)
#pragma unroll
        for (int j = 0; j < 8; ++j) xr_[i][j] = *(const u32x2*)(xr + (size_t)i * D + 256 * j);
    f32x4 gsc[8], shv[8];
#pragma unroll
    for (int j = 0; j < 8; ++j) {
        const int col = 4 * (lane + 64 * j);
        const f32x4 sh = *(const f32x4*)(modsrc + (size_t)b * (6 * D) + chunk_sh * D + col), sc = *(const f32x4*)(modsrc + (size_t)b * (6 * D) + (chunk_sh + 1) * D + col);
        const f32x4 g = *(const f32x4*)(gvec + col);
        gsc[j] = g * (sc + 1.0f); shv[j] = sh;
    }
#pragma unroll
    for (int i = 0; i < 4; ++i) {
        const int r = 4 * F.wave + i;
        f32x4 xv[8]; float ss = 0.f;
#pragma unroll
        for (int j = 0; j < 8; ++j) { const u32x2 q = xr_[i][j]; xv[j] = (f32x4){bf_lo(q.x), bf_hi(q.x), bf_lo(q.y), bf_hi(q.y)}; ss += (xv[j][0] * xv[j][0] + xv[j][1] * xv[j][1]) + (xv[j][2] * xv[j][2] + xv[j][3] * xv[j][3]); }
        const float rinv = rsqrtf(wave_sum(ss) * (1.0f / D) + EPS);
#pragma unroll
        for (int j = 0; j < 8; ++j) {
            const f32x4 hv = xv[j] * rinv * gsc[j] + shv[j];
            u32x2 p; p.x = pk2(hv[0], hv[1]); p.y = pk2(hv[2], hv[3]);
            *(LAS u32x2*)(F.lds + r * HL_STRIDE + 8 * lane + 512 * j) = p;
        }
    }
}
__device__ __forceinline__ void p1_rows(Frame& F, const Args& a) {
    unsigned char* ws = F.ws;
    const float* modp = (const float*)(ws + WS_MODP);
    { float* modf = (float*)(ws + WS_MODF);
      for (int i = F.wg * 512 + F.tid; i < NB * 6 * D; i += F.G * 512) { const int b = i / (6 * D), idx = i % (6 * D); float s = a.in[I_BADA][idx];
#pragma unroll
          for (int ks = 0; ks < 4; ++ks) s += modp[((size_t)ks * 4 + b) * (6 * D) + idx];
          modf[i] = s; } }
    if (F.wg == 0 && F.wave == 0) {
        float mq = fmaxf(fabsf(a.in[I_GQ][2 * F.lane]), fabsf(a.in[I_GQ][2 * F.lane + 1])), mk = fmaxf(fabsf(a.in[I_GK][2 * F.lane]), fabsf(a.in[I_GK][2 * F.lane + 1]));
#pragma unroll
        for (int o = 1; o < 64; o <<= 1) { mq = fmaxf(mq, __shfl_xor(mq, o)); mk = fmaxf(mk, __shfl_xor(mk, o)); }
        if (F.lane == 0) ((float*)F.ctl)[CW_MISC] = 16.3223f * 1.01f * mq * mk;
    }
    const bf16_t* wgf = (const bf16_t*)(ws + WS_WGF);
    float* gates = (float*)(ws + WS_GATES);
    LAS float* part = (LAS float*)(F.lds + PART_OFF);
    const int lane = F.lane, l15 = lane & 15, g4 = lane >> 4;
    for (int rb = F.wg; rb < T / 32; rb += F.G) {
        norm_rows_32<true>(F, a.in[I_X], a.in[I_GMIX], modp, a.in[I_BADA], 0, rb, nullptr, ws + WS_HBUF8);
        { const int rg = F.wave & 1, kq = F.wave >> 1; f32x4 acc = {0.f, 0.f, 0.f, 0.f};
          bf16x8 bvv[16];
          __builtin_amdgcn_sched_barrier(0);
          const bf16_t* wq = wgf + ((size_t)(16 * kq) * 64 + lane) * 8; asm volatile("" : "+v"(wq));
#pragma unroll
          for (int s = 0; s < 16; ++s) bvv[s] = *(const bf16x8*)(wq + (size_t)s * 512);
          __syncthreads();
#pragma unroll
          for (int s = 0; s < 16; ++s) { const int ks = 16 * kq + s;
              const bf16x8 av = *(const LAS bf16x8*)(F.lds + (16 * rg + l15) * HL_STRIDE + (32 * ks + 8 * g4) * 2);
              acc = __builtin_amdgcn_mfma_f32_16x16x32_bf16(av, bvv[s], acc, 0, 0, 0); }
#pragma unroll
          for (int r = 0; r < 4; ++r) part[(kq * 2 + rg) * 256 + (4 * g4 + r) * 16 + l15] = acc[r]; }
        __syncthreads();
        { const int rg = F.tid >> 8, rc = F.tid & 255; float s = 0.f;
#pragma unroll
          for (int kq = 0; kq < 4; ++kq) s += part[(kq * 2 + rg) * 256 + rc];
          gates[((size_t)rb * 32 + 16 * rg + (rc >> 4)) * 16 + (rc & 15)] = s; }
        __syncthreads();
    }
    if (F.G == 256) { for (int q = F.G - 1 - F.vcu; q < 640; q += F.G) cvt8_win_sub(F, a, q); }
}

__device__ __forceinline__ void p3_qknorm(Frame& F, const Args& a) {
    bf16_t* z = (bf16_t*)(F.ws + WS_Z); float* kmean = (float*)(F.ws + WS_KMEAN);
    LAS float* cs = (LAS float*)F.lds;
    const int lane = F.lane;
    for (int u = F.wg; u < 512; u += F.G) {
        const int which = u & 1, h = (u >> 1) & 7, blk = (u >> 4) & 7, b = u >> 7;
        const float* gv = which ? a.in[I_GK] : a.in[I_GQ];
        const float g0 = gv[2 * lane], g1 = gv[2 * lane + 1];
        bf16_t* base = z + ((size_t)b * SEQ + blk * 256 + 32 * F.wave) * ZP + (which ? ZKB : ZQB) + h * 128 + 2 * lane;
        unsigned v[32];
#pragma unroll
        for (int i = 0; i < 32; ++i) v[i] = *(const unsigned*)(base + (size_t)i * ZP);
        float c0 = 0.f, c1 = 0.f;
#pragma unroll
        for (int i = 0; i < 32; ++i) {
            const float f0 = bf_lo(v[i]), f1 = bf_hi(v[i]);
            const float rinv = rsqrtf(wave_sum(f0 * f0 + f1 * f1) * (1.0f / 128.0f) + EPS);
            const float y0 = f0 * rinv * g0, y1 = f1 * rinv * g1;
            *(unsigned*)(base + (size_t)i * ZP) = pk2(y0, y1);
            c0 += y0; c1 += y1;
        }
        if (which) {
            cs[F.wave * 128 + 2 * lane] = c0; cs[F.wave * 128 + 2 * lane + 1] = c1;
            __syncthreads();
            if (F.tid < 128) { float s = 0.f;
#pragma unroll
                for (int w = 0; w < 8; ++w) s += cs[w * 128 + F.tid];
                kmean[(((size_t)b * 8 + h) * 8 + blk) * 128 + F.tid] = s * (1.0f / 256.0f); }
            __syncthreads();
        }
    }
}

__device__ __forceinline__ s16x4 tr16(LAS unsigned char* p) { return __builtin_amdgcn_ds_read_tr16_b64_v4i16((LAS s16x4*)p); }
__device__ __forceinline__ bf16x8 cat8(s16x4 a, s16x4 b) { return (bf16x8){a[0], a[1], a[2], a[3], b[0], b[1], b[2], b[3]}; }
#define MFMA16(a, b, c) __builtin_amdgcn_mfma_f32_16x16x32_bf16((a), (b), (c), 0, 0, 0)

struct ChunkGates { float li, bcs, u, pmx, g, umax; };
__device__ __forceinline__ ChunkGates chunk_gates(float gi_raw, float gf_raw, float bi, float bfg, int lane) {
    ChunkGates G;
    const float ti = __expf((gi_raw + bi) * (2.0f / 15.0f)), tf = __expf((gf_raw + bfg) * (2.0f / 15.0f));
    G.li = 15.0f - 30.0f * __builtin_amdgcn_rcpf(ti + 1.0f);
    const float xf = 15.0f - 30.0f * __builtin_amdgcn_rcpf(tf + 1.0f);
    const float lf = fminf(xf, 0.f) - __logf(1.0f + __expf(-fabsf(xf)));
    float bcs = lf;
#pragma unroll
    for (int o = 1; o < 64; o <<= 1) { const float t = __shfl_up(bcs, o); if (lane >= o) bcs += t; }
    G.bcs = bcs; G.g = __shfl(bcs, 63); G.u = G.li - bcs;
    float pmx = G.u;
#pragma unroll
    for (int o = 1; o < 64; o <<= 1) { const float t = __shfl_up(pmx, o); if (lane >= o) pmx = fmaxf(pmx, t); }
    G.pmx = pmx; G.umax = __shfl(pmx, 63);
    return G;
}
constexpr int ML_QS = 0, ML_KS = 9216, ML_KW = 18432, ML_VS = 27648, ML_SB = 45056, ML_CB = 54272, ML_HO = 72704, ML_FLO = 90112, ML_RS = 144, ML_VR = 272;

struct PassAIn { u32x4 kv, v0, v1; float gi, gf; };
__device__ __forceinline__ PassAIn mlstm_passA_load(Frame& F, int u) {
    const bf16_t* z = (const bf16_t*)(F.ws + WS_Z); const float* gates = (const float*)(F.ws + WS_GATES);
    const int c = u & 31, h = (u >> 5) & 7, b = u >> 8;
    const size_t tok0 = (size_t)b * SEQ + c * 64;
    const int lr = F.tid >> 3, ls = F.tid & 7;
    const bf16_t* zr = z + (tok0 + lr) * ZP;
    PassAIn I;
    I.kv = *(const u32x4*)(zr + ZKA + h * 64 + ls * 8);
    I.v0 = *(const u32x4*)(zr + ZVA + h * 128 + ls * 8); I.v1 = *(const u32x4*)(zr + ZVA + h * 128 + 64 + ls * 8);
    I.gi = gates[(tok0 + F.lane) * 16 + h]; I.gf = gates[(tok0 + F.lane) * 16 + 8 + h];
    return I;
}
__device__ __forceinline__ void mlstm_passA(Frame& F, const Args& a, int u, const PassAIn& I) {
    LAS unsigned char* L = F.lds; LAS float* fl = (LAS float*)(L + ML_FLO);
    float* cloc = (float*)(F.ws + WS_CLOC) + (size_t)u * 8192; float* nloc = (float*)(F.ws + WS_NLOC) + (size_t)u * 64; float* msc = (float*)(F.ws + WS_MSC) + (size_t)u * 4;
    const int tid = F.tid, lane = F.lane, w = F.wave, l15 = lane & 15, g4 = lane >> 4;
    const int h = (u >> 5) & 7;
    const int lr = tid >> 3, ls = tid & 7;
    const u32x4 kv = I.kv, v0 = I.v0, v1 = I.v1;
    __syncthreads();
    if (w == 0) {
        const ChunkGates G = chunk_gates(I.gi, I.gf, a.in[I_BIG][h], a.in[I_BFG][h], lane);
        fl[256 + lane] = __expf(G.u - G.umax);
        if (lane == 0) { msc[0] = G.g + G.umax; msc[1] = G.g; }
    }
    *(LAS u32x4*)(L + ML_VS + lr * ML_VR + ls * 16) = v0; *(LAS u32x4*)(L + ML_VS + lr * ML_VR + 128 + ls * 16) = v1;
    __syncthreads();
    { const float wr_ = fl[256 + lr];
      u32x4 o; o.x = pk2(bf_lo(kv.x) * wr_, bf_hi(kv.x) * wr_); o.y = pk2(bf_lo(kv.y) * wr_, bf_hi(kv.y) * wr_); o.z = pk2(bf_lo(kv.z) * wr_, bf_hi(kv.z) * wr_); o.w = pk2(bf_lo(kv.w) * wr_, bf_hi(kv.w) * wr_);
      *(LAS u32x4*)(L + ML_KW + lr * ML_RS + ls * 16) = o; }
    __syncthreads();
    f32x4 Cacc[4];
#pragma unroll
    for (int et = 0; et < 4; ++et) Cacc[et] = (f32x4){0.f, 0.f, 0.f, 0.f};
#pragma unroll
    for (int ks = 0; ks < 2; ++ks) {
        LAS unsigned char* vp = L + ML_VS + (32 * ks + 8 * g4 + (l15 >> 2)) * ML_VR + (16 * w + 4 * (l15 & 3)) * 2;
        const bf16x8 av = cat8(tr16(vp), tr16(vp + 4 * ML_VR));
#pragma unroll
        for (int et = 0; et < 4; ++et) {
            LAS unsigned char* kp = L + ML_KW + (32 * ks + 8 * g4 + (l15 >> 2)) * ML_RS + (16 * et + 4 * (l15 & 3)) * 2;
            Cacc[et] = MFMA16(av, cat8(tr16(kp), tr16(kp + 4 * ML_RS)), Cacc[et]); } }
#pragma unroll
    for (int et = 0; et < 4; ++et)
#pragma unroll
        for (int r = 0; r < 4; ++r) cloc[(16 * w + 4 * g4 + r) * 64 + 16 * et + l15] = Cacc[et][r];
    { const int e = tid >> 3, part = tid & 7; float sacc = 0.f;
#pragma unroll
      for (int i = 0; i < 8; ++i) sacc += bf1(*(const LAS bf16_t*)(L + ML_KW + (8 * part + i) * ML_RS + e * 2));
      sacc = sum8_(sacc);
      if (part == 0) nloc[e] = sacc; }
}

__device__ __forceinline__ void mlstm_passA4(Frame& F, const Args& a) {
    constexpr int CH = 27648, VS = 0, KW = 17408, FL = 26624;
    const bf16_t* z = (const bf16_t*)(F.ws + WS_Z); const float* gates = (const float*)(F.ws + WS_GATES);
    int tid = F.tid; asm volatile("" : "+v"(tid));
    const int lane = tid & 63, w = F.wave, l15 = lane & 15, g4 = lane >> 4, lr = tid >> 3, ls = tid & 7;
    u32x4 kv[4], v0[4], v1[4]; float gi[4], gf[4];
#pragma unroll
    for (int k = 0; k < 4; ++k) {
        const int u = F.wg + 256 * k, c = u & 31, h = (u >> 5) & 7, b = u >> 8;
        const size_t tok0 = (size_t)b * SEQ + c * 64;
        const bf16_t* zr = z + (tok0 + lr) * ZP;
        kv[k] = *(const u32x4*)(zr + ZKA + h * 64 + ls * 8);
        v0[k] = *(const u32x4*)(zr + ZVA + h * 128 + ls * 8); v1[k] = *(const u32x4*)(zr + ZVA + h * 128 + 64 + ls * 8);
        gi[k] = gates[(tok0 + lane) * 16 + h]; gf[k] = gates[(tok0 + lane) * 16 + 8 + h];
    }
    __syncthreads();
#pragma unroll
    for (int k = 0; k < 4; ++k) {
        const int u = F.wg + 256 * k, h = (u >> 5) & 7;
        LAS unsigned char* L = F.lds + k * CH; LAS float* fl = (LAS float*)(L + FL);
        if (w == k) {
            const ChunkGates G = chunk_gates(gi[k], gf[k], a.in[I_BIG][h], a.in[I_BFG][h], lane);
            fl[lane] = __expf(G.u - G.umax);
            if (lane == 0) { float* msc = (float*)(F.ws + WS_MSC) + (size_t)u * 4; msc[0] = G.g + G.umax; msc[1] = G.g; }
        }
        *(LAS u32x4*)(L + VS + lr * ML_VR + ls * 16) = v0[k]; *(LAS u32x4*)(L + VS + lr * ML_VR + 128 + ls * 16) = v1[k];
    }
    __syncthreads();
#pragma unroll
    for (int k = 0; k < 4; ++k) {
        LAS unsigned char* L = F.lds + k * CH; const LAS float* fl = (const LAS float*)(L + FL);
        const float wr_ = fl[lr]; const u32x4 q = kv[k];
        u32x4 o; o.x = pk2(bf_lo(q.x) * wr_, bf_hi(q.x) * wr_); o.y = pk2(bf_lo(q.y) * wr_, bf_hi(q.y) * wr_); o.z = pk2(bf_lo(q.z) * wr_, bf_hi(q.z) * wr_); o.w = pk2(bf_lo(q.w) * wr_, bf_hi(q.w) * wr_);
        *(LAS u32x4*)(L + KW + lr * ML_RS + ls * 16) = o;
    }
    __syncthreads();
#pragma unroll
    for (int k = 0; k < 4; ++k) {
        const int u = F.wg + 256 * k;
        LAS unsigned char* L = F.lds + k * CH;
        float* cloc = (float*)(F.ws + WS_CLOC) + (size_t)u * 8192; float* nloc = (float*)(F.ws + WS_NLOC) + (size_t)u * 64;
        f32x4 Cacc[4];
#pragma unroll
        for (int et = 0; et < 4; ++et) Cacc[et] = (f32x4){0.f, 0.f, 0.f, 0.f};
#pragma unroll
        for (int ks = 0; ks < 2; ++ks) {
            LAS unsigned char* vp = L + VS + (32 * ks + 8 * g4 + (l15 >> 2)) * ML_VR + (16 * w + 4 * (l15 & 3)) * 2;
            const bf16x8 av = cat8(tr16(vp), tr16(vp + 4 * ML_VR));
#pragma unroll
            for (int et = 0; et < 4; ++et) {
                LAS unsigned char* kp = L + KW + (32 * ks + 8 * g4 + (l15 >> 2)) * ML_RS + (16 * et + 4 * (l15 & 3)) * 2;
                Cacc[et] = MFMA16(av, cat8(tr16(kp), tr16(kp + 4 * ML_RS)), Cacc[et]); } }
#pragma unroll
        for (int et = 0; et < 4; ++et)
#pragma unroll
            for (int r = 0; r < 4; ++r) cloc[(16 * w + 4 * g4 + r) * 64 + 16 * et + l15] = Cacc[et][r];
        { const int e = tid >> 3, part = tid & 7; float sacc = 0.f;
#pragma unroll
          for (int i = 0; i < 8; ++i) sacc += bf1(*(const LAS bf16_t*)(L + KW + (8 * part + i) * ML_RS + e * 2));
          sacc = sum8_(sacc);
          if (part == 0) nloc[e] = sacc; }
    }
}

__device__ __forceinline__ void mlstm_passB(Frame& F, int item) {
    const int bh = item >> 3, slice = item & 7, tid = F.tid;
    const float* cloc = (const float*)(F.ws + WS_CLOC) + (size_t)bh * 32 * 8192 + slice * 1024 + 2 * tid;
    bf16_t* cin = (bf16_t*)(F.ws + WS_CIN) + (size_t)bh * 32 * 8192 + slice * 1024 + 2 * tid;
    const float* nloc = (const float*)(F.ws + WS_NLOC) + (size_t)bh * 32 * 64 + 2 * tid;
    float* nin = (float*)(F.ws + WS_NIN) + (size_t)bh * 32 * 64 + 2 * tid;
    float* msc = (float*)(F.ws + WS_MSC) + (size_t)bh * 32 * 4;
    const bool do_n = (slice == 0) && (tid < 32);
    f32x2 cl[32], nl[32], mg[32];
#pragma unroll
    for (int c = 0; c < 32; ++c) { cl[c] = *(const f32x2*)(cloc + (size_t)c * 8192); nl[c] = do_n ? *(const f32x2*)(nloc + c * 64) : (f32x2){0.f, 0.f}; mg[c] = *(const f32x2*)(msc + c * 4); }
    __builtin_amdgcn_sched_barrier(0);
    float m = 0.f; f32x2 C = {0.f, 0.f}, N = {0.f, 0.f};
#pragma unroll
    for (int c = 0; c < 32; ++c) {
        *(unsigned*)(cin + (size_t)c * 8192) = pk2(C[0], C[1]);
        if (do_n) *(f32x2*)(nin + c * 64) = N;
        if (slice == 0 && tid == 0) msc[c * 4 + 2] = m;
        const float mloc = mg[c][0], g = mg[c][1];
        const float m_new = fmaxf(g + m, mloc), sp = __expf(g + m - m_new), sl = __expf(mloc - m_new);
        C = C * sp + cl[c] * sl; N = N * sp + nl[c] * sl; m = m_new;
    }
}

__device__ __forceinline__ void mlstm_passC(Frame& F, const Args& a, int u) {
    constexpr int QS = ML_QS, KS = ML_KS, VS = ML_VS, SB = ML_SB, CB = ML_CB, HO = ML_HO, RS = ML_RS, VR = ML_VR;
    LAS unsigned char* L = F.lds; LAS float* fl = (LAS float*)(L + ML_FLO);
    const bf16_t* z = (const bf16_t*)(F.ws + WS_Z); const float* gates = (const float*)(F.ws + WS_GATES);
    unsigned char* hm = F.ws + WS_HM;
    int tid = F.tid; asm volatile("" : "+v"(tid));
    const int lane = tid & 63, w = F.wave, l15 = lane & 15, g4 = lane >> 4;
    const int c = u & 31, h = (u >> 5) & 7, b = u >> 8;
    const float* gmo = a.in[I_GMO] + h * 128;
    const size_t tok0 = (size_t)b * SEQ + c * 64;
    const int lr = tid >> 3, ls = tid & 7, jt = w & 3, hf = w >> 2;
    const bf16_t* zr = z + (tok0 + lr) * ZP;
    const u32x4 qv = *(const u32x4*)(zr + ZQA + h * 64 + ls * 8), kv = *(const u32x4*)(zr + ZKA + h * 64 + ls * 8);
    const u32x4 v0 = *(const u32x4*)(zr + ZVA + h * 128 + ls * 8), v1 = *(const u32x4*)(zr + ZVA + h * 128 + 64 + ls * 8);
    const u32x4 oc0 = *(const u32x4*)(zr + ZOA + h * 128 + ls * 16), oc1 = *(const u32x4*)(zr + ZOA + h * 128 + ls * 16 + 8);
    const bf16_t* cin = (const bf16_t*)(F.ws + WS_CIN) + (size_t)u * 8192;
    const u32x4 c0 = *(const u32x4*)(cin + tid * 8), c1 = *(const u32x4*)(cin + 4096 + tid * 8);
    const float* msc = (const float*)(F.ws + WS_MSC) + (size_t)u * 4;
    const float mstate = msc[2], gi_raw = gates[(tok0 + lane) * 16 + h], gf_raw = gates[(tok0 + lane) * 16 + 8 + h], big = a.in[I_BIG][h], bfg = a.in[I_BFG][h];
    const float nin_l = ((const float*)(F.ws + WS_NIN))[(size_t)u * 64 + lane];
    float gmo_r[4];
#pragma unroll
    for (int d4 = 0; d4 < 4; ++d4) gmo_r[d4] = gmo[16 * (4 * hf + d4) + l15];
    __syncthreads();
    if (w == 0) {
        const ChunkGates G = chunk_gates(gi_raw, gf_raw, big, bfg, lane);
        const float M = fmaxf(mstate, G.pmx);
        fl[lane] = -M; fl[64 + lane] = G.u; fl[128 + lane] = __expf(mstate - M); fl[192 + lane] = __expf(-(G.bcs + M));
    }
    if (w == 1) fl[640 + lane] = nin_l;
    *(LAS u32x4*)(L + QS + lr * RS + ls * 16) = qv; *(LAS u32x4*)(L + KS + lr * RS + ls * 16) = kv;
    *(LAS u32x4*)(L + VS + lr * VR + ls * 16) = v0; *(LAS u32x4*)(L + VS + lr * VR + 128 + ls * 16) = v1;
    *(LAS u32x4*)(L + CB + lr * RS + ls * 16) = c0; *(LAS u32x4*)(L + CB + (64 + lr) * RS + ls * 16) = c1;
    __syncthreads();
    { const LAS float* nv = fl + 640 + ls * 8;
      float s = bf_lo(qv.x) * nv[0] + bf_hi(qv.x) * nv[1] + bf_lo(qv.y) * nv[2] + bf_hi(qv.y) * nv[3] + bf_lo(qv.z) * nv[4] + bf_hi(qv.z) * nv[5] + bf_lo(qv.w) * nv[6] + bf_hi(qv.w) * nv[7];
      s = sum8_(s);
      if (ls == 0) fl[320 + lr] = s * 0.125f; }
    { bf16x8 aq[2];
#pragma unroll
      for (int ks = 0; ks < 2; ++ks) aq[ks] = *(const LAS bf16x8*)(L + QS + (16 * jt + l15) * RS + (32 * ks + 8 * g4) * 2);
      float rsum[4] = {0.f, 0.f, 0.f, 0.f};
#pragma unroll
      for (int st2 = 0; st2 < 2; ++st2) { const int st = 2 * hf + st2; f32x4 s = {0.f, 0.f, 0.f, 0.f};
          if (st <= jt) {
#pragma unroll
              for (int ks = 0; ks < 2; ++ks) { const bf16x8 bk = *(const LAS bf16x8*)(L + KS + (16 * st + l15) * RS + (32 * ks + 8 * g4) * 2); s = MFMA16(aq[ks], bk, s); } }
          const int scol = 16 * st + l15; const float cf = fl[64 + scol];
#pragma unroll
          for (int r = 0; r < 4; ++r) { const int j = 16 * jt + 4 * g4 + r;
              const float val = (scol <= j) ? s[r] * 0.125f * __expf(fl[j] + cf) : 0.f; rsum[r] += val;
              *(LAS bf16_t*)(L + SB + j * RS + scol * 2) = f2bf(val); } }
#pragma unroll
      for (int r = 0; r < 4; ++r) { float t = sum16_(rsum[r]);
          if (l15 == 0) fl[384 + hf * 64 + 16 * jt + 4 * g4 + r] = t; } }
    __syncthreads();
    float hv[4][4];
    { bf16x8 as_[2], aq[2];
#pragma unroll
      for (int ks = 0; ks < 2; ++ks) { as_[ks] = *(const LAS bf16x8*)(L + SB + (16 * jt + l15) * RS + (32 * ks + 8 * g4) * 2); aq[ks] = *(const LAS bf16x8*)(L + QS + (16 * jt + l15) * RS + (32 * ks + 8 * g4) * 2); }
      float si[4], dn[4], en[4], ss[4] = {0.f, 0.f, 0.f, 0.f};
#pragma unroll
      for (int r = 0; r < 4; ++r) { const int j = 16 * jt + 4 * g4 + r; si[r] = fl[128 + j]; dn[r] = fl[384 + j] + fl[448 + j] + si[r] * fl[320 + j]; en[r] = fl[192 + j]; si[r] *= 0.125f; }
#pragma unroll
      for (int d4 = 0; d4 < 4; ++d4) { const int dt = 4 * hf + d4; f32x4 nacc = {0.f, 0.f, 0.f, 0.f}, iacc = nacc;
#pragma unroll
          for (int ks = 0; ks < 2; ++ks) {
              LAS unsigned char* vp = L + VS + (32 * ks + 8 * g4 + (l15 >> 2)) * VR + (16 * dt + 4 * (l15 & 3)) * 2;
              nacc = MFMA16(as_[ks], cat8(tr16(vp), tr16(vp + 4 * VR)), nacc);
              const bf16x8 bc = *(const LAS bf16x8*)(L + CB + (16 * dt + l15) * RS + (32 * ks + 8 * g4) * 2);
              iacc = MFMA16(aq[ks], bc, iacc); }
#pragma unroll
          for (int r = 0; r < 4; ++r) { const float num = nacc[r] + si[r] * iacc[r]; const float hvv = num * __builtin_amdgcn_rcpf(fmaxf(fabsf(dn[r]), en[r])); hv[d4][r] = hvv; ss[r] += hvv * hvv; } }
#pragma unroll
      for (int r = 0; r < 4; ++r) { float t = sum16_(ss[r]);
          if (l15 == 0) fl[512 + hf * 64 + 16 * jt + 4 * g4 + r] = t; } }
    __syncthreads();
    { float rinv[4];
#pragma unroll
      for (int r = 0; r < 4; ++r) { const int j = 16 * jt + 4 * g4 + r; rinv[r] = rsqrtf((fl[512 + j] + fl[576 + j]) * (1.0f / 128.0f) + EPS); }
#pragma unroll
      for (int d4 = 0; d4 < 4; ++d4) { const int d = 16 * (4 * hf + d4) + l15; const float gg = gmo_r[d4];
#pragma unroll
          for (int r = 0; r < 4; ++r) *(LAS bf16_t*)(L + HO + (16 * jt + 4 * g4 + r) * VR + d * 2) = f2bf(hv[d4][r] * rinv[r] * gg); } }
    __syncthreads();
    { const u32x4 h0 = *(const LAS u32x4*)(L + HO + lr * VR + ls * 32), h1 = *(const LAS u32x4*)(L + HO + lr * VR + ls * 32 + 16);
#define HG(hw, ow, lo) ((lo ? bf_lo(hw) : bf_hi(hw)) * sigmoidf_(lo ? bf_lo(ow) : bf_hi(ow)) * H8_SCALE)
      u32x4 r;
      r.x = pk4_fp8(HG(h0.x, oc0.x, 1), HG(h0.x, oc0.x, 0), HG(h0.y, oc0.y, 1), HG(h0.y, oc0.y, 0));
      r.y = pk4_fp8(HG(h0.z, oc0.z, 1), HG(h0.z, oc0.z, 0), HG(h0.w, oc0.w, 1), HG(h0.w, oc0.w, 0));
      r.z = pk4_fp8(HG(h1.x, oc1.x, 1), HG(h1.x, oc1.x, 0), HG(h1.y, oc1.y, 1), HG(h1.y, oc1.y, 0));
      r.w = pk4_fp8(HG(h1.z, oc1.z, 1), HG(h1.z, oc1.z, 0), HG(h1.w, oc1.w, 1), HG(h1.w, oc1.w, 0));
#undef HG
      *(u32x4*)(hm + (tok0 + lr) * 1024 + h * 128 + ls * 16) = r; }
}

__device__ __forceinline__ void mlstm_passC2(Frame& F, const Args& a, int ua, int ub) {
    constexpr int QS = 0, KS = 9216, VS = 18432, SB = 35840, CB = 45056, HO = 0, FLO = 63488, CH = 66560, RS = ML_RS, VR = ML_VR;
    const bf16_t* z = (const bf16_t*)(F.ws + WS_Z); const float* gates = (const float*)(F.ws + WS_GATES);
    unsigned char* hm = F.ws + WS_HM;
    int tid = F.tid; asm volatile("" : "+v"(tid));
    const int lane = tid & 63, w = F.wave, l15 = lane & 15, g4 = lane >> 4;
    const int lr = tid >> 3, ls = tid & 7, jt = w & 3, hf = w >> 2;
    u32x4 qv[2], kv[2], v0[2], v1[2], oc0[2], oc1[2], c0[2], c1[2];
    float mstate[2], gi_raw[2], gf_raw[2], big[2], bfg[2], nin_l[2], gmo_r[2][4];
    size_t tok0[2]; int hh[2];
#pragma unroll
    for (int k = 0; k < 2; ++k) {
        const int u = k ? ub : ua, c = u & 31, h = (u >> 5) & 7, b = u >> 8;
        hh[k] = h; tok0[k] = (size_t)b * SEQ + c * 64;
        const bf16_t* zr = z + (tok0[k] + lr) * ZP;
        qv[k] = *(const u32x4*)(zr + ZQA + h * 64 + ls * 8); kv[k] = *(const u32x4*)(zr + ZKA + h * 64 + ls * 8);
        v0[k] = *(const u32x4*)(zr + ZVA + h * 128 + ls * 8); v1[k] = *(const u32x4*)(zr + ZVA + h * 128 + 64 + ls * 8);
        oc0[k] = *(const u32x4*)(zr + ZOA + h * 128 + ls * 16); oc1[k] = *(const u32x4*)(zr + ZOA + h * 128 + ls * 16 + 8);
        const bf16_t* cin = (const bf16_t*)(F.ws + WS_CIN) + (size_t)u * 8192;
        c0[k] = *(const u32x4*)(cin + tid * 8); c1[k] = *(const u32x4*)(cin + 4096 + tid * 8);
        const float* msc = (const float*)(F.ws + WS_MSC) + (size_t)u * 4;
        mstate[k] = msc[2]; gi_raw[k] = gates[(tok0[k] + lane) * 16 + h]; gf_raw[k] = gates[(tok0[k] + lane) * 16 + 8 + h]; big[k] = a.in[I_BIG][h]; bfg[k] = a.in[I_BFG][h];
        nin_l[k] = ((const float*)(F.ws + WS_NIN))[(size_t)u * 64 + lane];
        const float* gmo = a.in[I_GMO] + h * 128;
#pragma unroll
        for (int d4 = 0; d4 < 4; ++d4) gmo_r[k][d4] = gmo[16 * (4 * hf + d4) + l15];
    }
    __syncthreads();
#pragma unroll
    for (int k = 0; k < 2; ++k) {
        LAS unsigned char* L = F.lds + k * CH; LAS float* fl = (LAS float*)(L + FLO);
        if (w == k) {
            const ChunkGates G = chunk_gates(gi_raw[k], gf_raw[k], big[k], bfg[k], lane);
            const float M = fmaxf(mstate[k], G.pmx);
            fl[lane] = -M; fl[64 + lane] = G.u; fl[128 + lane] = __expf(mstate[k] - M); fl[192 + lane] = __expf(-(G.bcs + M));
        }
        if (w == 2 + k) fl[640 + lane] = nin_l[k];
        *(LAS u32x4*)(L + QS + lr * RS + ls * 16) = qv[k]; *(LAS u32x4*)(L + KS + lr * RS + ls * 16) = kv[k];
        *(LAS u32x4*)(L + VS + lr * VR + ls * 16) = v0[k]; *(LAS u32x4*)(L + VS + lr * VR + 128 + ls * 16) = v1[k];
        *(LAS u32x4*)(L + CB + lr * RS + ls * 16) = c0[k]; *(LAS u32x4*)(L + CB + (64 + lr) * RS + ls * 16) = c1[k];
    }
    __syncthreads();
#pragma unroll
    for (int k = 0; k < 2; ++k) {
        LAS unsigned char* L = F.lds + k * CH; LAS float* fl = (LAS float*)(L + FLO);
        { const LAS float* nv = fl + 640 + ls * 8; const u32x4 q = qv[k];
          float s = bf_lo(q.x) * nv[0] + bf_hi(q.x) * nv[1] + bf_lo(q.y) * nv[2] + bf_hi(q.y) * nv[3] + bf_lo(q.z) * nv[4] + bf_hi(q.z) * nv[5] + bf_lo(q.w) * nv[6] + bf_hi(q.w) * nv[7];
          s = sum8_(s);
          if (ls == 0) fl[320 + lr] = s * 0.125f; }
        { bf16x8 aq[2];
#pragma unroll
          for (int ks = 0; ks < 2; ++ks) aq[ks] = *(const LAS bf16x8*)(L + QS + (16 * jt + l15) * RS + (32 * ks + 8 * g4) * 2);
          float rsum[4] = {0.f, 0.f, 0.f, 0.f};
#pragma unroll
          for (int st2 = 0; st2 < 2; ++st2) { const int st = 2 * hf + st2; f32x4 s = {0.f, 0.f, 0.f, 0.f};
              if (st <= jt) {
#pragma unroll
                  for (int ks = 0; ks < 2; ++ks) { const bf16x8 bk = *(const LAS bf16x8*)(L + KS + (16 * st + l15) * RS + (32 * ks + 8 * g4) * 2); s = MFMA16(aq[ks], bk, s); } }
              const int scol = 16 * st + l15; const float cf = fl[64 + scol];
#pragma unroll
              for (int r = 0; r < 4; ++r) { const int j = 16 * jt + 4 * g4 + r;
                  const float val = (scol <= j) ? s[r] * 0.125f * __expf(fl[j] + cf) : 0.f; rsum[r] += val;
                  *(LAS bf16_t*)(L + SB + j * RS + scol * 2) = f2bf(val); } }
#pragma unroll
          for (int r = 0; r < 4; ++r) { float t = sum16_(rsum[r]);
              if (l15 == 0) fl[384 + hf * 64 + 16 * jt + 4 * g4 + r] = t; } }
    }
    __syncthreads();
    float hv[2][4][4];
#pragma unroll
    for (int k = 0; k < 2; ++k) {
        LAS unsigned char* L = F.lds + k * CH; LAS float* fl = (LAS float*)(L + FLO);
        bf16x8 as_[2], aq[2];
#pragma unroll
        for (int ks = 0; ks < 2; ++ks) { as_[ks] = *(const LAS bf16x8*)(L + SB + (16 * jt + l15) * RS + (32 * ks + 8 * g4) * 2); aq[ks] = *(const LAS bf16x8*)(L + QS + (16 * jt + l15) * RS + (32 * ks + 8 * g4) * 2); }
        float si[4], dn[4], en[4], ss[4] = {0.f, 0.f, 0.f, 0.f};
#pragma unroll
        for (int r = 0; r < 4; ++r) { const int j = 16 * jt + 4 * g4 + r; si[r] = fl[128 + j]; dn[r] = fl[384 + j] + fl[448 + j] + si[r] * fl[320 + j]; en[r] = fl[192 + j]; si[r] *= 0.125f; }
#pragma unroll
        for (int d4 = 0; d4 < 4; ++d4) { const int dt = 4 * hf + d4; f32x4 nacc = {0.f, 0.f, 0.f, 0.f}, iacc = nacc;
#pragma unroll
            for (int ks = 0; ks < 2; ++ks) {
                LAS unsigned char* vp = L + VS + (32 * ks + 8 * g4 + (l15 >> 2)) * VR + (16 * dt + 4 * (l15 & 3)) * 2;
                nacc = MFMA16(as_[ks], cat8(tr16(vp), tr16(vp + 4 * VR)), nacc);
                const bf16x8 bc = *(const LAS bf16x8*)(L + CB + (16 * dt + l15) * RS + (32 * ks + 8 * g4) * 2);
                iacc = MFMA16(aq[ks], bc, iacc); }
#pragma unroll
            for (int r = 0; r < 4; ++r) { const float num = nacc[r] + si[r] * iacc[r]; const float hvv = num * __builtin_amdgcn_rcpf(fmaxf(fabsf(dn[r]), en[r])); hv[k][d4][r] = hvv; ss[r] += hvv * hvv; } }
#pragma unroll
        for (int r = 0; r < 4; ++r) { float t = sum16_(ss[r]);
            if (l15 == 0) fl[512 + hf * 64 + 16 * jt + 4 * g4 + r] = t; }
    }
    __syncthreads();
#pragma unroll
    for (int k = 0; k < 2; ++k) {
        LAS unsigned char* L = F.lds + k * CH; LAS float* fl = (LAS float*)(L + FLO);
        float rinv[4];
#pragma unroll
        for (int r = 0; r < 4; ++r) { const int j = 16 * jt + 4 * g4 + r; rinv[r] = rsqrtf((fl[512 + j] + fl[576 + j]) * (1.0f / 128.0f) + EPS); }
#pragma unroll
        for (int d4 = 0; d4 < 4; ++d4) { const int d = 16 * (4 * hf + d4) + l15; const float gg = gmo_r[k][d4];
#pragma unroll
            for (int r = 0; r < 4; ++r) *(LAS bf16_t*)(L + HO + (16 * jt + 4 * g4 + r) * VR + d * 2) = f2bf(hv[k][d4][r] * rinv[r] * gg); }
    }
    __syncthreads();
#pragma unroll
    for (int k = 0; k < 2; ++k) {
        LAS unsigned char* L = F.lds + k * CH;
        const u32x4 h0 = *(const LAS u32x4*)(L + HO + lr * VR + ls * 32), h1 = *(const LAS u32x4*)(L + HO + lr * VR + ls * 32 + 16);
        const u32x4 o0 = oc0[k], o1 = oc1[k];
#define HG(hw, ow, lo) ((lo ? bf_lo(hw) : bf_hi(hw)) * sigmoidf_(lo ? bf_lo(ow) : bf_hi(ow)) * H8_SCALE)
        u32x4 r;
        r.x = pk4_fp8(HG(h0.x, o0.x, 1), HG(h0.x, o0.x, 0), HG(h0.y, o0.y, 1), HG(h0.y, o0.y, 0));
        r.y = pk4_fp8(HG(h0.z, o0.z, 1), HG(h0.z, o0.z, 0), HG(h0.w, o0.w, 1), HG(h0.w, o0.w, 0));
        r.z = pk4_fp8(HG(h1.x, o1.x, 1), HG(h1.x, o1.x, 0), HG(h1.y, o1.y, 1), HG(h1.y, o1.y, 0));
        r.w = pk4_fp8(HG(h1.z, o1.z, 1), HG(h1.z, o1.z, 0), HG(h1.w, o1.w, 1), HG(h1.w, o1.w, 0));
#undef HG
        *(u32x4*)(hm + (tok0[k] + lr) * 1024 + hh[k] * 128 + ls * 16) = r;
    }
}

template <bool FIXED>
__device__ __forceinline__ void moba_unit(Frame& F, const Args& a, int b, int h, int qb, const float B2) {
    constexpr int KT = 0, VT = 34816, KM = 88064, TS = 17408, VR = 272;
    LAS unsigned char* L = F.lds;
    const bf16_t* z = (const bf16_t*)(F.ws + WS_Z);
    const float* kmean = (const float*)(F.ws + WS_KMEAN) + ((size_t)b * 8 + h) * 8 * 128;
    unsigned char* ob = F.ws + WS_OB;
    int tid = F.tid; asm volatile("" : "+v"(tid));
    const int lane = tid & 63, w = F.wave, l15 = lane & 15, g4 = lane >> 4;
    const int q0 = qb * 256, blk = qb, ntile = 4 * qb + 4;
    const size_t tokb = (size_t)b * SEQ;
    __syncthreads();
    if (tid < 256) *(LAS f32x4*)(L + KM + tid * 16) = *(const f32x4*)(kmean + tid * 4);
    bf16x8 qf[2][4];
#pragma unroll
    for (int g = 0; g < 2; ++g) { const bf16_t* qr = z + (tokb + q0 + 32 * w + 16 * g + l15) * ZP + ZQB + h * 128 + 8 * g4;
#pragma unroll
        for (int ks = 0; ks < 4; ++ks) qf[g][ks] = *(const bf16x8*)(qr + 32 * ks); }
    const int key0 = tid >> 4, seg = tid & 15;
    const bf16_t* kbase = z + (tokb + key0) * ZP + ZKB + h * 128 + seg * 8;
    const bf16_t* vbase = z + (tokb + key0) * ZP + ZVB + h * 128 + seg * 8;
    u32x4 kA0 = *(const u32x4*)kbase, kA1 = *(const u32x4*)(kbase + (size_t)32 * ZP), vA0 = *(const u32x4*)vbase, vA1 = *(const u32x4*)(vbase + (size_t)32 * ZP);
    u32x4 kB0 = *(const u32x4*)(kbase + (size_t)64 * ZP), kB1 = *(const u32x4*)(kbase + (size_t)96 * ZP), vB0 = *(const u32x4*)(vbase + (size_t)64 * ZP), vB1 = *(const u32x4*)(vbase + (size_t)96 * ZP);
    __syncthreads();
    unsigned mymask[2];
#pragma unroll
    for (int g = 0; g < 2; ++g) {
        if (blk <= 3) mymask[g] = (1u << blk) - 1u;
        else {
            float gate[7];
#pragma unroll
            for (int n = 0; n < 7; ++n) { float s = 0.f;
                if (n < blk) {
#pragma unroll
                    for (int ks = 0; ks < 4; ++ks) { const LAS float* km = (const LAS float*)(L + KM) + n * 128 + 32 * ks + 8 * g4;
#pragma unroll
                        for (int j = 0; j < 8; ++j) s += bf1((bf16_t)qf[g][ks][j]) * km[j]; }
                    s += __shfl_xor(s, 16); s += __shfl_xor(s, 32); }
                gate[n] = (n < blk) ? s : -3.0e38f; }
            unsigned mm = 0u;
#pragma unroll
            for (int t = 0; t < 3; ++t) { float best = -3.0e38f; int bi = 0;
#pragma unroll
                for (int n = 0; n < 7; ++n) { const bool take = (n < blk) && !((mm >> n) & 1u) && (gate[n] > best); best = take ? gate[n] : best; bi = take ? n : bi; }
                mm |= 1u << bi; }
            mymask[g] = mm;
        }
    }
    f32x4 O[2][8];
#pragma unroll
    for (int g = 0; g < 2; ++g)
#pragma unroll
        for (int dt = 0; dt < 8; ++dt) O[g][dt] = (f32x4){0.f, 0.f, 0.f, 0.f};
    float mrun[2] = {-1.0e30f, -1.0e30f}, lsum[2] = {0.f, 0.f};
    const float SC = 0.08838834764831845f * 1.4426950408889634f;
#pragma unroll 1
    for (int kt2 = 0; kt2 < ntile; kt2 += 2) {
#pragma unroll
      for (int buf = 0; buf < 2; ++buf) {
        const int kt = kt2 + buf;
        { LAS unsigned char* kd = L + KT + buf * TS + key0 * VR + seg * 16; LAS unsigned char* vd = L + VT + buf * TS + key0 * VR + seg * 16;
          const int t2 = (kt + 2 < ntile) ? kt + 2 : ntile - 1;
          const size_t adv = (size_t)t2 * 64 * ZP;
          if (buf == 0) { *(LAS u32x4*)kd = kA0; *(LAS u32x4*)(kd + 32 * VR) = kA1; *(LAS u32x4*)vd = vA0; *(LAS u32x4*)(vd + 32 * VR) = vA1;
              kA0 = *(const u32x4*)(kbase + adv); kA1 = *(const u32x4*)(kbase + adv + (size_t)32 * ZP); vA0 = *(const u32x4*)(vbase + adv); vA1 = *(const u32x4*)(vbase + adv + (size_t)32 * ZP); }
          else { *(LAS u32x4*)kd = kB0; *(LAS u32x4*)(kd + 32 * VR) = kB1; *(LAS u32x4*)vd = vB0; *(LAS u32x4*)(vd + 32 * VR) = vB1;
              kB0 = *(const u32x4*)(kbase + adv); kB1 = *(const u32x4*)(kbase + adv + (size_t)32 * ZP); vB0 = *(const u32x4*)(vbase + adv); vB1 = *(const u32x4*)(vbase + adv + (size_t)32 * ZP); } }
        __syncthreads();
        const int kb = kt >> 2; const bool past = kb < blk;
        const int kmin = 64 * kt;
        int cls[2];
#pragma unroll
        for (int g = 0; g < 2; ++g) { const int qmin = q0 + 32 * w + 16 * g; cls[g] = past ? 1 : ((kmin + 63 <= qmin) ? 1 : ((kmin > qmin + 15) ? 0 : 2)); }
        if ((cls[0] | cls[1]) != 0) {
            f32x4 st[2][4];
#pragma unroll
            for (int nt = 0; nt < 4; ++nt) { st[0][nt] = (f32x4){0.f, 0.f, 0.f, 0.f}; st[1][nt] = st[0][nt];
                bf16x8 bk[4];
#pragma unroll
                for (int ks = 0; ks < 4; ++ks) bk[ks] = *(const LAS bf16x8*)(L + KT + buf * TS + (16 * nt + l15) * VR + (32 * ks + 8 * g4) * 2);
                __builtin_amdgcn_sched_barrier(0);
#pragma unroll
                for (int ks = 0; ks < 4; ++ks) { st[0][nt] = MFMA16(bk[ks], qf[0][ks], st[0][nt]); st[1][nt] = MFMA16(bk[ks], qf[1][ks], st[1][nt]); }
                __builtin_amdgcn_sched_barrier(0); }
            bf16x8 pf[2][2];
#pragma unroll
            for (int g = 0; g < 2; ++g) {
                float pv[4][4]; float mnew = 0.f, alpha = 1.0f;
                if (FIXED) {
                    if (cls[g] == 1) {
                        const bool sel = past ? (((mymask[g] >> kb) & 1u) != 0u) : true;
                        const float nb = sel ? -B2 : -1.0e30f;
#pragma unroll
                        for (int nt = 0; nt < 4; ++nt)
#pragma unroll
                            for (int r = 0; r < 4; ++r) pv[nt][r] = __builtin_amdgcn_exp2f(fmaf(st[g][nt][r], SC, nb));
                    } else if (cls[g] == 2) {
                        const int qpos = q0 + 32 * w + 16 * g + l15;
#pragma unroll
                        for (int nt = 0; nt < 4; ++nt)
#pragma unroll
                            for (int r = 0; r < 4; ++r) { const bool ok = (kmin + 16 * nt + 4 * g4 + r) <= qpos; pv[nt][r] = __builtin_amdgcn_exp2f(ok ? fmaf(st[g][nt][r], SC, -B2) : -1.0e30f); }
                    } else {
#pragma unroll
                        for (int nt = 0; nt < 4; ++nt)
#pragma unroll
                            for (int r = 0; r < 4; ++r) pv[nt][r] = 0.f;
                    }
                } else if (cls[g] == 1) {
                    const bool sel = past ? (((mymask[g] >> kb) & 1u) != 0u) : true;
                    float mx = fmaxf(fmaxf(fmaxf(st[g][0][0], st[g][0][1]), fmaxf(st[g][0][2], st[g][0][3])), fmaxf(fmaxf(st[g][1][0], st[g][1][1]), fmaxf(st[g][1][2], st[g][1][3])));
                    mx = fmaxf(mx, fmaxf(fmaxf(fmaxf(st[g][2][0], st[g][2][1]), fmaxf(st[g][2][2], st[g][2][3])), fmaxf(fmaxf(st[g][3][0], st[g][3][1]), fmaxf(st[g][3][2], st[g][3][3]))));
                    mx = sel ? mx * SC : -1.0e30f;
                    mx = fmaxf(mx, __shfl_xor(mx, 16)); mx = fmaxf(mx, __shfl_xor(mx, 32));
                    mnew = fmaxf(mrun[g], mx); alpha = __builtin_amdgcn_exp2f(mrun[g] - mnew);
                    const float nb = sel ? -mnew : -1.0e30f;
#pragma unroll
                    for (int nt = 0; nt < 4; ++nt)
#pragma unroll
                        for (int r = 0; r < 4; ++r) pv[nt][r] = __builtin_amdgcn_exp2f(fmaf(st[g][nt][r], SC, nb));
                } else if (cls[g] == 2) {
                    const int qpos = q0 + 32 * w + 16 * g + l15; float sv[4][4]; float mx = -1.0e30f;
#pragma unroll
                    for (int nt = 0; nt < 4; ++nt)
#pragma unroll
                        for (int r = 0; r < 4; ++r) { const bool ok = (kmin + 16 * nt + 4 * g4 + r) <= qpos; sv[nt][r] = ok ? st[g][nt][r] * SC : -1.0e30f; mx = fmaxf(mx, sv[nt][r]); }
                    mx = fmaxf(mx, __shfl_xor(mx, 16)); mx = fmaxf(mx, __shfl_xor(mx, 32));
                    mnew = fmaxf(mrun[g], mx); alpha = __builtin_amdgcn_exp2f(mrun[g] - mnew);
#pragma unroll
                    for (int nt = 0; nt < 4; ++nt)
#pragma unroll
                        for (int r = 0; r < 4; ++r) pv[nt][r] = (sv[nt][r] > -1.0e29f) ? __builtin_amdgcn_exp2f(sv[nt][r] - mnew) : 0.f;
                } else {
                    mnew = mrun[g]; alpha = 1.0f;
#pragma unroll
                    for (int nt = 0; nt < 4; ++nt)
#pragma unroll
                        for (int r = 0; r < 4; ++r) pv[nt][r] = 0.f;
                }
                float ps = 0.f;
#pragma unroll
                for (int nt = 0; nt < 4; ++nt) ps += (pv[nt][0] + pv[nt][1]) + (pv[nt][2] + pv[nt][3]);
                if (FIXED) lsum[g] += ps;
                else { mrun[g] = mnew; lsum[g] = lsum[g] * alpha + ps;
#pragma unroll
                    for (int dt = 0; dt < 8; ++dt) O[g][dt] *= alpha; }
#pragma unroll
                for (int k2 = 0; k2 < 2; ++k2) {
                    u32x4 pw4; pw4.x = pk2(pv[2 * k2][0], pv[2 * k2][1]); pw4.y = pk2(pv[2 * k2][2], pv[2 * k2][3]); pw4.z = pk2(pv[2 * k2 + 1][0], pv[2 * k2 + 1][1]); pw4.w = pk2(pv[2 * k2 + 1][2], pv[2 * k2 + 1][3]);
                    pf[g][k2] = __builtin_bit_cast(bf16x8, pw4); }
            }
            bf16x8 vf[2][4];
#define MOBA_VREAD(bq, slot) do { _Pragma("unroll") for (int d = 0; d < 4; ++d) { const int k2_ = (bq) >> 1, dt_ = 4 * ((bq) & 1) + d; \
                LAS unsigned char* vp = L + VT + buf * TS + (32 * k2_ + 4 * g4 + (l15 >> 2)) * VR + (16 * dt_ + 4 * (l15 & 3)) * 2; vf[slot][d] = cat8(tr16(vp), tr16(vp + 16 * VR)); } } while (0)
            MOBA_VREAD(0, 0);
#pragma unroll
            for (int bq = 0; bq < 4; ++bq) {
                if (bq + 1 < 4) MOBA_VREAD(bq + 1, (bq + 1) & 1);
                __builtin_amdgcn_sched_barrier(0);
#pragma unroll
                for (int d = 0; d < 4; ++d) { const int k2 = bq >> 1, dt = 4 * (bq & 1) + d;
                    O[0][dt] = MFMA16(vf[bq & 1][d], pf[0][k2], O[0][dt]); O[1][dt] = MFMA16(vf[bq & 1][d], pf[1][k2], O[1][dt]); }
                __builtin_amdgcn_sched_barrier(0);
            }
#undef MOBA_VREAD
        }
      }
    }
#pragma unroll
    for (int g = 0; g < 2; ++g) { float t = lsum[g]; t += __shfl_xor(t, 16); t += __shfl_xor(t, 32);
      const float inv = O8_SCALE / t; unsigned char* op = ob + (tokb + q0 + 32 * w + 16 * g + l15) * 1024 + h * 128 + 4 * g4;
#pragma unroll
      for (int dt = 0; dt < 8; ++dt) *(unsigned*)(op + 16 * dt) = pk4_fp8(O[g][dt][0] * inv, O[g][dt][1] * inv, O[g][dt][2] * inv, O[g][dt][3] * inv); }
}

__device__ __forceinline__ void p4_mixers(Frame& F, const Args& a, bool with_cvt) {
    LAS int* qslot = (LAS int*)(F.lds + 140032);
    const int total = with_cvt ? 768 + 256 + 256 : 768;
    const float B2 = __builtin_bit_cast(float, __builtin_amdgcn_readfirstlane((int)__hip_atomic_load(F.ctl + CW_MISC, __ATOMIC_RELAXED, __HIP_MEMORY_SCOPE_AGENT)));
    const bool fixed_ok = B2 <= 40.0f;
    for (;;) {
        __syncthreads();
        if (F.tid == 0) *qslot = (int)__hip_atomic_fetch_add(F.ctl + CW_QUEUE, 1u, __ATOMIC_RELAXED, __HIP_MEMORY_SCOPE_AGENT);
        __syncthreads();
        const int idx = *qslot;
        __syncthreads();
        if (idx >= total) break;
        int it = idx;
        if (with_cvt) { const int g = idx / 5, r = idx - 5 * g; if (r == 3) { cvt8_item(F, a, 512 + g); continue; } if (r == 4) { if (g < 128) cvt8_wout_sub(F, a, g); else cvt8_wbr_sub(F, a, g - 128); continue; } it = 3 * g + r; }
        if (it < 256) { if (fixed_ok) moba_unit<true>(F, a, (it & 31) >> 3, it & 7, 7 - (it >> 5), B2); else moba_unit<false>(F, a, (it & 31) >> 3, it & 7, 7 - (it >> 5), B2); }
        else mlstm_passC2(F, a, it - 256, it - 256 + 512);
    }
}

__device__ __forceinline__ void p7_router(Frame& F, const Args& a) {
    unsigned char* ws = F.ws;
    const float* modf = (const float*)(ws + WS_MODF);
    const bf16_t* wrf = (const bf16_t*)(ws + WS_WRF);
    int* toke = (int*)(ws + WS_TOKE); float* tokw = (float*)(ws + WS_TOKW); int* toks = (int*)(ws + WS_TOKS); float* roww = (float*)(ws + WS_ROWW);
    unsigned char* tA = ws + WS_TA;
    LAS float* part = (LAS float*)(F.lds + PART_OFF);
    LAS float* logit = (LAS float*)(F.lds + LOGIT_OFF);
    LAS int* dstl = (LAS int*)(F.lds + DST_OFF);
    LAS int* lcnt = (LAS int*)(F.lds + DST_OFF + 512);
    const int lane = F.lane, l15 = lane & 15, g4 = lane >> 4;
    for (int rb = F.wg; rb < T / 32; rb += F.G) {
        norm_rows_32_b(F, (const bf16_t*)(ws + WS_X1), a.in[I_GFFN], modf, 3, rb);
        { const int rg = F.wave & 1, ct = (F.wave >> 1) & 1, kh = F.wave >> 2; f32x4 acc = {0.f, 0.f, 0.f, 0.f};
          bf16x8 bvv[32];
          __builtin_amdgcn_sched_barrier(0);
          const bf16_t* wq = wrf + ((size_t)ct * 4096 + (size_t)(32 * kh) * 64 + lane) * 8; asm volatile("" : "+v"(wq));
#pragma unroll
          for (int s = 0; s < 32; ++s) bvv[s] = *(const bf16x8*)(wq + (size_t)s * 512);
          __syncthreads();
#pragma unroll
          for (int s = 0; s < 32; ++s) { const int ks = 32 * kh + s;
              const bf16x8 av = *(const LAS bf16x8*)(F.lds + (16 * rg + l15) * HL_STRIDE + (32 * ks + 8 * g4) * 2);
              acc = __builtin_amdgcn_mfma_f32_16x16x32_bf16(av, bvv[s], acc, 0, 0, 0); }
#pragma unroll
          for (int r = 0; r < 4; ++r) part[((kh * 2 + rg) * 2 + ct) * 256 + (4 * g4 + r) * 16 + l15] = acc[r]; }
        __syncthreads();
#pragma unroll
        for (int q = 0; q < 2; ++q) { const int o = F.tid + 512 * q, row = o >> 5, e = o & 31, rg = row >> 4, ct = e >> 4;
            logit[o] = part[((0 * 2 + rg) * 2 + ct) * 256 + (row & 15) * 16 + (e & 15)] + part[((1 * 2 + rg) * 2 + ct) * 256 + (row & 15) * 16 + (e & 15)] + a.in[I_BR][e]; }
        __syncthreads();
        if (F.tid < 32) {
            const int row = F.tid; const size_t tok = (size_t)rb * 32 + row;
            lcnt[row] = 0;
            float v[NE];
#pragma unroll
            for (int e = 0; e < NE; ++e) v[e] = logit[row * NE + e];
            float tv[4]; int ti[4]; unsigned used = 0u;
#pragma unroll
            for (int k = 0; k < 4; ++k) { float best = -3.0e38f; int bi = 0;
#pragma unroll
                for (int e = 0; e < NE; ++e) { const bool take = !((used >> e) & 1u) && (v[e] > best); best = take ? v[e] : best; bi = take ? e : bi; }
                used |= 1u << bi; tv[k] = best; ti[k] = bi; }
            float ex[4], sum = 0.f;
#pragma unroll
            for (int k = 0; k < 4; ++k) { ex[k] = __expf(tv[k] - tv[0]); sum += ex[k]; }
            const float inv = 1.0f / sum;
            int lr[4];
#pragma unroll
            for (int k = 0; k < 4; ++k) lr[k] = __hip_atomic_fetch_add(lcnt + ti[k], 1, __ATOMIC_RELAXED, __HIP_MEMORY_SCOPE_WORKGROUP);
            __builtin_amdgcn_wave_barrier();
            { const int mine = lcnt[row];
              int base = 0; if (mine > 0) base = (int)__hip_atomic_fetch_add(F.ctl + CW_CNT + 64 * row, (unsigned)mine, __ATOMIC_RELAXED, __HIP_MEMORY_SCOPE_AGENT);
              lcnt[32 + row] = base; }
            __builtin_amdgcn_wave_barrier();
#pragma unroll
            for (int k = 0; k < 4; ++k) {
                const int slot = lcnt[32 + ti[k]] + lr[k];
                const float wk = ex[k] * inv;
                toke[tok * 4 + k] = ti[k]; tokw[tok * 4 + k] = wk; toks[tok * 4 + k] = slot;
                roww[(size_t)ti[k] * ECAP + slot] = wk;
                dstl[row * 4 + k] = ti[k] * ECAP + slot;
            }
        }
        __syncthreads();
#pragma unroll 1
        for (int i = 0; i < 4; ++i) { const int r = 4 * F.wave + i;
            u32x4 q8[2];
#pragma unroll
            for (int cidx = 0; cidx < 2; ++cidx) { const int ch = lane + 64 * cidx;
                const u32x4 lo = *(const LAS u32x4*)(F.lds + r * HL_STRIDE + ch * 32), hi = *(const LAS u32x4*)(F.lds + r * HL_STRIDE + ch * 32 + 16);
                q8[cidx].x = pk4_fp8(bf_lo(lo.x), bf_hi(lo.x), bf_lo(lo.y), bf_hi(lo.y)); q8[cidx].y = pk4_fp8(bf_lo(lo.z), bf_hi(lo.z), bf_lo(lo.w), bf_hi(lo.w));
                q8[cidx].z = pk4_fp8(bf_lo(hi.x), bf_hi(hi.x), bf_lo(hi.y), bf_hi(hi.y)); q8[cidx].w = pk4_fp8(bf_lo(hi.z), bf_hi(hi.z), bf_lo(hi.w), bf_hi(hi.w)); }
#pragma unroll
            for (int k = 0; k < 4; ++k) { unsigned char* dp = tA + (size_t)dstl[r * 4 + k] * D;
#pragma unroll
                for (int cidx = 0; cidx < 2; ++cidx) *(u32x4*)(dp + (lane + 64 * cidx) * 16) = q8[cidx]; } }
        __syncthreads();
    }
}

__device__ __forceinline__ void moe_tables(Frame& F) {
    LAS int* tb = (LAS int*)(F.lds + LDS_TABS);
    __syncthreads();
    if (F.wave == 0) {
        const int e = F.lane & 31;
        const int cnt = (int)__hip_atomic_load(F.ctl + CW_CNT + 64 * e, __ATOMIC_RELAXED, __HIP_MEMORY_SCOPE_AGENT);
        const int tl = (cnt + 255) >> 8;
        int inc = tl;
#pragma unroll
        for (int o = 1; o < 32; o <<= 1) { const int t = __shfl_up(inc, o); if (e >= o) inc += t; }
        const int exc = inc - tl;
        if (F.lane < 32) {
            tb[e] = tl; tb[32 + e] = exc * 256; tb[64 + e] = e * ECAP; tb[96 + e] = exc * 16; tb[160 + e] = exc * 8;
            if (e == NE - 1) { tb[96 + NE] = inc * 16; tb[160 + NE] = inc * 8; }
        }
    }
    __syncthreads();
}

__device__ __forceinline__ void p10_combine(Frame& F, const Args& a) {
    unsigned char* ws = F.ws;
    const bf16_t* x1 = (const bf16_t*)(ws + WS_X1); const unsigned char* ydn = ws + WS_YDN; const float* modf = (const float*)(ws + WS_MODF);
    const int* toke = (const int*)(ws + WS_TOKE); const int* toks = (const int*)(ws + WS_TOKS);
    const LAS int* tb = (const LAS int*)(F.lds + LDS_TABS);
    int tz = threadIdx.x; asm volatile("" : "+v"(tz));
    const int gw = F.vcu * 8 + F.wave, NGW = F.G * 8, lane = tz & 63;
    for (int tok = gw; tok < T; tok += NGW) {
        const float* gt = modf + (size_t)(tok >> 11) * (6 * D) + 5 * D;
        const unsigned char* yr[4];
#pragma unroll
        for (int k = 0; k < 4; ++k) yr[k] = ydn + (size_t)(tb[32 + toke[tok * 4 + k]] + toks[tok * 4 + k]) * D;
        u32x2 y[4][4]; u32x4 xq[4]; f32x4 g0[4], g1[4];
#pragma unroll
        for (int j = 0; j < 4; ++j) { const int col = 8 * (lane + 64 * j);
#pragma unroll
            for (int k = 0; k < 4; ++k) y[j][k] = __builtin_nontemporal_load((const u32x2*)(yr[k] + col));
            xq[j] = __builtin_nontemporal_load((const u32x4*)(x1 + (size_t)tok * D + col));
            g0[j] = *(const f32x4*)(gt + col); g1[j] = *(const f32x4*)(gt + col + 4); }
        __builtin_amdgcn_sched_barrier(0);
#pragma unroll
        for (int j = 0; j < 4; ++j) { const int col = 8 * (lane + 64 * j);
            f32x4 s0 = {0.f, 0.f, 0.f, 0.f}, s1 = s0;
#pragma unroll
            for (int k = 0; k < 4; ++k) {
                const f32x2 p0 = __builtin_amdgcn_cvt_pk_f32_fp8((int)y[j][k].x, false), p1 = __builtin_amdgcn_cvt_pk_f32_fp8((int)y[j][k].x, true);
                const f32x2 p2 = __builtin_amdgcn_cvt_pk_f32_fp8((int)y[j][k].y, false), p3 = __builtin_amdgcn_cvt_pk_f32_fp8((int)y[j][k].y, true);
                s0[0] += p0[0]; s0[1] += p0[1]; s0[2] += p1[0]; s0[3] += p1[1]; s1[0] += p2[0]; s1[1] += p2[1]; s1[2] += p3[0]; s1[3] += p3[1]; }
            const size_t o = (size_t)tok * D + col;
            const f32x4 xa = {bf_lo(xq[j].x), bf_hi(xq[j].x), bf_lo(xq[j].y), bf_hi(xq[j].y)}, xb = {bf_lo(xq[j].z), bf_hi(xq[j].z), bf_lo(xq[j].w), bf_hi(xq[j].w)};
            __builtin_nontemporal_store(xa + g0[j] * (s0 * (1.0f / YD_SCALE)), (f32x4*)(a.out + o));
            __builtin_nontemporal_store(xb + g1[j] * (s1 * (1.0f / YD_SCALE)), (f32x4*)(a.out + o + 4)); }
    }
}

__global__ void __launch_bounds__(512, 2) hybrid_fwd(Args args) {
    extern __shared__ __attribute__((aligned(16))) unsigned char lds_raw[];
    Frame F;
    F.lds = (LAS unsigned char*)lds_raw; F.ws = args.ws; F.ctl = (unsigned*)(args.ws + WS_CTL);
    F.tid = threadIdx.x; F.lane = F.tid & 63; F.wave = __builtin_amdgcn_readfirstlane(F.tid >> 6);
    F.G = gridDim.x; F.wg = blockIdx.x; F.vcu = (F.G % 8 == 0) ? (F.wg % 8) * (F.G / 8) + F.wg / 8 : F.wg;
    if (F.tid < 4) ((LAS unsigned*)(F.lds + LDS_XB))[F.tid] = 0u;
    __syncthreads();
    XcdBarrier bar; bar.bar = F.ctl + CW_BAR; bar.x = 0; bar.st = nullptr;
#if !MK_PER_PHASE
    bar = xcd_barrier_post(F.ctl + CW_BAR, (volatile LAS unsigned*)(F.lds + LDS_XB));
#endif
    const int lo = args.ph_lo, hi = args.ph_hi;
#define IN(k) (lo <= (k) && (k) < hi)
#define SEAM(k) do { if (IN(k) && IN((k) + 1)) xcd_barrier(bar); } while (0)
    unsigned char* ws = args.ws;

    if (IN(0)) { p0_prologue(F, args); } SEAM(0);
    if (IN(1)) { p1_rows(F, args); } SEAM(1);
    const bool cv_ok = (F.G == 256);
    if (IN(2)) {
        pg8::DenseOrder S0; S0.init(ws + WS_HBUF8, ws + WS_WIN8, T, ZP, F.G, F.wg);
        EpiZT<true> E{(bf16_t*)(ws + WS_Z), ZP, args.in[I_GQ], args.in[I_GK], (float*)(ws + WS_KMEAN), F.lds + 131072};
        unsigned gaps = 0u;
        if (cv_ok) { int c = F.wg % 15, g0 = 0; while (c >= 5 - g0) { c -= 5 - g0; ++g0; } gaps = (1u << g0) | (1u << (g0 + 1 + c)); }
        int cvn = F.wg * 2;
        if (!cv_ok) { for (int idx = F.wg; idx < 1536; idx += F.G) cvt8_item(F, args, idx); }
        int lo = 0;
#pragma unroll 1
        for (int seg = 0; seg < 3; ++seg) {
            if ((gaps >> lo) & 1u) { cvt8_item(F, args, cvn++); gaps &= ~(1u << lo); }
            int hi = lo + 1; while (hi < 5 && !((gaps >> hi) & 1u)) ++hi;
            if (lo < 5) { pg8::SubOrder<pg8::DenseOrder> S{S0, lo, hi - lo}; pg8::gemm_phase<EpiZT<true>, pg8::SubOrder<pg8::DenseOrder>, true>(F.lds, D / 2, S, E); }
            lo = hi;
        }
        if (gaps & 32u) cvt8_item(F, args, cvn++);
    } SEAM(2);
    if (IN(3) && F.G == 256) { mlstm_passA4(F, args); }
    else if (IN(3)) {
        PassAIn cur = mlstm_passA_load(F, F.wg < 1024 ? F.wg : 0);
        for (int u = F.wg; u < 1024; u += F.G) { const int un = u + F.G; const PassAIn nxt = mlstm_passA_load(F, un < 1024 ? un : u); mlstm_passA(F, args, u, cur); cur = nxt; }
    } SEAM(3);
    if (IN(11)) { for (int it = F.wg; it < 256; it += F.G) mlstm_passB(F, it); }
    if (IN(3) && IN(4)) xcd_barrier(bar);
    if (IN(4)) { p4_mixers(F, args, F.G == 256); } SEAM(4);
    if (IN(5)) {
        if (cv_ok && (F.wg & 1) == 0) cvt8_item(F, args, 768 + F.wg);
        { pg8::PairOrder S; S.d.init(ws + WS_HM, ws + WS_WA, T, D, F.G, F.wg); S.A2 = (const char*)(ws + WS_OB); S.Bt2 = (const char*)(ws + WS_WB);
          EpiBranchAB E{(const bf16_t*)(ws + WS_Z), ws + WS_YBUF8};
          pg8::gemm_phase<EpiBranchAB, pg8::PairOrder, true>(F.lds, 512, S, E); }
        if (cv_ok && (F.wg & 1) == 1) cvt8_item(F, args, 768 + F.wg);
    } SEAM(5);
    if (IN(6)) {
        if (cv_ok && (F.wg & 1) == 0) cvt8_item(F, args, 1024 + F.wg);
        pg8::DenseOrder S; S.init(ws + WS_YBUF8, ws + WS_WOUT8, T, D, F.G, F.wg);
        EpiOut E{args.in[I_X], (const float*)(ws + WS_MODF), (bf16_t*)(ws + WS_X1)};
        pg8::gemm_phase<EpiOut, pg8::DenseOrder, true>(F.lds, D / 2, S, E);
        if (cv_ok && (F.wg & 1) == 1) cvt8_item(F, args, 1024 + F.wg);
    } SEAM(6);
    if (IN(7)) { p7_router(F, args); } SEAM(7);
    if (IN(8)) {
        moe_tables(F);
        const LAS int* tb = (const LAS int*)(F.lds + LDS_TABS);
        pg8::MoeOrder S{(const char*)(ws + WS_TA), (const char*)(ws + WS_WUP), tb, tb + 64, tb + 96, 16, F.G, F.vcu, (size_t)(2 * D) * D, __builtin_amdgcn_readfirstlane(tb[96 + NE]), nullptr, 0u};
        EpiUpT<true> E{ws + WS_ACT, args.in[I_BUP], tb + 32, F.ctl + CW_UPD};
        const int cut = cv_ok ? ((F.wg >> 3) % 10) : 0;
        if (cut > 0) { pg8::SubOrder<pg8::MoeOrder> S1{S, 0, cut}; pg8::gemm_phase<EpiUpT<true>, pg8::SubOrder<pg8::MoeOrder>, true>(F.lds, D / 2, S1, E); }
        if (cv_ok) cvt8_item_signal(F, args, 1280 + F.wg, F.ctl + CW_UPD);
        { pg8::SubOrder<pg8::MoeOrder> S2{S, cut, 1 << 20}; pg8::gemm_phase<EpiUpT<true>, pg8::SubOrder<pg8::MoeOrder>, true>(F.lds, D / 2, S2, E); }
    }
    if (IN(9)) {
        if (!IN(8)) moe_tables(F);
        const LAS int* tb = (const LAS int*)(F.lds + LDS_TABS);
        const int utot = __builtin_amdgcn_readfirstlane(tb[96 + NE]);
        pg8::MoeDepOrder S{(const char*)(ws + WS_ACT), (const char*)(ws + WS_WDN), tb, tb + 32, tb + 160, 8, F.G, (F.vcu - utot % F.G + F.G) % F.G, (size_t)D * D, __builtin_amdgcn_readfirstlane(tb[160 + NE]), F.ctl + CW_UPD, cv_ok ? 16u : 0u};
        EpiDown E{ws + WS_YDN, args.in[I_BDN], (const float*)(ws + WS_ROWW), tb + 32};
        pg8::gemm_phase<EpiDown, pg8::MoeDepOrder, true>(F.lds, D / 2, S, E);
    } SEAM(9);
    if (IN(10)) { if (!IN(8) && !IN(9)) moe_tables(F); p10_combine(F, args); }
#undef IN
#undef SEAM
}

constexpr int N_PHASES = 12;
extern "C" void kernel_launch(void* const* d_in, const int* in_sizes, int n_in, void* d_out, int out_size, void* d_ws, size_t ws_size, hipStream_t stream) {
    static int grid = 0;
    if (grid == 0) {
        if (n_in != 21 || out_size != T * D || ws_size < WS_END) { fprintf(stderr, "kernel_launch: unexpected problem (n_in %d out %d ws %zu)\n", n_in, out_size, ws_size); grid = -1; return; }
        int dev = 0, cus = 0, per_cu = 0;
        if (hipGetDevice(&dev) != hipSuccess || hipDeviceGetAttribute(&cus, hipDeviceAttributeMultiprocessorCount, dev) != hipSuccess) { grid = -1; return; }
        if (hipFuncSetAttribute((const void*)hybrid_fwd, hipFuncAttributeMaxDynamicSharedMemorySize, LDS_BYTES) != hipSuccess) { fprintf(stderr, "kernel_launch: hipFuncSetAttribute failed\n"); grid = -1; return; }
        if (hipOccupancyMaxActiveBlocksPerMultiprocessor(&per_cu, (const void*)hybrid_fwd, 512, LDS_BYTES) != hipSuccess || per_cu < 1) fprintf(stderr, "kernel_launch: occupancy query says %d\n", per_cu);
        (void)hipGetLastError();
        grid = cus;
    }
    if (grid < 0) return;
    if (hipMemsetAsync((char*)d_ws + WS_CTL, 0, CTL_BYTES, stream) != hipSuccess) return;
    Args a{};
    for (int i = 0; i < 21; ++i) a.in[i] = (const float*)d_in[i];
    a.out = (float*)d_out; a.ws = (unsigned char*)d_ws;
#if MK_PER_PHASE
    for (int p = 0; p < N_PHASES; ++p) { a.ph_lo = p; a.ph_hi = p + 1; hipLaunchKernelGGL(hybrid_fwd, dim3(grid), dim3(512), LDS_BYTES, stream, a); }
#else
    a.ph_lo = 0; a.ph_hi = N_PHASES;
    hipLaunchKernelGGL(hybrid_fwd, dim3(grid), dim3(512), LDS_BYTES, stream, a);
#endif
}
```
